# Optimizing an MI355X kernel written in HIP

```python
import math
import jax
import jax.numpy as jnp
from jax import lax
import numpy as np

D_MODEL = 1024
BATCH = 4
SEQ = 4096
DEPTH = 2

MEM_LEN = 256
EPS = 1e-6

MLSTM_HEADS = 4
MLSTM_DH = 128
MLSTM_W = MLSTM_HEADS * MLSTM_DH
MLSTM_CHUNK = 64
CONV_WIDTH = 4

ATTN_PATTERNS = ((128, 1), (512, 4), (2048, 16))
N_ATTN_GROUPS = len(ATTN_PATTERNS)
HEADS_PER_GROUP = 4
ATTN_HEADS = N_ATTN_GROUPS * HEADS_PER_GROUP
ATTN_DH = 64
ATTN_W = ATTN_HEADS * ATTN_DH
ATTN_BLOCK = 128

GMLP_GROUPS = 4
GMLP_GC = 128
GMLP_W = GMLP_GROUPS * GMLP_GC
GMLP_CHUNK = 128

REL_BUCKETS = 32
REL_MAX_DIST = 2048

XATTN_HEADS = 4
XATTN_DH = 128
XATTN_W = XATTN_HEADS * XATTN_DH

N_EXPERTS = 16
N_EXPERT_GROUPS = 4
EXPERTS_PER_GROUP = N_EXPERTS // N_EXPERT_GROUPS
TOP_K = 2
D_FF_EXPERT = 512

N_BRANCH = 3
SPLIT_SIZES = (MLSTM_W, MLSTM_W, MLSTM_W, MLSTM_W, MLSTM_HEADS, MLSTM_HEADS,
               ATTN_W, ATTN_W, ATTN_W, GMLP_W, GMLP_W, N_BRANCH * D_MODEL)
SPLIT_POINTS = tuple(int(p) for p in np.cumsum(SPLIT_SIZES)[:-1])
N_IN = int(sum(SPLIT_SIZES))

kernel_name = 'hybrid_mlstm_dilated_gmlp_moe'


def rms_norm(x, gain):
    xf = x.astype(jnp.float32)
    y = xf * lax.rsqrt(jnp.mean(xf * xf, axis=-1, keepdims=True) + EPS)
    return (y * gain.astype(jnp.float32)).astype(x.dtype)


def causal_depthwise_conv(x, w):
    k = w.shape[0]
    xp = jnp.pad(x, ((0, 0), (k - 1, 0), (0, 0)))
    return lax.conv_general_dilated(xp, w[:, None, :].astype(x.dtype), window_strides=(1,), padding='VALID',
                                    dimension_numbers=('NWC', 'WIO', 'NWC'), feature_group_count=x.shape[-1])


def mlstm_chunkwise(q, k, v, i_pre, f_pre):
    b_, h_, s_, dh = q.shape
    L = MLSTM_CHUNK
    nc = s_ // L
    log_f = jax.nn.log_sigmoid(f_pre)

    def chunks(t):
        return jnp.moveaxis(t.reshape(b_, h_, nc, L, *t.shape[3:]), 2, 0)

    causal = jnp.tril(jnp.ones((L, L), dtype=bool))

    def step(carry, inp):
        c_st, n_st, m_st = carry
        qj, kj, vj, ij, fj = inp
        b = jnp.cumsum(fj, axis=-1)
        d_mat = jnp.where(causal, b[..., :, None] - b[..., None, :] + ij[..., None, :], -jnp.inf)
        inter = b + m_st[..., None]
        m_t = jnp.maximum(inter, jnp.max(d_mat, axis=-1))
        w_intra = jnp.exp(d_mat - m_t[..., None])
        w_inter = jnp.exp(inter - m_t)
        s = jnp.einsum('bhtd,bhrd->bhtr', qj, kj) * w_intra
        num = jnp.einsum('bhtr,bhre->bhte', s, vj) + w_inter[..., None] * jnp.einsum('bhtd,bhde->bhte', qj, c_st)
        den = jnp.sum(s, axis=-1) + w_inter * jnp.einsum('bhtd,bhd->bht', qj, n_st)
        h = num / jnp.maximum(jnp.abs(den), jnp.exp(-m_t))[..., None]
        b_last = b[..., -1]
        dec = b_last[..., None] - b + ij
        m_new = jnp.maximum(b_last + m_st, jnp.max(dec, axis=-1))
        w_k = jnp.exp(dec - m_new[..., None])
        w_c = jnp.exp(b_last + m_st - m_new)
        c_new = w_c[..., None, None] * c_st + jnp.einsum('bhr,bhrd,bhre->bhde', w_k, kj, vj)
        n_new = w_c[..., None] * n_st + jnp.einsum('bhr,bhrd->bhd', w_k, kj)
        return (c_new, n_new, m_new), h

    init = (jnp.zeros((b_, h_, dh, dh), jnp.float32), jnp.zeros((b_, h_, dh), jnp.float32),
            jnp.zeros((b_, h_), jnp.float32))
    _, hs = lax.scan(step, init, (chunks(q), chunks(k), chunks(v), chunks(i_pre), chunks(log_f)))
    return jnp.moveaxis(hs, 0, 2).reshape(b_, h_, s_, dh)


def mixer_mlstm(mq, mk, mv, mo, mi, mf, conv_w, gate_b, norm_g):
    b_, s_, _ = mq.shape
    qk = jax.nn.silu(causal_depthwise_conv(jnp.concatenate([mq, mk], axis=-1), conv_w))
    q, k = jnp.split(qk, 2, axis=-1)

    def heads(t):
        return t.reshape(b_, s_, MLSTM_HEADS, MLSTM_DH).transpose(0, 2, 1, 3).astype(jnp.float32)

    i_pre = (mi + gate_b[:MLSTM_HEADS]).astype(jnp.float32).transpose(0, 2, 1)
    f_pre = (mf + gate_b[MLSTM_HEADS:]).astype(jnp.float32).transpose(0, 2, 1)
    h = mlstm_chunkwise(heads(q), heads(k) * (MLSTM_DH ** -0.5), heads(mv), i_pre, f_pre)
    h = rms_norm(h.transpose(0, 2, 1, 3), norm_g.reshape(MLSTM_HEADS, MLSTM_DH))
    return (h.reshape(b_, s_, MLSTM_W) * jax.nn.sigmoid(mo.astype(jnp.float32))).astype(mq.dtype)


def rel_bucket(n):
    max_exact = REL_BUCKETS // 2
    nf = jnp.maximum(n, 1).astype(jnp.float32)
    log_b = max_exact + (jnp.log(nf / max_exact) / math.log(REL_MAX_DIST / max_exact)
                         * (REL_BUCKETS - max_exact)).astype(jnp.int32)
    return jnp.where(n < max_exact, n, jnp.minimum(log_b, REL_BUCKETS - 1))


def dilated_window_attention(q, k, v, bias_steps, dilation, steps):
    b_, hg, s_, dh = q.shape
    ls = s_ // dilation
    nb = -(-ls // ATTN_BLOCK)
    lp = nb * ATTN_BLOCK

    def gather_stride(t):
        t = t.reshape(b_, hg, ls, dilation, dh).transpose(0, 1, 3, 2, 4)
        t = jnp.pad(t, ((0, 0), (0, 0), (0, 0), (0, lp - ls), (0, 0)))
        return t.reshape(b_, hg, dilation, nb, ATTN_BLOCK, dh)

    def with_previous_block(t):
        prev = jnp.pad(t, ((0, 0), (0, 0), (0, 0), (1, 0), (0, 0), (0, 0)))[:, :, :, :-1]
        return jnp.concatenate([prev, t], axis=4)

    qb = gather_stride(q)
    kb = with_previous_block(gather_stride(k))
    vb = with_previous_block(gather_stride(v))
    qi = jnp.arange(ATTN_BLOCK)[:, None]
    ki = jnp.arange(2 * ATTN_BLOCK)[None, :]
    dist = ATTN_BLOCK + qi - ki
    local_ok = (dist >= 0) & (dist <= steps)
    first_ok = (jnp.arange(nb) > 0)[:, None, None] | (ki >= ATTN_BLOCK)[None]
    valid = local_ok[None] & first_ok
    bias = bias_steps[:, jnp.clip(dist, 0, steps)]
    logits = jnp.einsum('bhrnqd,bhrnkd->bhrnqk', qb, kb).astype(jnp.float32) * (ATTN_DH ** -0.5)
    logits = logits + bias.astype(jnp.float32)[None, :, None, None]
    logits = jnp.where(valid[None, None, None], logits, -jnp.inf)
    m = jnp.max(logits, axis=-1, keepdims=True)
    p = jnp.exp(logits - m)
    l = jnp.sum(p, axis=-1, keepdims=True)
    o = jnp.einsum('bhrnqk,bhrnkd->bhrnqd', p, vb.astype(jnp.float32)) / l
    lse = m + jnp.log(l)

    def scatter_back(t):
        c = t.shape[-1]
        t = t.reshape(b_, hg, dilation, lp, c)[:, :, :, :ls]
        return t.transpose(0, 1, 3, 2, 4).reshape(b_, hg, s_, c)

    return scatter_back(o), scatter_back(lse)[..., 0]


def mixer_dilated_attention(aq, ak, av, qk_g, rel_bias):
    b_, s_, _ = aq.shape

    def heads(t):
        return t.reshape(b_, s_, ATTN_HEADS, ATTN_DH)

    q = rms_norm(heads(aq), qk_g[0]).transpose(0, 2, 1, 3)
    k = rms_norm(heads(ak), qk_g[1]).transpose(0, 2, 1, 3)
    v = heads(av).transpose(0, 2, 1, 3)
    outs, lses = [], []
    for g, (window, dilation) in enumerate(ATTN_PATTERNS):
        steps = window // dilation
        hs = slice(g * HEADS_PER_GROUP, (g + 1) * HEADS_PER_GROUP)
        bias_steps = rel_bias[rel_bucket(jnp.arange(steps + 1) * dilation)][:, hs].T
        o, lse = dilated_window_attention(q[:, hs], k[:, hs], v[:, hs], bias_steps, dilation, steps)
        outs.append(o)
        lses.append(lse)
    alpha = jax.nn.softmax(jnp.stack(lses), axis=0)
    o = jnp.stack(outs) * alpha[..., None]
    return o.transpose(1, 3, 0, 2, 4).reshape(b_, s_, ATTN_W).astype(aq.dtype)


def mixer_spatial_gating(gu, gv, norm_g, w_s, b_s):
    b_, s_, _ = gu.shape
    nch = s_ // GMLP_CHUNK
    u = jax.nn.gelu(gu).reshape(b_, nch, GMLP_CHUNK, GMLP_GROUPS, GMLP_GC)
    v = rms_norm(jax.nn.gelu(gv).reshape(b_, nch, GMLP_CHUNK, GMLP_GROUPS, GMLP_GC),
                 norm_g.reshape(GMLP_GROUPS, GMLP_GC))
    w_causal = jnp.where(jnp.tril(jnp.ones((GMLP_CHUNK, GMLP_CHUNK), dtype=bool)), w_s, 0.0)
    mixed = jnp.einsum('gts,bnsgc->bntgc', w_causal.astype(v.dtype), v) + b_s.T.astype(v.dtype)[None, None, :, :, None]
    return (u * mixed).reshape(b_, s_, GMLP_W)


def memory_cross_attention(h, mem_n, w_q, w_kv, qk_g, w_o):
    b_, s_, _ = h.shape
    m_ = mem_n.shape[1]
    q = rms_norm((h @ w_q).reshape(b_, s_, XATTN_HEADS, XATTN_DH), qk_g[0])
    k, v = jnp.split(mem_n @ w_kv, 2, axis=-1)
    k = rms_norm(k.reshape(b_, m_, XATTN_HEADS, XATTN_DH), qk_g[1])
    v = v.reshape(b_, m_, XATTN_HEADS, XATTN_DH)
    logits = jnp.einsum('bshd,bmhd->bhsm', q, k).astype(jnp.float32) * (XATTN_DH ** -0.5)
    p = jax.nn.softmax(logits, axis=-1).astype(v.dtype)
    o = jnp.einsum('bhsm,bmhd->bshd', p, v).reshape(b_, s_, XATTN_W)
    return o @ w_o


def grouped_moe(h, router_w, router_b, w_gate, w_up, w_down):
    logits = (h @ router_w).astype(jnp.float32) + router_b.astype(jnp.float32)
    probs = jax.nn.softmax(logits, axis=-1)
    grouped = probs.reshape(*probs.shape[:-1], N_EXPERT_GROUPS, EXPERTS_PER_GROUP)
    group_score = jnp.sum(lax.top_k(grouped, TOP_K)[0], axis=-1)
    best = jnp.argmax(group_score, axis=-1)
    in_group = (best[..., None] == jnp.arange(N_EXPERT_GROUPS))[..., None]
    masked = jnp.where(in_group, grouped, -1.0).reshape(probs.shape)
    top_p, top_i = lax.top_k(masked, TOP_K)
    top_w = top_p / jnp.sum(top_p, axis=-1, keepdims=True)
    gates = jnp.sum(jax.nn.one_hot(top_i, N_EXPERTS, dtype=jnp.float32) * top_w[..., None], axis=-2).astype(h.dtype)
    out = jnp.zeros_like(h)
    for e in range(N_EXPERTS):
        a = jax.nn.silu(h @ w_gate[e]) * (h @ w_up[e])
        out = out + gates[..., e:e + 1] * (a @ w_down[e])
    return out


def setup_inputs(seed: int = 0) -> dict:
    key = jax.random.key(seed)
    ks = iter(jax.random.split(key, 40))

    def nrm(shape, scale):
        return jax.random.normal(next(ks), shape, jnp.float32) * scale

    def gain(shape):
        return 1.0 + nrm(shape, 0.05)

    L = DEPTH
    forget_b = jnp.broadcast_to(jnp.linspace(3.0, 6.0, MLSTM_HEADS), (L, MLSTM_HEADS))
    mlstm_gate_b = jnp.concatenate([nrm((L, MLSTM_HEADS), 0.5) - 2.0,
                                    forget_b + nrm((L, MLSTM_HEADS), 0.1)], axis=-1)
    return {
        'x': nrm((BATCH, SEQ, D_MODEL), 1.0),
        'mem': nrm((BATCH, MEM_LEN, D_MODEL), 1.0),
        'norm_mix': gain((L, D_MODEL)),
        'w_in': nrm((L, D_MODEL, N_IN), D_MODEL ** -0.5),
        'mlstm_conv': nrm((L, CONV_WIDTH, 2 * MLSTM_W), CONV_WIDTH ** -0.5),
        'mlstm_gate_b': mlstm_gate_b,
        'mlstm_norm': gain((L, MLSTM_W)),
        'attn_qk_norm': gain((L, 2, ATTN_DH)),
        'gmlp_norm': gain((L, GMLP_W)),
        'gmlp_ws': nrm((L, GMLP_GROUPS, GMLP_CHUNK, GMLP_CHUNK), GMLP_CHUNK ** -0.5),
        'gmlp_bs': 1.0 + nrm((L, GMLP_GROUPS, GMLP_CHUNK), 0.1),
        'w_branch_a': nrm((L, MLSTM_W, D_MODEL), MLSTM_W ** -0.5),
        'w_branch_b': nrm((L, ATTN_W, D_MODEL), ATTN_W ** -0.5),
        'w_branch_c': nrm((L, GMLP_W, D_MODEL), GMLP_W ** -0.5),
        'w_out': nrm((L, D_MODEL, D_MODEL), 0.5 * D_MODEL ** -0.5),
        'rel_bias': nrm((REL_BUCKETS, ATTN_HEADS), 0.5),
        'norm_xattn': gain((L, D_MODEL)),
        'norm_mem': gain((L, D_MODEL)),
        'w_xq': nrm((L, D_MODEL, XATTN_W), D_MODEL ** -0.5),
        'w_xkv': nrm((L, D_MODEL, 2 * XATTN_W), D_MODEL ** -0.5),
        'xattn_qk_norm': gain((L, 2, XATTN_DH)),
        'w_xo': nrm((L, XATTN_W, D_MODEL), 0.5 * XATTN_W ** -0.5),
        'norm_ffn': gain((L, D_MODEL)),
        'router_w': nrm((D_MODEL, N_EXPERTS), D_MODEL ** -0.5),
        'router_b': nrm((N_EXPERTS,), 0.01),
        'w_expert_gate': nrm((L, N_EXPERTS, D_MODEL, D_FF_EXPERT), D_MODEL ** -0.5),
        'w_expert_up': nrm((L, N_EXPERTS, D_MODEL, D_FF_EXPERT), D_MODEL ** -0.5),
        'w_expert_down': nrm((L, N_EXPERTS, D_FF_EXPERT, D_MODEL), 0.5 * D_FF_EXPERT ** -0.5),
    }


def reference(x, mem, norm_mix, w_in, mlstm_conv, mlstm_gate_b, mlstm_norm, attn_qk_norm, gmlp_norm,
              gmlp_ws, gmlp_bs, w_branch_a, w_branch_b, w_branch_c, w_out, rel_bias, norm_xattn, norm_mem,
              w_xq, w_xkv, xattn_qk_norm, w_xo, norm_ffn, router_w, router_b, w_expert_gate, w_expert_up,
              w_expert_down):
    b_, s_, _ = x.shape
    for l in range(DEPTH):
        h = rms_norm(x, norm_mix[l])
        (mq, mk, mv, mo, mi, mf, aq, ak, av, gu, gv, gate_pre) = jnp.split(h @ w_in[l], SPLIT_POINTS, axis=-1)
        ya = mixer_mlstm(mq, mk, mv, mo, mi, mf, mlstm_conv[l], mlstm_gate_b[l], mlstm_norm[l])
        yb = mixer_dilated_attention(aq, ak, av, attn_qk_norm[l], rel_bias)
        yc = mixer_spatial_gating(gu, gv, gmlp_norm[l], gmlp_ws[l], gmlp_bs[l])
        g = jax.nn.sigmoid(gate_pre.reshape(b_, s_, N_BRANCH, D_MODEL))
        merged = (g[:, :, 0] * (ya @ w_branch_a[l]) + g[:, :, 1] * (yb @ w_branch_b[l])
                  + g[:, :, 2] * (yc @ w_branch_c[l]))
        x = x + merged @ w_out[l]
        x = x + memory_cross_attention(rms_norm(x, norm_xattn[l]), rms_norm(mem, norm_mem[l]),
                                       w_xq[l], w_xkv[l], xattn_qk_norm[l], w_xo[l])
        x = x + grouped_moe(rms_norm(x, norm_ffn[l]), router_w, router_b,
                            w_expert_gate[l], w_expert_up[l], w_expert_down[l])
    return x
```

```cpp
#include <hip/hip_runtime.h>
#include <cstdio>
#include <cstdint>

#define GAS __attribute__((address_space(1)))
#define LAS __attribute__((address_space(3)))
typedef unsigned short bf16;
typedef short bf16x8 __attribute__((ext_vector_type(8)));
typedef float f32x4 __attribute__((ext_vector_type(4)));
typedef float f32x2 __attribute__((ext_vector_type(2)));
typedef unsigned u32x4 __attribute__((ext_vector_type(4)));
typedef unsigned u32x2 __attribute__((ext_vector_type(2)));

constexpr int D = 1024, NBATCH = 4, SEQ = 4096, M = NBATCH * SEQ, DEPTH = 2, MEML = 256, MM = NBATCH * MEML;
constexpr int NIN = 8456;
constexpr int PP = 5376;
constexpr int C_MQ = 0, C_MK = 512, C_MV = 1024, C_MO = 1536, C_AQ = 2048, C_AK = 2816, C_AV = 3584, C_GU = 4352, C_GV = 4864;
constexpr int NEXP = 16, DFF = 512;
constexpr int LCH = 128, NCH = SEQ / LCH;
constexpr float EPS = 1e-6f;
constexpr int MAXT = 144;

constexpr size_t MiB = 1u << 20;
constexpr size_t WS_CTL = 0, CTL_ZERO_BYTES = 1 * MiB;
constexpr size_t WS_SMALL = 1 * MiB;
constexpr size_t OFF_GATES = WS_SMALL;
constexpr size_t OFF_AMA = OFF_GATES + (size_t)M * 8 * 4;
constexpr size_t OFF_AMM = OFF_AMA + 16 * SEQ * 4;
constexpr size_t OFF_AMB = OFF_AMM + 16 * SEQ * 4;
constexpr size_t OFF_LSE = OFF_AMB + 16 * SEQ * 4;
constexpr size_t OFF_BIAS = OFF_LSE + (size_t)M * 12 * 4;
constexpr size_t OFF_TOKE = OFF_BIAS + 12 * 132 * 4;
constexpr size_t OFF_TOKP = OFF_TOKE + (size_t)M * 2 * 4;
constexpr size_t OFF_TOKW = OFF_TOKP + (size_t)M * 2 * 4;
constexpr size_t OFF_SLOT = OFF_TOKW + (size_t)M * 2 * 4;
constexpr size_t OFF_WROW = OFF_SLOT + (size_t)M * 2 * 4;
constexpr size_t OFF_NST = OFF_WROW + (size_t)MAXT * 256 * 4;
constexpr size_t OFF_MEMB = OFF_NST + (size_t)16 * NCH * 128 * 4;
constexpr size_t OFF_KV = OFF_MEMB + (size_t)MM * D * 2;
constexpr size_t OFF_SMALL_END = OFF_KV + (size_t)MM * 1024 * 2;
static_assert(OFF_SMALL_END <= 17 * MiB, "small region");
constexpr size_t WS_W = 17 * MiB;
constexpr size_t OFF_WIN1 = WS_W;
constexpr size_t OFF_WG = OFF_WIN1 + (size_t)5376 * 1024 * 2;
constexpr size_t OFF_WA = OFF_WG + (size_t)3072 * 1024 * 2;
constexpr size_t OFF_WB = OFF_WA + (size_t)1024 * 512 * 2;
constexpr size_t OFF_WC = OFF_WB + (size_t)1024 * 768 * 2;
constexpr size_t OFF_WOUT = OFF_WC + (size_t)1024 * 512 * 2;
constexpr size_t OFF_WXQ = OFF_WOUT + (size_t)1024 * 1024 * 2;
constexpr size_t OFF_WXKV = OFF_WXQ + (size_t)512 * 1024 * 2;
constexpr size_t OFF_WXO = OFF_WXKV + (size_t)1024 * 1024 * 2;
constexpr size_t OFF_WGU = OFF_WXO + (size_t)1024 * 512 * 2;
constexpr size_t OFF_WD = OFF_WGU + (size_t)16 * 1024 * 1024 * 2;
constexpr size_t OFF_W_END = OFF_WD + (size_t)16 * 1024 * 512 * 2;
static_assert(OFF_W_END <= 93 * MiB, "weight region");
constexpr size_t WS_XB = 93 * MiB;
constexpr size_t WS_PROJ = 125 * MiB;
constexpr size_t OFF_XG = WS_PROJ, OFF_HID = WS_PROJ + 72 * MiB;
constexpr size_t WS_T = 293 * MiB;
constexpr size_t OFF_Q = WS_T, OFF_O = WS_T + 16 * MiB;
constexpr size_t WS_END = 327 * MiB;
constexpr int CW_TMO = 0, CW_CODE = 1;
constexpr int CW_CNT = 64;
constexpr int CW_BAR = 4096;

constexpr int LDS_BYTES = 147456;
constexpr int LDS_TAB = 145408;
constexpr int LDS_MISC = 146944;

#define RLX_AGENT __ATOMIC_RELAXED, __HIP_MEMORY_SCOPE_AGENT
#define LDS_WAIT() asm volatile("s_waitcnt lgkmcnt(0)" ::: "memory")
#define VM_WAIT() asm volatile("s_waitcnt vmcnt(0)" ::: "memory")
__device__ __forceinline__ unsigned f2bf(float f) { unsigned u = __builtin_bit_cast(unsigned, f); return (u + 0x7fffu + ((u >> 16) & 1u)) >> 16; }
__device__ __forceinline__ unsigned pk2(float lo, float hi) { return f2bf(lo) | (f2bf(hi) << 16); }
__device__ __forceinline__ float bf2f(unsigned h) { return __builtin_bit_cast(float, h << 16); }
__device__ __forceinline__ float bflo(unsigned w) { return __builtin_bit_cast(float, w << 16); }
__device__ __forceinline__ float bfhi(unsigned w) { return __builtin_bit_cast(float, w & 0xffff0000u); }
__device__ __forceinline__ float wave_sum(float v) {
#pragma unroll
    for (int o = 1; o < 64; o <<= 1) v += __shfl_xor(v, o);
    return v;
}
__device__ __forceinline__ float sigmoidf_(float x) { return 1.f / (1.f + __expf(-x)); }
__device__ __forceinline__ float siluf_(float x) { return x / (1.f + __expf(-x)); }
__device__ __forceinline__ float gelu_tanh(float x) { const float u = 0.7978845608028654f * (x + 0.044715f * x * x * x); const float t = 1.f - 2.f / (1.f + __expf(2.f * u)); return 0.5f * x * (1.f + t); }
__device__ __forceinline__ void unpack8(const u32x4 w, float (&f)[8]) { f[0] = bflo(w.x); f[1] = bfhi(w.x); f[2] = bflo(w.y); f[3] = bfhi(w.y); f[4] = bflo(w.z); f[5] = bfhi(w.z); f[6] = bflo(w.w); f[7] = bfhi(w.w); }
__device__ __forceinline__ u32x4 pack8(const float (&f)[8]) { u32x4 w; w.x = pk2(f[0], f[1]); w.y = pk2(f[2], f[3]); w.z = pk2(f[4], f[5]); w.w = pk2(f[6], f[7]); return w; }

namespace pg8 {
constexpr int BM = 256, BK = 64, HALF = 128, HTB = HALF * BK * 2  , STAGE_BYTES = 8 * HTB, NXCD = 8, WGM = 8;
__host__ __device__ __forceinline__ int lds_byte(int r, int c) { const int st = (r >> 4) * 2 + (c >> 5), rr = r & 15, cc = c & 31, ob = rr * 64 + cc * 2; return st * 1024 + (ob ^ (((ob >> 9) & 1) << 5)); }
__host__ __device__ __forceinline__ void stage_rc(int b, int& R, int& C) { const int st = b / 1024, sb = b % 1024, swz = sb ^ (((sb >> 9) & 1) << 5); R = (st >> 1) * 16 + swz / 64; C = (st & 1) * 32 + (swz % 64) / 2; }
__host__ __device__ __forceinline__ int perm32(int rho) { const int n = rho >> 4, i = rho & 15; return 8 * (i >> 2) + 4 * n + (i & 3); }

struct Unit { int pm, pn; };
struct Gemm { const bf16* A; const bf16* Bt; int lda, K; };

struct StaticOrder {
    int nM, nN, nwg, G, c;
    __host__ __device__ void init(int M_, int N_, int G_, int c_) { nM = M_ / BM; nN = N_ / BM; nwg = nM * nN; G = G_; c = c_; }
    __host__ __device__ bool next(int i, Unit& u) const {
        const long L = (long)i * G + c; if (L >= nwg) return false;
        int wgid = (int)L; { const int q = nwg / NXCD, r = nwg % NXCD, xcd = wgid % NXCD, off = wgid / NXCD; wgid = (xcd < r ? xcd * (q + 1) : r * (q + 1) + (xcd - r) * q) + off; }
        const int nig = WGM * nN, gid = wgid / nig, fm = gid * WGM, gsz = (nM - fm) < WGM ? (nM - fm) : WGM;
        u.pm = fm + ((wgid % nig) % gsz); u.pn = (wgid % nig) / gsz; return true;
    }
    __device__ __forceinline__ void a_ready(const Unit&) const {}
    __device__ __forceinline__ void done(const Unit&) const {}
};

__device__ __forceinline__ unsigned cvt_pk_bf16(float lo, float hi) { unsigned r; asm volatile("v_cvt_pk_bf16_f32 %0, %1, %2" : "=v"(r) : "v"(lo), "v"(hi)); return r; }


template <class Epi, class Sched, bool ALIGN_EPI = false>
__device__ __forceinline__ void gemm_phase(LAS unsigned char* lds, const Gemm g, const Sched& S, const Epi& E) {
    int tid_ = threadIdx.x; asm volatile("" : "+v"(tid_));
    const int tid = tid_, wid = __builtin_amdgcn_readfirstlane(tid >> 6), lane = tid & 63, wr = wid >> 2, wc = wid & 3, fr = lane & 15, fq = lane >> 4;
    const int K = g.K, nt = K / BK, lda = g.lda;
    unsigned voffA[2], voffB[2];
#pragma unroll
    for (int i = 0; i < 2; ++i) { int R, C; stage_rc(tid * 16 + i * 8192, R, C); const int Rb = Epi::PERM ? ((R & ~31) + perm32(R & 31)) : R;
        voffA[i] = (unsigned)(R * lda + C) * 2u; voffB[i] = (unsigned)(Rb * K + C) * 2u; }
    const size_t kstep = (size_t)(BK * 2);
    const size_t hstepA = (size_t)HALF * lda * 2, hstepB = (size_t)HALF * K * 2;
    const size_t tstepA = 2 * hstepA, tstepB = 2 * hstepB;
    const unsigned ldsw = (unsigned)wid * 1024u;
    const int aoff = lds_byte(wr * 64 + fr, fq * 8), boff = lds_byte(wc * 32 + fr, fq * 8);
#define PG8_SA(b, h) (((b) * 2 + (h)) * HTB)
#define PG8_SB(b, h) ((4 + (b) * 2 + (h)) * HTB)
#define PG8_STAGE(bufoff, gbase, voff) do { _Pragma("unroll") for (int _i = 0; _i < 2; ++_i) \
        __builtin_amdgcn_global_load_lds((const unsigned*)((const char*)(gbase) + (voff)[_i]), (LAS unsigned*)(lds + (bufoff) + ldsw + _i * 8192), 16, 0, 0); } while (0)
#define PG8_LDA(dst, b, h) do { _Pragma("unroll") for (int m = 0; m < 4; ++m) _Pragma("unroll") for (int k = 0; k < 2; ++k) dst[m][k] = *(const LAS bf16x8*)(lds + PG8_SA(b, h) + aoff + m * 2048 + k * 1024); } while (0)
#define PG8_LDB(dst, b, h) do { _Pragma("unroll") for (int n = 0; n < 2; ++n) _Pragma("unroll") for (int k = 0; k < 2; ++k) dst[n][k] = *(const LAS bf16x8*)(lds + PG8_SB(b, h) + boff + n * 2048 + k * 1024); } while (0)
#define PG8_MMA(ai, bj, At, Bt) do { __builtin_amdgcn_s_setprio(1); _Pragma("unroll") for (int m = 0; m < 4; ++m) _Pragma("unroll") for (int n = 0; n < 2; ++n) _Pragma("unroll") for (int k = 0; k < 2; ++k) \
        acc[ai][bj][m][n] = __builtin_amdgcn_mfma_f32_16x16x32_bf16(Bt[n][k], At[m][k], acc[ai][bj][m][n], 0, 0, 0); __builtin_amdgcn_s_setprio(0); } while (0)
#define PG8_WAIT_V(n) asm volatile("s_waitcnt vmcnt(" #n ")" ::: "memory")
#define PG8_WAIT_L(n) asm volatile("s_waitcnt lgkmcnt(" #n ")" ::: "memory")
#define PG8_BAR __builtin_amdgcn_s_barrier()
#define PG8_SCHED __builtin_amdgcn_sched_barrier(0)
    Unit cur, nxt; int ui = 0;
    if (!S.next(0, cur)) return;
    f32x4 acc[2][2][4][2];
#pragma unroll
    for (int a = 0; a < 2; ++a)
#pragma unroll
        for (int b = 0; b < 2; ++b)
#pragma unroll
            for (int m = 0; m < 4; ++m)
#pragma unroll
                for (int n = 0; n < 2; ++n) acc[a][b][m][n] = (f32x4){0.f, 0.f, 0.f, 0.f};
    bf16x8 At[4][2], B0[2][2], B1[2][2];
    const char* cA = (const char*)g.A + (size_t)cur.pm * tstepA; const char* cB = (const char*)g.Bt + (size_t)cur.pn * tstepB;
    S.a_ready(cur);
    PG8_STAGE(PG8_SB(0, 0), cB, voffB); PG8_STAGE(PG8_SB(0, 1), cB + hstepB, voffB); PG8_STAGE(PG8_SA(0, 0), cA, voffA); PG8_STAGE(PG8_SA(0, 1), cA + hstepA, voffA);
    if (wr == 1) PG8_BAR;
    PG8_WAIT_V(2); PG8_BAR;
    PG8_STAGE(PG8_SB(1, 0), cB + kstep, voffB); PG8_STAGE(PG8_SA(1, 0), cA + kstep, voffA); PG8_STAGE(PG8_SB(1, 1), cB + hstepB + kstep, voffB);
    PG8_WAIT_V(6); PG8_BAR;
    for (;;) {
        const bool has_next = S.next(ui + 1, nxt);
        const char* nA = has_next ? (const char*)g.A + (size_t)nxt.pm * tstepA : cA; const char* nB = has_next ? (const char*)g.Bt + (size_t)nxt.pn * tstepB : cB;
        for (int t = 0; t < nt; t += 2) {
            const bool last = (t == nt - 2);
            const char* a1 = cA + (size_t)(t + 1) * kstep;
            const char* a2 = last ? nA : cA + (size_t)(t + 2) * kstep; const char* b2 = last ? nB : cB + (size_t)(t + 2) * kstep;
            const char* a3 = a2 + kstep; const char* b3 = b2 + kstep;
            if (last && has_next) S.a_ready(nxt);
            PG8_LDB(B0, 0, 0); PG8_LDB(B1, 0, 1); PG8_SCHED; PG8_LDA(At, 0, 0); PG8_STAGE(PG8_SA(1, 1), a1 + hstepA, voffA);
            PG8_WAIT_V(8); PG8_WAIT_L(0); PG8_BAR; PG8_MMA(0, 0, At, B0); PG8_MMA(0, 1, At, B1); PG8_BAR; PG8_SCHED;
            PG8_LDA(At, 0, 1); PG8_STAGE(PG8_SB(0, 0), b2, voffB); PG8_STAGE(PG8_SB(0, 1), b2 + hstepB, voffB); PG8_STAGE(PG8_SA(0, 0), a2, voffA);
            PG8_WAIT_V(8); PG8_WAIT_L(0); PG8_BAR; PG8_MMA(1, 0, At, B0); PG8_MMA(1, 1, At, B1); PG8_BAR; PG8_SCHED;
            PG8_LDB(B0, 1, 0); PG8_LDB(B1, 1, 1); PG8_SCHED; PG8_LDA(At, 1, 0); PG8_STAGE(PG8_SA(0, 1), a2 + hstepA, voffA);
            PG8_WAIT_V(8); PG8_WAIT_L(0); PG8_BAR; PG8_MMA(0, 0, At, B0); PG8_MMA(0, 1, At, B1); PG8_BAR; PG8_SCHED;
            PG8_LDA(At, 1, 1); PG8_STAGE(PG8_SB(1, 0), b3, voffB); PG8_STAGE(PG8_SB(1, 1), b3 + hstepB, voffB); PG8_STAGE(PG8_SA(1, 0), a3, voffA);
            PG8_WAIT_V(8); PG8_WAIT_L(0); PG8_BAR; PG8_MMA(1, 0, At, B0); PG8_MMA(1, 1, At, B1); PG8_BAR; PG8_SCHED;
        }
        if constexpr (ALIGN_EPI) { if (wr == 0) PG8_BAR; }
        E(acc, cur, wr, wc, fr, fq); S.done(cur);
        if (!has_next) break;
#pragma unroll
        for (int a = 0; a < 2; ++a)
#pragma unroll
            for (int b = 0; b < 2; ++b)
#pragma unroll
                for (int m = 0; m < 4; ++m)
#pragma unroll
                    for (int n = 0; n < 2; ++n) acc[a][b][m][n] = (f32x4){0.f, 0.f, 0.f, 0.f};
        cur = nxt; cA = nA; cB = nB; ++ui;
        if constexpr (ALIGN_EPI) { if (wr == 1) PG8_BAR; }
    }
    PG8_WAIT_V(0);
    if constexpr (!ALIGN_EPI) { if (wr == 0) PG8_BAR; }
    PG8_BAR;
#undef PG8_SA
#undef PG8_SB
#undef PG8_STAGE
#undef PG8_LDA
#undef PG8_LDB
#undef PG8_MMA
#undef PG8_WAIT_V
#undef PG8_WAIT_L
#undef PG8_BAR
#undef PG8_SCHED
}
}

namespace epi {
using pg8::Unit; using pg8::BM; using pg8::HALF; using pg8::cvt_pk_bf16;
__device__ __forceinline__ u32x4 pk8(const f32x4 v0, const f32x4 v1) { u32x4 w; w.x = cvt_pk_bf16(v0[0], v0[1]); w.y = cvt_pk_bf16(v0[2], v0[3]); w.z = cvt_pk_bf16(v1[0], v1[1]); w.w = cvt_pk_bf16(v1[2], v1[3]); return w; }
__device__ __forceinline__ void up8(const u32x4 w, f32x4& a, f32x4& b) { a = (f32x4){bflo(w.x), bfhi(w.x), bflo(w.y), bfhi(w.y)}; b = (f32x4){bflo(w.z), bfhi(w.z), bflo(w.w), bfhi(w.w)}; }
__device__ __forceinline__ int gcol(int tg) { return tg < 6 ? 256 * tg : 2816 + 256 * (tg - 6); }

struct Bf16Out {
    static constexpr bool PERM = true;
    bf16* O; int ldc;
    __device__ __forceinline__ void operator()(const f32x4 (&acc)[2][2][4][2], const Unit& u, int wr, int wc, int fr, int fq) const {
        const int row0 = u.pm * BM + wr * 64 + fr, col0 = u.pn * BM + wc * 32 + 8 * fq;
#pragma unroll
        for (int ai = 0; ai < 2; ++ai)
#pragma unroll
            for (int m = 0; m < 4; ++m) { bf16* rowp = O + (size_t)(row0 + ai * HALF + m * 16) * ldc + col0;
#pragma unroll
                for (int bj = 0; bj < 2; ++bj) *(u32x4*)(rowp + bj * HALF) = pk8(acc[ai][bj][m][0], acc[ai][bj][m][1]); }
    }
};
struct SigOut {
    static constexpr bool PERM = true;
    bf16* PROJ;
    __device__ __forceinline__ void operator()(const f32x4 (&acc)[2][2][4][2], const Unit& u, int wr, int wc, int fr, int fq) const {
        const int row0 = u.pm * BM + wr * 64 + fr, col0 = gcol(u.pn) + wc * 32 + 8 * fq;
#pragma unroll
        for (int ai = 0; ai < 2; ++ai)
#pragma unroll
            for (int m = 0; m < 4; ++m) { bf16* rowp = PROJ + (size_t)(row0 + ai * HALF + m * 16) * PP + col0;
#pragma unroll
                for (int bj = 0; bj < 2; ++bj) { f32x4 a = acc[ai][bj][m][0], b = acc[ai][bj][m][1];
#pragma unroll
                    for (int e = 0; e < 4; ++e) { a[e] = sigmoidf_(a[e]); b[e] = sigmoidf_(b[e]); }
                    *(u32x4*)(rowp + bj * HALF) = pk8(a, b); } }
    }
};
template <int BR> struct BranchOut {
    static constexpr bool PERM = true;
    const bf16* PROJ; bf16* T; bf16* OUT;
    __device__ __forceinline__ void operator()(const f32x4 (&acc)[2][2][4][2], const Unit& u, int wr, int wc, int fr, int fq) const {
        const int row0 = u.pm * BM + wr * 64 + fr, cw = wc * 32 + 8 * fq, gc0 = gcol(BR * 4 + u.pn) + cw, col0 = u.pn * BM + cw;
#pragma unroll
        for (int ai = 0; ai < 2; ++ai)
#pragma unroll
            for (int m = 0; m < 4; ++m) { const size_t row = (size_t)(row0 + ai * HALF + m * 16);
#pragma unroll
                for (int bj = 0; bj < 2; ++bj) {
                    f32x4 g0, g1; up8(*(const u32x4*)(PROJ + row * PP + gc0 + bj * HALF), g0, g1);
                    f32x4 v0 = g0 * acc[ai][bj][m][0], v1 = g1 * acc[ai][bj][m][1];
                    if (BR > 0) { f32x4 t0, t1; up8(*(const u32x4*)(T + row * 1024 + col0 + bj * HALF), t0, t1); v0 += t0; v1 += t1; }
                    bf16* dst = (BR == 2 ? OUT : T) + row * 1024 + col0 + bj * HALF;
                    *(u32x4*)dst = pk8(v0, v1); } }
    }
};
struct ResidOut {
    static constexpr bool PERM = false;
    const float* SRC; float* DST;
    __device__ __forceinline__ void operator()(const f32x4 (&acc)[2][2][4][2], const Unit& u, int wr, int wc, int fr, int fq) const {
        const int row0 = u.pm * BM + wr * 64 + fr, col0 = u.pn * BM + wc * 32 + 4 * fq;
#pragma unroll
        for (int ai = 0; ai < 2; ++ai)
#pragma unroll
            for (int m = 0; m < 4; ++m) { const size_t off = (size_t)(row0 + ai * HALF + m * 16) * 1024 + col0;
#pragma unroll
                for (int bj = 0; bj < 2; ++bj)
#pragma unroll
                    for (int n = 0; n < 2; ++n) { const size_t o = off + bj * HALF + n * 16; *(f32x4*)(DST + o) = *(const f32x4*)(SRC + o) + acc[ai][bj][m][n]; } }
    }
};
struct GluOut {
    static constexpr bool PERM = true;
    bf16* HID;
    __device__ __forceinline__ void operator()(const f32x4 (&acc)[2][2][4][2], const Unit& u, int wr, int wc, int fr, int fq) const {
        const int row0 = u.pm * BM + wr * 64 + fr, col0 = (u.pn & 3) * 128 + wc * 32 + 8 * fq;
#pragma unroll
        for (int ai = 0; ai < 2; ++ai)
#pragma unroll
            for (int m = 0; m < 4; ++m) { f32x4 a = acc[ai][0][m][0], b = acc[ai][0][m][1]; const f32x4 ua = acc[ai][1][m][0], ub = acc[ai][1][m][1];
#pragma unroll
                for (int e = 0; e < 4; ++e) { a[e] = siluf_(a[e]) * ua[e]; b[e] = siluf_(b[e]) * ub[e]; }
                *(u32x4*)(HID + (size_t)(row0 + ai * HALF + m * 16) * DFF + col0) = pk8(a, b); }
    }
};
struct DownOut {
    static constexpr bool PERM = true;
    bf16* YE; const float* WROW;
    __device__ __forceinline__ void operator()(const f32x4 (&acc)[2][2][4][2], const Unit& u, int wr, int wc, int fr, int fq) const {
        const int row0 = u.pm * BM + wr * 64 + fr, col0 = (u.pn & 3) * BM + wc * 32 + 8 * fq;
#pragma unroll
        for (int ai = 0; ai < 2; ++ai)
#pragma unroll
            for (int m = 0; m < 4; ++m) { const int row = row0 + ai * HALF + m * 16; const float w = WROW[row]; bf16* rowp = YE + (size_t)row * 1024 + col0;
#pragma unroll
                for (int bj = 0; bj < 2; ++bj) *(u32x4*)(rowp + bj * HALF) = pk8(acc[ai][bj][m][0] * w, acc[ai][bj][m][1] * w); }
    }
};
}

struct MoeOrder {
    const LAS int* tab; int G, c;
    __device__ __forceinline__ bool next(int i, pg8::Unit& u) const {
        const int L = i * G + c; const int nT = tab[176]; if (L >= 4 * nT) return false;
        const int pm = L >> 2; u.pm = pm; u.pn = tab[pm] * 4 + (L & 3); return true;
    }
    __device__ __forceinline__ void a_ready(const pg8::Unit&) const {}
    __device__ __forceinline__ void done(const pg8::Unit&) const {}
};
#define XB_TMO      128
#define XB_XCNT(j)  (256  + 64 * (j))
#define XB_XSUB(j)  (1280 + 64 * (j))
#define XB_XGEN(j)  (2304 + 64 * (j))
#define XB_TOP      3328
#define XB_TOPGEN   3392
#define XCD_BAR_WORDS 3456
#define XB_SPIN_CAP (1u << 18)

__device__ __forceinline__ unsigned xb_ld(unsigned* p)              { return __hip_atomic_load(p, __ATOMIC_RELAXED, __HIP_MEMORY_SCOPE_AGENT); }
__device__ __forceinline__ unsigned xb_add(unsigned* p, unsigned v) { return __hip_atomic_fetch_add(p, v, __ATOMIC_RELAXED, __HIP_MEMORY_SCOPE_AGENT); }
__device__ __forceinline__ unsigned xb_xcc_id() { return (unsigned)__builtin_amdgcn_s_getreg((3 << 11) | 20) & 0xFu; }
#define XB_SPIN(cond, bar) do { unsigned _sp = 0; while (cond) { __builtin_amdgcn_s_sleep(1); \
    if ((++_sp & 255u) == 0u) { if (xb_ld(&(bar)[XB_TMO])) break; if (_sp > XB_SPIN_CAP) { atomicAdd(&(bar)[XB_TMO], 1u); break; } } } } while (0)

struct XcdBarrier {
    unsigned* bar; unsigned x;
    volatile LAS unsigned* st;
};

__device__ __forceinline__ XcdBarrier xcd_barrier_post(unsigned* bar, volatile LAS unsigned* st) {
    XcdBarrier b; b.bar = bar; b.x = xb_xcc_id(); b.st = st;
    if (threadIdx.x == 0) (void)xb_add(&bar[XB_XCNT(b.x)], 1u);
    return b;
}
__device__ __forceinline__ void xcd_barrier_complete(unsigned* bar, unsigned x, unsigned& nloc, unsigned& nx) {
    const unsigned G = gridDim.x * gridDim.y * gridDim.z;
    unsigned sum, cnt, mine, sp = 0u;
    for (;;) {
        sum = 0u; cnt = 0u; mine = 0u;
#pragma unroll
        for (unsigned j = 0; j < 16; ++j) { const unsigned c = xb_ld(&bar[XB_XCNT(j)]); sum += c; cnt += (c > 0u) ? 1u : 0u; mine = (j == x) ? c : mine; }
        if (sum == G) break;
        __builtin_amdgcn_s_sleep(1);
        if ((++sp & 255u) == 0u) { if (xb_ld(&bar[XB_TMO])) break; if (sp > XB_SPIN_CAP) { atomicAdd(&bar[XB_TMO], 1u); break; } }
    }
    nloc = mine > 0u ? mine : 1u; nx = cnt > 0u ? cnt : 1u;
}

__device__ __forceinline__ void xcd_barrier(const XcdBarrier& b) {
    asm volatile("s_waitcnt vmcnt(0)" ::: "memory");
    __syncthreads();
    if (threadIdx.x == 0) {
        unsigned* bar = b.bar;
        __builtin_amdgcn_s_waitcnt(0);
        unsigned nloc = b.st[0], nx = b.st[1];
        if (nloc == 0u) { xcd_barrier_complete(bar, b.x, nloc, nx); b.st[0] = nloc; b.st[1] = nx; }
        const unsigned old = xb_add(&bar[XB_XSUB(b.x)], 1u);
        const unsigned gen = old / nloc;
        if (old + 1u == (gen + 1u) * nloc) {
            __builtin_amdgcn_fence(__ATOMIC_RELEASE, "agent");
            asm volatile("s_waitcnt vmcnt(0)" ::: "memory");
            const unsigned og = xb_add(&bar[XB_TOP], 1u);
            const unsigned tg = og / nx;
            if (og + 1u == (tg + 1u) * nx) xb_add(&bar[XB_TOPGEN], 1u);
            else XB_SPIN(xb_ld(&bar[XB_TOPGEN]) == tg, bar);
            __builtin_amdgcn_fence(__ATOMIC_ACQUIRE, "agent");
            xb_add(&bar[XB_XGEN(b.x)], 1u);
            asm volatile("s_waitcnt vmcnt(0)" ::: "memory");
        } else {
            XB_SPIN(xb_ld(&bar[XB_XGEN(b.x)]) == gen, bar);
            __builtin_amdgcn_fence(__ATOMIC_ACQUIRE, "agent");
            asm volatile("s_waitcnt vmcnt(0)" ::: "memory");
        }
    }
    __syncthreads();
}

struct Params { const float* in[28]; float* out; unsigned char* ws; };
enum { I_X = 0, I_MEM, I_NORM_MIX, I_W_IN, I_CONV, I_GATE_B, I_MLSTM_NORM, I_ATTN_QKN, I_GMLP_NORM, I_GMLP_WS, I_GMLP_BS, I_WBA, I_WBB, I_WBC, I_WOUT, I_REL_BIAS,
       I_NORM_XATTN, I_NORM_MEM, I_WXQ, I_WXKV, I_XATTN_QKN, I_WXO, I_NORM_FFN, I_ROUTER_W, I_ROUTER_B, I_EG, I_EU, I_ED };

struct Ctx {
    LAS unsigned char* lds;
    unsigned char* ws;
    int tid, lane, wave, vcu, G, bx;
};
template <class T> __device__ __forceinline__ T* wsp(const Ctx& c, size_t off) { return (T*)(c.ws + off); }

__device__ const unsigned char REL_BUCKET[3][132] = {
  {0,1,2,3,4,5,6,7,8,9,10,11,12,13,14,15,16,16,16,16,16,16,17,17,17,17,17,17,17,17,18,18,18,18,18,18,18,18,18,18,19,19,19,19,19,19,19,19,19,19,19,19,19,19,20,20,20,20,20,20,20,20,20,20,20,20,20,20,20,20,20,20,20,21,21,21,21,21,21,21,21,21,21,21,21,21,21,21,21,21,21,21,21,21,21,21,21,21,21,22,22,22,22,22,22,22,22,22,22,22,22,22,22,22,22,22,22,22,22,22,22,22,22,22,22,22,22,22,22,0,0,0},
  {0,4,8,12,16,16,17,17,18,18,19,19,19,19,20,20,20,20,20,21,21,21,21,21,21,22,22,22,22,22,22,22,22,22,23,23,23,23,23,23,23,23,23,23,23,23,24,24,24,24,24,24,24,24,24,24,24,24,24,24,24,24,25,25,25,25,25,25,25,25,25,25,25,25,25,25,25,25,25,25,25,25,25,26,26,26,26,26,26,26,26,26,26,26,26,26,26,26,26,26,26,26,26,26,26,26,26,26,26,26,26,26,26,27,27,27,27,27,27,27,27,27,27,27,27,27,27,27,27,0,0,0},
  {0,16,18,19,20,21,21,22,22,23,23,23,24,24,24,24,25,25,25,25,25,26,26,26,26,26,26,26,26,27,27,27,27,27,27,27,27,27,27,28,28,28,28,28,28,28,28,28,28,28,28,28,29,29,29,29,29,29,29,29,29,29,29,29,29,29,29,29,29,29,30,30,30,30,30,30,30,30,30,30,30,30,30,30,30,30,30,30,30,30,30,30,30,30,30,31,31,31,31,31,31,31,31,31,31,31,31,31,31,31,31,31,31,31,31,31,31,31,31,31,31,31,31,31,31,31,31,31,31,0,0,0}};

template <class RowMap>
__device__ __forceinline__ void tr_item(const float* W, int ldw, int c0, const float* gain, bf16* WT, int K, LAS float* scr, int kb, int nb, int lane, RowMap rm) {
    const int k0 = 64 * kb, n0 = 32 * nb;
#pragma unroll 8
    for (int i = 0; i < 32; ++i) { const int kk = 2 * i + (lane >> 5); float v = W[(size_t)(k0 + kk) * ldw + c0 + n0 + (lane & 31)]; if (gain) v *= gain[k0 + kk]; scr[kk * 33 + (lane & 31)] = v; }
    LDS_WAIT(); asm volatile("" ::: "memory");
    const int c = lane & 7;
#pragma unroll
    for (int j = 0; j < 4; ++j) { const int n = (lane >> 3) + 8 * j; const LAS float* s = scr + (8 * c) * 33 + n;
        u32x4 o; o.x = pk2(s[0 * 33], s[1 * 33]); o.y = pk2(s[2 * 33], s[3 * 33]); o.z = pk2(s[4 * 33], s[5 * 33]); o.w = pk2(s[6 * 33], s[7 * 33]);
        *(u32x4*)(WT + (size_t)rm(n0 + n) * K + k0 + 8 * c) = o; }
    LDS_WAIT(); asm volatile("" ::: "memory");
}
struct RmId { int off; __device__ __forceinline__ int operator()(int n) const { return off + n; } };
struct RmGate { __device__ __forceinline__ int operator()(int n) const { return (n >> 7) * 256 + (n & 127); } };
struct RmUp { __device__ __forceinline__ int operator()(int n) const { return (n >> 7) * 256 + 128 + (n & 127); } };

__device__ __forceinline__ void phase_weights(const Ctx& c, const Params& p, int l) {
    LAS float* scr = (LAS float*)(c.lds + c.wave * 16384);
    const int gw = c.vcu * 8 + c.wave, NGW = c.G * 8;
    const float* w_in = p.in[I_W_IN] + (size_t)l * D * NIN;
    constexpr int N1 = 16 * 64, N2 = 16 * 104, N3 = 16 * 96, N4 = 8 * 32, N5 = 12 * 32, N6 = 8 * 32, N7 = 16 * 32, N8 = 16 * 16, N9 = 16 * 32, N10 = 8 * 32, NE = 16 * 16, NDN = 8 * 32;
    constexpr int NITEMS = N1 + N2 + N3 + N4 + N5 + N6 + N7 + N8 + N9 + N10 + 16 * NE * 2 + 16 * NDN;
    for (int it = gw; it < NITEMS; it += NGW) {
        int r = it;
        if (r < N1) { tr_item(w_in, NIN, 0, p.in[I_NORM_MIX] + l * D, wsp<bf16>(c, OFF_WIN1), D, scr, r / 64, r % 64, c.lane, RmId{0}); continue; } r -= N1;
        if (r < N2) { tr_item(w_in, NIN, 2056, p.in[I_NORM_MIX] + l * D, wsp<bf16>(c, OFF_WIN1), D, scr, r / 104, r % 104, c.lane, RmId{2048}); continue; } r -= N2;
        if (r < N3) { tr_item(w_in, NIN, 5384, p.in[I_NORM_MIX] + l * D, wsp<bf16>(c, OFF_WG), D, scr, r / 96, r % 96, c.lane, RmId{0}); continue; } r -= N3;
        if (r < N4) { tr_item(p.in[I_WBA] + (size_t)l * 512 * 1024, 1024, 0, nullptr, wsp<bf16>(c, OFF_WA), 512, scr, r / 32, r % 32, c.lane, RmId{0}); continue; } r -= N4;
        if (r < N5) { tr_item(p.in[I_WBB] + (size_t)l * 768 * 1024, 1024, 0, nullptr, wsp<bf16>(c, OFF_WB), 768, scr, r / 32, r % 32, c.lane, RmId{0}); continue; } r -= N5;
        if (r < N6) { tr_item(p.in[I_WBC] + (size_t)l * 512 * 1024, 1024, 0, nullptr, wsp<bf16>(c, OFF_WC), 512, scr, r / 32, r % 32, c.lane, RmId{0}); continue; } r -= N6;
        if (r < N7) { tr_item(p.in[I_WOUT] + (size_t)l * 1024 * 1024, 1024, 0, nullptr, wsp<bf16>(c, OFF_WOUT), 1024, scr, r / 32, r % 32, c.lane, RmId{0}); continue; } r -= N7;
        if (r < N8) { tr_item(p.in[I_WXQ] + (size_t)l * 1024 * 512, 512, 0, p.in[I_NORM_XATTN] + l * D, wsp<bf16>(c, OFF_WXQ), 1024, scr, r / 16, r % 16, c.lane, RmId{0}); continue; } r -= N8;
        if (r < N9) { tr_item(p.in[I_WXKV] + (size_t)l * 1024 * 1024, 1024, 0, p.in[I_NORM_MEM] + l * D, wsp<bf16>(c, OFF_WXKV), 1024, scr, r / 32, r % 32, c.lane, RmId{0}); continue; } r -= N9;
        if (r < N10) { tr_item(p.in[I_WXO] + (size_t)l * 512 * 1024, 1024, 0, nullptr, wsp<bf16>(c, OFF_WXO), 512, scr, r / 32, r % 32, c.lane, RmId{0}); continue; } r -= N10;
        if (r < 16 * NE) { const int e = r / NE, rr = r % NE; tr_item(p.in[I_EG] + ((size_t)l * 16 + e) * 1024 * 512, 512, 0, p.in[I_NORM_FFN] + l * D, wsp<bf16>(c, OFF_WGU) + (size_t)e * 1024 * 1024, 1024, scr, rr / 16, rr % 16, c.lane, RmGate{}); continue; } r -= 16 * NE;
        if (r < 16 * NE) { const int e = r / NE, rr = r % NE; tr_item(p.in[I_EU] + ((size_t)l * 16 + e) * 1024 * 512, 512, 0, p.in[I_NORM_FFN] + l * D, wsp<bf16>(c, OFF_WGU) + (size_t)e * 1024 * 1024, 1024, scr, rr / 16, rr % 16, c.lane, RmUp{}); continue; } r -= 16 * NE;
        { const int e = r / NDN, rr = r % NDN; tr_item(p.in[I_ED] + ((size_t)l * 16 + e) * 512 * 1024, 1024, 0, nullptr, wsp<bf16>(c, OFF_WD) + (size_t)e * 1024 * 512, 512, scr, rr / 32, rr % 32, c.lane, RmId{0}); }
    }
}

__device__ __forceinline__ void row_norm_store(f32x4 (&v)[4], bf16* xbrow, int lane) {
    float s = 0.f;
#pragma unroll
    for (int j = 0; j < 4; ++j) s += (v[j].x * v[j].x + v[j].y * v[j].y) + (v[j].z * v[j].z + v[j].w * v[j].w);
    const float rs = 1.f / sqrtf(wave_sum(s) * (1.f / D) + EPS);
    unsigned long long* o8 = (unsigned long long*)xbrow + lane;
#pragma unroll
    for (int j = 0; j < 4; ++j) { v[j] = v[j] * rs; o8[64 * j] = (unsigned long long)pk2(v[j].x, v[j].y) | ((unsigned long long)pk2(v[j].z, v[j].w) << 32); }
}
__device__ __forceinline__ void row_gates(const f32x4 (&v)[4], const LAS float* W8, const float* gate_b, float* gates_row, int lane) {
    float a[8];
#pragma unroll
    for (int q = 0; q < 8; ++q) a[q] = 0.f;
#pragma unroll 1
    for (int j = 0; j < 4; ++j)
#pragma unroll
        for (int i = 0; i < 4; ++i) { const int k = 256 * j + 4 * lane + i; const f32x4 w0 = *(const LAS f32x4*)(W8 + k * 8), w1 = *(const LAS f32x4*)(W8 + k * 8 + 4); const float x = v[j][i];
            a[0] += x * w0.x; a[1] += x * w0.y; a[2] += x * w0.z; a[3] += x * w0.w; a[4] += x * w1.x; a[5] += x * w1.y; a[6] += x * w1.z; a[7] += x * w1.w; }
#pragma unroll
    for (int q = 0; q < 8; ++q) a[q] = wave_sum(a[q]);
    if (lane == 0) {
#pragma unroll
        for (int q = 0; q < 8; ++q) gates_row[q] = a[q] + gate_b[q]; }
}
__device__ __forceinline__ void load_w8(const Ctx& c, const Params& p, int l) {
    LAS float* W8 = (LAS float*)c.lds; const float* w_in = p.in[I_W_IN] + (size_t)l * D * NIN; const float* g = p.in[I_NORM_MIX] + l * D;
    for (int idx = c.tid; idx < D * 8; idx += 512) { const int k = idx >> 3, q = idx & 7; W8[idx] = w_in[(size_t)k * NIN + 2048 + q] * g[k]; }
    __syncthreads();
}
__device__ __forceinline__ void phase_rp0_input(const Ctx& c, const Params& p) {
    load_w8(c, p, 0);
    const int gw = c.vcu * 8 + c.wave, NGW = c.G * 8;
    const float* x = p.in[I_X];
    for (int m = gw; m < M; m += NGW) {
        f32x4 v[4]; const f32x4* xr = (const f32x4*)(x + (size_t)m * D) + c.lane;
#pragma unroll
        for (int j = 0; j < 4; ++j) v[j] = xr[64 * j];
        row_norm_store(v, wsp<bf16>(c, WS_XB) + (size_t)m * D, c.lane);
        row_gates(v, (const LAS float*)c.lds, p.in[I_GATE_B], wsp<float>(c, OFF_GATES) + (size_t)m * 8, c.lane);
    }
    const float* mem = p.in[I_MEM];
    for (int m = gw; m < MM; m += NGW) {
        f32x4 v[4]; const f32x4* xr = (const f32x4*)(mem + (size_t)m * D) + c.lane;
#pragma unroll
        for (int j = 0; j < 4; ++j) v[j] = xr[64 * j];
        row_norm_store(v, wsp<bf16>(c, OFF_MEMB) + (size_t)m * D, c.lane);
    }
    if (c.bx == 0) { float* bt = wsp<float>(c, OFF_BIAS); const float* rb = p.in[I_REL_BIAS];
        for (int idx = c.tid; idx < 12 * 132; idx += 512) { const int h = idx / 132, dist = idx % 132; bt[idx] = rb[(int)REL_BUCKET[h >> 2][dist] * 12 + h]; } }
}
__device__ __forceinline__ void phase_rp1(const Ctx& c, const float* X) {
    const int gw = c.vcu * 8 + c.wave, NGW = c.G * 8;
    for (int m = gw; m < M; m += NGW) {
        f32x4 v[4]; const f32x4* xr = (const f32x4*)(X + (size_t)m * D) + c.lane;
#pragma unroll
        for (int j = 0; j < 4; ++j) v[j] = xr[64 * j];
        row_norm_store(v, wsp<bf16>(c, WS_XB) + (size_t)m * D, c.lane);
    }
}
__device__ __forceinline__ void phase_rp2_route(const Ctx& c, const Params& p, int l, const float* X) {
    LAS float* RW = (LAS float*)c.lds;
    { const float* rw = p.in[I_ROUTER_W]; const float* g = p.in[I_NORM_FFN] + l * D;
      for (int idx = c.tid; idx < D * 16; idx += 512) RW[idx] = rw[idx] * g[idx >> 4];
      __syncthreads(); }
    const int gw = c.vcu * 8 + c.wave, NGW = c.G * 8;
    unsigned* cnt = wsp<unsigned>(c, WS_CTL) + CW_CNT + 32 * l;
    const float* rbias = p.in[I_ROUTER_B];
    for (int m = gw; m < M; m += NGW) {
        f32x4 v[4]; const f32x4* xr = (const f32x4*)(X + (size_t)m * D) + c.lane;
#pragma unroll
        for (int j = 0; j < 4; ++j) v[j] = xr[64 * j];
        row_norm_store(v, wsp<bf16>(c, WS_XB) + (size_t)m * D, c.lane);
        float a[16];
#pragma unroll
        for (int q = 0; q < 16; ++q) a[q] = 0.f;
#pragma unroll 1
        for (int j = 0; j < 4; ++j)
#pragma unroll
            for (int i = 0; i < 4; ++i) { const int k = 256 * j + 4 * c.lane + i; const float x = v[j][i];
#pragma unroll
                for (int qq = 0; qq < 4; ++qq) { const f32x4 w = *(const LAS f32x4*)(RW + k * 16 + 4 * qq); a[4 * qq] += x * w.x; a[4 * qq + 1] += x * w.y; a[4 * qq + 2] += x * w.z; a[4 * qq + 3] += x * w.w; } }
        float mx = -3.0e38f;
#pragma unroll
        for (int q = 0; q < 16; ++q) { a[q] = wave_sum(a[q]) + rbias[q]; mx = fmaxf(mx, a[q]); }
#pragma unroll
        for (int q = 0; q < 16; ++q) a[q] = __expf(a[q] - mx);
        float bs = -1.f, p1 = 0.f, p2 = 0.f; int e1 = 0, e2 = 1;
#pragma unroll
        for (int g = 0; g < 4; ++g) {
            const float q0 = a[4 * g], q1 = a[4 * g + 1], q2 = a[4 * g + 2], q3 = a[4 * g + 3];
            int i1 = 0; float m1 = q0; if (q1 > m1) { m1 = q1; i1 = 1; } if (q2 > m1) { m1 = q2; i1 = 2; } if (q3 > m1) { m1 = q3; i1 = 3; }
            int i2 = -1; float m2 = -1.f;
            if (i1 != 0 && q0 > m2) { m2 = q0; i2 = 0; } if (i1 != 1 && q1 > m2) { m2 = q1; i2 = 1; } if (i1 != 2 && q2 > m2) { m2 = q2; i2 = 2; } if (i1 != 3 && q3 > m2) { m2 = q3; i2 = 3; }
            const float sc = m1 + m2;
            if (sc > bs) { bs = sc; e1 = 4 * g + i1; e2 = 4 * g + i2; p1 = m1; p2 = m2; }
        }
        if (c.lane == 0) {
            const float inv = 1.f / (p1 + p2);
            const unsigned pos1 = __hip_atomic_fetch_add(cnt + e1, 1u, RLX_AGENT), pos2 = __hip_atomic_fetch_add(cnt + e2, 1u, RLX_AGENT);
            int* te = wsp<int>(c, OFF_TOKE) + 2 * m; int* tp = wsp<int>(c, OFF_TOKP) + 2 * m; float* tw = wsp<float>(c, OFF_TOKW) + 2 * m;
            te[0] = e1; te[1] = e2; tp[0] = (int)pos1; tp[1] = (int)pos2; tw[0] = p1 * inv; tw[1] = p2 * inv;
        }
    }
}
__device__ __forceinline__ void moe_tables(const Ctx& c, int l) {
    LAS int* tab = (LAS int*)(c.lds + LDS_TAB);
    if (c.tid == 0) {
        const unsigned* cnt = wsp<unsigned>(c, WS_CTL) + CW_CNT + 32 * l; int t = 0;
        for (int e = 0; e < 16; ++e) { const int n = (int)__hip_atomic_load(cnt + e, RLX_AGENT); const int nt = (n + 255) >> 8; tab[160 + e] = t * 256; for (int i = 0; i < nt && t < MAXT; ++i) tab[t++] = e; }
        tab[176] = t;
    }
    __syncthreads();
}
__device__ __forceinline__ void phase_gather(const Ctx& c, int l) {
    moe_tables(c, l);
    const LAS int* tab = (const LAS int*)(c.lds + LDS_TAB);
    const int gw = c.vcu * 8 + c.wave, NGW = c.G * 8;
    const int* te = wsp<int>(c, OFF_TOKE); const int* tp = wsp<int>(c, OFF_TOKP); const float* tw = wsp<float>(c, OFF_TOKW);
    int* slot = wsp<int>(c, OFF_SLOT); float* wrow = wsp<float>(c, OFF_WROW);
    const bf16* XB = wsp<bf16>(c, WS_XB); bf16* XG = wsp<bf16>(c, OFF_XG);
    for (int it = gw; it < 2 * M; it += NGW) {
        const int m = it >> 1; const int e = te[it], s = tab[160 + e] + tp[it];
        const u32x4* src = (const u32x4*)(XB + (size_t)m * D) + c.lane; u32x4* dst = (u32x4*)(XG + (size_t)s * D) + c.lane;
        dst[0] = src[0]; dst[64] = src[64];
        if (c.lane == 0) { slot[it] = s; wrow[s] = tw[it]; }
    }
}
template <bool NEXT>
__device__ __forceinline__ void phase_combine(const Ctx& c, const Params& p, int l, const float* Xsrc, float* Xdst) {
    if (NEXT) load_w8(c, p, l + 1);
    const int gw = c.vcu * 8 + c.wave, NGW = c.G * 8;
    const int* slot = wsp<int>(c, OFF_SLOT); const bf16* YE = wsp<bf16>(c, OFF_XG);
    for (int m = gw; m < M; m += NGW) {
        const int s0 = slot[2 * m], s1 = slot[2 * m + 1];
        f32x4 v[4]; const f32x4* xr = (const f32x4*)(Xsrc + (size_t)m * D) + c.lane;
        const u32x2* y0 = (const u32x2*)(YE + (size_t)s0 * D) + c.lane; const u32x2* y1 = (const u32x2*)(YE + (size_t)s1 * D) + c.lane;
#pragma unroll
        for (int j = 0; j < 4; ++j) { const u32x2 a = y0[64 * j], b = y1[64 * j]; v[j] = xr[64 * j];
            v[j].x = (v[j].x + bflo(a.x)) + bflo(b.x); v[j].y = (v[j].y + bfhi(a.x)) + bfhi(b.x); v[j].z = (v[j].z + bflo(a.y)) + bflo(b.y); v[j].w = (v[j].w + bfhi(a.y)) + bfhi(b.y); }
        f32x4* xo = (f32x4*)(Xdst + (size_t)m * D) + c.lane;
#pragma unroll
        for (int j = 0; j < 4; ++j) xo[64 * j] = v[j];
        if (NEXT) {
            row_norm_store(v, wsp<bf16>(c, WS_XB) + (size_t)m * D, c.lane);
            row_gates(v, (const LAS float*)c.lds, p.in[I_GATE_B] + 8 * (l + 1), wsp<float>(c, OFF_GATES) + (size_t)m * 8, c.lane);
        }
    }
}
__device__ __forceinline__ void gate_scan(const Ctx& c, int bh) {
    const int b = bh >> 2, h = bh & 3, lane = c.lane;
    const float* G = wsp<float>(c, OFF_GATES) + (size_t)b * SEQ * 8;
    float* Aa = wsp<float>(c, OFF_AMA) + bh * SEQ; float* Am = wsp<float>(c, OFF_AMM) + bh * SEQ; float* Ab = wsp<float>(c, OFF_AMB) + bh * SEQ;
    const int t0 = lane * 64;
    float s = 0.f;
    for (int i = 0; i < 64; ++i) { const float f = G[(size_t)(t0 + i) * 8 + 4 + h]; s += fminf(f, 0.f) - log1pf(__expf(-fabsf(f))); }
    float incl = s;
#pragma unroll
    for (int o = 1; o < 64; o <<= 1) { const float t = __shfl_up(incl, o); if (lane >= o) incl += t; }
    float Bc = incl - s;
    float mxl = -3.0e38f;
    for (int i = 0; i < 64; ++i) { const float f = G[(size_t)(t0 + i) * 8 + 4 + h]; Bc += fminf(f, 0.f) - log1pf(__expf(-fabsf(f))); const float a = G[(size_t)(t0 + i) * 8 + h] - Bc; Ab[t0 + i] = Bc; Aa[t0 + i] = a; mxl = fmaxf(mxl, a); }
    float inm = mxl;
#pragma unroll
    for (int o = 1; o < 64; o <<= 1) { const float t = __shfl_up(inm, o); if (lane >= o) inm = fmaxf(inm, t); }
    float run = __shfl_up(inm, 1); if (lane == 0) run = 0.f; run = fmaxf(run, 0.f);
    for (int i = 0; i < 64; ++i) { run = fmaxf(run, Aa[t0 + i]); Am[t0 + i] = run; }
}

template <int MT, int NT>
__device__ __forceinline__ void mma_ab(f32x4 (&acc)[MT][NT], const LAS bf16* A, int lda, const LAS bf16* Bt, int ldb, int K, int lane) {
    const int r = lane & 15, q = lane >> 4;
    for (int k0 = 0; k0 < K; k0 += 32) {
        bf16x8 a[MT], b[NT];
#pragma unroll
        for (int mt = 0; mt < MT; ++mt) a[mt] = *(const LAS bf16x8*)(A + (16 * mt + r) * lda + k0 + 8 * q);
#pragma unroll
        for (int nt = 0; nt < NT; ++nt) b[nt] = *(const LAS bf16x8*)(Bt + (16 * nt + r) * ldb + k0 + 8 * q);
#pragma unroll
        for (int mt = 0; mt < MT; ++mt)
#pragma unroll
            for (int nt = 0; nt < NT; ++nt) acc[mt][nt] = __builtin_amdgcn_mfma_f32_16x16x32_bf16(a[mt], b[nt], acc[mt][nt], 0, 0, 0);
    }
}
template <int MT, int NT> __device__ __forceinline__ void zero_acc(f32x4 (&acc)[MT][NT]) {
#pragma unroll
    for (int mt = 0; mt < MT; ++mt)
#pragma unroll
        for (int nt = 0; nt < NT; ++nt) acc[mt][nt] = (f32x4){0.f, 0.f, 0.f, 0.f};
}
__device__ __forceinline__ float red16_sum(float v) { v += __shfl_xor(v, 1); v += __shfl_xor(v, 2); v += __shfl_xor(v, 4); v += __shfl_xor(v, 8); return v; }
__device__ __forceinline__ float red16_max(float v) { v = fmaxf(v, __shfl_xor(v, 1)); v = fmaxf(v, __shfl_xor(v, 2)); v = fmaxf(v, __shfl_xor(v, 4)); v = fmaxf(v, __shfl_xor(v, 8)); return v; }

constexpr int LS = 136;

__device__ __forceinline__ void conv_silu8(const bf16* projb, int t, int col, const float* cw, float (&o)[8]) {
#pragma unroll
    for (int i = 0; i < 8; ++i) o[i] = 0.f;
#pragma unroll
    for (int jj = 0; jj < 4; ++jj) { const int tt = t - 3 + jj;
        if (tt >= 0) { float x[8]; unpack8(*(const u32x4*)(projb + (size_t)tt * PP + col), x); const f32x4 w0 = *(const f32x4*)(cw + jj * 1024), w1 = *(const f32x4*)(cw + jj * 1024 + 4);
            o[0] += w0.x * x[0]; o[1] += w0.y * x[1]; o[2] += w0.z * x[2]; o[3] += w0.w * x[3]; o[4] += w1.x * x[4]; o[5] += w1.y * x[5]; o[6] += w1.z * x[6]; o[7] += w1.w * x[7]; } }
#pragma unroll
    for (int i = 0; i < 8; ++i) o[i] = siluf_(o[i]);
}

__device__ __forceinline__ void mlstm_delta_unit(const Ctx& c, const Params& p, int l, int bh, int j) {
    const int b = bh >> 2, h = bh & 3, tid = c.tid, lane = c.lane, w = c.wave;
    LAS bf16* vT = (LAS bf16*)c.lds; LAS bf16* kT = vT + 128 * LS;
    const bf16* projb = wsp<bf16>(c, WS_PROJ) + (size_t)b * SEQ * PP;
    const float* Aa = wsp<float>(c, OFF_AMA) + bh * SEQ + LCH * j; const float Mend = wsp<float>(c, OFF_AMM)[bh * SEQ + LCH * j + LCH - 1];
    const float* cw = p.in[I_CONV] + (size_t)l * 4 * 1024 + 512 + h * 128;
    for (int it = tid; it < 2048; it += 512) {
        const int r = it >> 4, c8 = (it & 15) * 8, t = LCH * j + r;
        float x[8]; unpack8(*(const u32x4*)(projb + (size_t)t * PP + C_MV + h * 128 + c8), x);
#pragma unroll
        for (int i = 0; i < 8; ++i) vT[(c8 + i) * LS + r] = (bf16)f2bf(x[i]);
        float k[8]; conv_silu8(projb, t, C_MK + h * 128 + c8, cw + c8, k);
        const float wgt = __expf(Aa[r] - Mend) * 0.08838834764831845f;
#pragma unroll
        for (int i = 0; i < 8; ++i) kT[(c8 + i) * LS + r] = (bf16)f2bf(k[i] * wgt);
    }
    __syncthreads();
    f32x4 acc[1][8]; zero_acc(acc);
    mma_ab<1, 8>(acc, vT + 16 * w * LS, LS, kT, LS, 128, lane);
    float* st = wsp<float>(c, WS_T) + (size_t)(bh * NCH + j) * (128 * 128);
    const int r16 = lane & 15, q = lane >> 4;
#pragma unroll
    for (int nt = 0; nt < 8; ++nt)
#pragma unroll
        for (int i = 0; i < 4; ++i) st[(16 * w + 4 * q + i) * 128 + 16 * nt + r16] = acc[0][nt][i];
    if (tid < 128) { float s = 0.f; for (int r = 0; r < 128; ++r) s += bf2f(kT[tid * LS + r]); wsp<float>(c, OFF_NST)[(bh * NCH + j) * 128 + tid] = s; }
    __syncthreads();
}
__device__ __forceinline__ void mlstm_scan(const Ctx& c) {
    constexpr int EL = 128 * 128 + 128;
    const int gt = c.vcu * 512 + c.tid, NT = c.G * 512;
    for (int idx = gt; idx < 16 * EL; idx += NT) {
        const int bh = idx / EL, el = idx % EL;
        const float* Am = wsp<float>(c, OFF_AMM) + bh * SEQ;
        float cs = 0.f, Mprev = 0.f;
        for (int j = 0; j < NCH; ++j) {
            const float Mend = Am[LCH * j + LCH - 1]; const float g = __expf(Mprev - Mend); Mprev = Mend;
            float* ptr = el < 16384 ? wsp<float>(c, WS_T) + (size_t)(bh * NCH + j) * 16384 + el : wsp<float>(c, OFF_NST) + (bh * NCH + j) * 128 + (el - 16384);
            cs = g * cs + *ptr; *ptr = cs;
        }
    }
}
__device__ __forceinline__ void mlstm_out_unit(const Ctx& c, const Params& p, int l, int bh, int j) {
    const int b = bh >> 2, h = bh & 3, tid = c.tid, lane = c.lane, w = c.wave, r16 = lane & 15, q = lane >> 4;
    LAS bf16* qS = (LAS bf16*)c.lds; LAS bf16* kk = qS + 128 * LS; LAS bf16* vT = kk + 128 * LS; LAS bf16* CTb = vT + 128 * LS;
    LAS float* fa = (LAS float*)(CTb + 144 * LS); LAS float* fM = fa + 128; LAS float* fB = fM + 128;
    bf16* projb = wsp<bf16>(c, WS_PROJ) + (size_t)b * SEQ * PP;
    const float* cwq = p.in[I_CONV] + (size_t)l * 4 * 1024 + h * 128; const float* cwk = cwq + 512;
    for (int it = tid; it < 2048; it += 512) {
        const int r = it >> 4, c8 = (it & 15) * 8, t = LCH * j + r;
        float x[8]; unpack8(*(const u32x4*)(projb + (size_t)t * PP + C_MV + h * 128 + c8), x);
#pragma unroll
        for (int i = 0; i < 8; ++i) vT[(c8 + i) * LS + r] = (bf16)f2bf(x[i]);
        float k[8]; conv_silu8(projb, t, C_MK + h * 128 + c8, cwk + c8, k);
#pragma unroll
        for (int i = 0; i < 8; ++i) k[i] *= 0.08838834764831845f;
        *(LAS u32x4*)(kk + r * LS + c8) = pack8(k);
        float qq[8]; conv_silu8(projb, t, C_MQ + h * 128 + c8, cwq + c8, qq);
        *(LAS u32x4*)(qS + r * LS + c8) = pack8(qq);
        const int e = r;
        float s8[8];
        if (j > 0) { const float* st = wsp<float>(c, WS_T) + (size_t)(bh * NCH + j - 1) * 16384 + e * 128 + c8; const f32x4 s0 = *(const f32x4*)st, s1 = *(const f32x4*)(st + 4);
            s8[0] = s0.x; s8[1] = s0.y; s8[2] = s0.z; s8[3] = s0.w; s8[4] = s1.x; s8[5] = s1.y; s8[6] = s1.z; s8[7] = s1.w; }
        else {
#pragma unroll
            for (int i = 0; i < 8; ++i) s8[i] = 0.f; }
        *(LAS u32x4*)(CTb + e * LS + c8) = pack8(s8);
    }
    if (tid < 256) { const int e = 128 + (tid >> 4), c8 = (tid & 15) * 8; float s8[8];
#pragma unroll
        for (int i = 0; i < 8; ++i) s8[i] = 0.f;
        if (e == 128 && j > 0) { const float* nn = wsp<float>(c, OFF_NST) + (bh * NCH + j - 1) * 128 + c8;
#pragma unroll
            for (int i = 0; i < 8; ++i) s8[i] = nn[i]; }
        *(LAS u32x4*)(CTb + e * LS + c8) = pack8(s8); }
    if (tid < 128) { const int t = bh * SEQ + LCH * j + tid; fa[tid] = wsp<float>(c, OFF_AMA)[t]; fM[tid] = wsp<float>(c, OFF_AMM)[t]; fB[tid] = wsp<float>(c, OFF_AMB)[t]; }
    __syncthreads();
    const float Mprev = j > 0 ? wsp<float>(c, OFF_AMM)[bh * SEQ + LCH * j - 1] : 0.f;
    f32x4 as[1][8], ai[1][9]; zero_acc(as); zero_acc(ai);
    mma_ab<1, 8>(as, qS + 16 * w * LS, LS, kk, LS, 128, lane);
    mma_ab<1, 9>(ai, qS + 16 * w * LS, LS, CTb, LS, 128, lane);
    float Mt[4], winter[4], den[4];
#pragma unroll
    for (int i = 0; i < 4; ++i) { Mt[i] = fM[16 * w + 4 * q + i]; winter[i] = __expf(Mprev - Mt[i]); den[i] = 0.f; }
    __syncthreads();
#pragma unroll
    for (int nt = 0; nt < 8; ++nt) { const int r = 16 * nt + r16; const float ar = fa[r];
#pragma unroll
        for (int i = 0; i < 4; ++i) { const int t = 16 * w + 4 * q + i; const float wg = (r <= t) ? __expf(ar - Mt[i]) : 0.f; const float sw = as[0][nt][i] * wg; den[i] += sw; qS[t * LS + r] = (bf16)f2bf(sw); } }
    f32x4 ao[1][8];
#pragma unroll
    for (int nt = 0; nt < 8; ++nt)
#pragma unroll
        for (int i = 0; i < 4; ++i) ao[0][nt][i] = winter[i] * ai[0][nt][i];
    float dn[4];
#pragma unroll
    for (int i = 0; i < 4; ++i) { const float dintra = red16_sum(den[i]); const float dinter = __shfl(ai[0][8][i], lane & 48); const float dd = dintra + winter[i] * dinter;
        dn[i] = fmaxf(fabsf(dd), __expf(-(fB[16 * w + 4 * q + i] + Mt[i]))); }
    __syncthreads();
    mma_ab<1, 8>(ao, qS + 16 * w * LS, LS, vT, LS, 128, lane);
    const float* gain = p.in[I_MLSTM_NORM] + l * 512 + h * 128;
#pragma unroll
    for (int i = 0; i < 4; ++i) {
        const float inv = 1.f / dn[i]; float ss = 0.f;
#pragma unroll
        for (int nt = 0; nt < 8; ++nt) { ao[0][nt][i] *= inv; ss += ao[0][nt][i] * ao[0][nt][i]; }
        ss = red16_sum(ss); const float rs = 1.f / sqrtf(ss * (1.f / 128.f) + EPS);
        const int t = LCH * j + 16 * w + 4 * q + i; bf16* orow = projb + (size_t)t * PP + C_MO + h * 128;
#pragma unroll
        for (int nt = 0; nt < 8; ++nt) { const int e = 16 * nt + r16; const float og = sigmoidf_(bf2f(orow[e])); orow[e] = (bf16)f2bf(ao[0][nt][i] * rs * gain[e] * og); }
    }
    __syncthreads();
}

__device__ __forceinline__ void dattn_unit(const Ctx& c, const Params& p, int l, int b, int h, int blk) {
    const int tid = c.tid, lane = c.lane, w = c.wave, r16 = lane & 15, q = lane >> 4;
    const int g = h >> 2, dil = g == 0 ? 1 : (g == 1 ? 4 : 16), nb = 32 / dil, res = blk / nb, n = blk % nb;
    constexpr int QS = 72, VS = 296, PS = 168;
    LAS bf16* qn = (LAS bf16*)c.lds; LAS bf16* kn = qn + 128 * QS; LAS bf16* vT = kn + 256 * QS; LAS bf16* Pb = vT + 64 * VS; LAS float* bias = (LAS float*)(Pb + 8 * 16 * PS);
    bf16* projb = wsp<bf16>(c, WS_PROJ) + (size_t)b * SEQ * PP;
    const float* gq = p.in[I_ATTN_QKN] + l * 128; const float* gk = gq + 64;
    for (int it = tid; it < 1024; it += 512) {
        const int i = it >> 3, c8 = (it & 7) * 8; const int pos = (128 * n + i) * dil + res;
        float x[8]; unpack8(*(const u32x4*)(projb + (size_t)pos * PP + C_AQ + h * 64 + c8), x);
        float ss = 0.f;
#pragma unroll
        for (int e = 0; e < 8; ++e) ss += x[e] * x[e];
        ss += __shfl_xor(ss, 1); ss += __shfl_xor(ss, 2); ss += __shfl_xor(ss, 4);
        const float rs = 0.125f / sqrtf(ss * (1.f / 64.f) + EPS);
#pragma unroll
        for (int e = 0; e < 8; ++e) x[e] *= rs * gq[c8 + e];
        *(LAS u32x4*)(qn + i * QS + c8) = pack8(x);
    }
    for (int it = tid; it < 2048; it += 512) {
        const int ki = it >> 3, c8 = (it & 7) * 8; const int s = 128 * (n - 1) + ki;
        float x[8], v[8];
        if (s >= 0) { const int pos = s * dil + res; unpack8(*(const u32x4*)(projb + (size_t)pos * PP + C_AK + h * 64 + c8), x); unpack8(*(const u32x4*)(projb + (size_t)pos * PP + C_AV + h * 64 + c8), v); }
        else {
#pragma unroll
            for (int e = 0; e < 8; ++e) { x[e] = 0.f; v[e] = 0.f; } }
        float ss = 0.f;
#pragma unroll
        for (int e = 0; e < 8; ++e) ss += x[e] * x[e];
        ss += __shfl_xor(ss, 1); ss += __shfl_xor(ss, 2); ss += __shfl_xor(ss, 4);
        const float rs = 1.f / sqrtf(ss * (1.f / 64.f) + EPS);
#pragma unroll
        for (int e = 0; e < 8; ++e) x[e] *= rs * gk[c8 + e];
        *(LAS u32x4*)(kn + ki * QS + c8) = pack8(x);
#pragma unroll
        for (int e = 0; e < 8; ++e) vT[(c8 + e) * VS + ki] = (bf16)f2bf(v[e]);
    }
    for (int it = tid; it < 64 * 40; it += 512) { const int e = it / 40, cc = 256 + it % 40; vT[e * VS + cc] = 0; }
    if (tid < 132) bias[tid] = wsp<float>(c, OFF_BIAS)[h * 132 + tid];
    __syncthreads();
    const int kb = 16 * w;
    f32x4 acc[1][9]; zero_acc(acc);
    mma_ab<1, 9>(acc, qn + 16 * w * QS, QS, kn + kb * QS, QS, 64, lane);
    float mx[4], lsum[4];
#pragma unroll
    for (int i = 0; i < 4; ++i) mx[i] = -3.0e38f;
#pragma unroll
    for (int nt = 0; nt < 9; ++nt)
#pragma unroll
        for (int i = 0; i < 4; ++i) { const int qi = 16 * w + 4 * q + i, ki = kb + 16 * nt + r16, dist = 128 + qi - ki; const bool ok = dist >= 0 && dist <= 128 && (n > 0 || ki >= 128);
            const float lg = ok ? acc[0][nt][i] + bias[ok ? dist : 0] : -3.0e38f; acc[0][nt][i] = lg; mx[i] = fmaxf(mx[i], lg); }
    LAS bf16* Pw = Pb + w * 16 * PS;
#pragma unroll
    for (int i = 0; i < 4; ++i) { mx[i] = red16_max(mx[i]); lsum[i] = 0.f; }
#pragma unroll
    for (int nt = 0; nt < 9; ++nt)
#pragma unroll
        for (int i = 0; i < 4; ++i) { const float lg = acc[0][nt][i]; const float pe = lg > -1.0e38f ? __expf(lg - mx[i]) : 0.f; lsum[i] += pe; Pw[(4 * q + i) * PS + 16 * nt + r16] = (bf16)f2bf(pe); }
#pragma unroll
    for (int i = 0; i < 4; ++i) { lsum[i] = red16_sum(lsum[i]); Pw[(4 * q + i) * PS + 144 + r16] = 0; }
    __syncthreads();
    f32x4 ao[1][4]; zero_acc(ao);
    mma_ab<1, 4>(ao, Pw, PS, vT + kb, VS, 160, lane);
    float* LSE = wsp<float>(c, OFF_LSE);
#pragma unroll
    for (int i = 0; i < 4; ++i) { const int qi = 16 * w + 4 * q + i; const int pos = (128 * n + qi) * dil + res; const float inv = 1.f / lsum[i];
        bf16* orow = projb + (size_t)pos * PP + C_AQ + h * 64;
#pragma unroll
        for (int nt = 0; nt < 4; ++nt) orow[16 * nt + r16] = (bf16)f2bf(ao[0][nt][i] * inv);
        if (r16 == 0) LSE[((size_t)b * SEQ + pos) * 12 + h] = mx[i] + __logf(lsum[i]); }
    __syncthreads();
}
__device__ __forceinline__ void dattn_merge(const Ctx& c) {
    const int gt = c.vcu * 512 + c.tid, NT = c.G * 512;
    const float* LSE = wsp<float>(c, OFF_LSE); bf16* proj = wsp<bf16>(c, WS_PROJ);
    for (int it = gt; it < M * 96; it += NT) {
        const int m = it / 96, rr = it % 96, h = rr >> 3, c8 = (rr & 7) * 8, hg = h & 3;
        const float l0 = LSE[(size_t)m * 12 + hg], l1 = LSE[(size_t)m * 12 + 4 + hg], l2 = LSE[(size_t)m * 12 + 8 + hg], lm = LSE[(size_t)m * 12 + h];
        const float mxx = fmaxf(l0, fmaxf(l1, l2)); const float al = __expf(lm - mxx) / (__expf(l0 - mxx) + __expf(l1 - mxx) + __expf(l2 - mxx));
        u32x4* ptr = (u32x4*)(proj + (size_t)m * PP + C_AQ + h * 64 + c8); float x[8]; unpack8(*ptr, x);
#pragma unroll
        for (int e = 0; e < 8; ++e) x[e] *= al;
        *ptr = pack8(x);
    }
}

__device__ __forceinline__ void gmlp_unit(const Ctx& c, const Params& p, int l, int b, int n, int g) {
    const int tid = c.tid, lane = c.lane, w = c.wave, r16 = lane & 15, q = lane >> 4;
    LAS bf16* Wc = (LAS bf16*)c.lds; LAS bf16* vT = Wc + 128 * LS;
    bf16* projb = wsp<bf16>(c, WS_PROJ) + ((size_t)b * SEQ + 128 * n) * PP;
    const float* ws = p.in[I_GMLP_WS] + ((size_t)l * 4 + g) * 128 * 128; const float* gain = p.in[I_GMLP_NORM] + l * 512 + g * 128; const float* bs = p.in[I_GMLP_BS] + (l * 4 + g) * 128;
    for (int it = tid; it < 2048; it += 512) {
        const int r = it >> 4, c8 = (it & 15) * 8;
        const f32x4 w0 = *(const f32x4*)(ws + r * 128 + c8), w1 = *(const f32x4*)(ws + r * 128 + c8 + 4);
        float wv[8] = {w0.x, w0.y, w0.z, w0.w, w1.x, w1.y, w1.z, w1.w};
#pragma unroll
        for (int e = 0; e < 8; ++e) if (c8 + e > r) wv[e] = 0.f;
        *(LAS u32x4*)(Wc + r * LS + c8) = pack8(wv);
        float x[8]; unpack8(*(const u32x4*)(projb + (size_t)r * PP + C_GV + g * 128 + c8), x);
        float ss = 0.f;
#pragma unroll
        for (int e = 0; e < 8; ++e) { x[e] = gelu_tanh(x[e]); ss += x[e] * x[e]; }
        ss = red16_sum(ss); const float rs = 1.f / sqrtf(ss * (1.f / 128.f) + EPS);
#pragma unroll
        for (int e = 0; e < 8; ++e) vT[(c8 + e) * LS + r] = (bf16)f2bf(x[e] * rs * gain[c8 + e]);
    }
    __syncthreads();
    f32x4 acc[1][8]; zero_acc(acc);
    mma_ab<1, 8>(acc, Wc + 16 * w * LS, LS, vT, LS, 128, lane);
#pragma unroll
    for (int i = 0; i < 4; ++i) { const int t = 16 * w + 4 * q + i; const float bb = bs[t]; bf16* orow = projb + (size_t)t * PP + C_GU + g * 128;
#pragma unroll
        for (int nt = 0; nt < 8; ++nt) { const int cc = 16 * nt + r16; const float u = gelu_tanh(bf2f(orow[cc])); orow[cc] = (bf16)f2bf(u * (acc[0][nt][i] + bb)); } }
    __syncthreads();
}

__device__ __forceinline__ void xattn_unit(const Ctx& c, const Params& p, int l, int b, int h, int tt) {
    const int tid = c.tid, lane = c.lane, w = c.wave, r16 = lane & 15, q = lane >> 4;
    constexpr int VS = 264;
    LAS bf16* kn = (LAS bf16*)c.lds;
    LAS bf16* Pb = kn + 256 * LS;
    const bf16* KV = wsp<bf16>(c, OFF_KV) + (size_t)b * MEML * 1024;
    const float* gq = p.in[I_XATTN_QKN] + l * 256; const float* gk = gq + 128;
    for (int it = tid; it < 4096; it += 512) {
        const int ki = it >> 4, c8 = (it & 15) * 8;
        float x[8]; unpack8(*(const u32x4*)(KV + (size_t)ki * 1024 + h * 128 + c8), x);
        float ss = 0.f;
#pragma unroll
        for (int e = 0; e < 8; ++e) ss += x[e] * x[e];
        ss = red16_sum(ss); const float rs = 1.f / sqrtf(ss * (1.f / 128.f) + EPS);
#pragma unroll
        for (int e = 0; e < 8; ++e) x[e] *= rs * gk[c8 + e];
        *(LAS u32x4*)(kn + ki * LS + c8) = pack8(x);
    }
    const size_t row = (size_t)b * SEQ + 128 * tt + 16 * w + r16;
    const bf16* qrow = wsp<bf16>(c, OFF_Q) + row * 512 + h * 128;
    float qf[4][8]; float ss = 0.f;
#pragma unroll
    for (int ks = 0; ks < 4; ++ks) { unpack8(*(const u32x4*)(qrow + 32 * ks + 8 * q), qf[ks]);
#pragma unroll
        for (int e = 0; e < 8; ++e) ss += qf[ks][e] * qf[ks][e]; }
    ss += __shfl_xor(ss, 16); ss += __shfl_xor(ss, 32);
    const float rsq = 0.08838834764831845f / sqrtf(ss * (1.f / 128.f) + EPS);
    bf16x8 qa[4];
#pragma unroll
    for (int ks = 0; ks < 4; ++ks) {
#pragma unroll
        for (int e = 0; e < 8; ++e) qf[ks][e] *= rsq * gq[32 * ks + 8 * q + e];
        qa[ks] = __builtin_bit_cast(bf16x8, pack8(qf[ks])); }
    __syncthreads();
    f32x4 acc[16];
#pragma unroll
    for (int nt = 0; nt < 16; ++nt) acc[nt] = (f32x4){0.f, 0.f, 0.f, 0.f};
#pragma unroll
    for (int ks = 0; ks < 4; ++ks)
#pragma unroll
        for (int nt = 0; nt < 16; ++nt) { const bf16x8 bfr = *(const LAS bf16x8*)(kn + (16 * nt + r16) * LS + 32 * ks + 8 * q); acc[nt] = __builtin_amdgcn_mfma_f32_16x16x32_bf16(qa[ks], bfr, acc[nt], 0, 0, 0); }
    float mx[4], lsum[4];
#pragma unroll
    for (int i = 0; i < 4; ++i) { float m_ = -3.0e38f;
#pragma unroll
        for (int nt = 0; nt < 16; ++nt) m_ = fmaxf(m_, acc[nt][i]);
        mx[i] = red16_max(m_); lsum[i] = 0.f; }
    __syncthreads();
    LAS bf16* Pw = Pb + w * 16 * VS; LAS bf16* vT = kn;
#pragma unroll
    for (int nt = 0; nt < 16; ++nt)
#pragma unroll
        for (int i = 0; i < 4; ++i) { const float pe = __expf(acc[nt][i] - mx[i]); lsum[i] += pe; Pw[(4 * q + i) * VS + 16 * nt + r16] = (bf16)f2bf(pe); }
#pragma unroll
    for (int i = 0; i < 4; ++i) lsum[i] = red16_sum(lsum[i]);
    for (int it = tid; it < 4096; it += 512) {
        const int ki = it >> 4, c8 = (it & 15) * 8;
        float x[8]; unpack8(*(const u32x4*)(KV + (size_t)ki * 1024 + 512 + h * 128 + c8), x);
#pragma unroll
        for (int e = 0; e < 8; ++e) vT[(c8 + e) * VS + ki] = (bf16)f2bf(x[e]);
    }
    __syncthreads();
    f32x4 ao[1][8]; zero_acc(ao);
    mma_ab<1, 8>(ao, Pw, VS, vT, VS, 256, lane);
    bf16* O = wsp<bf16>(c, OFF_O);
#pragma unroll
    for (int i = 0; i < 4; ++i) { const size_t orow = (size_t)b * SEQ + 128 * tt + 16 * w + 4 * q + i; const float inv = 1.f / lsum[i];
#pragma unroll
        for (int nt = 0; nt < 8; ++nt) O[orow * 512 + h * 128 + 16 * nt + r16] = (bf16)f2bf(ao[0][nt][i] * inv); }
    __syncthreads();
}
enum { PH_W = 0, PH_RP0, PH_GSCAN, PH_A1, PH_KV, PH_MIX1, PH_MIX2, PH_MIX3, PH_GATE, PH_BR0, PH_BR1, PH_BR2, PH_WOUT, PH_RP1, PH_XQ, PH_XA, PH_XO, PH_RP2, PH_GATHER, PH_GU, PH_DOWN, PH_COMB, NPH_LAYER };

template <int PH>
__device__ __forceinline__ void run_phase(const Ctx& c, const Params& p, int l) {
    bf16* const XB = wsp<bf16>(c, WS_XB); bf16* const PROJ = wsp<bf16>(c, WS_PROJ);
    const float* Xin = (l == 0) ? p.in[I_X] : p.out;
    if constexpr (PH == PH_W) phase_weights(c, p, l);
    if constexpr (PH == PH_RP0) { if (l == 0) phase_rp0_input(c, p); }
    if constexpr (PH == PH_GSCAN) { if (c.bx < 16 && c.wave == 0) gate_scan(c, c.bx); }
    if constexpr (PH == PH_A1) { pg8::Gemm g{XB, wsp<bf16>(c, OFF_WIN1), D, D}; pg8::StaticOrder S; S.init(M, PP, c.G, c.bx); epi::Bf16Out E{PROJ, PP};
        pg8::gemm_phase<epi::Bf16Out, pg8::StaticOrder, true>(c.lds, g, S, E); }
    if constexpr (PH == PH_KV) { pg8::Gemm g{wsp<bf16>(c, OFF_MEMB), wsp<bf16>(c, OFF_WXKV), D, D}; pg8::StaticOrder S; S.init(MM, 1024, c.G, c.bx); epi::Bf16Out E{wsp<bf16>(c, OFF_KV), 1024};
        pg8::gemm_phase<epi::Bf16Out, pg8::StaticOrder, true>(c.lds, g, S, E); }
    if constexpr (PH == PH_MIX1) {
        for (int u = c.bx; u < 16 * NCH; u += c.G) mlstm_delta_unit(c, p, l, u / NCH, u % NCH);
        for (int u = c.bx; u < NBATCH * 12 * 32; u += c.G) { const int blk = u & 31, bh = u >> 5; dattn_unit(c, p, l, bh / 12, bh % 12, blk); }
        for (int u = c.bx; u < NBATCH * 32 * 4; u += c.G) gmlp_unit(c, p, l, u >> 7, (u >> 2) & 31, u & 3);
    }
    if constexpr (PH == PH_MIX2) { mlstm_scan(c); dattn_merge(c); }
    if constexpr (PH == PH_MIX3) { for (int u = c.bx; u < 16 * NCH; u += c.G) mlstm_out_unit(c, p, l, u / NCH, u % NCH); }
    if constexpr (PH == PH_GATE) { pg8::Gemm g{XB, wsp<bf16>(c, OFF_WG), D, D}; pg8::StaticOrder S; S.init(M, 3072, c.G, c.bx); epi::SigOut E{PROJ};
        pg8::gemm_phase<epi::SigOut, pg8::StaticOrder, true>(c.lds, g, S, E); }
    if constexpr (PH == PH_BR0) { pg8::StaticOrder S; S.init(M, 1024, c.G, c.bx); pg8::Gemm g{PROJ + C_MO, wsp<bf16>(c, OFF_WA), PP, 512}; epi::BranchOut<0> E{PROJ, wsp<bf16>(c, WS_T), XB};
        pg8::gemm_phase<epi::BranchOut<0>, pg8::StaticOrder, false>(c.lds, g, S, E); }
    if constexpr (PH == PH_BR1) { pg8::StaticOrder S; S.init(M, 1024, c.G, c.bx); pg8::Gemm g{PROJ + C_AQ, wsp<bf16>(c, OFF_WB), PP, 768}; epi::BranchOut<1> E{PROJ, wsp<bf16>(c, WS_T), XB};
        pg8::gemm_phase<epi::BranchOut<1>, pg8::StaticOrder, false>(c.lds, g, S, E); }
    if constexpr (PH == PH_BR2) { pg8::StaticOrder S; S.init(M, 1024, c.G, c.bx); pg8::Gemm g{PROJ + C_GU, wsp<bf16>(c, OFF_WC), PP, 512}; epi::BranchOut<2> E{PROJ, wsp<bf16>(c, WS_T), XB};
        pg8::gemm_phase<epi::BranchOut<2>, pg8::StaticOrder, false>(c.lds, g, S, E); }
    if constexpr (PH == PH_WOUT) { pg8::Gemm g{XB, wsp<bf16>(c, OFF_WOUT), D, D}; pg8::StaticOrder S; S.init(M, 1024, c.G, c.bx); epi::ResidOut E{Xin, p.out};
        pg8::gemm_phase<epi::ResidOut, pg8::StaticOrder, false>(c.lds, g, S, E); }
    if constexpr (PH == PH_RP1) phase_rp1(c, p.out);
    if constexpr (PH == PH_XQ) { pg8::Gemm g{XB, wsp<bf16>(c, OFF_WXQ), D, D}; pg8::StaticOrder S; S.init(M, 512, c.G, c.bx); epi::Bf16Out E{wsp<bf16>(c, OFF_Q), 512};
        pg8::gemm_phase<epi::Bf16Out, pg8::StaticOrder, false>(c.lds, g, S, E); }
    if constexpr (PH == PH_XA) { for (int u = c.bx; u < NBATCH * 4 * 32; u += c.G) xattn_unit(c, p, l, u >> 7, (u >> 5) & 3, u & 31); }
    if constexpr (PH == PH_XO) { pg8::Gemm g{wsp<bf16>(c, OFF_O), wsp<bf16>(c, OFF_WXO), 512, 512}; pg8::StaticOrder S; S.init(M, 1024, c.G, c.bx); epi::ResidOut E{p.out, p.out};
        pg8::gemm_phase<epi::ResidOut, pg8::StaticOrder, false>(c.lds, g, S, E); }
    if constexpr (PH == PH_RP2) phase_rp2_route(c, p, l, p.out);
    if constexpr (PH == PH_GATHER) phase_gather(c, l);
    if constexpr (PH == PH_GU) { moe_tables(c, l); pg8::Gemm g{wsp<bf16>(c, OFF_XG), wsp<bf16>(c, OFF_WGU), D, D}; MoeOrder S{(const LAS int*)(c.lds + LDS_TAB), c.G, c.bx}; epi::GluOut E{wsp<bf16>(c, OFF_HID)};
        pg8::gemm_phase<epi::GluOut, MoeOrder, true>(c.lds, g, S, E); }
    if constexpr (PH == PH_DOWN) { moe_tables(c, l); pg8::Gemm g{wsp<bf16>(c, OFF_HID), wsp<bf16>(c, OFF_WD), DFF, DFF}; MoeOrder S{(const LAS int*)(c.lds + LDS_TAB), c.G, c.bx}; epi::DownOut E{wsp<bf16>(c, OFF_XG), wsp<float>(c, OFF_WROW)};
        pg8::gemm_phase<epi::DownOut, MoeOrder, true>(c.lds, g, S, E); }
    if constexpr (PH == PH_COMB) { if (l + 1 < DEPTH) phase_combine<true>(c, p, l, p.out, p.out); else phase_combine<false>(c, p, l, p.out, p.out); }
}

__device__ __forceinline__ Ctx make_ctx(const Params& p, unsigned char* lds_raw) {
    Ctx c;
    c.lds = (LAS unsigned char*)lds_raw; c.ws = p.ws;
    int tid_ = threadIdx.x, bx = blockIdx.x, G_ = gridDim.x;
    asm volatile("" : "+v"(tid_), "+s"(bx), "+s"(G_));
    c.tid = tid_; c.lane = c.tid & 63; c.wave = __builtin_amdgcn_readfirstlane(c.tid >> 6);
    c.G = G_; c.bx = bx; c.vcu = (c.G % 8 == 0) ? (bx % 8) * (c.G / 8) + bx / 8 : bx;
    return c;
}
#ifndef MK_ONE_LAUNCH
#define MK_ONE_LAUNCH 1
#endif
#if !MK_ONE_LAUNCH
template <int PH>
__global__ void __launch_bounds__(512, 2) phase_kernel(Params p, int l) {
    extern __shared__ __attribute__((aligned(16))) unsigned char lds_raw[];
    const Ctx c = make_ctx(p, lds_raw);
    run_phase<PH>(c, p, l);
}
template <int PH> static void launch_phases(int grid, const Params& a, int l, hipStream_t stream) {
    if constexpr (PH < NPH_LAYER) {
        static bool attr_done = false;
        if (!attr_done) { (void)hipFuncSetAttribute((const void*)phase_kernel<PH>, hipFuncAttributeMaxDynamicSharedMemorySize, LDS_BYTES); attr_done = true; }
        if (!(PH == PH_RP0 && l != 0)) hipLaunchKernelGGL(phase_kernel<PH>, dim3(grid), dim3(512), LDS_BYTES, stream, a, l);
        launch_phases<PH + 1>(grid, a, l, stream);
    }
}
#else
#if defined(__HIP_DEVICE_COMPILE__)
typedef const __attribute__((address_space(4))) Params* KParams;
#else
typedef const Params* KParams;
#endif
template <int PH>
__device__ __forceinline__ void phase_site(KParams kp, int l) {
    extern __shared__ __attribute__((aligned(16))) unsigned char lds_raw[];
    asm volatile("" : "+s"(kp));
    Params p;
#pragma unroll
    for (int i = 0; i < 28; ++i) p.in[i] = kp->in[i];
    p.out = kp->out; p.ws = kp->ws;
    const Ctx c = make_ctx(p, lds_raw);
    run_phase<PH>(c, p, l);
}
__device__ __forceinline__ void seam(KParams kp) {
    extern __shared__ __attribute__((aligned(16))) unsigned char lds_raw[];
    asm volatile("" : "+s"(kp));
    XcdBarrier b; b.bar = (unsigned*)(kp->ws + WS_CTL) + CW_BAR; b.x = xb_xcc_id(); b.st = (volatile LAS unsigned*)((LAS unsigned char*)lds_raw + LDS_MISC) + 8;
    xcd_barrier(b);
}
template <int PH> __device__ __forceinline__ void run_layer(KParams kp, int l) {
    if constexpr (PH < NPH_LAYER) {
        if (!(PH == PH_RP0 && l != 0)) { phase_site<PH>(kp, l); seam(kp); }
        run_layer<PH + 1>(kp, l);
    }
}
__global__ void __launch_bounds__(512, 2) fwd_kernel(Params p) {
    extern __shared__ __attribute__((aligned(16))) unsigned char lds_raw[];
    volatile LAS unsigned* MISC = (volatile LAS unsigned*)((LAS unsigned char*)lds_raw + LDS_MISC);
    for (int u = threadIdx.x; u < (LDS_BYTES - LDS_MISC) / 4; u += 512) MISC[u] = 0u;
    __syncthreads();
    (void)xcd_barrier_post((unsigned*)(p.ws + WS_CTL) + CW_BAR, MISC + 8);
    KParams kp = (KParams)__builtin_amdgcn_kernarg_segment_ptr();
    run_layer<0>(kp, 0);
    run_layer<0>(kp, 1);
    static_assert(DEPTH == 2, "layers are written out");
}
#endif

extern "C" void kernel_launch(void* const* d_in, const int* in_sizes, int n_in, void* d_out, int out_size, void* d_ws, size_t ws_size, hipStream_t stream) {
    static int grid = 0;
    if (grid == 0) {
        if (n_in != 28 || in_sizes[0] != M * D || out_size != M * D || ws_size < WS_END) { fprintf(stderr, "kernel_launch: unexpected shapes (n_in %d, in0 %d, out %d, ws %zu < %zu); nothing launched\n", n_in, n_in > 0 ? in_sizes[0] : -1, out_size, ws_size, (size_t)WS_END); grid = -1; return; }
        int dev = 0, cus = 0;
        if (hipGetDevice(&dev) != hipSuccess || hipDeviceGetAttribute(&cus, hipDeviceAttributeMultiprocessorCount, dev) != hipSuccess) { grid = -1; return; }
#if MK_ONE_LAUNCH
        if (hipFuncSetAttribute((const void*)fwd_kernel, hipFuncAttributeMaxDynamicSharedMemorySize, LDS_BYTES) != hipSuccess) { fprintf(stderr, "kernel_launch: hipFuncSetAttribute failed\n"); grid = -1; return; }
        int per_cu = 0;
        if (hipOccupancyMaxActiveBlocksPerMultiprocessor(&per_cu, (const void*)fwd_kernel, 512, LDS_BYTES) != hipSuccess || per_cu < 1) { fprintf(stderr, "kernel_launch: occupancy query reports %d workgroups per CU\n", per_cu); }
        (void)hipGetLastError();
#endif
        grid = cus;
    }
    if (grid < 0) return;
    if (hipMemsetAsync((char*)d_ws + WS_CTL, 0, CTL_ZERO_BYTES, stream) != hipSuccess) return;
    Params a{};
    for (int i = 0; i < 28; ++i) a.in[i] = (const float*)d_in[i];
    a.out = (float*)d_out; a.ws = (unsigned char*)d_ws;
#if MK_ONE_LAUNCH
    hipLaunchKernelGGL(fwd_kernel, dim3(grid), dim3(512), LDS_BYTES, stream, a);
#else
    for (int l = 0; l < DEPTH; ++l) launch_phases<0>(grid, a, l, stream);
#endif
}
```

```cpp
#include <hip/hip_runtime.h>
#include <cstdio>
#include <cstdint>

#define GAS __attribute__((address_space(1)))
#define LAS __attribute__((address_space(3)))
typedef unsigned short bf16;
typedef short bf16x8 __attribute__((ext_vector_type(8)));
typedef float f32x4 __attribute__((ext_vector_type(4)));
typedef float f32x2 __attribute__((ext_vector_type(2)));
typedef unsigned u32x4 __attribute__((ext_vector_type(4)));
typedef unsigned u32x2 __attribute__((ext_vector_type(2)));

constexpr int D = 1024, NBATCH = 4, SEQ = 4096, M = NBATCH * SEQ, DEPTH = 2, MEML = 256, MM = NBATCH * MEML;
constexpr int NIN = 8456;
constexpr int PP = 5376;
constexpr int C_MQ = 0, C_MK = 512, C_MV = 1024, C_MO = 1536, C_AQ = 2048, C_AK = 2816, C_AV = 3584, C_GU = 4352, C_GV = 4864;
constexpr int NEXP = 16, DFF = 512;
constexpr int LCH = 128, NCH = SEQ / LCH;
constexpr float EPS = 1e-6f;
constexpr int MAXT = 144;

constexpr size_t MiB = 1u << 20;
constexpr size_t WS_CTL = 0, CTL_ZERO_BYTES = 1 * MiB;
constexpr size_t WS_SMALL = 1 * MiB;
constexpr size_t OFF_GATES = WS_SMALL;
constexpr size_t OFF_AMA = OFF_GATES + (size_t)M * 8 * 4;
constexpr size_t OFF_AMM = OFF_AMA + 16 * SEQ * 4;
constexpr size_t OFF_AMB = OFF_AMM + 16 * SEQ * 4;
constexpr size_t OFF_LSE = OFF_AMB + 16 * SEQ * 4;
constexpr size_t OFF_BIAS = OFF_LSE + (size_t)M * 12 * 4;
constexpr size_t OFF_TOKE = OFF_BIAS + 12 * 132 * 4;
constexpr size_t OFF_TOKP = OFF_TOKE + (size_t)M * 2 * 4;
constexpr size_t OFF_TOKW = OFF_TOKP + (size_t)M * 2 * 4;
constexpr size_t OFF_SLOT = OFF_TOKW + (size_t)M * 2 * 4;
constexpr size_t OFF_WROW = OFF_SLOT + (size_t)M * 2 * 4;
constexpr size_t OFF_NST = OFF_WROW + (size_t)MAXT * 256 * 4;
constexpr size_t OFF_MEMB = OFF_NST + (size_t)16 * NCH * 128 * 4;
constexpr size_t OFF_KV = OFF_MEMB + (size_t)MM * D * 2;
constexpr size_t OFF_CNTW = OFF_KV + (size_t)MM * 1024 * 2;
constexpr size_t OFF_SMALL_END = OFF_CNTW + 256 * 16 * 4;
static_assert(OFF_SMALL_END <= 17 * MiB, "small region");
constexpr size_t WS_W = 17 * MiB;
constexpr size_t OFF_WIN1 = WS_W;
constexpr size_t OFF_WG = OFF_WIN1 + (size_t)5376 * 1024 * 2;
constexpr size_t OFF_WA = OFF_WG + (size_t)3072 * 1024 * 2;
constexpr size_t OFF_WB = OFF_WA + (size_t)1024 * 512 * 2;
constexpr size_t OFF_WC = OFF_WB + (size_t)1024 * 768 * 2;
constexpr size_t OFF_WOUT = OFF_WC + (size_t)1024 * 512 * 2;
constexpr size_t OFF_WXQ = OFF_WOUT + (size_t)1024 * 1024 * 2;
constexpr size_t OFF_WXKV = OFF_WXQ + (size_t)512 * 1024 * 2;
constexpr size_t OFF_WXO = OFF_WXKV + (size_t)1024 * 1024 * 2;
constexpr size_t OFF_WGU = OFF_WXO + (size_t)1024 * 512 * 2;
constexpr size_t OFF_WD = OFF_WGU + (size_t)16 * 1024 * 1024 * 2;
constexpr size_t OFF_W_END = OFF_WD + (size_t)16 * 1024 * 512 * 2;
static_assert(OFF_W_END <= 93 * MiB, "weight region");
constexpr size_t WS_XB = 93 * MiB;
constexpr size_t WS_PROJ = 125 * MiB;
constexpr size_t OFF_XG = WS_PROJ, OFF_HID = WS_PROJ + 72 * MiB;
constexpr size_t WS_T = 293 * MiB;
constexpr size_t OFF_Q = WS_T, OFF_O = WS_T + 16 * MiB;
constexpr size_t WS_END = 327 * MiB;
constexpr int CW_TMO = 0, CW_CODE = 1;
constexpr int CW_CNT = 64;
constexpr int CW_BAR = 4096;

constexpr int LDS_BYTES = 147456;
constexpr int LDS_TAB = 145408;
constexpr int LDS_WOFF = 0;
constexpr int LDS_MISC = 146944;

#define RLX_AGENT __ATOMIC_RELAXED, __HIP_MEMORY_SCOPE_AGENT
#define LDS_WAIT() asm volatile("s_waitcnt lgkmcnt(0)" ::: "memory")
#define VM_WAIT() asm volatile("s_waitcnt vmcnt(0)" ::: "memory")
typedef __bf16 bf16x2_t __attribute__((ext_vector_type(2)));
__device__ __forceinline__ unsigned pk2(float lo, float hi) { const f32x2 v = {lo, hi}; return __builtin_bit_cast(unsigned, __builtin_convertvector(v, bf16x2_t)); }
__device__ __forceinline__ unsigned f2bf(float f) { return pk2(f, 0.f) & 0xffffu; }
__device__ __forceinline__ float bf2f(unsigned h) { return __builtin_bit_cast(float, h << 16); }
__device__ __forceinline__ float bflo(unsigned w) { return __builtin_bit_cast(float, w << 16); }
__device__ __forceinline__ float bfhi(unsigned w) { return __builtin_bit_cast(float, w & 0xffff0000u); }
__device__ __forceinline__ float wave_sum(float v) {
#pragma unroll
    for (int o = 1; o < 64; o <<= 1) v += __shfl_xor(v, o);
    return v;
}
__device__ __forceinline__ float sigmoidf_(float x) { return 1.f / (1.f + __expf(-x)); }
__device__ __forceinline__ float siluf_(float x) { return x / (1.f + __expf(-x)); }
__device__ __forceinline__ float gelu_tanh(float x) { const float u = 0.7978845608028654f * (x + 0.044715f * x * x * x); const float t = 1.f - 2.f / (1.f + __expf(2.f * u)); return 0.5f * x * (1.f + t); }
__device__ __forceinline__ void unpack8(const u32x4 w, float (&f)[8]) { f[0] = bflo(w.x); f[1] = bfhi(w.x); f[2] = bflo(w.y); f[3] = bfhi(w.y); f[4] = bflo(w.z); f[5] = bfhi(w.z); f[6] = bflo(w.w); f[7] = bfhi(w.w); }
__device__ __forceinline__ u32x4 pack8(const float (&f)[8]) { u32x4 w; w.x = pk2(f[0], f[1]); w.y = pk2(f[2], f[3]); w.z = pk2(f[4], f[5]); w.w = pk2(f[6], f[7]); return w; }

namespace pg8 {
constexpr int BM = 256, BK = 64, HALF = 128, HTB = HALF * BK * 2  , STAGE_BYTES = 8 * HTB, NXCD = 8, WGM = 8;
__host__ __device__ __forceinline__ int lds_byte(int r, int c) { const int st = (r >> 4) * 2 + (c >> 5), rr = r & 15, cc = c & 31, ob = rr * 64 + cc * 2; return st * 1024 + (ob ^ (((ob >> 9) & 1) << 5)); }
__host__ __device__ __forceinline__ void stage_rc(int b, int& R, int& C) { const int st = b / 1024, sb = b % 1024, swz = sb ^ (((sb >> 9) & 1) << 5); R = (st >> 1) * 16 + swz / 64; C = (st & 1) * 32 + (swz % 64) / 2; }
__host__ __device__ __forceinline__ int perm32(int rho) { const int n = rho >> 4, i = rho & 15; return 8 * (i >> 2) + 4 * n + (i & 3); }

struct Unit { int pm, pn; };
struct Gemm { const bf16* A; const bf16* Bt; int lda, K; };

struct StaticOrder {
    int nM, nN, nwg, G, c;
    __host__ __device__ void init(int M_, int N_, int G_, int c_) { nM = M_ / BM; nN = N_ / BM; nwg = nM * nN; G = G_; c = c_; }
    __host__ __device__ bool next(int i, Unit& u) const {
        const long L = (long)i * G + c; if (L >= nwg) return false;
        int wgid = (int)L; { const int q = nwg / NXCD, r = nwg % NXCD, xcd = wgid % NXCD, off = wgid / NXCD; wgid = (xcd < r ? xcd * (q + 1) : r * (q + 1) + (xcd - r) * q) + off; }
        const int nig = WGM * nN, gid = wgid / nig, fm = gid * WGM, gsz = (nM - fm) < WGM ? (nM - fm) : WGM;
        u.pm = fm + ((wgid % nig) % gsz); u.pn = (wgid % nig) / gsz; return true;
    }
    __device__ __forceinline__ void a_ready(const Unit&) const {}
    __device__ __forceinline__ void done(const Unit&) const {}
};

__device__ __forceinline__ unsigned cvt_pk_bf16(float lo, float hi) { unsigned r; asm volatile("v_cvt_pk_bf16_f32 %0, %1, %2" : "=v"(r) : "v"(lo), "v"(hi)); return r; }


template <class Epi, class Sched, bool ALIGN_EPI = false>
__device__ __forceinline__ void gemm_phase(LAS unsigned char* lds, const Gemm g, const Sched& S, const Epi& E) {
    int tid_ = threadIdx.x; asm volatile("" : "+v"(tid_));
    const int tid = tid_, wid = __builtin_amdgcn_readfirstlane(tid >> 6), lane = tid & 63, wr = wid >> 2, wc = wid & 3, fr = lane & 15, fq = lane >> 4;
    const int K = g.K, nt = K / BK, lda = g.lda;
    unsigned voffA[2], voffB[2];
#pragma unroll
    for (int i = 0; i < 2; ++i) { int R, C; stage_rc(tid * 16 + i * 8192, R, C); const int Rb = Epi::PERM ? ((R & ~31) + perm32(R & 31)) : R;
        voffA[i] = (unsigned)(R * lda + C) * 2u; voffB[i] = (unsigned)(Rb * K + C) * 2u; }
    const size_t kstep = (size_t)(BK * 2);
    const size_t hstepA = (size_t)HALF * lda * 2, hstepB = (size_t)HALF * K * 2;
    const size_t tstepA = 2 * hstepA, tstepB = 2 * hstepB;
    const unsigned ldsw = (unsigned)wid * 1024u;
    const int aoff = lds_byte(wr * 64 + fr, fq * 8), boff = lds_byte(wc * 32 + fr, fq * 8);
#define PG8_SA(b, h) (((b) * 2 + (h)) * HTB)
#define PG8_SB(b, h) ((4 + (b) * 2 + (h)) * HTB)
#define PG8_STAGE(bufoff, gbase, voff) do { _Pragma("unroll") for (int _i = 0; _i < 2; ++_i) \
        __builtin_amdgcn_global_load_lds((const unsigned*)((const char*)(gbase) + (voff)[_i]), (LAS unsigned*)(lds + (bufoff) + ldsw + _i * 8192), 16, 0, 0); } while (0)
#define PG8_LDA(dst, b, h) do { _Pragma("unroll") for (int m = 0; m < 4; ++m) _Pragma("unroll") for (int k = 0; k < 2; ++k) dst[m][k] = *(const LAS bf16x8*)(lds + PG8_SA(b, h) + aoff + m * 2048 + k * 1024); } while (0)
#define PG8_LDB(dst, b, h) do { _Pragma("unroll") for (int n = 0; n < 2; ++n) _Pragma("unroll") for (int k = 0; k < 2; ++k) dst[n][k] = *(const LAS bf16x8*)(lds + PG8_SB(b, h) + boff + n * 2048 + k * 1024); } while (0)
#define PG8_MMA(ai, bj, At, Bt) do { __builtin_amdgcn_s_setprio(1); _Pragma("unroll") for (int m = 0; m < 4; ++m) _Pragma("unroll") for (int n = 0; n < 2; ++n) _Pragma("unroll") for (int k = 0; k < 2; ++k) \
        acc[ai][bj][m][n] = __builtin_amdgcn_mfma_f32_16x16x32_bf16(Bt[n][k], At[m][k], acc[ai][bj][m][n], 0, 0, 0); __builtin_amdgcn_s_setprio(0); } while (0)
#define PG8_WAIT_V(n) asm volatile("s_waitcnt vmcnt(" #n ")" ::: "memory")
#define PG8_WAIT_L(n) asm volatile("s_waitcnt lgkmcnt(" #n ")" ::: "memory")
#define PG8_BAR __builtin_amdgcn_s_barrier()
#define PG8_SCHED __builtin_amdgcn_sched_barrier(0)
    Unit cur, nxt; int ui = 0;
    if (!S.next(0, cur)) return;
    f32x4 acc[2][2][4][2];
#pragma unroll
    for (int a = 0; a < 2; ++a)
#pragma unroll
        for (int b = 0; b < 2; ++b)
#pragma unroll
            for (int m = 0; m < 4; ++m)
#pragma unroll
                for (int n = 0; n < 2; ++n) acc[a][b][m][n] = (f32x4){0.f, 0.f, 0.f, 0.f};
    bf16x8 At[4][2], B0[2][2], B1[2][2];
    const char* cA = (const char*)g.A + (size_t)cur.pm * tstepA; const char* cB = (const char*)g.Bt + (size_t)cur.pn * tstepB;
    S.a_ready(cur);
    PG8_STAGE(PG8_SB(0, 0), cB, voffB); PG8_STAGE(PG8_SB(0, 1), cB + hstepB, voffB); PG8_STAGE(PG8_SA(0, 0), cA, voffA); PG8_STAGE(PG8_SA(0, 1), cA + hstepA, voffA);
    if (wr == 1) PG8_BAR;
    PG8_WAIT_V(2); PG8_BAR;
    PG8_STAGE(PG8_SB(1, 0), cB + kstep, voffB); PG8_STAGE(PG8_SA(1, 0), cA + kstep, voffA); PG8_STAGE(PG8_SB(1, 1), cB + hstepB + kstep, voffB);
    PG8_WAIT_V(6); PG8_BAR;
    for (;;) {
        const bool has_next = S.next(ui + 1, nxt);
        const char* nA = has_next ? (const char*)g.A + (size_t)nxt.pm * tstepA : cA; const char* nB = has_next ? (const char*)g.Bt + (size_t)nxt.pn * tstepB : cB;
        for (int t = 0; t < nt; t += 2) {
            const bool last = (t == nt - 2);
            const char* a1 = cA + (size_t)(t + 1) * kstep;
            const char* a2 = last ? nA : cA + (size_t)(t + 2) * kstep; const char* b2 = last ? nB : cB + (size_t)(t + 2) * kstep;
            const char* a3 = a2 + kstep; const char* b3 = b2 + kstep;
            if (last && has_next) S.a_ready(nxt);
            PG8_LDB(B0, 0, 0); PG8_LDB(B1, 0, 1); PG8_SCHED; PG8_LDA(At, 0, 0); PG8_STAGE(PG8_SA(1, 1), a1 + hstepA, voffA);
            PG8_WAIT_V(8); PG8_WAIT_L(0); PG8_BAR; PG8_MMA(0, 0, At, B0); PG8_MMA(0, 1, At, B1); PG8_BAR; PG8_SCHED;
            PG8_LDA(At, 0, 1); PG8_STAGE(PG8_SB(0, 0), b2, voffB); PG8_STAGE(PG8_SB(0, 1), b2 + hstepB, voffB); PG8_STAGE(PG8_SA(0, 0), a2, voffA);
            PG8_WAIT_V(8); PG8_WAIT_L(0); PG8_BAR; PG8_MMA(1, 0, At, B0); PG8_MMA(1, 1, At, B1); PG8_BAR; PG8_SCHED;
            PG8_LDB(B0, 1, 0); PG8_LDB(B1, 1, 1); PG8_SCHED; PG8_LDA(At, 1, 0); PG8_STAGE(PG8_SA(0, 1), a2 + hstepA, voffA);
            PG8_WAIT_V(8); PG8_WAIT_L(0); PG8_BAR; PG8_MMA(0, 0, At, B0); PG8_MMA(0, 1, At, B1); PG8_BAR; PG8_SCHED;
            PG8_LDA(At, 1, 1); PG8_STAGE(PG8_SB(1, 0), b3, voffB); PG8_STAGE(PG8_SB(1, 1), b3 + hstepB, voffB); PG8_STAGE(PG8_SA(1, 0), a3, voffA);
            PG8_WAIT_V(8); PG8_WAIT_L(0); PG8_BAR; PG8_MMA(1, 0, At, B0); PG8_MMA(1, 1, At, B1); PG8_BAR; PG8_SCHED;
        }
        if constexpr (ALIGN_EPI) { if (wr == 0) PG8_BAR; }
        E(acc, cur, wr, wc, fr, fq); S.done(cur);
        if (!has_next) break;
#pragma unroll
        for (int a = 0; a < 2; ++a)
#pragma unroll
            for (int b = 0; b < 2; ++b)
#pragma unroll
                for (int m = 0; m < 4; ++m)
#pragma unroll
                    for (int n = 0; n < 2; ++n) acc[a][b][m][n] = (f32x4){0.f, 0.f, 0.f, 0.f};
        cur = nxt; cA = nA; cB = nB; ++ui;
        if constexpr (ALIGN_EPI) { if (wr == 1) PG8_BAR; }
    }
    PG8_WAIT_V(0);
    if constexpr (!ALIGN_EPI) { if (wr == 0) PG8_BAR; }
    PG8_BAR;
#undef PG8_SA
#undef PG8_SB
#undef PG8_STAGE
#undef PG8_LDA
#undef PG8_LDB
#undef PG8_MMA
#undef PG8_WAIT_V
#undef PG8_WAIT_L
#undef PG8_BAR
#undef PG8_SCHED
}
}

namespace epi {
using pg8::Unit; using pg8::BM; using pg8::HALF; using pg8::cvt_pk_bf16;
__device__ __forceinline__ u32x4 pk8(const f32x4 v0, const f32x4 v1) { u32x4 w; w.x = cvt_pk_bf16(v0[0], v0[1]); w.y = cvt_pk_bf16(v0[2], v0[3]); w.z = cvt_pk_bf16(v1[0], v1[1]); w.w = cvt_pk_bf16(v1[2], v1[3]); return w; }
__device__ __forceinline__ void up8(const u32x4 w, f32x4& a, f32x4& b) { a = (f32x4){bflo(w.x), bfhi(w.x), bflo(w.y), bfhi(w.y)}; b = (f32x4){bflo(w.z), bfhi(w.z), bflo(w.w), bfhi(w.w)}; }
__device__ __forceinline__ int gcol(int tg) { return tg < 6 ? 256 * tg : 2816 + 256 * (tg - 6); }

struct Bf16Out {
    static constexpr bool PERM = true;
    bf16* O; int ldc;
    __device__ __forceinline__ void operator()(const f32x4 (&acc)[2][2][4][2], const Unit& u, int wr, int wc, int fr, int fq) const {
        const int row0 = u.pm * BM + wr * 64 + fr, col0 = u.pn * BM + wc * 32 + 8 * fq;
#pragma unroll
        for (int ai = 0; ai < 2; ++ai)
#pragma unroll
            for (int m = 0; m < 4; ++m) { bf16* rowp = O + (size_t)(row0 + ai * HALF + m * 16) * ldc + col0;
#pragma unroll
                for (int bj = 0; bj < 2; ++bj) *(u32x4*)(rowp + bj * HALF) = pk8(acc[ai][bj][m][0], acc[ai][bj][m][1]); }
    }
};
struct SigOut {
    static constexpr bool PERM = true;
    bf16* PROJ;
    __device__ __forceinline__ void operator()(const f32x4 (&acc)[2][2][4][2], const Unit& u, int wr, int wc, int fr, int fq) const {
        const int row0 = u.pm * BM + wr * 64 + fr, col0 = gcol(u.pn) + wc * 32 + 8 * fq;
#pragma unroll
        for (int ai = 0; ai < 2; ++ai)
#pragma unroll
            for (int m = 0; m < 4; ++m) { bf16* rowp = PROJ + (size_t)(row0 + ai * HALF + m * 16) * PP + col0;
#pragma unroll
                for (int bj = 0; bj < 2; ++bj) { f32x4 a = acc[ai][bj][m][0], b = acc[ai][bj][m][1];
#pragma unroll
                    for (int e = 0; e < 4; ++e) { a[e] = sigmoidf_(a[e]); b[e] = sigmoidf_(b[e]); }
                    *(u32x4*)(rowp + bj * HALF) = pk8(a, b); } }
    }
};
template <int BR> struct BranchOut {
    static constexpr bool PERM = true;
    const bf16* PROJ; bf16* T; bf16* OUT;
    __device__ __forceinline__ void operator()(const f32x4 (&acc)[2][2][4][2], const Unit& u, int wr, int wc, int fr, int fq) const {
        const int row0 = u.pm * BM + wr * 64 + fr, cw = wc * 32 + 8 * fq, gc0 = gcol(BR * 4 + u.pn) + cw, col0 = u.pn * BM + cw;
#pragma unroll
        for (int ai = 0; ai < 2; ++ai)
#pragma unroll
            for (int m = 0; m < 4; ++m) { const size_t row = (size_t)(row0 + ai * HALF + m * 16);
#pragma unroll
                for (int bj = 0; bj < 2; ++bj) {
                    f32x4 g0, g1; up8(*(const u32x4*)(PROJ + row * PP + gc0 + bj * HALF), g0, g1);
                    f32x4 v0 = g0 * acc[ai][bj][m][0], v1 = g1 * acc[ai][bj][m][1];
                    if (BR > 0) { f32x4 t0, t1; up8(*(const u32x4*)(T + row * 1024 + col0 + bj * HALF), t0, t1); v0 += t0; v1 += t1; }
                    bf16* dst = (BR == 2 ? OUT : T) + row * 1024 + col0 + bj * HALF;
                    *(u32x4*)dst = pk8(v0, v1); } }
    }
};
struct ResidOut {
    static constexpr bool PERM = false;
    const float* SRC; float* DST;
    __device__ __forceinline__ void operator()(const f32x4 (&acc)[2][2][4][2], const Unit& u, int wr, int wc, int fr, int fq) const {
        const int row0 = u.pm * BM + wr * 64 + fr, col0 = u.pn * BM + wc * 32 + 4 * fq;
#pragma unroll
        for (int ai = 0; ai < 2; ++ai)
#pragma unroll
            for (int m = 0; m < 4; ++m) { const size_t off = (size_t)(row0 + ai * HALF + m * 16) * 1024 + col0;
#pragma unroll
                for (int bj = 0; bj < 2; ++bj)
#pragma unroll
                    for (int n = 0; n < 2; ++n) { const size_t o = off + bj * HALF + n * 16; *(f32x4*)(DST + o) = *(const f32x4*)(SRC + o) + acc[ai][bj][m][n]; } }
    }
};
struct GluOut {
    static constexpr bool PERM = true;
    bf16* HID;
    __device__ __forceinline__ void operator()(const f32x4 (&acc)[2][2][4][2], const Unit& u, int wr, int wc, int fr, int fq) const {
        const int row0 = u.pm * BM + wr * 64 + fr, col0 = (u.pn & 3) * 128 + wc * 32 + 8 * fq;
#pragma unroll
        for (int ai = 0; ai < 2; ++ai)
#pragma unroll
            for (int m = 0; m < 4; ++m) { f32x4 a = acc[ai][0][m][0], b = acc[ai][0][m][1]; const f32x4 ua = acc[ai][1][m][0], ub = acc[ai][1][m][1];
#pragma unroll
                for (int e = 0; e < 4; ++e) { a[e] = siluf_(a[e]) * ua[e]; b[e] = siluf_(b[e]) * ub[e]; }
                *(u32x4*)(HID + (size_t)(row0 + ai * HALF + m * 16) * DFF + col0) = pk8(a, b); }
    }
};
struct DownOut {
    static constexpr bool PERM = true;
    bf16* YE; const float* WROW;
    __device__ __forceinline__ void operator()(const f32x4 (&acc)[2][2][4][2], const Unit& u, int wr, int wc, int fr, int fq) const {
        const int row0 = u.pm * BM + wr * 64 + fr, col0 = (u.pn & 3) * BM + wc * 32 + 8 * fq;
#pragma unroll
        for (int ai = 0; ai < 2; ++ai)
#pragma unroll
            for (int m = 0; m < 4; ++m) { const int row = row0 + ai * HALF + m * 16; const float w = WROW[row]; bf16* rowp = YE + (size_t)row * 1024 + col0;
#pragma unroll
                for (int bj = 0; bj < 2; ++bj) *(u32x4*)(rowp + bj * HALF) = pk8(acc[ai][bj][m][0] * w, acc[ai][bj][m][1] * w); }
    }
};
}

struct MoeOrder {
    const LAS int* tab; int G, c;
    __device__ __forceinline__ bool next(int i, pg8::Unit& u) const {
        const int L = i * G + c; const int nT = tab[176]; if (L >= 4 * nT) return false;
        const int pm = L >> 2; u.pm = pm; u.pn = tab[pm] * 4 + (L & 3); return true;
    }
    __device__ __forceinline__ void a_ready(const pg8::Unit&) const {}
    __device__ __forceinline__ void done(const pg8::Unit&) const {}
};
#define XB_TMO      128
#define XB_XCNT(j)  (256  + 64 * (j))
#define XB_XSUB(j)  (1280 + 64 * (j))
#define XB_XGEN(j)  (2304 + 64 * (j))
#define XB_TOP      3328
#define XB_TOPGEN   3392
#define XCD_BAR_WORDS 3456
#define XB_SPIN_CAP (1u << 18)

__device__ __forceinline__ unsigned xb_ld(unsigned* p)              { return __hip_atomic_load(p, __ATOMIC_RELAXED, __HIP_MEMORY_SCOPE_AGENT); }
__device__ __forceinline__ unsigned xb_add(unsigned* p, unsigned v) { return __hip_atomic_fetch_add(p, v, __ATOMIC_RELAXED, __HIP_MEMORY_SCOPE_AGENT); }
__device__ __forceinline__ unsigned xb_xcc_id() { return (unsigned)__builtin_amdgcn_s_getreg((3 << 11) | 20) & 0xFu; }
#define XB_SPIN(cond, bar) do { unsigned _sp = 0; while (cond) { __builtin_amdgcn_s_sleep(1); \
    if ((++_sp & 255u) == 0u) { if (xb_ld(&(bar)[XB_TMO])) break; if (_sp > XB_SPIN_CAP) { atomicAdd(&(bar)[XB_TMO], 1u); break; } } } } while (0)

struct XcdBarrier {
    unsigned* bar; unsigned x;
    volatile LAS unsigned* st;
};

__device__ __forceinline__ XcdBarrier xcd_barrier_post(unsigned* bar, volatile LAS unsigned* st) {
    XcdBarrier b; b.bar = bar; b.x = xb_xcc_id(); b.st = st;
    if (threadIdx.x == 0) (void)xb_add(&bar[XB_XCNT(b.x)], 1u);
    return b;
}
__device__ __forceinline__ void xcd_barrier_complete(unsigned* bar, unsigned x, unsigned& nloc, unsigned& nx) {
    const unsigned G = gridDim.x * gridDim.y * gridDim.z;
    unsigned sum, cnt, mine, sp = 0u;
    for (;;) {
        sum = 0u; cnt = 0u; mine = 0u;
#pragma unroll
        for (unsigned j = 0; j < 16; ++j) { const unsigned c = xb_ld(&bar[XB_XCNT(j)]); sum += c; cnt += (c > 0u) ? 1u : 0u; mine = (j == x) ? c : mine; }
        if (sum == G) break;
        __builtin_amdgcn_s_sleep(1);
        if ((++sp & 255u) == 0u) { if (xb_ld(&bar[XB_TMO])) break; if (sp > XB_SPIN_CAP) { atomicAdd(&bar[XB_TMO], 1u); break; } }
    }
    nloc = mine > 0u ? mine : 1u; nx = cnt > 0u ? cnt : 1u;
}

__device__ __forceinline__ void xcd_barrier(const XcdBarrier& b) {
    asm volatile("s_waitcnt vmcnt(0)" ::: "memory");
    __syncthreads();
    if (threadIdx.x == 0) {
        unsigned* bar = b.bar;
        __builtin_amdgcn_s_waitcnt(0);
        unsigned nloc = b.st[0], nx = b.st[1];
        if (nloc == 0u) { xcd_barrier_complete(bar, b.x, nloc, nx); b.st[0] = nloc; b.st[1] = nx; }
        const unsigned old = xb_add(&bar[XB_XSUB(b.x)], 1u);
        const unsigned gen = old / nloc;
        if (old + 1u == (gen + 1u) * nloc) {
            __builtin_amdgcn_fence(__ATOMIC_RELEASE, "agent");
            asm volatile("s_waitcnt vmcnt(0)" ::: "memory");
            const unsigned og = xb_add(&bar[XB_TOP], 1u);
            const unsigned tg = og / nx;
            if (og + 1u == (tg + 1u) * nx) xb_add(&bar[XB_TOPGEN], 1u);
            else XB_SPIN(xb_ld(&bar[XB_TOPGEN]) == tg, bar);
            __builtin_amdgcn_fence(__ATOMIC_ACQUIRE, "agent");
            xb_add(&bar[XB_XGEN(b.x)], 1u);
            asm volatile("s_waitcnt vmcnt(0)" ::: "memory");
        } else {
            XB_SPIN(xb_ld(&bar[XB_XGEN(b.x)]) == gen, bar);
            __builtin_amdgcn_fence(__ATOMIC_ACQUIRE, "agent");
            asm volatile("s_waitcnt vmcnt(0)" ::: "memory");
        }
    }
    __syncthreads();
}

struct Params { const float* in[28]; float* out; unsigned char* ws; };
enum { I_X = 0, I_MEM, I_NORM_MIX, I_W_IN, I_CONV, I_GATE_B, I_MLSTM_NORM, I_ATTN_QKN, I_GMLP_NORM, I_GMLP_WS, I_GMLP_BS, I_WBA, I_WBB, I_WBC, I_WOUT, I_REL_BIAS,
       I_NORM_XATTN, I_NORM_MEM, I_WXQ, I_WXKV, I_XATTN_QKN, I_WXO, I_NORM_FFN, I_ROUTER_W, I_ROUTER_B, I_EG, I_EU, I_ED };

struct Ctx {
    LAS unsigned char* lds;
    unsigned char* ws;
    int tid, lane, wave, vcu, G, bx;
};
template <class T> __device__ __forceinline__ T* wsp(const Ctx& c, size_t off) { return (T*)(c.ws + off); }

__device__ const unsigned char REL_BUCKET[3][132] = {
  {0,1,2,3,4,5,6,7,8,9,10,11,12,13,14,15,16,16,16,16,16,16,17,17,17,17,17,17,17,17,18,18,18,18,18,18,18,18,18,18,19,19,19,19,19,19,19,19,19,19,19,19,19,19,20,20,20,20,20,20,20,20,20,20,20,20,20,20,20,20,20,20,20,21,21,21,21,21,21,21,21,21,21,21,21,21,21,21,21,21,21,21,21,21,21,21,21,21,21,22,22,22,22,22,22,22,22,22,22,22,22,22,22,22,22,22,22,22,22,22,22,22,22,22,22,22,22,22,22,0,0,0},
  {0,4,8,12,16,16,17,17,18,18,19,19,19,19,20,20,20,20,20,21,21,21,21,21,21,22,22,22,22,22,22,22,22,22,23,23,23,23,23,23,23,23,23,23,23,23,24,24,24,24,24,24,24,24,24,24,24,24,24,24,24,24,25,25,25,25,25,25,25,25,25,25,25,25,25,25,25,25,25,25,25,25,25,26,26,26,26,26,26,26,26,26,26,26,26,26,26,26,26,26,26,26,26,26,26,26,26,26,26,26,26,26,26,27,27,27,27,27,27,27,27,27,27,27,27,27,27,27,27,0,0,0},
  {0,16,18,19,20,21,21,22,22,23,23,23,24,24,24,24,25,25,25,25,25,26,26,26,26,26,26,26,26,27,27,27,27,27,27,27,27,27,27,28,28,28,28,28,28,28,28,28,28,28,28,28,29,29,29,29,29,29,29,29,29,29,29,29,29,29,29,29,29,29,30,30,30,30,30,30,30,30,30,30,30,30,30,30,30,30,30,30,30,30,30,30,30,30,30,31,31,31,31,31,31,31,31,31,31,31,31,31,31,31,31,31,31,31,31,31,31,31,31,31,31,31,31,31,31,31,31,31,31,0,0,0}};

template <class RowMap>
__device__ __forceinline__ void tr_item(const float* W, int ldw, int c0, const float* gain, bf16* WT, int K, LAS float* scr, int kb, int nb, int lane, RowMap rm) {
    const int k0 = 64 * kb, n0 = 32 * nb;
#pragma unroll 8
    for (int i = 0; i < 32; ++i) { const int kk = 2 * i + (lane >> 5); float v = W[(size_t)(k0 + kk) * ldw + c0 + n0 + (lane & 31)]; if (gain) v *= gain[k0 + kk]; scr[kk * 33 + (lane & 31)] = v; }
    LDS_WAIT(); asm volatile("" ::: "memory");
    const int c = lane & 7;
#pragma unroll
    for (int j = 0; j < 4; ++j) { const int n = (lane >> 3) + 8 * j; const LAS float* s = scr + (8 * c) * 33 + n;
        u32x4 o; o.x = pk2(s[0 * 33], s[1 * 33]); o.y = pk2(s[2 * 33], s[3 * 33]); o.z = pk2(s[4 * 33], s[5 * 33]); o.w = pk2(s[6 * 33], s[7 * 33]);
        *(u32x4*)(WT + (size_t)rm(n0 + n) * K + k0 + 8 * c) = o; }
    LDS_WAIT(); asm volatile("" ::: "memory");
}
struct RmId { int off; __device__ __forceinline__ int operator()(int n) const { return off + n; } };
struct RmGate { __device__ __forceinline__ int operator()(int n) const { return (n >> 7) * 256 + (n & 127); } };
struct RmUp { __device__ __forceinline__ int operator()(int n) const { return (n >> 7) * 256 + 128 + (n & 127); } };

__device__ __forceinline__ void phase_weights(const Ctx& c, const Params& p, int l) {
    LAS float* scr = (LAS float*)(c.lds + c.wave * 16384);
    const int gw = c.vcu * 8 + c.wave, NGW = c.G * 8;
    const float* w_in = p.in[I_W_IN] + (size_t)l * D * NIN;
    constexpr int N1 = 16 * 64, N2 = 16 * 104, N3 = 16 * 96, N4 = 8 * 32, N5 = 12 * 32, N6 = 8 * 32, N7 = 16 * 32, N8 = 16 * 16, N9 = 16 * 32, N10 = 8 * 32, NE = 16 * 16, NDN = 8 * 32;
    constexpr int NITEMS = N1 + N2 + N3 + N4 + N5 + N6 + N7 + N8 + N9 + N10 + 16 * NE * 2 + 16 * NDN;
    for (int it = gw; it < NITEMS; it += NGW) {
        int r = it;
        if (r < N1) { tr_item(w_in, NIN, 0, p.in[I_NORM_MIX] + l * D, wsp<bf16>(c, OFF_WIN1), D, scr, r / 64, r % 64, c.lane, RmId{0}); continue; } r -= N1;
        if (r < N2) { tr_item(w_in, NIN, 2056, p.in[I_NORM_MIX] + l * D, wsp<bf16>(c, OFF_WIN1), D, scr, r / 104, r % 104, c.lane, RmId{2048}); continue; } r -= N2;
        if (r < N3) { tr_item(w_in, NIN, 5384, p.in[I_NORM_MIX] + l * D, wsp<bf16>(c, OFF_WG), D, scr, r / 96, r % 96, c.lane, RmId{0}); continue; } r -= N3;
        if (r < N4) { tr_item(p.in[I_WBA] + (size_t)l * 512 * 1024, 1024, 0, nullptr, wsp<bf16>(c, OFF_WA), 512, scr, r / 32, r % 32, c.lane, RmId{0}); continue; } r -= N4;
        if (r < N5) { tr_item(p.in[I_WBB] + (size_t)l * 768 * 1024, 1024, 0, nullptr, wsp<bf16>(c, OFF_WB), 768, scr, r / 32, r % 32, c.lane, RmId{0}); continue; } r -= N5;
        if (r < N6) { tr_item(p.in[I_WBC] + (size_t)l * 512 * 1024, 1024, 0, nullptr, wsp<bf16>(c, OFF_WC), 512, scr, r / 32, r % 32, c.lane, RmId{0}); continue; } r -= N6;
        if (r < N7) { tr_item(p.in[I_WOUT] + (size_t)l * 1024 * 1024, 1024, 0, nullptr, wsp<bf16>(c, OFF_WOUT), 1024, scr, r / 32, r % 32, c.lane, RmId{0}); continue; } r -= N7;
        if (r < N8) { tr_item(p.in[I_WXQ] + (size_t)l * 1024 * 512, 512, 0, p.in[I_NORM_XATTN] + l * D, wsp<bf16>(c, OFF_WXQ), 1024, scr, r / 16, r % 16, c.lane, RmId{0}); continue; } r -= N8;
        if (r < N9) { tr_item(p.in[I_WXKV] + (size_t)l * 1024 * 1024, 1024, 0, p.in[I_NORM_MEM] + l * D, wsp<bf16>(c, OFF_WXKV), 1024, scr, r / 32, r % 32, c.lane, RmId{0}); continue; } r -= N9;
        if (r < N10) { tr_item(p.in[I_WXO] + (size_t)l * 512 * 1024, 1024, 0, nullptr, wsp<bf16>(c, OFF_WXO), 512, scr, r / 32, r % 32, c.lane, RmId{0}); continue; } r -= N10;
        if (r < 16 * NE) { const int e = r / NE, rr = r % NE; tr_item(p.in[I_EG] + ((size_t)l * 16 + e) * 1024 * 512, 512, 0, p.in[I_NORM_FFN] + l * D, wsp<bf16>(c, OFF_WGU) + (size_t)e * 1024 * 1024, 1024, scr, rr / 16, rr % 16, c.lane, RmGate{}); continue; } r -= 16 * NE;
        if (r < 16 * NE) { const int e = r / NE, rr = r % NE; tr_item(p.in[I_EU] + ((size_t)l * 16 + e) * 1024 * 512, 512, 0, p.in[I_NORM_FFN] + l * D, wsp<bf16>(c, OFF_WGU) + (size_t)e * 1024 * 1024, 1024, scr, rr / 16, rr % 16, c.lane, RmUp{}); continue; } r -= 16 * NE;
        { const int e = r / NDN, rr = r % NDN; tr_item(p.in[I_ED] + ((size_t)l * 16 + e) * 512 * 1024, 1024, 0, nullptr, wsp<bf16>(c, OFF_WD) + (size_t)e * 1024 * 512, 512, scr, rr / 32, rr % 32, c.lane, RmId{0}); }
    }
}

__device__ __forceinline__ void row_norm_store(f32x4 (&v)[4], bf16* xbrow, int lane) {
    float s = 0.f;
#pragma unroll
    for (int j = 0; j < 4; ++j) s += (v[j].x * v[j].x + v[j].y * v[j].y) + (v[j].z * v[j].z + v[j].w * v[j].w);
    const float rs = 1.f / sqrtf(wave_sum(s) * (1.f / D) + EPS);
    unsigned long long* o8 = (unsigned long long*)xbrow + lane;
#pragma unroll
    for (int j = 0; j < 4; ++j) { v[j] = v[j] * rs; o8[64 * j] = (unsigned long long)pk2(v[j].x, v[j].y) | ((unsigned long long)pk2(v[j].z, v[j].w) << 32); }
}
__device__ __forceinline__ void row_gates(const f32x4 (&v)[4], const LAS float* W8t, const float* gate_b, float* gates_row, int lane) {
    float a[8];
#pragma unroll
    for (int q = 0; q < 8; ++q) { float s = 0.f;
#pragma unroll
        for (int j = 0; j < 4; ++j) { const f32x4 w = *(const LAS f32x4*)(W8t + q * 1024 + 256 * j + 4 * lane); s += (v[j].x * w.x + v[j].y * w.y) + (v[j].z * w.z + v[j].w * w.w); }
        a[q] = wave_sum(s); if ((q & 3) == 3) __builtin_amdgcn_sched_barrier(0); }
    if (lane == 0) {
#pragma unroll
        for (int q = 0; q < 8; ++q) gates_row[q] = a[q] + gate_b[q]; }
}
__device__ __forceinline__ void load_w8(const Ctx& c, const Params& p, int l) {
    LAS float* W8t = (LAS float*)c.lds; const float* w_in = p.in[I_W_IN] + (size_t)l * D * NIN; const float* g = p.in[I_NORM_MIX] + l * D;
    for (int idx = c.tid; idx < D * 8; idx += 512) { const int k = idx >> 3, q = idx & 7; W8t[q * 1024 + k] = w_in[(size_t)k * NIN + 2048 + q] * g[k]; }
    __syncthreads();
}
__device__ __forceinline__ void phase_rp0_input(const Ctx& c, const Params& p) {
    load_w8(c, p, 0);
    const int gw = c.vcu * 8 + c.wave, NGW = c.G * 8;
    const float* x = p.in[I_X];
    for (int m = gw; m < M; m += NGW) {
        f32x4 v[4]; const f32x4* xr = (const f32x4*)(x + (size_t)m * D) + c.lane;
#pragma unroll
        for (int j = 0; j < 4; ++j) v[j] = xr[64 * j];
        row_norm_store(v, wsp<bf16>(c, WS_XB) + (size_t)m * D, c.lane);
        row_gates(v, (const LAS float*)c.lds, p.in[I_GATE_B], wsp<float>(c, OFF_GATES) + (size_t)m * 8, c.lane);
    }
    const float* mem = p.in[I_MEM];
    for (int m = gw; m < MM; m += NGW) {
        f32x4 v[4]; const f32x4* xr = (const f32x4*)(mem + (size_t)m * D) + c.lane;
#pragma unroll
        for (int j = 0; j < 4; ++j) v[j] = xr[64 * j];
        row_norm_store(v, wsp<bf16>(c, OFF_MEMB) + (size_t)m * D, c.lane);
    }
    if (c.bx == 0) { float* bt = wsp<float>(c, OFF_BIAS); const float* rb = p.in[I_REL_BIAS];
        for (int idx = c.tid; idx < 12 * 132; idx += 512) { const int h = idx / 132, dist = idx % 132; bt[idx] = rb[(int)REL_BUCKET[h >> 2][dist] * 12 + h]; } }
}
__device__ __forceinline__ void phase_rp1(const Ctx& c, const float* X) {
    const int gw = c.vcu * 8 + c.wave, NGW = c.G * 8;
    for (int m = gw; m < M; m += NGW) {
        f32x4 v[4]; const f32x4* xr = (const f32x4*)(X + (size_t)m * D) + c.lane;
#pragma unroll
        for (int j = 0; j < 4; ++j) v[j] = xr[64 * j];
        row_norm_store(v, wsp<bf16>(c, WS_XB) + (size_t)m * D, c.lane);
    }
}
__device__ __forceinline__ void phase_rp2_route(const Ctx& c, const Params& p, int l, const float* X) {
    LAS float* RWt = (LAS float*)c.lds;
    { const float* rw = p.in[I_ROUTER_W]; const float* g = p.in[I_NORM_FFN] + l * D;
      for (int idx = c.tid; idx < D * 16; idx += 512) RWt[(idx & 15) * 1024 + (idx >> 4)] = rw[idx] * g[idx >> 4];
      __syncthreads(); }
    const int gw = c.vcu * 8 + c.wave, NGW = c.G * 8;
    LAS unsigned* lcnt = (LAS unsigned*)(c.lds + LDS_TAB);
    if (c.tid < 16) lcnt[c.tid] = 0u;
    __syncthreads();
    const float* rbias = p.in[I_ROUTER_B];
    for (int m = gw; m < M; m += NGW) {
        f32x4 v[4]; const f32x4* xr = (const f32x4*)(X + (size_t)m * D) + c.lane;
#pragma unroll
        for (int j = 0; j < 4; ++j) v[j] = xr[64 * j];
        row_norm_store(v, wsp<bf16>(c, WS_XB) + (size_t)m * D, c.lane);
        float a[16];
#pragma unroll
        for (int q = 0; q < 16; ++q) { float s = 0.f;
#pragma unroll
            for (int j = 0; j < 4; ++j) { const f32x4 w = *(const LAS f32x4*)(RWt + q * 1024 + 256 * j + 4 * c.lane); s += (v[j].x * w.x + v[j].y * w.y) + (v[j].z * w.z + v[j].w * w.w); }
            a[q] = s; if ((q & 3) == 3) __builtin_amdgcn_sched_barrier(0); }
        float mx = -3.0e38f;
#pragma unroll
        for (int q = 0; q < 16; ++q) { a[q] = wave_sum(a[q]) + rbias[q]; mx = fmaxf(mx, a[q]); }
#pragma unroll
        for (int q = 0; q < 16; ++q) a[q] = __expf(a[q] - mx);
        float bs = -1.f, p1 = 0.f, p2 = 0.f; int e1 = 0, e2 = 1;
#pragma unroll
        for (int g = 0; g < 4; ++g) {
            const float q0 = a[4 * g], q1 = a[4 * g + 1], q2 = a[4 * g + 2], q3 = a[4 * g + 3];
            int i1 = 0; float m1 = q0; if (q1 > m1) { m1 = q1; i1 = 1; } if (q2 > m1) { m1 = q2; i1 = 2; } if (q3 > m1) { m1 = q3; i1 = 3; }
            int i2 = -1; float m2 = -1.f;
            if (i1 != 0 && q0 > m2) { m2 = q0; i2 = 0; } if (i1 != 1 && q1 > m2) { m2 = q1; i2 = 1; } if (i1 != 2 && q2 > m2) { m2 = q2; i2 = 2; } if (i1 != 3 && q3 > m2) { m2 = q3; i2 = 3; }
            const float sc = m1 + m2;
            if (sc > bs) { bs = sc; e1 = 4 * g + i1; e2 = 4 * g + i2; p1 = m1; p2 = m2; }
        }
        if (c.lane == 0) {
            const float inv = 1.f / (p1 + p2);
            const unsigned pos1 = __hip_atomic_fetch_add(lcnt + e1, 1u, __ATOMIC_RELAXED, __HIP_MEMORY_SCOPE_WORKGROUP), pos2 = __hip_atomic_fetch_add(lcnt + e2, 1u, __ATOMIC_RELAXED, __HIP_MEMORY_SCOPE_WORKGROUP);
            int* te = wsp<int>(c, OFF_TOKE) + 2 * m; int* tp = wsp<int>(c, OFF_TOKP) + 2 * m; float* tw = wsp<float>(c, OFF_TOKW) + 2 * m;
            te[0] = e1; te[1] = e2; tp[0] = (int)pos1; tp[1] = (int)pos2; tw[0] = p1 * inv; tw[1] = p2 * inv;
        }
    }
    __syncthreads();
    if (c.tid < 16) wsp<unsigned>(c, OFF_CNTW)[c.vcu * 16 + c.tid] = lcnt[c.tid];
}
template <bool WITH_OFF>
__device__ __forceinline__ void moe_tables(const Ctx& c) {
    LAS int* tab = (LAS int*)(c.lds + LDS_TAB); LAS int* woff = (LAS int*)(c.lds + LDS_WOFF); LAS int* tot = tab + 180;
    const unsigned* cw = wsp<unsigned>(c, OFF_CNTW);
    if (c.tid < 16) { int s = 0;
#pragma unroll 8
        for (int v = 0; v < c.G; ++v) { if (WITH_OFF) woff[v * 16 + c.tid] = s; s += (int)cw[v * 16 + c.tid]; }
        tot[c.tid] = s; }
    __syncthreads();
    if (c.tid == 0) { int t = 0;
        for (int e = 0; e < 16; ++e) { const int nt = (tot[e] + 255) >> 8; tab[160 + e] = t * 256; for (int i = 0; i < nt && t < MAXT; ++i) tab[t++] = e; }
        tab[176] = t; }
    __syncthreads();
}
__device__ __forceinline__ void phase_gather(const Ctx& c, int l) {
    moe_tables<true>(c);
    const LAS int* tab = (const LAS int*)(c.lds + LDS_TAB); const LAS int* woff = (const LAS int*)(c.lds + LDS_WOFF);
    const int gw = c.vcu * 8 + c.wave, NGW = c.G * 8;
    const int* te = wsp<int>(c, OFF_TOKE); const int* tp = wsp<int>(c, OFF_TOKP); const float* tw = wsp<float>(c, OFF_TOKW);
    int* slot = wsp<int>(c, OFF_SLOT); float* wrow = wsp<float>(c, OFF_WROW);
    const bf16* XB = wsp<bf16>(c, WS_XB); bf16* XG = wsp<bf16>(c, OFF_XG);
    for (int it0 = gw * 4; it0 < 2 * M; it0 += NGW * 4) {
        int s[4]; u32x4 r0[4], r1[4];
#pragma unroll
        for (int a = 0; a < 4; ++a) { const int it = it0 + a; const int e = te[it], m_ = it >> 1; s[a] = tab[160 + e] + woff[((m_ % (c.G * 8)) >> 3) * 16 + e] + tp[it];     const u32x4* src = (const u32x4*)(XB + (size_t)(it >> 1) * D) + c.lane; r0[a] = src[0]; r1[a] = src[64]; }
#pragma unroll
        for (int a = 0; a < 4; ++a) { const int it = it0 + a; u32x4* dst = (u32x4*)(XG + (size_t)s[a] * D) + c.lane; dst[0] = r0[a]; dst[64] = r1[a];
            if (c.lane == 0) { slot[it] = s[a]; wrow[s[a]] = tw[it]; } }
    }
}
template <bool NEXT>
__device__ __forceinline__ void phase_combine(const Ctx& c, const Params& p, int l, const float* Xsrc, float* Xdst) {
    if (NEXT) load_w8(c, p, l + 1);
    const int gw = c.vcu * 8 + c.wave, NGW = c.G * 8;
    const int* slot = wsp<int>(c, OFF_SLOT); const bf16* YE = wsp<bf16>(c, OFF_XG);
    for (int m = gw; m < M; m += NGW) {
        const int s0 = slot[2 * m], s1 = slot[2 * m + 1];
        f32x4 v[4]; const f32x4* xr = (const f32x4*)(Xsrc + (size_t)m * D) + c.lane;
        const u32x2* y0 = (const u32x2*)(YE + (size_t)s0 * D) + c.lane; const u32x2* y1 = (const u32x2*)(YE + (size_t)s1 * D) + c.lane;
#pragma unroll
        for (int j = 0; j < 4; ++j) { const u32x2 a = y0[64 * j], b = y1[64 * j]; v[j] = xr[64 * j];
            v[j].x = (v[j].x + bflo(a.x)) + bflo(b.x); v[j].y = (v[j].y + bfhi(a.x)) + bfhi(b.x); v[j].z = (v[j].z + bflo(a.y)) + bflo(b.y); v[j].w = (v[j].w + bfhi(a.y)) + bfhi(b.y); }
        f32x4* xo = (f32x4*)(Xdst + (size_t)m * D) + c.lane;
#pragma unroll
        for (int j = 0; j < 4; ++j) xo[64 * j] = v[j];
        if (NEXT) {
            row_norm_store(v, wsp<bf16>(c, WS_XB) + (size_t)m * D, c.lane);
            row_gates(v, (const LAS float*)c.lds, p.in[I_GATE_B] + 8 * (l + 1), wsp<float>(c, OFF_GATES) + (size_t)m * 8, c.lane);
        }
    }
}
__device__ __forceinline__ void gate_scan(const Ctx& c, int bh) {
    const int b = bh >> 2, h = bh & 3, tid = c.tid, lane = c.lane, w = c.wave;
    LAS float* ws_ = (LAS float*)c.lds;
    const float* G = wsp<float>(c, OFF_GATES) + ((size_t)b * SEQ + 8 * tid) * 8;
    float* Aa = wsp<float>(c, OFF_AMA) + bh * SEQ + 8 * tid; float* Am = wsp<float>(c, OFF_AMM) + bh * SEQ + 8 * tid; float* Ab = wsp<float>(c, OFF_AMB) + bh * SEQ + 8 * tid;
    float lf[8], ip[8];
#pragma unroll
    for (int i = 0; i < 8; ++i) { const float f = G[i * 8 + 4 + h]; ip[i] = G[i * 8 + h]; lf[i] = fminf(f, 0.f) - log1pf(__expf(-fabsf(f))); }
    float s = 0.f;
#pragma unroll
    for (int i = 0; i < 8; ++i) { s += lf[i]; lf[i] = s; }
    float incl = s;
#pragma unroll
    for (int o = 1; o < 64; o <<= 1) { const float t = __shfl_up(incl, o); if (lane >= o) incl += t; }
    if (lane == 63) ws_[w] = incl;
    __syncthreads();
    float base = incl - s;
    for (int ww = 0; ww < w; ++ww) base += ws_[ww];
    float av[8], mxl = -3.0e38f;
#pragma unroll
    for (int i = 0; i < 8; ++i) { const float Bc = base + lf[i]; lf[i] = Bc; av[i] = ip[i] - Bc; mxl = fmaxf(mxl, av[i]); }
    float inm = mxl;
#pragma unroll
    for (int o = 1; o < 64; o <<= 1) { const float t = __shfl_up(inm, o); if (lane >= o) inm = fmaxf(inm, t); }
    if (lane == 63) ws_[8 + w] = inm;
    __syncthreads();
    float run = __shfl_up(inm, 1); if (lane == 0) run = 0.f;
    run = fmaxf(run, 0.f);
    for (int ww = 0; ww < w; ++ww) run = fmaxf(run, ws_[8 + ww]);
    float mv[8];
#pragma unroll
    for (int i = 0; i < 8; ++i) { run = fmaxf(run, av[i]); mv[i] = run; }
    *(f32x4*)(Aa) = (f32x4){av[0], av[1], av[2], av[3]}; *(f32x4*)(Aa + 4) = (f32x4){av[4], av[5], av[6], av[7]};
    *(f32x4*)(Am) = (f32x4){mv[0], mv[1], mv[2], mv[3]}; *(f32x4*)(Am + 4) = (f32x4){mv[4], mv[5], mv[6], mv[7]};
    *(f32x4*)(Ab) = (f32x4){lf[0], lf[1], lf[2], lf[3]}; *(f32x4*)(Ab + 4) = (f32x4){lf[4], lf[5], lf[6], lf[7]};
    __syncthreads();
}

typedef short s16x4 __attribute__((ext_vector_type(4)));
__device__ __forceinline__ s16x4 ds_tr(const LAS bf16* p) { return __builtin_bit_cast(s16x4, __builtin_amdgcn_ds_read_tr16_b64_v4i16((LAS s16x4*)p)); }
__device__ __forceinline__ bf16x8 cat4(const s16x4 lo, const s16x4 hi) { return (bf16x8){lo[0], lo[1], lo[2], lo[3], hi[0], hi[1], hi[2], hi[3]}; }
__device__ __forceinline__ bf16x8 ldsA(const LAS bf16* p) { return *(const LAS bf16x8*)p; }
__device__ __forceinline__ bf16x8 pk8f(const f32x4 a, const f32x4 b) { u32x4 w; w.x = pk2(a[0], a[1]); w.y = pk2(a[2], a[3]); w.z = pk2(b[0], b[1]); w.w = pk2(b[2], b[3]); return __builtin_bit_cast(bf16x8, w); }
#define MFMA16(a, b, c) __builtin_amdgcn_mfma_f32_16x16x32_bf16((a), (b), (c), 0, 0, 0)
__device__ __forceinline__ float red4g_sum(float v) { v += __shfl_xor(v, 16); v += __shfl_xor(v, 32); return v; }
__device__ __forceinline__ float red4g_max(float v) { v = fmaxf(v, __shfl_xor(v, 16)); v = fmaxf(v, __shfl_xor(v, 32)); return v; }
__device__ __forceinline__ float red16_sum(float v) { v += __shfl_xor(v, 1); v += __shfl_xor(v, 2); v += __shfl_xor(v, 4); v += __shfl_xor(v, 8); return v; }
constexpr f32x4 Z4 = {0.f, 0.f, 0.f, 0.f};

constexpr int LS = 136;
constexpr int QS = 72;

__device__ __forceinline__ void conv4_silu(const u32x4 (&x)[7], const float* cw, float (&o)[4][8]) {
    float w[4][8];
#pragma unroll
    for (int jj = 0; jj < 4; ++jj) { const f32x4 w0 = *(const f32x4*)(cw + jj * 1024), w1 = *(const f32x4*)(cw + jj * 1024 + 4);
        w[jj][0] = w0.x; w[jj][1] = w0.y; w[jj][2] = w0.z; w[jj][3] = w0.w; w[jj][4] = w1.x; w[jj][5] = w1.y; w[jj][6] = w1.z; w[jj][7] = w1.w; }
    float xf[7][8];
#pragma unroll
    for (int a = 0; a < 7; ++a) unpack8(x[a], xf[a]);
#pragma unroll
    for (int rr = 0; rr < 4; ++rr)
#pragma unroll
        for (int e = 0; e < 8; ++e) { const float s = (w[0][e] * xf[rr][e] + w[1][e] * xf[rr + 1][e]) + (w[2][e] * xf[rr + 2][e] + w[3][e] * xf[rr + 3][e]); o[rr][e] = siluf_(s); }
}
__device__ __forceinline__ void load7(const bf16* colp, int t0, u32x4 (&x)[7]) {
#pragma unroll
    for (int a = 0; a < 7; ++a) { const int t = t0 - 3 + a; x[a] = (t >= 0) ? *(const u32x4*)(colp + (size_t)t * PP) : (u32x4){0u, 0u, 0u, 0u}; }
}

__device__ __forceinline__ void mlstm_delta_unit(const Ctx& c, const Params& p, int l, int bh, int j) {
    const int b = bh >> 2, h = bh & 3, tid = c.tid, lane = c.lane, w = c.wave, r16 = lane & 15, g = lane >> 4;
    LAS bf16* vv = (LAS bf16*)c.lds; LAS bf16* kw = vv + 128 * LS;
    const bf16* projb = wsp<bf16>(c, WS_PROJ) + (size_t)b * SEQ * PP;
    const float* Aa = wsp<float>(c, OFF_AMA) + bh * SEQ + LCH * j; const float Mend = wsp<float>(c, OFF_AMM)[bh * SEQ + LCH * j + LCH - 1];
    {
        const int rg = tid >> 4, c8 = (tid & 15) * 8, t0 = LCH * j + 4 * rg;
        u32x4 xk[7], xv[4];
        load7(projb + C_MK + h * 128 + c8, t0, xk);
#pragma unroll
        for (int rr = 0; rr < 4; ++rr) xv[rr] = *(const u32x4*)(projb + (size_t)(t0 + rr) * PP + C_MV + h * 128 + c8);
        const f32x4 a4 = *(const f32x4*)(Aa + 4 * rg);
        float k[4][8]; conv4_silu(xk, p.in[I_CONV] + (size_t)l * 4 * 1024 + 512 + h * 128 + c8, k);
#pragma unroll
        for (int rr = 0; rr < 4; ++rr) { const float wgt = __expf(a4[rr] - Mend) * 0.08838834764831845f;
#pragma unroll
            for (int e = 0; e < 8; ++e) k[rr][e] *= wgt;
            *(LAS u32x4*)(kw + (4 * rg + rr) * LS + c8) = pack8(k[rr]); *(LAS u32x4*)(vv + (4 * rg + rr) * LS + c8) = xv[rr]; }
    }
    __syncthreads();
    f32x4 acc[8];
#pragma unroll
    for (int nt = 0; nt < 8; ++nt) acc[nt] = Z4;
    const LAS bf16* ap = vv + (8 * g + (r16 >> 2)) * LS + 16 * w + 4 * (r16 & 3); const LAS bf16* bp = kw + (8 * g + (r16 >> 2)) * LS + 4 * (r16 & 3);
#pragma unroll
    for (int ks = 0; ks < 4; ++ks) { const bf16x8 a = cat4(ds_tr(ap + 32 * ks * LS), ds_tr(ap + (32 * ks + 4) * LS));
#pragma unroll
        for (int nt = 0; nt < 8; ++nt) { const bf16x8 bb = cat4(ds_tr(bp + 32 * ks * LS + 16 * nt), ds_tr(bp + (32 * ks + 4) * LS + 16 * nt)); acc[nt] = MFMA16(a, bb, acc[nt]); } }
    float* st = wsp<float>(c, WS_T) + (size_t)(bh * NCH + j) * (128 * 128);
#pragma unroll
    for (int nt = 0; nt < 8; ++nt)
#pragma unroll
        for (int i = 0; i < 4; ++i) st[(16 * w + 4 * g + i) * 128 + 16 * nt + r16] = acc[nt][i];
    if (tid < 128) { float s = 0.f;
#pragma unroll 8
        for (int r = 0; r < 128; ++r) s += bf2f(kw[r * LS + tid]);
        wsp<float>(c, OFF_NST)[(bh * NCH + j) * 128 + tid] = s; }
    __syncthreads();
}
__device__ __forceinline__ void mlstm_scan(const Ctx& c) {
    constexpr int EL4 = (128 * 128 + 128) / 4;
    const int gt = c.vcu * 512 + c.tid, NT = c.G * 512;
    for (int idx = gt; idx < 16 * EL4; idx += NT) {
        const int bh = idx / EL4, el = idx % EL4;
        const float* Am = wsp<float>(c, OFF_AMM) + bh * SEQ;
        f32x4* base = el < 4096 ? (f32x4*)(wsp<float>(c, WS_T) + (size_t)bh * NCH * 16384) + el : (f32x4*)(wsp<float>(c, OFF_NST) + bh * NCH * 128) + (el - 4096);
        const int stride = el < 4096 ? 4096 : 32;
        f32x4 cs = {0.f, 0.f, 0.f, 0.f}; float Mprev = 0.f;
#pragma unroll 1
        for (int j0 = 0; j0 < NCH; j0 += 8) {
            f32x4 dl[8]; float gg[8];
#pragma unroll
            for (int a = 0; a < 8; ++a) { dl[a] = base[(size_t)(j0 + a) * stride]; const float Mend = Am[LCH * (j0 + a) + LCH - 1]; gg[a] = __expf(Mprev - Mend); Mprev = Mend; }
#pragma unroll
            for (int a = 0; a < 8; ++a) { cs = cs * gg[a] + dl[a]; base[(size_t)(j0 + a) * stride] = cs; }
        }
    }
}
__device__ __forceinline__ void mlstm_out_unit(const Ctx& c, const Params& p, int l, int bh, int j) {
    const int b = bh >> 2, h = bh & 3, tid = c.tid, lane = c.lane, w = c.wave, r16 = lane & 15, g = lane >> 4;
    LAS bf16* qq = (LAS bf16*)c.lds; LAS bf16* kk = qq + 128 * LS; LAS bf16* vv = kk + 128 * LS; LAS bf16* CTb = vv + 128 * LS;
    LAS float* fa = (LAS float*)(CTb + 144 * LS); LAS float* fM = fa + 128; LAS float* fB = fM + 128;
    bf16* projb = wsp<bf16>(c, WS_PROJ) + (size_t)b * SEQ * PP;
    {
        const int rg = tid >> 4, c8 = (tid & 15) * 8, t0 = LCH * j + 4 * rg;
        u32x4 xq[7], xk[7], xv[4];
        load7(projb + C_MQ + h * 128 + c8, t0, xq); load7(projb + C_MK + h * 128 + c8, t0, xk);
#pragma unroll
        for (int rr = 0; rr < 4; ++rr) xv[rr] = *(const u32x4*)(projb + (size_t)(t0 + rr) * PP + C_MV + h * 128 + c8);
        const int e = tid >> 2, d0 = (tid & 3) * 32;
        f32x4 sv[8];
        if (j > 0) { const f32x4* sp = (const f32x4*)(wsp<float>(c, WS_T) + (size_t)(bh * NCH + j - 1) * 16384 + e * 128 + d0);
#pragma unroll
            for (int a = 0; a < 8; ++a) sv[a] = sp[a]; }
        else {
#pragma unroll
            for (int a = 0; a < 8; ++a) sv[a] = Z4; }
        const float* cwq = p.in[I_CONV] + (size_t)l * 4 * 1024 + h * 128 + c8;
        float o[4][8];
        conv4_silu(xq, cwq, o);
#pragma unroll
        for (int rr = 0; rr < 4; ++rr) *(LAS u32x4*)(qq + (4 * rg + rr) * LS + c8) = pack8(o[rr]);
        conv4_silu(xk, cwq + 512, o);
#pragma unroll
        for (int rr = 0; rr < 4; ++rr) {
#pragma unroll
            for (int e2 = 0; e2 < 8; ++e2) o[rr][e2] *= 0.08838834764831845f;
            *(LAS u32x4*)(kk + (4 * rg + rr) * LS + c8) = pack8(o[rr]); *(LAS u32x4*)(vv + (4 * rg + rr) * LS + c8) = xv[rr]; }
#pragma unroll
        for (int a = 0; a < 4; ++a) *(LAS bf16x8*)(CTb + e * LS + d0 + 8 * a) = pk8f(sv[2 * a], sv[2 * a + 1]);
    }
    if (tid < 256) { const int e = 128 + (tid >> 4), c8 = (tid & 15) * 8; float s8[8];
#pragma unroll
        for (int i = 0; i < 8; ++i) s8[i] = 0.f;
        if (e == 128 && j > 0) { const float* nn = wsp<float>(c, OFF_NST) + (bh * NCH + j - 1) * 128 + c8;
#pragma unroll
            for (int i = 0; i < 8; ++i) s8[i] = nn[i]; }
        *(LAS u32x4*)(CTb + e * LS + c8) = pack8(s8); }
    if (tid < 128) { const int t = bh * SEQ + LCH * j + tid; fa[tid] = wsp<float>(c, OFF_AMA)[t]; fM[tid] = wsp<float>(c, OFF_AMM)[t]; fB[tid] = wsp<float>(c, OFF_AMB)[t]; }
    __syncthreads();
    const float Mprev = j > 0 ? wsp<float>(c, OFF_AMM)[bh * SEQ + LCH * j - 1] : 0.f;
    const int tq = 16 * w + r16;
    f32x4 as[8], ai[9];
#pragma unroll
    for (int a = 0; a < 8; ++a) as[a] = Z4;
#pragma unroll
    for (int a = 0; a < 9; ++a) ai[a] = Z4;
#pragma unroll
    for (int ks = 0; ks < 4; ++ks) { const bf16x8 bq = ldsA(qq + tq * LS + 32 * ks + 8 * g);
#pragma unroll
        for (int mt = 0; mt < 8; ++mt) if (mt <= w) as[mt] = MFMA16(ldsA(kk + (16 * mt + r16) * LS + 32 * ks + 8 * g), bq, as[mt]);
#pragma unroll
        for (int et = 0; et < 9; ++et) ai[et] = MFMA16(ldsA(CTb + (16 * et + r16) * LS + 32 * ks + 8 * g), bq, ai[et]);
        __builtin_amdgcn_sched_barrier(0); }
    const float Mt = fM[tq], winter = __expf(Mprev - Mt);
    float den = 0.f;
#pragma unroll
    for (int mt = 0; mt < 8; ++mt)
#pragma unroll
        for (int i = 0; i < 4; ++i) { const int r = 16 * mt + 4 * g + i; const float wg = (mt <= w && r <= tq) ? __expf(fa[r] - Mt) : 0.f; const float sw = as[mt][i] * wg; as[mt][i] = sw; den += sw; }
    den = red4g_sum(den);
    const float dinter = __shfl(ai[8][0], r16);
    const float dd = den + winter * dinter;
    const float dn = fmaxf(fabsf(dd), __expf(-(fB[tq] + Mt)));
    f32x4 ao[8];
#pragma unroll
    for (int et = 0; et < 8; ++et) ao[et] = ai[et] * winter;
    const LAS bf16* vp = vv + (4 * g + (r16 >> 2)) * LS + 4 * (r16 & 3);
#pragma unroll
    for (int ks = 0; ks < 4; ++ks) if (2 * ks <= w) { const bf16x8 bp = pk8f(as[2 * ks], as[2 * ks + 1]);
#pragma unroll
        for (int et = 0; et < 8; ++et) ao[et] = MFMA16(cat4(ds_tr(vp + 32 * ks * LS + 16 * et), ds_tr(vp + (32 * ks + 16) * LS + 16 * et)), bp, ao[et]);
        __builtin_amdgcn_sched_barrier(0); }
    const float inv = 1.f / dn; float ss = 0.f;
#pragma unroll
    for (int et = 0; et < 8; ++et) { ao[et] = ao[et] * inv; ss += (ao[et][0] * ao[et][0] + ao[et][1] * ao[et][1]) + (ao[et][2] * ao[et][2] + ao[et][3] * ao[et][3]); }
    ss = red4g_sum(ss); const float rs = 1.f / sqrtf(ss * (1.f / 128.f) + EPS);
    const float* gain = p.in[I_MLSTM_NORM] + l * 512 + h * 128; bf16* orow = projb + (size_t)(LCH * j + tq) * PP + C_MO + h * 128;
#pragma unroll
    for (int et = 0; et < 8; ++et) { const int e0 = 16 * et + 4 * g; const u32x2 mo = *(const u32x2*)(orow + e0); const f32x4 gn = *(const f32x4*)(gain + e0);
        u32x2 o; o.x = pk2(ao[et][0] * rs * gn[0] * sigmoidf_(bflo(mo.x)), ao[et][1] * rs * gn[1] * sigmoidf_(bfhi(mo.x))); o.y = pk2(ao[et][2] * rs * gn[2] * sigmoidf_(bflo(mo.y)), ao[et][3] * rs * gn[3] * sigmoidf_(bfhi(mo.y)));
        *(u32x2*)(orow + e0) = o; }
    __syncthreads();
}

__device__ __forceinline__ void dattn_unit(const Ctx& c, const Params& p, int l, int b, int h, int blk) {
    const int tid = c.tid, lane = c.lane, w = c.wave, r16 = lane & 15, g = lane >> 4;
    const int grp = h >> 2, dil = grp == 0 ? 1 : (grp == 1 ? 4 : 16), nb = 32 / dil, res = blk / nb, n = blk % nb;
    LAS bf16* kn = (LAS bf16*)c.lds; LAS bf16* vv = kn + 256 * QS; LAS float* bias = (LAS float*)(vv + 272 * QS);
    bf16* projb = wsp<bf16>(c, WS_PROJ) + (size_t)b * SEQ * PP;
    const float* gq = p.in[I_ATTN_QKN] + l * 128; const float* gk = gq + 64;
    {
        const int c8 = (tid & 7) * 8; u32x4 xk[4], xv[4];
#pragma unroll
        for (int a = 0; a < 4; ++a) { const int ki = (tid >> 3) + 64 * a, s = 128 * (n - 1) + ki;
            if (s >= 0) { const size_t pos = (size_t)(s * dil + res); xk[a] = *(const u32x4*)(projb + pos * PP + C_AK + h * 64 + c8); xv[a] = *(const u32x4*)(projb + pos * PP + C_AV + h * 64 + c8); }
            else { xk[a] = (u32x4){0u, 0u, 0u, 0u}; xv[a] = (u32x4){0u, 0u, 0u, 0u}; } }
        const f32x4 g0 = *(const f32x4*)(gk + c8), g1 = *(const f32x4*)(gk + c8 + 4);
#pragma unroll
        for (int a = 0; a < 4; ++a) { const int ki = (tid >> 3) + 64 * a; float x[8]; unpack8(xk[a], x);
            float ss = 0.f;
#pragma unroll
            for (int e = 0; e < 8; ++e) ss += x[e] * x[e];
            ss += __shfl_xor(ss, 1); ss += __shfl_xor(ss, 2); ss += __shfl_xor(ss, 4);
            const float rs = 1.f / sqrtf(ss * (1.f / 64.f) + EPS);
            x[0] *= rs * g0.x; x[1] *= rs * g0.y; x[2] *= rs * g0.z; x[3] *= rs * g0.w; x[4] *= rs * g1.x; x[5] *= rs * g1.y; x[6] *= rs * g1.z; x[7] *= rs * g1.w;
            *(LAS u32x4*)(kn + ki * QS + c8) = pack8(x); *(LAS u32x4*)(vv + ki * QS + c8) = xv[a]; }
        if (tid < 144) *(LAS u32x4*)(vv + 256 * QS + tid * 8) = (u32x4){0u, 0u, 0u, 0u};
        if (tid < 132) bias[tid] = wsp<float>(c, OFF_BIAS)[h * 132 + tid];
    }
    const int qi = 16 * w + r16; const size_t qpos = (size_t)((128 * n + qi) * dil + res);
    bf16* qrow = projb + qpos * PP + C_AQ + h * 64;
    bf16x8 bq[2];
    { float x0[8], x1[8]; unpack8(*(const u32x4*)(qrow + 8 * g), x0); unpack8(*(const u32x4*)(qrow + 32 + 8 * g), x1);
      float ss = 0.f;
#pragma unroll
      for (int e = 0; e < 8; ++e) ss += x0[e] * x0[e] + x1[e] * x1[e];
      ss = red4g_sum(ss); const float rs = 0.125f / sqrtf(ss * (1.f / 64.f) + EPS);
#pragma unroll
      for (int e = 0; e < 8; ++e) { x0[e] *= rs * gq[8 * g + e]; x1[e] *= rs * gq[32 + 8 * g + e]; }
      bq[0] = __builtin_bit_cast(bf16x8, pack8(x0)); bq[1] = __builtin_bit_cast(bf16x8, pack8(x1)); }
    __syncthreads();
    const int kb = 16 * w;
    f32x4 acc[10];
#pragma unroll
    for (int mt = 0; mt < 10; ++mt) acc[mt] = Z4;
#pragma unroll
    for (int ks = 0; ks < 2; ++ks)
#pragma unroll
        for (int mt = 0; mt < 9; ++mt) acc[mt] = MFMA16(ldsA(kn + (kb + 16 * mt + r16) * QS + 32 * ks + 8 * g), bq[ks], acc[mt]);
    float mx = -3.0e38f;
#pragma unroll
    for (int mt = 0; mt < 9; ++mt)
#pragma unroll
        for (int i = 0; i < 4; ++i) { const int ki = kb + 16 * mt + 4 * g + i, dist = 128 + qi - ki; const bool ok = dist >= 0 && dist <= 128 && (n > 0 || ki >= 128);
            const float lg = ok ? acc[mt][i] + bias[ok ? dist : 0] : -3.0e38f; acc[mt][i] = lg; mx = fmaxf(mx, lg); }
    mx = red4g_max(mx);
    float lsum = 0.f;
#pragma unroll
    for (int mt = 0; mt < 9; ++mt)
#pragma unroll
        for (int i = 0; i < 4; ++i) { const float lg = acc[mt][i]; const float pe = lg > -1.0e38f ? __expf(lg - mx) : 0.f; lsum += pe; acc[mt][i] = pe; }
    lsum = red4g_sum(lsum);
    f32x4 ao[4];
#pragma unroll
    for (int et = 0; et < 4; ++et) ao[et] = Z4;
    const LAS bf16* vp = vv + (kb + 4 * g + (r16 >> 2)) * QS + 4 * (r16 & 3);
#pragma unroll
    for (int ks = 0; ks < 5; ++ks) { const bf16x8 bp = pk8f(acc[2 * ks], acc[2 * ks + 1]);
#pragma unroll
        for (int et = 0; et < 4; ++et) ao[et] = MFMA16(cat4(ds_tr(vp + 32 * ks * QS + 16 * et), ds_tr(vp + (32 * ks + 16) * QS + 16 * et)), bp, ao[et]); }
    const float inv = 1.f / lsum;
#pragma unroll
    for (int et = 0; et < 4; ++et) { u32x2 o; o.x = pk2(ao[et][0] * inv, ao[et][1] * inv); o.y = pk2(ao[et][2] * inv, ao[et][3] * inv); *(u32x2*)(qrow + 16 * et + 4 * g) = o; }
    if (g == 0) wsp<float>(c, OFF_LSE)[((size_t)b * SEQ + qpos) * 12 + h] = mx + __logf(lsum);
    __syncthreads();
}
__device__ __forceinline__ void dattn_merge(const Ctx& c) {
    const int gt = c.vcu * 512 + c.tid, NT = c.G * 512;
    const float* LSE = wsp<float>(c, OFF_LSE); bf16* proj = wsp<bf16>(c, WS_PROJ);
    for (int it = gt; it < M * 96; it += NT) {
        const int m = it / 96, rr = it % 96, h = rr >> 3, c8 = (rr & 7) * 8, hg = h & 3;
        const float l0 = LSE[(size_t)m * 12 + hg], l1 = LSE[(size_t)m * 12 + 4 + hg], l2 = LSE[(size_t)m * 12 + 8 + hg], lm = LSE[(size_t)m * 12 + h];
        const float mxx = fmaxf(l0, fmaxf(l1, l2)); const float al = __expf(lm - mxx) / (__expf(l0 - mxx) + __expf(l1 - mxx) + __expf(l2 - mxx));
        u32x4* ptr = (u32x4*)(proj + (size_t)m * PP + C_AQ + h * 64 + c8); float x[8]; unpack8(*ptr, x);
#pragma unroll
        for (int e = 0; e < 8; ++e) x[e] *= al;
        *ptr = pack8(x);
    }
}

__device__ __forceinline__ void gmlp_unit(const Ctx& c, const Params& p, int l, int b, int n, int grp) {
    const int tid = c.tid, lane = c.lane, w = c.wave, r16 = lane & 15, g = lane >> 4;
    LAS bf16* Wc = (LAS bf16*)c.lds; LAS bf16* vn = Wc + 128 * LS;
    bf16* projb = wsp<bf16>(c, WS_PROJ) + ((size_t)b * SEQ + 128 * n) * PP;
    const float* ws = p.in[I_GMLP_WS] + ((size_t)l * 4 + grp) * 128 * 128; const float* gain = p.in[I_GMLP_NORM] + l * 512 + grp * 128; const float* bs = p.in[I_GMLP_BS] + (l * 4 + grp) * 128;
    {
        const int c8 = (tid & 15) * 8; u32x4 xv[4]; f32x4 wv[4][2];
#pragma unroll
        for (int a = 0; a < 4; ++a) { const int r = (tid >> 4) + 32 * a; xv[a] = *(const u32x4*)(projb + (size_t)r * PP + C_GV + grp * 128 + c8); wv[a][0] = *(const f32x4*)(ws + r * 128 + c8); wv[a][1] = *(const f32x4*)(ws + r * 128 + c8 + 4); }
        const f32x4 g0 = *(const f32x4*)(gain + c8), g1 = *(const f32x4*)(gain + c8 + 4);
#pragma unroll
        for (int a = 0; a < 4; ++a) { const int r = (tid >> 4) + 32 * a;
            float wf[8] = {wv[a][0].x, wv[a][0].y, wv[a][0].z, wv[a][0].w, wv[a][1].x, wv[a][1].y, wv[a][1].z, wv[a][1].w};
#pragma unroll
            for (int e = 0; e < 8; ++e) if (c8 + e > r) wf[e] = 0.f;
            *(LAS u32x4*)(Wc + r * LS + c8) = pack8(wf);
            float x[8]; unpack8(xv[a], x); float ss = 0.f;
#pragma unroll
            for (int e = 0; e < 8; ++e) { x[e] = gelu_tanh(x[e]); ss += x[e] * x[e]; }
            ss = red16_sum(ss); const float rs = 1.f / sqrtf(ss * (1.f / 128.f) + EPS);
            x[0] *= rs * g0.x; x[1] *= rs * g0.y; x[2] *= rs * g0.z; x[3] *= rs * g0.w; x[4] *= rs * g1.x; x[5] *= rs * g1.y; x[6] *= rs * g1.z; x[7] *= rs * g1.w;
            *(LAS u32x4*)(vn + r * LS + c8) = pack8(x); }
    }
    __syncthreads();
    const int tq = 16 * w + r16;
    f32x4 acc[8];
#pragma unroll
    for (int ct = 0; ct < 8; ++ct) acc[ct] = Z4;
    const LAS bf16* vp = vn + (8 * g + (r16 >> 2)) * LS + 4 * (r16 & 3);
#pragma unroll
    for (int ks = 0; ks < 4; ++ks) if (32 * ks <= 16 * w + 15) { const bf16x8 bw = ldsA(Wc + tq * LS + 32 * ks + 8 * g);
#pragma unroll
        for (int ct = 0; ct < 8; ++ct) acc[ct] = MFMA16(cat4(ds_tr(vp + 32 * ks * LS + 16 * ct), ds_tr(vp + (32 * ks + 4) * LS + 16 * ct)), bw, acc[ct]); }
    const float bb = bs[tq]; bf16* orow = projb + (size_t)tq * PP + C_GU + grp * 128;
#pragma unroll
    for (int ct = 0; ct < 8; ++ct) { const int c0 = 16 * ct + 4 * g; const u32x2 u = *(const u32x2*)(orow + c0);
        u32x2 o; o.x = pk2(gelu_tanh(bflo(u.x)) * (acc[ct][0] + bb), gelu_tanh(bfhi(u.x)) * (acc[ct][1] + bb)); o.y = pk2(gelu_tanh(bflo(u.y)) * (acc[ct][2] + bb), gelu_tanh(bfhi(u.y)) * (acc[ct][3] + bb));
        *(u32x2*)(orow + c0) = o; }
    __syncthreads();
}

__device__ __forceinline__ void xattn_unit(const Ctx& c, const Params& p, int l, int bh, int tp) {
    const int b = bh >> 2, h = bh & 3, tid = c.tid, lane = c.lane, w = c.wave, r16 = lane & 15, g = lane >> 4;
    LAS bf16* kn = (LAS bf16*)c.lds; LAS bf16* vv = kn + 256 * LS;
    const bf16* KV = wsp<bf16>(c, OFF_KV) + (size_t)b * MEML * 1024;
    const float* gq = p.in[I_XATTN_QKN] + l * 256; const float* gk = gq + 128;
    {
        const int c8 = (tid & 15) * 8; const f32x4 g0 = *(const f32x4*)(gk + c8), g1 = *(const f32x4*)(gk + c8 + 4);
#pragma unroll
        for (int half = 0; half < 2; ++half) { u32x4 xk[4], xv[4];
#pragma unroll
            for (int a = 0; a < 4; ++a) { const int ki = (tid >> 4) + 32 * (4 * half + a); xk[a] = *(const u32x4*)(KV + (size_t)ki * 1024 + h * 128 + c8); xv[a] = *(const u32x4*)(KV + (size_t)ki * 1024 + 512 + h * 128 + c8); }
#pragma unroll
            for (int a = 0; a < 4; ++a) { const int ki = (tid >> 4) + 32 * (4 * half + a); float x[8]; unpack8(xk[a], x); float ss = 0.f;
#pragma unroll
                for (int e = 0; e < 8; ++e) ss += x[e] * x[e];
                ss = red16_sum(ss); const float rs = 1.f / sqrtf(ss * (1.f / 128.f) + EPS);
                x[0] *= rs * g0.x; x[1] *= rs * g0.y; x[2] *= rs * g0.z; x[3] *= rs * g0.w; x[4] *= rs * g1.x; x[5] *= rs * g1.y; x[6] *= rs * g1.z; x[7] *= rs * g1.w;
                *(LAS u32x4*)(kn + ki * LS + c8) = pack8(x); *(LAS u32x4*)(vv + ki * LS + c8) = xv[a]; } }
    }
    __syncthreads();
    const LAS bf16* vp = vv + (4 * g + (r16 >> 2)) * LS + 4 * (r16 & 3);
    for (int tt = 2 * tp; tt < 2 * tp + 2; ++tt) {
        const size_t row = (size_t)b * SEQ + 128 * tt + 16 * w + r16;
        const bf16* qrow = wsp<bf16>(c, OFF_Q) + row * 512 + h * 128;
        bf16x8 bq[4];
        { float qf[4][8]; float ss = 0.f;
#pragma unroll
          for (int ks = 0; ks < 4; ++ks) { unpack8(*(const u32x4*)(qrow + 32 * ks + 8 * g), qf[ks]);
#pragma unroll
              for (int e = 0; e < 8; ++e) ss += qf[ks][e] * qf[ks][e]; }
          ss = red4g_sum(ss); const float rsq = 0.08838834764831845f / sqrtf(ss * (1.f / 128.f) + EPS);
#pragma unroll
          for (int ks = 0; ks < 4; ++ks) {
#pragma unroll
              for (int e = 0; e < 8; ++e) qf[ks][e] *= rsq * gq[32 * ks + 8 * g + e];
              bq[ks] = __builtin_bit_cast(bf16x8, pack8(qf[ks])); } }
        f32x4 acc[16];
#pragma unroll
        for (int mt = 0; mt < 16; ++mt) acc[mt] = Z4;
#pragma unroll
        for (int ks = 0; ks < 4; ++ks) {
#pragma unroll
            for (int mt = 0; mt < 16; ++mt) acc[mt] = MFMA16(ldsA(kn + (16 * mt + r16) * LS + 32 * ks + 8 * g), bq[ks], acc[mt]);
            __builtin_amdgcn_sched_barrier(0); }
        float mx = -3.0e38f;
#pragma unroll
        for (int mt = 0; mt < 16; ++mt) mx = fmaxf(fmaxf(mx, fmaxf(acc[mt][0], acc[mt][1])), fmaxf(acc[mt][2], acc[mt][3]));
        mx = red4g_max(mx);
        float lsum = 0.f;
#pragma unroll
        for (int mt = 0; mt < 16; ++mt)
#pragma unroll
            for (int i = 0; i < 4; ++i) { const float pe = __expf(acc[mt][i] - mx); lsum += pe; acc[mt][i] = pe; }
        lsum = red4g_sum(lsum);
        f32x4 ao[8];
#pragma unroll
        for (int et = 0; et < 8; ++et) ao[et] = Z4;
#pragma unroll
        for (int ks = 0; ks < 8; ++ks) { const bf16x8 bp = pk8f(acc[2 * ks], acc[2 * ks + 1]);
#pragma unroll
            for (int et = 0; et < 8; ++et) ao[et] = MFMA16(cat4(ds_tr(vp + 32 * ks * LS + 16 * et), ds_tr(vp + (32 * ks + 16) * LS + 16 * et)), bp, ao[et]);
            __builtin_amdgcn_sched_barrier(0); }
        const float inv = 1.f / lsum; bf16* orow = wsp<bf16>(c, OFF_O) + row * 512 + h * 128;
#pragma unroll
        for (int et = 0; et < 8; ++et) { u32x2 o; o.x = pk2(ao[et][0] * inv, ao[et][1] * inv); o.y = pk2(ao[et][2] * inv, ao[et][3] * inv); *(u32x2*)(orow + 16 * et + 4 * g) = o; }
    }
    __syncthreads();
}
enum { PH_W = 0, PH_RP0, PH_GSCAN, PH_A1, PH_KV, PH_MIX1, PH_MIX2, PH_MIX3, PH_GATE, PH_BR0, PH_BR1, PH_BR2, PH_WOUT, PH_RP1, PH_XQ, PH_XA, PH_XO, PH_RP2, PH_GATHER, PH_GU, PH_DOWN, PH_COMB, NPH_LAYER };

template <int PH>
__device__ __forceinline__ void run_phase(const Ctx& c, const Params& p, int l) {
    bf16* const XB = wsp<bf16>(c, WS_XB); bf16* const PROJ = wsp<bf16>(c, WS_PROJ);
    const float* Xin = (l == 0) ? p.in[I_X] : p.out;
    if constexpr (PH == PH_W) phase_weights(c, p, l);
    if constexpr (PH == PH_RP0) { if (l == 0) phase_rp0_input(c, p); }
    if constexpr (PH == PH_GSCAN) { if (c.bx < 16) gate_scan(c, c.bx); }
    if constexpr (PH == PH_A1) { pg8::Gemm g{XB, wsp<bf16>(c, OFF_WIN1), D, D}; pg8::StaticOrder S; S.init(M, PP, c.G, c.bx); epi::Bf16Out E{PROJ, PP};
        pg8::gemm_phase<epi::Bf16Out, pg8::StaticOrder, true>(c.lds, g, S, E); }
    if constexpr (PH == PH_KV) { pg8::Gemm g{wsp<bf16>(c, OFF_MEMB), wsp<bf16>(c, OFF_WXKV), D, D}; pg8::StaticOrder S; S.init(MM, 1024, c.G, c.bx); epi::Bf16Out E{wsp<bf16>(c, OFF_KV), 1024};
        pg8::gemm_phase<epi::Bf16Out, pg8::StaticOrder, true>(c.lds, g, S, E); }
    if constexpr (PH == PH_MIX1) {
        for (int u = c.bx; u < 16 * NCH; u += c.G) mlstm_delta_unit(c, p, l, u / NCH, u % NCH);
        for (int u = c.bx; u < NBATCH * 12 * 32; u += c.G) { const int blk = u & 31, bh = u >> 5; dattn_unit(c, p, l, bh / 12, bh % 12, blk); }
        for (int u = c.bx; u < NBATCH * 32 * 4; u += c.G) gmlp_unit(c, p, l, u >> 7, (u >> 2) & 31, u & 3);
    }
    if constexpr (PH == PH_MIX2) { mlstm_scan(c); dattn_merge(c); }
    if constexpr (PH == PH_MIX3) { for (int u = c.bx; u < 16 * NCH; u += c.G) mlstm_out_unit(c, p, l, u / NCH, u % NCH); }
    if constexpr (PH == PH_GATE) { pg8::Gemm g{XB, wsp<bf16>(c, OFF_WG), D, D}; pg8::StaticOrder S; S.init(M, 3072, c.G, c.bx); epi::SigOut E{PROJ};
        pg8::gemm_phase<epi::SigOut, pg8::StaticOrder, true>(c.lds, g, S, E); }
    if constexpr (PH == PH_BR0) { pg8::StaticOrder S; S.init(M, 1024, c.G, c.bx); pg8::Gemm g{PROJ + C_MO, wsp<bf16>(c, OFF_WA), PP, 512}; epi::BranchOut<0> E{PROJ, wsp<bf16>(c, WS_T), XB};
        pg8::gemm_phase<epi::BranchOut<0>, pg8::StaticOrder, false>(c.lds, g, S, E); }
    if constexpr (PH == PH_BR1) { pg8::StaticOrder S; S.init(M, 1024, c.G, c.bx); pg8::Gemm g{PROJ + C_AQ, wsp<bf16>(c, OFF_WB), PP, 768}; epi::BranchOut<1> E{PROJ, wsp<bf16>(c, WS_T), XB};
        pg8::gemm_phase<epi::BranchOut<1>, pg8::StaticOrder, false>(c.lds, g, S, E); }
    if constexpr (PH == PH_BR2) { pg8::StaticOrder S; S.init(M, 1024, c.G, c.bx); pg8::Gemm g{PROJ + C_GU, wsp<bf16>(c, OFF_WC), PP, 512}; epi::BranchOut<2> E{PROJ, wsp<bf16>(c, WS_T), XB};
        pg8::gemm_phase<epi::BranchOut<2>, pg8::StaticOrder, false>(c.lds, g, S, E); }
    if constexpr (PH == PH_WOUT) { pg8::Gemm g{XB, wsp<bf16>(c, OFF_WOUT), D, D}; pg8::StaticOrder S; S.init(M, 1024, c.G, c.bx); epi::ResidOut E{Xin, p.out};
        pg8::gemm_phase<epi::ResidOut, pg8::StaticOrder, false>(c.lds, g, S, E); }
    if constexpr (PH == PH_RP1) phase_rp1(c, p.out);
    if constexpr (PH == PH_XQ) { pg8::Gemm g{XB, wsp<bf16>(c, OFF_WXQ), D, D}; pg8::StaticOrder S; S.init(M, 512, c.G, c.bx); epi::Bf16Out E{wsp<bf16>(c, OFF_Q), 512};
        pg8::gemm_phase<epi::Bf16Out, pg8::StaticOrder, false>(c.lds, g, S, E); }
    if constexpr (PH == PH_XA) { for (int u = c.bx; u < 16 * 16; u += c.G) xattn_unit(c, p, l, u >> 4, u & 15); }
    if constexpr (PH == PH_XO) { pg8::Gemm g{wsp<bf16>(c, OFF_O), wsp<bf16>(c, OFF_WXO), 512, 512}; pg8::StaticOrder S; S.init(M, 1024, c.G, c.bx); epi::ResidOut E{p.out, p.out};
        pg8::gemm_phase<epi::ResidOut, pg8::StaticOrder, false>(c.lds, g, S, E); }
    if constexpr (PH == PH_RP2) phase_rp2_route(c, p, l, p.out);
    if constexpr (PH == PH_GATHER) phase_gather(c, l);
    if constexpr (PH == PH_GU) { moe_tables<false>(c); pg8::Gemm g{wsp<bf16>(c, OFF_XG), wsp<bf16>(c, OFF_WGU), D, D}; MoeOrder S{(const LAS int*)(c.lds + LDS_TAB), c.G, c.bx}; epi::GluOut E{wsp<bf16>(c, OFF_HID)};
        pg8::gemm_phase<epi::GluOut, MoeOrder, true>(c.lds, g, S, E); }
    if constexpr (PH == PH_DOWN) { moe_tables<false>(c); pg8::Gemm g{wsp<bf16>(c, OFF_HID), wsp<bf16>(c, OFF_WD), DFF, DFF}; MoeOrder S{(const LAS int*)(c.lds + LDS_TAB), c.G, c.bx}; epi::DownOut E{wsp<bf16>(c, OFF_XG), wsp<float>(c, OFF_WROW)};
        pg8::gemm_phase<epi::DownOut, MoeOrder, true>(c.lds, g, S, E); }
    if constexpr (PH == PH_COMB) { if (l + 1 < DEPTH) phase_combine<true>(c, p, l, p.out, p.out); else phase_combine<false>(c, p, l, p.out, p.out); }
}

__device__ __forceinline__ Ctx make_ctx(const Params& p, unsigned char* lds_raw) {
    Ctx c;
    c.lds = (LAS unsigned char*)lds_raw; c.ws = p.ws;
    int tid_ = threadIdx.x, bx = blockIdx.x, G_ = gridDim.x;
    asm volatile("" : "+v"(tid_), "+s"(bx), "+s"(G_));
    c.tid = tid_; c.lane = c.tid & 63; c.wave = __builtin_amdgcn_readfirstlane(c.tid >> 6);
    c.G = G_; c.bx = bx; c.vcu = (c.G % 8 == 0) ? (bx % 8) * (c.G / 8) + bx / 8 : bx;
    return c;
}
#ifndef MK_ONE_LAUNCH
#define MK_ONE_LAUNCH 1
#endif
#if !MK_ONE_LAUNCH
template <int PH>
__global__ void __launch_bounds__(512, 2) phase_kernel(Params p, int l) {
    extern __shared__ __attribute__((aligned(16))) unsigned char lds_raw[];
    const Ctx c = make_ctx(p, lds_raw);
    run_phase<PH>(c, p, l);
}
template <int PH> static void launch_phases(int grid, const Params& a, int l, hipStream_t stream) {
    if constexpr (PH < NPH_LAYER) {
        static bool attr_done = false;
        if (!attr_done) { (void)hipFuncSetAttribute((const void*)phase_kernel<PH>, hipFuncAttributeMaxDynamicSharedMemorySize, LDS_BYTES); attr_done = true; }
        if (!(PH == PH_RP0 && l != 0)) hipLaunchKernelGGL(phase_kernel<PH>, dim3(grid), dim3(512), LDS_BYTES, stream, a, l);
        launch_phases<PH + 1>(grid, a, l, stream);
    }
}
#else
#if defined(__HIP_DEVICE_COMPILE__)
typedef const __attribute__((address_space(4))) Params* KParams;
#else
typedef const Params* KParams;
#endif
template <int PH>
__device__ __forceinline__ void phase_site(KParams kp, int l) {
    extern __shared__ __attribute__((aligned(16))) unsigned char lds_raw[];
    asm volatile("" : "+s"(kp));
    Params p;
#pragma unroll
    for (int i = 0; i < 28; ++i) p.in[i] = kp->in[i];
    p.out = kp->out; p.ws = kp->ws;
    const Ctx c = make_ctx(p, lds_raw);
    run_phase<PH>(c, p, l);
}
__device__ __forceinline__ void seam(KParams kp) {
    extern __shared__ __attribute__((aligned(16))) unsigned char lds_raw[];
    asm volatile("" : "+s"(kp));
    XcdBarrier b; b.bar = (unsigned*)(kp->ws + WS_CTL) + CW_BAR; b.x = xb_xcc_id(); b.st = (volatile LAS unsigned*)((LAS unsigned char*)lds_raw + LDS_MISC) + 8;
    xcd_barrier(b);
}
template <int PH> __device__ __forceinline__ void run_layer(KParams kp, int l) {
    if constexpr (PH < NPH_LAYER) {
        if (!(PH == PH_RP0 && l != 0)) {
#ifdef PROBE_AMP
            const unsigned long long t0_ = __builtin_amdgcn_s_memrealtime();
#endif
            phase_site<PH>(kp, l); seam(kp);
#ifdef PROBE_AMP
            if ((PROBE_AMP >> PH) & 1) { const unsigned long long dt_ = __builtin_amdgcn_s_memrealtime() - t0_; const unsigned long long t1_ = __builtin_amdgcn_s_memrealtime();
                while (__builtin_amdgcn_s_memrealtime() - t1_ < 3 * dt_) __builtin_amdgcn_s_sleep(4); seam(kp); }
#endif
#ifdef PROBE_REPEAT
            if ((PROBE_REPEAT >> PH) & 1) { phase_site<PH>(kp, l); seam(kp); }
#endif
        }
        run_layer<PH + 1>(kp, l);
    }
}
__global__ void __launch_bounds__(512, 2) fwd_kernel(Params p) {
    extern __shared__ __attribute__((aligned(16))) unsigned char lds_raw[];
    volatile LAS unsigned* MISC = (volatile LAS unsigned*)((LAS unsigned char*)lds_raw + LDS_MISC);
    for (int u = threadIdx.x; u < (LDS_BYTES - LDS_MISC) / 4; u += 512) MISC[u] = 0u;
    __syncthreads();
    (void)xcd_barrier_post((unsigned*)(p.ws + WS_CTL) + CW_BAR, MISC + 8);
    KParams kp = (KParams)__builtin_amdgcn_kernarg_segment_ptr();
    run_layer<0>(kp, 0);
    run_layer<0>(kp, 1);
    static_assert(DEPTH == 2, "layers are written out");
}
#endif

extern "C" void kernel_launch(void* const* d_in, const int* in_sizes, int n_in, void* d_out, int out_size, void* d_ws, size_t ws_size, hipStream_t stream) {
    static int grid = 0;
    if (grid == 0) {
        if (n_in != 28 || in_sizes[0] != M * D || out_size != M * D || ws_size < WS_END) { fprintf(stderr, "kernel_launch: unexpected shapes (n_in %d, in0 %d, out %d, ws %zu < %zu); nothing launched\n", n_in, n_in > 0 ? in_sizes[0] : -1, out_size, ws_size, (size_t)WS_END); grid = -1; return; }
        int dev = 0, cus = 0;
        if (hipGetDevice(&dev) != hipSuccess || hipDeviceGetAttribute(&cus, hipDeviceAttributeMultiprocessorCount, dev) != hipSuccess) { grid = -1; return; }
#if MK_ONE_LAUNCH
        if (hipFuncSetAttribute((const void*)fwd_kernel, hipFuncAttributeMaxDynamicSharedMemorySize, LDS_BYTES) != hipSuccess) { fprintf(stderr, "kernel_launch: hipFuncSetAttribute failed\n"); grid = -1; return; }
        int per_cu = 0;
        if (hipOccupancyMaxActiveBlocksPerMultiprocessor(&per_cu, (const void*)fwd_kernel, 512, LDS_BYTES) != hipSuccess || per_cu < 1) { fprintf(stderr, "kernel_launch: occupancy query reports %d workgroups per CU\n", per_cu); }
        (void)hipGetLastError();
#endif
        grid = cus;
    }
    if (grid < 0) return;
    if (hipMemsetAsync((char*)d_ws + WS_CTL, 0, CTL_ZERO_BYTES, stream) != hipSuccess) return;
    Params a{};
    for (int i = 0; i < 28; ++i) a.in[i] = (const float*)d_in[i];
    a.out = (float*)d_out; a.ws = (unsigned char*)d_ws;
#if MK_ONE_LAUNCH
    hipLaunchKernelGGL(fwd_kernel, dim3(grid), dim3(512), LDS_BYTES, stream, a);
#else
    for (int l = 0; l < DEPTH; ++l) launch_phases<0>(grid, a, l, stream);
#endif
}
```

```cpp
#include <hip/hip_runtime.h>
#include <cstdio>
#include <cstdint>

#define GAS __attribute__((address_space(1)))
#define LAS __attribute__((address_space(3)))
typedef unsigned short bf16;
typedef short bf16x8 __attribute__((ext_vector_type(8)));
typedef float f32x4 __attribute__((ext_vector_type(4)));
typedef float f32x2 __attribute__((ext_vector_type(2)));
typedef unsigned u32x4 __attribute__((ext_vector_type(4)));
typedef unsigned u32x2 __attribute__((ext_vector_type(2)));

constexpr int D = 1024, NBATCH = 4, SEQ = 4096, M = NBATCH * SEQ, DEPTH = 2, MEML = 256, MM = NBATCH * MEML;
constexpr int NIN = 8456;
constexpr int PP = 5376;
constexpr int C_MQ = 0, C_MK = 512, C_MV = 1024, C_MO = 1536, C_AQ = 2048, C_AK = 2816, C_AV = 3584, C_GU = 4352, C_GV = 4864;
constexpr int NEXP = 16, DFF = 512;
constexpr int LCH = 128, NCH = SEQ / LCH;
constexpr float EPS = 1e-6f;
constexpr int MAXT = 144;

constexpr size_t MiB = 1u << 20;
constexpr size_t WS_CTL = 0, CTL_ZERO_BYTES = 1 * MiB;
constexpr size_t WS_SMALL = 1 * MiB;
constexpr size_t OFF_GATES = WS_SMALL;
constexpr size_t OFF_AMA = OFF_GATES + (size_t)M * 8 * 4;
constexpr size_t OFF_AMM = OFF_AMA + 16 * SEQ * 4;
constexpr size_t OFF_AMB = OFF_AMM + 16 * SEQ * 4;
constexpr size_t OFF_LSE = OFF_AMB + 16 * SEQ * 4;
constexpr size_t OFF_BIAS = OFF_LSE + (size_t)M * 12 * 4;
constexpr size_t OFF_TOKE = OFF_BIAS + 12 * 132 * 4;
constexpr size_t OFF_TOKP = OFF_TOKE + (size_t)M * 2 * 4;
constexpr size_t OFF_TOKW = OFF_TOKP + (size_t)M * 2 * 4;
constexpr size_t OFF_SLOT = OFF_TOKW + (size_t)M * 2 * 4;
constexpr size_t OFF_WROW = OFF_SLOT + (size_t)M * 2 * 4;
constexpr size_t OFF_NST = OFF_WROW + (size_t)MAXT * 256 * 4;
constexpr size_t OFF_MEMB = OFF_NST + (size_t)16 * NCH * 128 * 4;
constexpr size_t OFF_KV = OFF_MEMB + (size_t)MM * D * 2;
constexpr size_t OFF_CNTW = OFF_KV + (size_t)MM * 1024 * 2;
constexpr size_t OFF_SMALL_END = OFF_CNTW + 256 * 16 * 4;
static_assert(OFF_SMALL_END <= 17 * MiB, "small region");
constexpr size_t WS_W = 17 * MiB;
constexpr size_t OFF_WIN1 = WS_W;
constexpr size_t OFF_WG = OFF_WIN1 + (size_t)5376 * 1024 * 2;
constexpr size_t OFF_WA = OFF_WG + (size_t)3072 * 1024 * 2;
constexpr size_t OFF_WB = OFF_WA + (size_t)1024 * 512 * 2;
constexpr size_t OFF_WC = OFF_WB + (size_t)1024 * 768 * 2;
constexpr size_t OFF_WOUT = OFF_WC + (size_t)1024 * 512 * 2;
constexpr size_t OFF_WXQ = OFF_WOUT + (size_t)1024 * 1024 * 2;
constexpr size_t OFF_WXKV = OFF_WXQ + (size_t)512 * 1024 * 2;
constexpr size_t OFF_WXO = OFF_WXKV + (size_t)1024 * 1024 * 2;
constexpr size_t OFF_WGU = OFF_WXO + (size_t)1024 * 512 * 2;
constexpr size_t OFF_WD = OFF_WGU + (size_t)16 * 1024 * 1024 * 2;
constexpr size_t OFF_W_END = OFF_WD + (size_t)16 * 1024 * 512 * 2;
static_assert(OFF_W_END <= 93 * MiB, "weight region");
constexpr size_t WS_XB = 93 * MiB;
constexpr size_t WS_PROJ = 125 * MiB;
constexpr size_t OFF_XG = WS_PROJ, OFF_HID = WS_PROJ + 72 * MiB;
constexpr size_t WS_T = 293 * MiB;
constexpr size_t OFF_Q = WS_T, OFF_O = WS_T + 16 * MiB;
constexpr size_t WS_END = 327 * MiB;
constexpr int CW_TMO = 0, CW_CODE = 1;
constexpr int CW_CNT = 64;
constexpr int CW_BAR = 4096;

constexpr int LDS_BYTES = 147456;
constexpr int LDS_TAB = 145408;
constexpr int LDS_WOFF = 0;
constexpr int LDS_MISC = 146944;

#define RLX_AGENT __ATOMIC_RELAXED, __HIP_MEMORY_SCOPE_AGENT
#define LDS_WAIT() asm volatile("s_waitcnt lgkmcnt(0)" ::: "memory")
#define VM_WAIT() asm volatile("s_waitcnt vmcnt(0)" ::: "memory")
typedef __bf16 bf16x2_t __attribute__((ext_vector_type(2)));
__device__ __forceinline__ unsigned pk2(float lo, float hi) { const f32x2 v = {lo, hi}; return __builtin_bit_cast(unsigned, __builtin_convertvector(v, bf16x2_t)); }
__device__ __forceinline__ unsigned f2bf(float f) { return pk2(f, 0.f) & 0xffffu; }
__device__ __forceinline__ float bf2f(unsigned h) { return __builtin_bit_cast(float, h << 16); }
__device__ __forceinline__ float bflo(unsigned w) { return __builtin_bit_cast(float, w << 16); }
__device__ __forceinline__ float bfhi(unsigned w) { return __builtin_bit_cast(float, w & 0xffff0000u); }
__device__ __forceinline__ float wave_sum(float v) {
#pragma unroll
    for (int o = 1; o < 64; o <<= 1) v += __shfl_xor(v, o);
    return v;
}
__device__ __forceinline__ float sigmoidf_(float x) { return 1.f / (1.f + __expf(-x)); }
__device__ __forceinline__ float siluf_(float x) { return x / (1.f + __expf(-x)); }
__device__ __forceinline__ float gelu_tanh(float x) { const float u = 0.7978845608028654f * (x + 0.044715f * x * x * x); const float t = 1.f - 2.f / (1.f + __expf(2.f * u)); return 0.5f * x * (1.f + t); }
__device__ __forceinline__ void unpack8(const u32x4 w, float (&f)[8]) { f[0] = bflo(w.x); f[1] = bfhi(w.x); f[2] = bflo(w.y); f[3] = bfhi(w.y); f[4] = bflo(w.z); f[5] = bfhi(w.z); f[6] = bflo(w.w); f[7] = bfhi(w.w); }
__device__ __forceinline__ u32x4 pack8(const float (&f)[8]) { u32x4 w; w.x = pk2(f[0], f[1]); w.y = pk2(f[2], f[3]); w.z = pk2(f[4], f[5]); w.w = pk2(f[6], f[7]); return w; }

namespace pg8 {
constexpr int BM = 256, BK = 64, HALF = 128, HTB = HALF * BK * 2  , STAGE_BYTES = 8 * HTB, NXCD = 8, WGM = 8;
__host__ __device__ __forceinline__ int lds_byte(int r, int c) { const int st = (r >> 4) * 2 + (c >> 5), rr = r & 15, cc = c & 31, ob = rr * 64 + cc * 2; return st * 1024 + (ob ^ (((ob >> 9) & 1) << 5)); }
__host__ __device__ __forceinline__ void stage_rc(int b, int& R, int& C) { const int st = b / 1024, sb = b % 1024, swz = sb ^ (((sb >> 9) & 1) << 5); R = (st >> 1) * 16 + swz / 64; C = (st & 1) * 32 + (swz % 64) / 2; }
__host__ __device__ __forceinline__ int perm32(int rho) { const int n = rho >> 4, i = rho & 15; return 8 * (i >> 2) + 4 * n + (i & 3); }

struct Unit { int pm, pn; };
struct Gemm { const bf16* A; const bf16* Bt; int lda, K; };

struct StaticOrder {
    int nM, nN, nwg, G, c;
    __host__ __device__ void init(int M_, int N_, int G_, int c_) { nM = M_ / BM; nN = N_ / BM; nwg = nM * nN; G = G_; c = c_; }
    __host__ __device__ bool next(int i, Unit& u) const {
        const long L = (long)i * G + c; if (L >= nwg) return false;
        int wgid = (int)L; { const int q = nwg / NXCD, r = nwg % NXCD, xcd = wgid % NXCD, off = wgid / NXCD; wgid = (xcd < r ? xcd * (q + 1) : r * (q + 1) + (xcd - r) * q) + off; }
        const int nig = WGM * nN, gid = wgid / nig, fm = gid * WGM, gsz = (nM - fm) < WGM ? (nM - fm) : WGM;
        u.pm = fm + ((wgid % nig) % gsz); u.pn = (wgid % nig) / gsz; return true;
    }
    __device__ __forceinline__ void a_ready(const Unit&) const {}
    __device__ __forceinline__ void done(const Unit&) const {}
};

__device__ __forceinline__ unsigned cvt_pk_bf16(float lo, float hi) { unsigned r; asm volatile("v_cvt_pk_bf16_f32 %0, %1, %2" : "=v"(r) : "v"(lo), "v"(hi)); return r; }


template <class Epi, class Sched, bool ALIGN_EPI = false>
__device__ __forceinline__ void gemm_phase(LAS unsigned char* lds, const Gemm g, const Sched& S, const Epi& E) {
    int tid_ = threadIdx.x; asm volatile("" : "+v"(tid_));
    const int tid = tid_, wid = __builtin_amdgcn_readfirstlane(tid >> 6), lane = tid & 63, wr = wid >> 2, wc = wid & 3, fr = lane & 15, fq = lane >> 4;
    const int K = g.K, nt = K / BK, lda = g.lda;
    unsigned voffA[2], voffB[2];
#pragma unroll
    for (int i = 0; i < 2; ++i) { int R, C; stage_rc(tid * 16 + i * 8192, R, C); const int Rb = Epi::PERM ? ((R & ~31) + perm32(R & 31)) : R;
        voffA[i] = (unsigned)(R * lda + C) * 2u; voffB[i] = (unsigned)(Rb * K + C) * 2u; }
    const size_t kstep = (size_t)(BK * 2);
    const size_t hstepA = (size_t)HALF * lda * 2, hstepB = (size_t)HALF * K * 2;
    const size_t tstepA = 2 * hstepA, tstepB = 2 * hstepB;
    const unsigned ldsw = (unsigned)wid * 1024u;
    const int aoff = lds_byte(wr * 64 + fr, fq * 8), boff = lds_byte(wc * 32 + fr, fq * 8);
#define PG8_SA(b, h) (((b) * 2 + (h)) * HTB)
#define PG8_SB(b, h) ((4 + (b) * 2 + (h)) * HTB)
#define PG8_STAGE(bufoff, gbase, voff) do { _Pragma("unroll") for (int _i = 0; _i < 2; ++_i) \
        __builtin_amdgcn_global_load_lds((const unsigned*)((const char*)(gbase) + (voff)[_i]), (LAS unsigned*)(lds + (bufoff) + ldsw + _i * 8192), 16, 0, 0); } while (0)
#define PG8_LDA(dst, b, h) do { _Pragma("unroll") for (int m = 0; m < 4; ++m) _Pragma("unroll") for (int k = 0; k < 2; ++k) dst[m][k] = *(const LAS bf16x8*)(lds + PG8_SA(b, h) + aoff + m * 2048 + k * 1024); } while (0)
#define PG8_LDB(dst, b, h) do { _Pragma("unroll") for (int n = 0; n < 2; ++n) _Pragma("unroll") for (int k = 0; k < 2; ++k) dst[n][k] = *(const LAS bf16x8*)(lds + PG8_SB(b, h) + boff + n * 2048 + k * 1024); } while (0)
#define PG8_MMA(ai, bj, At, Bt) do { __builtin_amdgcn_s_setprio(1); _Pragma("unroll") for (int m = 0; m < 4; ++m) _Pragma("unroll") for (int n = 0; n < 2; ++n) _Pragma("unroll") for (int k = 0; k < 2; ++k) \
        acc[ai][bj][m][n] = __builtin_amdgcn_mfma_f32_16x16x32_bf16(Bt[n][k], At[m][k], acc[ai][bj][m][n], 0, 0, 0); __builtin_amdgcn_s_setprio(0); } while (0)
#define PG8_WAIT_V(n) asm volatile("s_waitcnt vmcnt(" #n ")" ::: "memory")
#define PG8_WAIT_L(n) asm volatile("s_waitcnt lgkmcnt(" #n ")" ::: "memory")
#define PG8_BAR __builtin_amdgcn_s_barrier()
#define PG8_SCHED __builtin_amdgcn_sched_barrier(0)
    Unit cur, nxt; int ui = 0;
    if (!S.next(0, cur)) return;
    f32x4 acc[2][2][4][2];
#pragma unroll
    for (int a = 0; a < 2; ++a)
#pragma unroll
        for (int b = 0; b < 2; ++b)
#pragma unroll
            for (int m = 0; m < 4; ++m)
#pragma unroll
                for (int n = 0; n < 2; ++n) acc[a][b][m][n] = (f32x4){0.f, 0.f, 0.f, 0.f};
    bf16x8 At[4][2], B0[2][2], B1[2][2];
    const char* cA = (const char*)g.A + (size_t)cur.pm * tstepA; const char* cB = (const char*)g.Bt + (size_t)cur.pn * tstepB;
    S.a_ready(cur);
    PG8_STAGE(PG8_SB(0, 0), cB, voffB); PG8_STAGE(PG8_SB(0, 1), cB + hstepB, voffB); PG8_STAGE(PG8_SA(0, 0), cA, voffA); PG8_STAGE(PG8_SA(0, 1), cA + hstepA, voffA);
    if (wr == 1) PG8_BAR;
    PG8_WAIT_V(2); PG8_BAR;
    PG8_STAGE(PG8_SB(1, 0), cB + kstep, voffB); PG8_STAGE(PG8_SA(1, 0), cA + kstep, voffA); PG8_STAGE(PG8_SB(1, 1), cB + hstepB + kstep, voffB);
    PG8_WAIT_V(6); PG8_BAR;
    for (;;) {
        const bool has_next = S.next(ui + 1, nxt);
        const char* nA = has_next ? (const char*)g.A + (size_t)nxt.pm * tstepA : cA; const char* nB = has_next ? (const char*)g.Bt + (size_t)nxt.pn * tstepB : cB;
        for (int t = 0; t < nt; t += 2) {
            const bool last = (t == nt - 2);
            const char* a1 = cA + (size_t)(t + 1) * kstep;
            const char* a2 = last ? nA : cA + (size_t)(t + 2) * kstep; const char* b2 = last ? nB : cB + (size_t)(t + 2) * kstep;
            const char* a3 = a2 + kstep; const char* b3 = b2 + kstep;
            if (last && has_next) S.a_ready(nxt);
            PG8_LDB(B0, 0, 0); PG8_LDB(B1, 0, 1); PG8_SCHED; PG8_LDA(At, 0, 0); PG8_STAGE(PG8_SA(1, 1), a1 + hstepA, voffA);
            PG8_WAIT_V(8); PG8_WAIT_L(0); PG8_BAR; PG8_MMA(0, 0, At, B0); PG8_MMA(0, 1, At, B1); PG8_BAR; PG8_SCHED;
            PG8_LDA(At, 0, 1); PG8_STAGE(PG8_SB(0, 0), b2, voffB); PG8_STAGE(PG8_SB(0, 1), b2 + hstepB, voffB); PG8_STAGE(PG8_SA(0, 0), a2, voffA);
            PG8_WAIT_V(8); PG8_WAIT_L(0); PG8_BAR; PG8_MMA(1, 0, At, B0); PG8_MMA(1, 1, At, B1); PG8_BAR; PG8_SCHED;
            PG8_LDB(B0, 1, 0); PG8_LDB(B1, 1, 1); PG8_SCHED; PG8_LDA(At, 1, 0); PG8_STAGE(PG8_SA(0, 1), a2 + hstepA, voffA);
            PG8_WAIT_V(8); PG8_WAIT_L(0); PG8_BAR; PG8_MMA(0, 0, At, B0); PG8_MMA(0, 1, At, B1); PG8_BAR; PG8_SCHED;
            PG8_LDA(At, 1, 1); PG8_STAGE(PG8_SB(1, 0), b3, voffB); PG8_STAGE(PG8_SB(1, 1), b3 + hstepB, voffB); PG8_STAGE(PG8_SA(1, 0), a3, voffA);
            PG8_WAIT_V(8); PG8_WAIT_L(0); PG8_BAR; PG8_MMA(1, 0, At, B0); PG8_MMA(1, 1, At, B1); PG8_BAR; PG8_SCHED;
        }
        if constexpr (ALIGN_EPI) { if (wr == 0) PG8_BAR; }
        E(acc, cur, wr, wc, fr, fq); S.done(cur);
        if (!has_next) break;
#pragma unroll
        for (int a = 0; a < 2; ++a)
#pragma unroll
            for (int b = 0; b < 2; ++b)
#pragma unroll
                for (int m = 0; m < 4; ++m)
#pragma unroll
                    for (int n = 0; n < 2; ++n) acc[a][b][m][n] = (f32x4){0.f, 0.f, 0.f, 0.f};
        cur = nxt; cA = nA; cB = nB; ++ui;
        if constexpr (ALIGN_EPI) { if (wr == 1) PG8_BAR; }
    }
    PG8_WAIT_V(0);
    if constexpr (!ALIGN_EPI) { if (wr == 0) PG8_BAR; }
    PG8_BAR;
#undef PG8_SA
#undef PG8_SB
#undef PG8_STAGE
#undef PG8_LDA
#undef PG8_LDB
#undef PG8_MMA
#undef PG8_WAIT_V
#undef PG8_WAIT_L
#undef PG8_BAR
#undef PG8_SCHED
}
}

namespace epi {
using pg8::Unit; using pg8::BM; using pg8::HALF; using pg8::cvt_pk_bf16;
__device__ __forceinline__ u32x4 pk8(const f32x4 v0, const f32x4 v1) { u32x4 w; w.x = cvt_pk_bf16(v0[0], v0[1]); w.y = cvt_pk_bf16(v0[2], v0[3]); w.z = cvt_pk_bf16(v1[0], v1[1]); w.w = cvt_pk_bf16(v1[2], v1[3]); return w; }
__device__ __forceinline__ void up8(const u32x4 w, f32x4& a, f32x4& b) { a = (f32x4){bflo(w.x), bfhi(w.x), bflo(w.y), bfhi(w.y)}; b = (f32x4){bflo(w.z), bfhi(w.z), bflo(w.w), bfhi(w.w)}; }
__device__ __forceinline__ int gcol(int tg) { return tg < 6 ? 256 * tg : 2816 + 256 * (tg - 6); }

struct Bf16Out {
    static constexpr bool PERM = true;
    bf16* O; int ldc;
    __device__ __forceinline__ void operator()(const f32x4 (&acc)[2][2][4][2], const Unit& u, int wr, int wc, int fr, int fq) const {
        const int row0 = u.pm * BM + wr * 64 + fr, col0 = u.pn * BM + wc * 32 + 8 * fq;
#pragma unroll
        for (int ai = 0; ai < 2; ++ai)
#pragma unroll
            for (int m = 0; m < 4; ++m) { bf16* rowp = O + (size_t)(row0 + ai * HALF + m * 16) * ldc + col0;
#pragma unroll
                for (int bj = 0; bj < 2; ++bj) *(u32x4*)(rowp + bj * HALF) = pk8(acc[ai][bj][m][0], acc[ai][bj][m][1]); }
    }
};
struct SigOut {
    static constexpr bool PERM = true;
    bf16* PROJ;
    __device__ __forceinline__ void operator()(const f32x4 (&acc)[2][2][4][2], const Unit& u, int wr, int wc, int fr, int fq) const {
        const int row0 = u.pm * BM + wr * 64 + fr, col0 = gcol(u.pn) + wc * 32 + 8 * fq;
#pragma unroll
        for (int ai = 0; ai < 2; ++ai)
#pragma unroll
            for (int m = 0; m < 4; ++m) { bf16* rowp = PROJ + (size_t)(row0 + ai * HALF + m * 16) * PP + col0;
#pragma unroll
                for (int bj = 0; bj < 2; ++bj) { f32x4 a = acc[ai][bj][m][0], b = acc[ai][bj][m][1];
#pragma unroll
                    for (int e = 0; e < 4; ++e) { a[e] = sigmoidf_(a[e]); b[e] = sigmoidf_(b[e]); }
                    *(u32x4*)(rowp + bj * HALF) = pk8(a, b); } }
    }
};
template <int BR> struct BranchOut {
    static constexpr bool PERM = true;
    const bf16* PROJ; bf16* T; bf16* OUT;
    __device__ __forceinline__ void operator()(const f32x4 (&acc)[2][2][4][2], const Unit& u, int wr, int wc, int fr, int fq) const {
        const int row0 = u.pm * BM + wr * 64 + fr, cw = wc * 32 + 8 * fq, gc0 = gcol(BR * 4 + u.pn) + cw, col0 = u.pn * BM + cw;
#pragma unroll
        for (int ai = 0; ai < 2; ++ai)
#pragma unroll
            for (int m = 0; m < 4; ++m) { const size_t row = (size_t)(row0 + ai * HALF + m * 16);
#pragma unroll
                for (int bj = 0; bj < 2; ++bj) {
                    f32x4 g0, g1; up8(*(const u32x4*)(PROJ + row * PP + gc0 + bj * HALF), g0, g1);
                    f32x4 v0 = g0 * acc[ai][bj][m][0], v1 = g1 * acc[ai][bj][m][1];
                    if (BR > 0) { f32x4 t0, t1; up8(*(const u32x4*)(T + row * 1024 + col0 + bj * HALF), t0, t1); v0 += t0; v1 += t1; }
                    bf16* dst = (BR == 2 ? OUT : T) + row * 1024 + col0 + bj * HALF;
                    *(u32x4*)dst = pk8(v0, v1); } }
    }
};
struct ResidOut {
    static constexpr bool PERM = false;
    const float* SRC; float* DST;
    __device__ __forceinline__ void operator()(const f32x4 (&acc)[2][2][4][2], const Unit& u, int wr, int wc, int fr, int fq) const {
        const int row0 = u.pm * BM + wr * 64 + fr, col0 = u.pn * BM + wc * 32 + 4 * fq;
#pragma unroll
        for (int ai = 0; ai < 2; ++ai)
#pragma unroll
            for (int m = 0; m < 4; ++m) { const size_t off = (size_t)(row0 + ai * HALF + m * 16) * 1024 + col0;
#pragma unroll
                for (int bj = 0; bj < 2; ++bj)
#pragma unroll
                    for (int n = 0; n < 2; ++n) { const size_t o = off + bj * HALF + n * 16; *(f32x4*)(DST + o) = *(const f32x4*)(SRC + o) + acc[ai][bj][m][n]; } }
    }
};
struct GluOut {
    static constexpr bool PERM = true;
    bf16* HID;
    __device__ __forceinline__ void operator()(const f32x4 (&acc)[2][2][4][2], const Unit& u, int wr, int wc, int fr, int fq) const {
        const int row0 = u.pm * BM + wr * 64 + fr, col0 = (u.pn & 3) * 128 + wc * 32 + 8 * fq;
#pragma unroll
        for (int ai = 0; ai < 2; ++ai)
#pragma unroll
            for (int m = 0; m < 4; ++m) { f32x4 a = acc[ai][0][m][0], b = acc[ai][0][m][1]; const f32x4 ua = acc[ai][1][m][0], ub = acc[ai][1][m][1];
#pragma unroll
                for (int e = 0; e < 4; ++e) { a[e] = siluf_(a[e]) * ua[e]; b[e] = siluf_(b[e]) * ub[e]; }
                *(u32x4*)(HID + (size_t)(row0 + ai * HALF + m * 16) * DFF + col0) = pk8(a, b); }
    }
};
struct DownOut {
    static constexpr bool PERM = true;
    bf16* YE; const float* WROW;
    __device__ __forceinline__ void operator()(const f32x4 (&acc)[2][2][4][2], const Unit& u, int wr, int wc, int fr, int fq) const {
        const int row0 = u.pm * BM + wr * 64 + fr, col0 = (u.pn & 3) * BM + wc * 32 + 8 * fq;
#pragma unroll
        for (int ai = 0; ai < 2; ++ai)
#pragma unroll
            for (int m = 0; m < 4; ++m) { const int row = row0 + ai * HALF + m * 16; const float w = WROW[row]; bf16* rowp = YE + (size_t)row * 1024 + col0;
#pragma unroll
                for (int bj = 0; bj < 2; ++bj) *(u32x4*)(rowp + bj * HALF) = pk8(acc[ai][bj][m][0] * w, acc[ai][bj][m][1] * w); }
    }
};
}

struct MoeOrder {
    const LAS int* tab; int G, c;
    __device__ __forceinline__ bool next(int i, pg8::Unit& u) const {
        const int L = i * G + c; const int nT = tab[176]; if (L >= 4 * nT) return false;
        const int pm = L >> 2; u.pm = pm; u.pn = tab[pm] * 4 + (L & 3); return true;
    }
    __device__ __forceinline__ void a_ready(const pg8::Unit&) const {}
    __device__ __forceinline__ void done(const pg8::Unit&) const {}
};
#define XB_TMO      128
#define XB_XCNT(j)  (256  + 64 * (j))
#define XB_XSUB(j)  (1280 + 64 * (j))
#define XB_XGEN(j)  (2304 + 64 * (j))
#define XB_TOP      3328
#define XB_TOPGEN   3392
#define XCD_BAR_WORDS 3456
#define XB_SPIN_CAP (1u << 18)

__device__ __forceinline__ unsigned xb_ld(unsigned* p)              { return __hip_atomic_load(p, __ATOMIC_RELAXED, __HIP_MEMORY_SCOPE_AGENT); }
__device__ __forceinline__ unsigned xb_add(unsigned* p, unsigned v) { return __hip_atomic_fetch_add(p, v, __ATOMIC_RELAXED, __HIP_MEMORY_SCOPE_AGENT); }
__device__ __forceinline__ unsigned xb_xcc_id() { return (unsigned)__builtin_amdgcn_s_getreg((3 << 11) | 20) & 0xFu; }
#define XB_SPIN(cond, bar) do { unsigned _sp = 0; while (cond) { __builtin_amdgcn_s_sleep(1); \
    if ((++_sp & 255u) == 0u) { if (xb_ld(&(bar)[XB_TMO])) break; if (_sp > XB_SPIN_CAP) { atomicAdd(&(bar)[XB_TMO], 1u); break; } } } } while (0)

struct XcdBarrier {
    unsigned* bar; unsigned x;
    volatile LAS unsigned* st;
};

__device__ __forceinline__ XcdBarrier xcd_barrier_post(unsigned* bar, volatile LAS unsigned* st) {
    XcdBarrier b; b.bar = bar; b.x = xb_xcc_id(); b.st = st;
    if (threadIdx.x == 0) (void)xb_add(&bar[XB_XCNT(b.x)], 1u);
    return b;
}
__device__ __forceinline__ void xcd_barrier_complete(unsigned* bar, unsigned x, unsigned& nloc, unsigned& nx) {
    const unsigned G = gridDim.x * gridDim.y * gridDim.z;
    unsigned sum, cnt, mine, sp = 0u;
    for (;;) {
        sum = 0u; cnt = 0u; mine = 0u;
#pragma unroll
        for (unsigned j = 0; j < 16; ++j) { const unsigned c = xb_ld(&bar[XB_XCNT(j)]); sum += c; cnt += (c > 0u) ? 1u : 0u; mine = (j == x) ? c : mine; }
        if (sum == G) break;
        __builtin_amdgcn_s_sleep(1);
        if ((++sp & 255u) == 0u) { if (xb_ld(&bar[XB_TMO])) break; if (sp > XB_SPIN_CAP) { atomicAdd(&bar[XB_TMO], 1u); break; } }
    }
    nloc = mine > 0u ? mine : 1u; nx = cnt > 0u ? cnt : 1u;
}

__device__ __forceinline__ void xcd_barrier(const XcdBarrier& b) {
    asm volatile("s_waitcnt vmcnt(0)" ::: "memory");
    __syncthreads();
    if (threadIdx.x == 0) {
        unsigned* bar = b.bar;
        __builtin_amdgcn_s_waitcnt(0);
        unsigned nloc = b.st[0], nx = b.st[1];
        if (nloc == 0u) { xcd_barrier_complete(bar, b.x, nloc, nx); b.st[0] = nloc; b.st[1] = nx; }
        const unsigned old = xb_add(&bar[XB_XSUB(b.x)], 1u);
        const unsigned gen = old / nloc;
        if (old + 1u == (gen + 1u) * nloc) {
            __builtin_amdgcn_fence(__ATOMIC_RELEASE, "agent");
            asm volatile("s_waitcnt vmcnt(0)" ::: "memory");
            const unsigned og = xb_add(&bar[XB_TOP], 1u);
            const unsigned tg = og / nx;
            if (og + 1u == (tg + 1u) * nx) xb_add(&bar[XB_TOPGEN], 1u);
            else XB_SPIN(xb_ld(&bar[XB_TOPGEN]) == tg, bar);
            __builtin_amdgcn_fence(__ATOMIC_ACQUIRE, "agent");
            xb_add(&bar[XB_XGEN(b.x)], 1u);
            asm volatile("s_waitcnt vmcnt(0)" ::: "memory");
        } else {
            XB_SPIN(xb_ld(&bar[XB_XGEN(b.x)]) == gen, bar);
            __builtin_amdgcn_fence(__ATOMIC_ACQUIRE, "agent");
            asm volatile("s_waitcnt vmcnt(0)" ::: "memory");
        }
    }
    __syncthreads();
}

struct Params { const float* in[28]; float* out; unsigned char* ws; };
enum { I_X = 0, I_MEM, I_NORM_MIX, I_W_IN, I_CONV, I_GATE_B, I_MLSTM_NORM, I_ATTN_QKN, I_GMLP_NORM, I_GMLP_WS, I_GMLP_BS, I_WBA, I_WBB, I_WBC, I_WOUT, I_REL_BIAS,
       I_NORM_XATTN, I_NORM_MEM, I_WXQ, I_WXKV, I_XATTN_QKN, I_WXO, I_NORM_FFN, I_ROUTER_W, I_ROUTER_B, I_EG, I_EU, I_ED };

struct Ctx {
    LAS unsigned char* lds;
    unsigned char* ws;
    int tid, lane, wave, vcu, G, bx;
};
template <class T> __device__ __forceinline__ T* wsp(const Ctx& c, size_t off) { return (T*)(c.ws + off); }

__device__ const unsigned char REL_BUCKET[3][132] = {
  {0,1,2,3,4,5,6,7,8,9,10,11,12,13,14,15,16,16,16,16,16,16,17,17,17,17,17,17,17,17,18,18,18,18,18,18,18,18,18,18,19,19,19,19,19,19,19,19,19,19,19,19,19,19,20,20,20,20,20,20,20,20,20,20,20,20,20,20,20,20,20,20,20,21,21,21,21,21,21,21,21,21,21,21,21,21,21,21,21,21,21,21,21,21,21,21,21,21,21,22,22,22,22,22,22,22,22,22,22,22,22,22,22,22,22,22,22,22,22,22,22,22,22,22,22,22,22,22,22,0,0,0},
  {0,4,8,12,16,16,17,17,18,18,19,19,19,19,20,20,20,20,20,21,21,21,21,21,21,22,22,22,22,22,22,22,22,22,23,23,23,23,23,23,23,23,23,23,23,23,24,24,24,24,24,24,24,24,24,24,24,24,24,24,24,24,25,25,25,25,25,25,25,25,25,25,25,25,25,25,25,25,25,25,25,25,25,26,26,26,26,26,26,26,26,26,26,26,26,26,26,26,26,26,26,26,26,26,26,26,26,26,26,26,26,26,26,27,27,27,27,27,27,27,27,27,27,27,27,27,27,27,27,0,0,0},
  {0,16,18,19,20,21,21,22,22,23,23,23,24,24,24,24,25,25,25,25,25,26,26,26,26,26,26,26,26,27,27,27,27,27,27,27,27,27,27,28,28,28,28,28,28,28,28,28,28,28,28,28,29,29,29,29,29,29,29,29,29,29,29,29,29,29,29,29,29,29,30,30,30,30,30,30,30,30,30,30,30,30,30,30,30,30,30,30,30,30,30,30,30,30,30,31,31,31,31,31,31,31,31,31,31,31,31,31,31,31,31,31,31,31,31,31,31,31,31,31,31,31,31,31,31,31,31,31,31,0,0,0}};

template <class RowMap>
__device__ __forceinline__ void tr_item(const float* W, int ldw, int c0, const float* gain, bf16* WT, int K, LAS float* scr, int kb, int nb, int lane, RowMap rm) {
    const int k0 = 64 * kb, n0 = 64 * nb, lr = lane >> 4, lc = 4 * (lane & 15);
    f32x4 v[16];
#pragma unroll
    for (int i = 0; i < 16; ++i) v[i] = *(const f32x4*)(W + (size_t)(k0 + 4 * i + lr) * ldw + c0 + n0 + lc);
#pragma unroll
    for (int i = 0; i < 16; ++i) { const int kk = 4 * i + lr; const float gg = gain ? gain[k0 + kk] : 1.f; LAS float* s = scr + kk * 65 + lc; s[0] = v[i].x * gg; s[1] = v[i].y * gg; s[2] = v[i].z * gg; s[3] = v[i].w * gg; }
    LDS_WAIT(); asm volatile("" ::: "memory");
    const int c = lane & 7;
#pragma unroll
    for (int j = 0; j < 8; ++j) { const int n = (lane >> 3) + 8 * j; const LAS float* s = scr + (8 * c) * 65 + n;
        u32x4 o; o.x = pk2(s[0 * 65], s[1 * 65]); o.y = pk2(s[2 * 65], s[3 * 65]); o.z = pk2(s[4 * 65], s[5 * 65]); o.w = pk2(s[6 * 65], s[7 * 65]);
        *(u32x4*)(WT + (size_t)rm(n0 + n) * K + k0 + 8 * c) = o; }
    LDS_WAIT(); asm volatile("" ::: "memory");
}
struct RmId { int off; __device__ __forceinline__ int operator()(int n) const { return off + n; } };
struct RmGate { __device__ __forceinline__ int operator()(int n) const { return (n >> 7) * 256 + (n & 127); } };
struct RmUp { __device__ __forceinline__ int operator()(int n) const { return (n >> 7) * 256 + 128 + (n & 127); } };

__device__ __forceinline__ void phase_weights(const Ctx& c, const Params& p, int l) {
    LAS float* scr = (LAS float*)(c.lds + c.wave * 16640);
    const int gw = c.vcu * 8 + c.wave, NGW = c.G * 8;
    const float* w_in = p.in[I_W_IN] + (size_t)l * D * NIN;
    constexpr int N1 = 16 * 32, N2 = 16 * 52, N3 = 16 * 48, N4 = 8 * 16, N5 = 12 * 16, N6 = 8 * 16, N7 = 16 * 16, N8 = 16 * 8, N9 = 16 * 16, N10 = 8 * 16, NE = 16 * 8, NDN = 8 * 16;
    constexpr int NITEMS = N1 + N2 + N3 + N4 + N5 + N6 + N7 + N8 + N9 + N10 + 16 * NE * 2 + 16 * NDN;
    for (int it = gw; it < NITEMS; it += NGW) {
        int r = it;
        if (r < N1) { tr_item(w_in, NIN, 0, p.in[I_NORM_MIX] + l * D, wsp<bf16>(c, OFF_WIN1), D, scr, r / 32, r % 32, c.lane, RmId{0}); continue; } r -= N1;
        if (r < N2) { tr_item(w_in, NIN, 2056, p.in[I_NORM_MIX] + l * D, wsp<bf16>(c, OFF_WIN1), D, scr, r / 52, r % 52, c.lane, RmId{2048}); continue; } r -= N2;
        if (r < N3) { tr_item(w_in, NIN, 5384, p.in[I_NORM_MIX] + l * D, wsp<bf16>(c, OFF_WG), D, scr, r / 48, r % 48, c.lane, RmId{0}); continue; } r -= N3;
        if (r < N4) { tr_item(p.in[I_WBA] + (size_t)l * 512 * 1024, 1024, 0, nullptr, wsp<bf16>(c, OFF_WA), 512, scr, r / 16, r % 16, c.lane, RmId{0}); continue; } r -= N4;
        if (r < N5) { tr_item(p.in[I_WBB] + (size_t)l * 768 * 1024, 1024, 0, nullptr, wsp<bf16>(c, OFF_WB), 768, scr, r / 16, r % 16, c.lane, RmId{0}); continue; } r -= N5;
        if (r < N6) { tr_item(p.in[I_WBC] + (size_t)l * 512 * 1024, 1024, 0, nullptr, wsp<bf16>(c, OFF_WC), 512, scr, r / 16, r % 16, c.lane, RmId{0}); continue; } r -= N6;
        if (r < N7) { tr_item(p.in[I_WOUT] + (size_t)l * 1024 * 1024, 1024, 0, nullptr, wsp<bf16>(c, OFF_WOUT), 1024, scr, r / 16, r % 16, c.lane, RmId{0}); continue; } r -= N7;
        if (r < N8) { tr_item(p.in[I_WXQ] + (size_t)l * 1024 * 512, 512, 0, p.in[I_NORM_XATTN] + l * D, wsp<bf16>(c, OFF_WXQ), 1024, scr, r / 8, r % 8, c.lane, RmId{0}); continue; } r -= N8;
        if (r < N9) { tr_item(p.in[I_WXKV] + (size_t)l * 1024 * 1024, 1024, 0, p.in[I_NORM_MEM] + l * D, wsp<bf16>(c, OFF_WXKV), 1024, scr, r / 16, r % 16, c.lane, RmId{0}); continue; } r -= N9;
        if (r < N10) { tr_item(p.in[I_WXO] + (size_t)l * 512 * 1024, 1024, 0, nullptr, wsp<bf16>(c, OFF_WXO), 512, scr, r / 16, r % 16, c.lane, RmId{0}); continue; } r -= N10;
        if (r < 16 * NE) { const int e = r / NE, rr = r % NE; tr_item(p.in[I_EG] + ((size_t)l * 16 + e) * 1024 * 512, 512, 0, p.in[I_NORM_FFN] + l * D, wsp<bf16>(c, OFF_WGU) + (size_t)e * 1024 * 1024, 1024, scr, rr / 8, rr % 8, c.lane, RmGate{}); continue; } r -= 16 * NE;
        if (r < 16 * NE) { const int e = r / NE, rr = r % NE; tr_item(p.in[I_EU] + ((size_t)l * 16 + e) * 1024 * 512, 512, 0, p.in[I_NORM_FFN] + l * D, wsp<bf16>(c, OFF_WGU) + (size_t)e * 1024 * 1024, 1024, scr, rr / 8, rr % 8, c.lane, RmUp{}); continue; } r -= 16 * NE;
        { const int e = r / NDN, rr = r % NDN; tr_item(p.in[I_ED] + ((size_t)l * 16 + e) * 512 * 1024, 1024, 0, nullptr, wsp<bf16>(c, OFF_WD) + (size_t)e * 1024 * 512, 512, scr, rr / 16, rr % 16, c.lane, RmId{0}); }
    }
}

__device__ __forceinline__ void row_norm_store(f32x4 (&v)[4], bf16* xbrow, int lane) {
    float s = 0.f;
#pragma unroll
    for (int j = 0; j < 4; ++j) s += (v[j].x * v[j].x + v[j].y * v[j].y) + (v[j].z * v[j].z + v[j].w * v[j].w);
    const float rs = 1.f / sqrtf(wave_sum(s) * (1.f / D) + EPS);
    unsigned long long* o8 = (unsigned long long*)xbrow + lane;
#pragma unroll
    for (int j = 0; j < 4; ++j) { v[j] = v[j] * rs; o8[64 * j] = (unsigned long long)pk2(v[j].x, v[j].y) | ((unsigned long long)pk2(v[j].z, v[j].w) << 32); }
}
__device__ __forceinline__ void row_gates(const f32x4 (&v)[4], const LAS float* W8t, const float* gate_b, float* gates_row, int lane) {
    float a[8];
#pragma unroll
    for (int q = 0; q < 8; ++q) { float s = 0.f;
#pragma unroll
        for (int j = 0; j < 4; ++j) { const f32x4 w = *(const LAS f32x4*)(W8t + q * 1024 + 256 * j + 4 * lane); s += (v[j].x * w.x + v[j].y * w.y) + (v[j].z * w.z + v[j].w * w.w); }
        a[q] = wave_sum(s); if ((q & 3) == 3) __builtin_amdgcn_sched_barrier(0); }
    if (lane == 0) {
#pragma unroll
        for (int q = 0; q < 8; ++q) gates_row[q] = a[q] + gate_b[q]; }
}
__device__ __forceinline__ void load_w8(const Ctx& c, const Params& p, int l) {
    LAS float* W8t = (LAS float*)c.lds; const float* w_in = p.in[I_W_IN] + (size_t)l * D * NIN; const float* g = p.in[I_NORM_MIX] + l * D;
    for (int idx = c.tid; idx < D * 8; idx += 512) { const int k = idx >> 3, q = idx & 7; W8t[q * 1024 + k] = w_in[(size_t)k * NIN + 2048 + q] * g[k]; }
    __syncthreads();
}
__device__ __forceinline__ void phase_rp0_input(const Ctx& c, const Params& p) {
    load_w8(c, p, 0);
    const int gw = c.vcu * 8 + c.wave, NGW = c.G * 8;
    const float* x = p.in[I_X];
    for (int m = gw; m < M; m += NGW) {
        f32x4 v[4]; const f32x4* xr = (const f32x4*)(x + (size_t)m * D) + c.lane;
#pragma unroll
        for (int j = 0; j < 4; ++j) v[j] = xr[64 * j];
        row_norm_store(v, wsp<bf16>(c, WS_XB) + (size_t)m * D, c.lane);
        row_gates(v, (const LAS float*)c.lds, p.in[I_GATE_B], wsp<float>(c, OFF_GATES) + (size_t)m * 8, c.lane);
    }
    const float* mem = p.in[I_MEM];
    for (int m = gw; m < MM; m += NGW) {
        f32x4 v[4]; const f32x4* xr = (const f32x4*)(mem + (size_t)m * D) + c.lane;
#pragma unroll
        for (int j = 0; j < 4; ++j) v[j] = xr[64 * j];
        row_norm_store(v, wsp<bf16>(c, OFF_MEMB) + (size_t)m * D, c.lane);
    }
    if (c.bx == 0) { float* bt = wsp<float>(c, OFF_BIAS); const float* rb = p.in[I_REL_BIAS];
        for (int idx = c.tid; idx < 12 * 132; idx += 512) { const int h = idx / 132, dist = idx % 132; bt[idx] = rb[(int)REL_BUCKET[h >> 2][dist] * 12 + h]; } }
}
__device__ __forceinline__ void phase_rp1(const Ctx& c, const float* X) {
    const int gw = c.vcu * 8 + c.wave, NGW = c.G * 8;
    for (int m = gw; m < M; m += NGW) {
        f32x4 v[4]; const f32x4* xr = (const f32x4*)(X + (size_t)m * D) + c.lane;
#pragma unroll
        for (int j = 0; j < 4; ++j) v[j] = xr[64 * j];
        row_norm_store(v, wsp<bf16>(c, WS_XB) + (size_t)m * D, c.lane);
    }
}
__device__ __forceinline__ void phase_rp2_route(const Ctx& c, const Params& p, int l, const float* X) {
    LAS float* RWt = (LAS float*)c.lds;
    { const float* rw = p.in[I_ROUTER_W]; const float* g = p.in[I_NORM_FFN] + l * D;
      for (int idx = c.tid; idx < D * 16; idx += 512) RWt[(idx & 15) * 1024 + (idx >> 4)] = rw[idx] * g[idx >> 4];
      __syncthreads(); }
    const int gw = c.vcu * 8 + c.wave, NGW = c.G * 8;
    LAS unsigned* lcnt = (LAS unsigned*)(c.lds + LDS_TAB);
    if (c.tid < 16) lcnt[c.tid] = 0u;
    __syncthreads();
    const float* rbias = p.in[I_ROUTER_B];
    for (int m = gw; m < M; m += NGW) {
        f32x4 v[4]; const f32x4* xr = (const f32x4*)(X + (size_t)m * D) + c.lane;
#pragma unroll
        for (int j = 0; j < 4; ++j) v[j] = xr[64 * j];
        row_norm_store(v, wsp<bf16>(c, WS_XB) + (size_t)m * D, c.lane);
        float a[16];
#pragma unroll
        for (int q = 0; q < 16; ++q) { float s = 0.f;
#pragma unroll
            for (int j = 0; j < 4; ++j) { const f32x4 w = *(const LAS f32x4*)(RWt + q * 1024 + 256 * j + 4 * c.lane); s += (v[j].x * w.x + v[j].y * w.y) + (v[j].z * w.z + v[j].w * w.w); }
            a[q] = s; if ((q & 3) == 3) __builtin_amdgcn_sched_barrier(0); }
        float mx = -3.0e38f;
#pragma unroll
        for (int q = 0; q < 16; ++q) { a[q] = wave_sum(a[q]) + rbias[q]; mx = fmaxf(mx, a[q]); }
#pragma unroll
        for (int q = 0; q < 16; ++q) a[q] = __expf(a[q] - mx);
        float bs = -1.f, p1 = 0.f, p2 = 0.f; int e1 = 0, e2 = 1;
#pragma unroll
        for (int g = 0; g < 4; ++g) {
            const float q0 = a[4 * g], q1 = a[4 * g + 1], q2 = a[4 * g + 2], q3 = a[4 * g + 3];
            int i1 = 0; float m1 = q0; if (q1 > m1) { m1 = q1; i1 = 1; } if (q2 > m1) { m1 = q2; i1 = 2; } if (q3 > m1) { m1 = q3; i1 = 3; }
            int i2 = -1; float m2 = -1.f;
            if (i1 != 0 && q0 > m2) { m2 = q0; i2 = 0; } if (i1 != 1 && q1 > m2) { m2 = q1; i2 = 1; } if (i1 != 2 && q2 > m2) { m2 = q2; i2 = 2; } if (i1 != 3 && q3 > m2) { m2 = q3; i2 = 3; }
            const float sc = m1 + m2;
            if (sc > bs) { bs = sc; e1 = 4 * g + i1; e2 = 4 * g + i2; p1 = m1; p2 = m2; }
        }
        if (c.lane == 0) {
            const float inv = 1.f / (p1 + p2);
            const unsigned pos1 = __hip_atomic_fetch_add(lcnt + e1, 1u, __ATOMIC_RELAXED, __HIP_MEMORY_SCOPE_WORKGROUP), pos2 = __hip_atomic_fetch_add(lcnt + e2, 1u, __ATOMIC_RELAXED, __HIP_MEMORY_SCOPE_WORKGROUP);
            int* te = wsp<int>(c, OFF_TOKE) + 2 * m; int* tp = wsp<int>(c, OFF_TOKP) + 2 * m; float* tw = wsp<float>(c, OFF_TOKW) + 2 * m;
            te[0] = e1; te[1] = e2; tp[0] = (int)pos1; tp[1] = (int)pos2; tw[0] = p1 * inv; tw[1] = p2 * inv;
        }
    }
    __syncthreads();
    if (c.tid < 16) wsp<unsigned>(c, OFF_CNTW)[c.vcu * 16 + c.tid] = lcnt[c.tid];
}
template <bool WITH_OFF>
__device__ __forceinline__ void moe_tables(const Ctx& c) {
    LAS int* tab = (LAS int*)(c.lds + LDS_TAB); LAS int* woff = (LAS int*)(c.lds + LDS_WOFF); LAS int* tot = tab + 180;
    const unsigned* cw = wsp<unsigned>(c, OFF_CNTW);
    if (c.tid < 16) { int s = 0;
#pragma unroll 8
        for (int v = 0; v < c.G; ++v) { if (WITH_OFF) woff[v * 16 + c.tid] = s; s += (int)cw[v * 16 + c.tid]; }
        tot[c.tid] = s; }
    __syncthreads();
    if (c.tid == 0) { int t = 0;
        for (int e = 0; e < 16; ++e) { const int nt = (tot[e] + 255) >> 8; tab[160 + e] = t * 256; for (int i = 0; i < nt && t < MAXT; ++i) tab[t++] = e; }
        tab[176] = t; }
    __syncthreads();
}
__device__ __forceinline__ void phase_gather(const Ctx& c, int l) {
    moe_tables<true>(c);
    const LAS int* tab = (const LAS int*)(c.lds + LDS_TAB); const LAS int* woff = (const LAS int*)(c.lds + LDS_WOFF);
    const int gw = c.vcu * 8 + c.wave, NGW = c.G * 8;
    const int* te = wsp<int>(c, OFF_TOKE); const int* tp = wsp<int>(c, OFF_TOKP); const float* tw = wsp<float>(c, OFF_TOKW);
    int* slot = wsp<int>(c, OFF_SLOT); float* wrow = wsp<float>(c, OFF_WROW);
    const bf16* XB = wsp<bf16>(c, WS_XB); bf16* XG = wsp<bf16>(c, OFF_XG);
    for (int it0 = gw * 4; it0 < 2 * M; it0 += NGW * 4) {
        int s[4]; u32x4 r0[4], r1[4];
#pragma unroll
        for (int a = 0; a < 4; ++a) { const int it = it0 + a; const int e = te[it], m_ = it >> 1; s[a] = tab[160 + e] + woff[((m_ % (c.G * 8)) >> 3) * 16 + e] + tp[it];     const u32x4* src = (const u32x4*)(XB + (size_t)(it >> 1) * D) + c.lane; r0[a] = src[0]; r1[a] = src[64]; }
#pragma unroll
        for (int a = 0; a < 4; ++a) { const int it = it0 + a; u32x4* dst = (u32x4*)(XG + (size_t)s[a] * D) + c.lane; dst[0] = r0[a]; dst[64] = r1[a];
            if (c.lane == 0) { slot[it] = s[a]; wrow[s[a]] = tw[it]; } }
    }
}
template <bool NEXT>
__device__ __forceinline__ void phase_combine(const Ctx& c, const Params& p, int l, const float* Xsrc, float* Xdst) {
    if (NEXT) load_w8(c, p, l + 1);
    const int gw = c.vcu * 8 + c.wave, NGW = c.G * 8;
    const int* slot = wsp<int>(c, OFF_SLOT); const bf16* YE = wsp<bf16>(c, OFF_XG);
    for (int m = gw; m < M; m += NGW) {
        const int s0 = slot[2 * m], s1 = slot[2 * m + 1];
        f32x4 v[4]; const f32x4* xr = (const f32x4*)(Xsrc + (size_t)m * D) + c.lane;
        const u32x2* y0 = (const u32x2*)(YE + (size_t)s0 * D) + c.lane; const u32x2* y1 = (const u32x2*)(YE + (size_t)s1 * D) + c.lane;
#pragma unroll
        for (int j = 0; j < 4; ++j) { const u32x2 a = y0[64 * j], b = y1[64 * j]; v[j] = xr[64 * j];
            v[j].x = (v[j].x + bflo(a.x)) + bflo(b.x); v[j].y = (v[j].y + bfhi(a.x)) + bfhi(b.x); v[j].z = (v[j].z + bflo(a.y)) + bflo(b.y); v[j].w = (v[j].w + bfhi(a.y)) + bfhi(b.y); }
        f32x4* xo = (f32x4*)(Xdst + (size_t)m * D) + c.lane;
#pragma unroll
        for (int j = 0; j < 4; ++j) xo[64 * j] = v[j];
        if (NEXT) {
            row_norm_store(v, wsp<bf16>(c, WS_XB) + (size_t)m * D, c.lane);
            row_gates(v, (const LAS float*)c.lds, p.in[I_GATE_B] + 8 * (l + 1), wsp<float>(c, OFF_GATES) + (size_t)m * 8, c.lane);
        }
    }
}
__device__ __forceinline__ void gate_scan(const Ctx& c, int bh) {
    const int b = bh >> 2, h = bh & 3, tid = c.tid, lane = c.lane, w = c.wave;
    LAS float* ws_ = (LAS float*)c.lds;
    const float* G = wsp<float>(c, OFF_GATES) + ((size_t)b * SEQ + 8 * tid) * 8;
    float* Aa = wsp<float>(c, OFF_AMA) + bh * SEQ + 8 * tid; float* Am = wsp<float>(c, OFF_AMM) + bh * SEQ + 8 * tid; float* Ab = wsp<float>(c, OFF_AMB) + bh * SEQ + 8 * tid;
    float lf[8], ip[8];
#pragma unroll
    for (int i = 0; i < 8; ++i) { const float f = G[i * 8 + 4 + h]; ip[i] = G[i * 8 + h]; lf[i] = fminf(f, 0.f) - log1pf(__expf(-fabsf(f))); }
    float s = 0.f;
#pragma unroll
    for (int i = 0; i < 8; ++i) { s += lf[i]; lf[i] = s; }
    float incl = s;
#pragma unroll
    for (int o = 1; o < 64; o <<= 1) { const float t = __shfl_up(incl, o); if (lane >= o) incl += t; }
    if (lane == 63) ws_[w] = incl;
    __syncthreads();
    float base = incl - s;
    for (int ww = 0; ww < w; ++ww) base += ws_[ww];
    float av[8], mxl = -3.0e38f;
#pragma unroll
    for (int i = 0; i < 8; ++i) { const float Bc = base + lf[i]; lf[i] = Bc; av[i] = ip[i] - Bc; mxl = fmaxf(mxl, av[i]); }
    float inm = mxl;
#pragma unroll
    for (int o = 1; o < 64; o <<= 1) { const float t = __shfl_up(inm, o); if (lane >= o) inm = fmaxf(inm, t); }
    if (lane == 63) ws_[8 + w] = inm;
    __syncthreads();
    float run = __shfl_up(inm, 1); if (lane == 0) run = 0.f;
    run = fmaxf(run, 0.f);
    for (int ww = 0; ww < w; ++ww) run = fmaxf(run, ws_[8 + ww]);
    float mv[8];
#pragma unroll
    for (int i = 0; i < 8; ++i) { run = fmaxf(run, av[i]); mv[i] = run; }
    *(f32x4*)(Aa) = (f32x4){av[0], av[1], av[2], av[3]}; *(f32x4*)(Aa + 4) = (f32x4){av[4], av[5], av[6], av[7]};
    *(f32x4*)(Am) = (f32x4){mv[0], mv[1], mv[2], mv[3]}; *(f32x4*)(Am + 4) = (f32x4){mv[4], mv[5], mv[6], mv[7]};
    *(f32x4*)(Ab) = (f32x4){lf[0], lf[1], lf[2], lf[3]}; *(f32x4*)(Ab + 4) = (f32x4){lf[4], lf[5], lf[6], lf[7]};
    __syncthreads();
}

typedef short s16x4 __attribute__((ext_vector_type(4)));
__device__ __forceinline__ s16x4 ds_tr(const LAS bf16* p) { return __builtin_bit_cast(s16x4, __builtin_amdgcn_ds_read_tr16_b64_v4i16((LAS s16x4*)p)); }
__device__ __forceinline__ bf16x8 cat4(const s16x4 lo, const s16x4 hi) { return (bf16x8){lo[0], lo[1], lo[2], lo[3], hi[0], hi[1], hi[2], hi[3]}; }
__device__ __forceinline__ bf16x8 ldsA(const LAS bf16* p) { return *(const LAS bf16x8*)p; }
__device__ __forceinline__ bf16x8 pk8f(const f32x4 a, const f32x4 b) { u32x4 w; w.x = pk2(a[0], a[1]); w.y = pk2(a[2], a[3]); w.z = pk2(b[0], b[1]); w.w = pk2(b[2], b[3]); return __builtin_bit_cast(bf16x8, w); }
#define MFMA16(a, b, c) __builtin_amdgcn_mfma_f32_16x16x32_bf16((a), (b), (c), 0, 0, 0)
__device__ __forceinline__ float red4g_sum(float v) { v += __shfl_xor(v, 16); v += __shfl_xor(v, 32); return v; }
__device__ __forceinline__ float red4g_max(float v) { v = fmaxf(v, __shfl_xor(v, 16)); v = fmaxf(v, __shfl_xor(v, 32)); return v; }
__device__ __forceinline__ float red16_sum(float v) { v += __shfl_xor(v, 1); v += __shfl_xor(v, 2); v += __shfl_xor(v, 4); v += __shfl_xor(v, 8); return v; }
constexpr f32x4 Z4 = {0.f, 0.f, 0.f, 0.f};

constexpr int LS = 136;
constexpr int QS = 72;

__device__ __forceinline__ void conv4_silu(const u32x4 (&x)[7], const float* cw, float (&o)[4][8]) {
    float w[4][8];
#pragma unroll
    for (int jj = 0; jj < 4; ++jj) { const f32x4 w0 = *(const f32x4*)(cw + jj * 1024), w1 = *(const f32x4*)(cw + jj * 1024 + 4);
        w[jj][0] = w0.x; w[jj][1] = w0.y; w[jj][2] = w0.z; w[jj][3] = w0.w; w[jj][4] = w1.x; w[jj][5] = w1.y; w[jj][6] = w1.z; w[jj][7] = w1.w; }
    float xf[7][8];
#pragma unroll
    for (int a = 0; a < 7; ++a) unpack8(x[a], xf[a]);
#pragma unroll
    for (int rr = 0; rr < 4; ++rr)
#pragma unroll
        for (int e = 0; e < 8; ++e) { const float s = (w[0][e] * xf[rr][e] + w[1][e] * xf[rr + 1][e]) + (w[2][e] * xf[rr + 2][e] + w[3][e] * xf[rr + 3][e]); o[rr][e] = siluf_(s); }
}
__device__ __forceinline__ void load7(const bf16* colp, int t0, u32x4 (&x)[7]) {
#pragma unroll
    for (int a = 0; a < 7; ++a) { const int t = t0 - 3 + a; x[a] = (t >= 0) ? *(const u32x4*)(colp + (size_t)t * PP) : (u32x4){0u, 0u, 0u, 0u}; }
}

__device__ __forceinline__ void mlstm_delta_unit(const Ctx& c, const Params& p, int l, int bh, int j) {
    const int b = bh >> 2, h = bh & 3, tid = c.tid, lane = c.lane, w = c.wave, r16 = lane & 15, g = lane >> 4;
    LAS bf16* vv = (LAS bf16*)c.lds; LAS bf16* kw = vv + 128 * LS;
    const bf16* projb = wsp<bf16>(c, WS_PROJ) + (size_t)b * SEQ * PP;
    const float* Aa = wsp<float>(c, OFF_AMA) + bh * SEQ + LCH * j; const float Mend = wsp<float>(c, OFF_AMM)[bh * SEQ + LCH * j + LCH - 1];
    {
        const int rg = tid >> 4, c8 = (tid & 15) * 8, t0 = LCH * j + 4 * rg;
        u32x4 xk[7], xv[4];
        load7(projb + C_MK + h * 128 + c8, t0, xk);
#pragma unroll
        for (int rr = 0; rr < 4; ++rr) xv[rr] = *(const u32x4*)(projb + (size_t)(t0 + rr) * PP + C_MV + h * 128 + c8);
        const f32x4 a4 = *(const f32x4*)(Aa + 4 * rg);
        float k[4][8]; conv4_silu(xk, p.in[I_CONV] + (size_t)l * 4 * 1024 + 512 + h * 128 + c8, k);
#pragma unroll
        for (int rr = 0; rr < 4; ++rr) { const float wgt = __expf(a4[rr] - Mend) * 0.08838834764831845f;
#pragma unroll
            for (int e = 0; e < 8; ++e) k[rr][e] *= wgt;
            *(LAS u32x4*)(kw + (4 * rg + rr) * LS + c8) = pack8(k[rr]); *(LAS u32x4*)(vv + (4 * rg + rr) * LS + c8) = xv[rr]; }
    }
    __syncthreads();
    f32x4 acc[8];
#pragma unroll
    for (int nt = 0; nt < 8; ++nt) acc[nt] = Z4;
    const LAS bf16* ap = vv + (8 * g + (r16 >> 2)) * LS + 16 * w + 4 * (r16 & 3); const LAS bf16* bp = kw + (8 * g + (r16 >> 2)) * LS + 4 * (r16 & 3);
#pragma unroll
    for (int ks = 0; ks < 4; ++ks) { const bf16x8 a = cat4(ds_tr(ap + 32 * ks * LS), ds_tr(ap + (32 * ks + 4) * LS));
#pragma unroll
        for (int nt = 0; nt < 8; ++nt) { const bf16x8 bb = cat4(ds_tr(bp + 32 * ks * LS + 16 * nt), ds_tr(bp + (32 * ks + 4) * LS + 16 * nt)); acc[nt] = MFMA16(a, bb, acc[nt]); } }
    float* st = wsp<float>(c, WS_T) + (size_t)(bh * NCH + j) * (128 * 128);
#pragma unroll
    for (int nt = 0; nt < 8; ++nt)
#pragma unroll
        for (int i = 0; i < 4; ++i) st[(16 * w + 4 * g + i) * 128 + 16 * nt + r16] = acc[nt][i];
    if (tid < 128) { float s = 0.f;
#pragma unroll 8
        for (int r = 0; r < 128; ++r) s += bf2f(kw[r * LS + tid]);
        wsp<float>(c, OFF_NST)[(bh * NCH + j) * 128 + tid] = s; }
    __syncthreads();
}
__device__ __forceinline__ void mlstm_scan(const Ctx& c) {
    constexpr int EL4 = (128 * 128 + 128) / 4;
    const int gt = c.vcu * 512 + c.tid, NT = c.G * 512;
    for (int idx = gt; idx < 16 * EL4; idx += NT) {
        const int bh = idx / EL4, el = idx % EL4;
        const float* Am = wsp<float>(c, OFF_AMM) + bh * SEQ;
        f32x4* base = el < 4096 ? (f32x4*)(wsp<float>(c, WS_T) + (size_t)bh * NCH * 16384) + el : (f32x4*)(wsp<float>(c, OFF_NST) + bh * NCH * 128) + (el - 4096);
        const int stride = el < 4096 ? 4096 : 32;
        f32x4 cs = {0.f, 0.f, 0.f, 0.f}; float Mprev = 0.f;
#pragma unroll 1
        for (int j0 = 0; j0 < NCH; j0 += 8) {
            f32x4 dl[8]; float gg[8];
#pragma unroll
            for (int a = 0; a < 8; ++a) { dl[a] = base[(size_t)(j0 + a) * stride]; const float Mend = Am[LCH * (j0 + a) + LCH - 1]; gg[a] = __expf(Mprev - Mend); Mprev = Mend; }
#pragma unroll
            for (int a = 0; a < 8; ++a) { cs = cs * gg[a] + dl[a]; base[(size_t)(j0 + a) * stride] = cs; }
        }
    }
}
__device__ __forceinline__ void mlstm_out_unit(const Ctx& c, const Params& p, int l, int bh, int j) {
    const int b = bh >> 2, h = bh & 3, tid = c.tid, lane = c.lane, w = c.wave, r16 = lane & 15, g = lane >> 4;
    LAS bf16* qq = (LAS bf16*)c.lds; LAS bf16* kk = qq + 128 * LS; LAS bf16* vv = kk + 128 * LS; LAS bf16* CTb = vv + 128 * LS;
    LAS float* fa = (LAS float*)(CTb + 144 * LS); LAS float* fM = fa + 128; LAS float* fB = fM + 128;
    bf16* projb = wsp<bf16>(c, WS_PROJ) + (size_t)b * SEQ * PP;
    {
        const int rg = tid >> 4, c8 = (tid & 15) * 8, t0 = LCH * j + 4 * rg;
        u32x4 xq[7], xk[7], xv[4];
        load7(projb + C_MQ + h * 128 + c8, t0, xq); load7(projb + C_MK + h * 128 + c8, t0, xk);
#pragma unroll
        for (int rr = 0; rr < 4; ++rr) xv[rr] = *(const u32x4*)(projb + (size_t)(t0 + rr) * PP + C_MV + h * 128 + c8);
        const int e = tid >> 2, d0 = (tid & 3) * 32;
        f32x4 sv[8];
        if (j > 0) { const f32x4* sp = (const f32x4*)(wsp<float>(c, WS_T) + (size_t)(bh * NCH + j - 1) * 16384 + e * 128 + d0);
#pragma unroll
            for (int a = 0; a < 8; ++a) sv[a] = sp[a]; }
        else {
#pragma unroll
            for (int a = 0; a < 8; ++a) sv[a] = Z4; }
        const float* cwq = p.in[I_CONV] + (size_t)l * 4 * 1024 + h * 128 + c8;
        float o[4][8];
        conv4_silu(xq, cwq, o);
#pragma unroll
        for (int rr = 0; rr < 4; ++rr) *(LAS u32x4*)(qq + (4 * rg + rr) * LS + c8) = pack8(o[rr]);
        conv4_silu(xk, cwq + 512, o);
#pragma unroll
        for (int rr = 0; rr < 4; ++rr) {
#pragma unroll
            for (int e2 = 0; e2 < 8; ++e2) o[rr][e2] *= 0.08838834764831845f;
            *(LAS u32x4*)(kk + (4 * rg + rr) * LS + c8) = pack8(o[rr]); *(LAS u32x4*)(vv + (4 * rg + rr) * LS + c8) = xv[rr]; }
#pragma unroll
        for (int a = 0; a < 4; ++a) *(LAS bf16x8*)(CTb + e * LS + d0 + 8 * a) = pk8f(sv[2 * a], sv[2 * a + 1]);
    }
    if (tid < 256) { const int e = 128 + (tid >> 4), c8 = (tid & 15) * 8; float s8[8];
#pragma unroll
        for (int i = 0; i < 8; ++i) s8[i] = 0.f;
        if (e == 128 && j > 0) { const float* nn = wsp<float>(c, OFF_NST) + (bh * NCH + j - 1) * 128 + c8;
#pragma unroll
            for (int i = 0; i < 8; ++i) s8[i] = nn[i]; }
        *(LAS u32x4*)(CTb + e * LS + c8) = pack8(s8); }
    if (tid < 128) { const int t = bh * SEQ + LCH * j + tid; fa[tid] = wsp<float>(c, OFF_AMA)[t]; fM[tid] = wsp<float>(c, OFF_AMM)[t]; fB[tid] = wsp<float>(c, OFF_AMB)[t]; }
    __syncthreads();
    const float Mprev = j > 0 ? wsp<float>(c, OFF_AMM)[bh * SEQ + LCH * j - 1] : 0.f;
    const int tq = 16 * w + r16;
    f32x4 as[8], ai[9];
#pragma unroll
    for (int a = 0; a < 8; ++a) as[a] = Z4;
#pragma unroll
    for (int a = 0; a < 9; ++a) ai[a] = Z4;
#pragma unroll
    for (int ks = 0; ks < 4; ++ks) { const bf16x8 bq = ldsA(qq + tq * LS + 32 * ks + 8 * g);
#pragma unroll
        for (int mt = 0; mt < 8; ++mt) if (mt <= w) as[mt] = MFMA16(ldsA(kk + (16 * mt + r16) * LS + 32 * ks + 8 * g), bq, as[mt]);
#pragma unroll
        for (int et = 0; et < 9; ++et) ai[et] = MFMA16(ldsA(CTb + (16 * et + r16) * LS + 32 * ks + 8 * g), bq, ai[et]);
        __builtin_amdgcn_sched_barrier(0); }
    const float Mt = fM[tq], winter = __expf(Mprev - Mt);
    float den = 0.f;
#pragma unroll
    for (int mt = 0; mt < 8; ++mt)
#pragma unroll
        for (int i = 0; i < 4; ++i) { const int r = 16 * mt + 4 * g + i; const float wg = (mt <= w && r <= tq) ? __expf(fa[r] - Mt) : 0.f; const float sw = as[mt][i] * wg; as[mt][i] = sw; den += sw; }
    den = red4g_sum(den);
    const float dinter = __shfl(ai[8][0], r16);
    const float dd = den + winter * dinter;
    const float dn = fmaxf(fabsf(dd), __expf(-(fB[tq] + Mt)));
    f32x4 ao[8];
#pragma unroll
    for (int et = 0; et < 8; ++et) ao[et] = ai[et] * winter;
    const LAS bf16* vp = vv + (4 * g + (r16 >> 2)) * LS + 4 * (r16 & 3);
#pragma unroll
    for (int ks = 0; ks < 4; ++ks) if (2 * ks <= w) { const bf16x8 bp = pk8f(as[2 * ks], as[2 * ks + 1]);
#pragma unroll
        for (int et = 0; et < 8; ++et) ao[et] = MFMA16(cat4(ds_tr(vp + 32 * ks * LS + 16 * et), ds_tr(vp + (32 * ks + 16) * LS + 16 * et)), bp, ao[et]);
        __builtin_amdgcn_sched_barrier(0); }
    const float inv = 1.f / dn; float ss = 0.f;
#pragma unroll
    for (int et = 0; et < 8; ++et) { ao[et] = ao[et] * inv; ss += (ao[et][0] * ao[et][0] + ao[et][1] * ao[et][1]) + (ao[et][2] * ao[et][2] + ao[et][3] * ao[et][3]); }
    ss = red4g_sum(ss); const float rs = 1.f / sqrtf(ss * (1.f / 128.f) + EPS);
    const float* gain = p.in[I_MLSTM_NORM] + l * 512 + h * 128; bf16* orow = projb + (size_t)(LCH * j + tq) * PP + C_MO + h * 128;
#pragma unroll
    for (int et = 0; et < 8; ++et) { const int e0 = 16 * et + 4 * g; const u32x2 mo = *(const u32x2*)(orow + e0); const f32x4 gn = *(const f32x4*)(gain + e0);
        u32x2 o; o.x = pk2(ao[et][0] * rs * gn[0] * sigmoidf_(bflo(mo.x)), ao[et][1] * rs * gn[1] * sigmoidf_(bfhi(mo.x))); o.y = pk2(ao[et][2] * rs * gn[2] * sigmoidf_(bflo(mo.y)), ao[et][3] * rs * gn[3] * sigmoidf_(bfhi(mo.y)));
        *(u32x2*)(orow + e0) = o; }
    __syncthreads();
}

__device__ __forceinline__ void dattn_unit(const Ctx& c, const Params& p, int l, int b, int h, int blk) {
    const int tid = c.tid, lane = c.lane, w = c.wave, r16 = lane & 15, g = lane >> 4;
    const int grp = h >> 2, dil = grp == 0 ? 1 : (grp == 1 ? 4 : 16), nb = 32 / dil, res = blk / nb, n = blk % nb;
    LAS bf16* kn = (LAS bf16*)c.lds; LAS bf16* vv = kn + 256 * QS; LAS float* bias = (LAS float*)(vv + 272 * QS);
    bf16* projb = wsp<bf16>(c, WS_PROJ) + (size_t)b * SEQ * PP;
    const float* gq = p.in[I_ATTN_QKN] + l * 128; const float* gk = gq + 64;
    {
        const int c8 = (tid & 7) * 8; u32x4 xk[4], xv[4];
#pragma unroll
        for (int a = 0; a < 4; ++a) { const int ki = (tid >> 3) + 64 * a, s = 128 * (n - 1) + ki;
            if (s >= 0) { const size_t pos = (size_t)(s * dil + res); xk[a] = *(const u32x4*)(projb + pos * PP + C_AK + h * 64 + c8); xv[a] = *(const u32x4*)(projb + pos * PP + C_AV + h * 64 + c8); }
            else { xk[a] = (u32x4){0u, 0u, 0u, 0u}; xv[a] = (u32x4){0u, 0u, 0u, 0u}; } }
        const f32x4 g0 = *(const f32x4*)(gk + c8), g1 = *(const f32x4*)(gk + c8 + 4);
#pragma unroll
        for (int a = 0; a < 4; ++a) { const int ki = (tid >> 3) + 64 * a; float x[8]; unpack8(xk[a], x);
            float ss = 0.f;
#pragma unroll
            for (int e = 0; e < 8; ++e) ss += x[e] * x[e];
            ss += __shfl_xor(ss, 1); ss += __shfl_xor(ss, 2); ss += __shfl_xor(ss, 4);
            const float rs = 1.f / sqrtf(ss * (1.f / 64.f) + EPS);
            x[0] *= rs * g0.x; x[1] *= rs * g0.y; x[2] *= rs * g0.z; x[3] *= rs * g0.w; x[4] *= rs * g1.x; x[5] *= rs * g1.y; x[6] *= rs * g1.z; x[7] *= rs * g1.w;
            *(LAS u32x4*)(kn + ki * QS + c8) = pack8(x); *(LAS u32x4*)(vv + ki * QS + c8) = xv[a]; }
        if (tid < 144) *(LAS u32x4*)(vv + 256 * QS + tid * 8) = (u32x4){0u, 0u, 0u, 0u};
        if (tid < 132) bias[tid] = wsp<float>(c, OFF_BIAS)[h * 132 + tid];
    }
    const int qi = 16 * w + r16; const size_t qpos = (size_t)((128 * n + qi) * dil + res);
    bf16* qrow = projb + qpos * PP + C_AQ + h * 64;
    bf16x8 bq[2];
    { float x0[8], x1[8]; unpack8(*(const u32x4*)(qrow + 8 * g), x0); unpack8(*(const u32x4*)(qrow + 32 + 8 * g), x1);
      float ss = 0.f;
#pragma unroll
      for (int e = 0; e < 8; ++e) ss += x0[e] * x0[e] + x1[e] * x1[e];
      ss = red4g_sum(ss); const float rs = 0.125f / sqrtf(ss * (1.f / 64.f) + EPS);
#pragma unroll
      for (int e = 0; e < 8; ++e) { x0[e] *= rs * gq[8 * g + e]; x1[e] *= rs * gq[32 + 8 * g + e]; }
      bq[0] = __builtin_bit_cast(bf16x8, pack8(x0)); bq[1] = __builtin_bit_cast(bf16x8, pack8(x1)); }
    __syncthreads();
    const int kb = 16 * w;
    f32x4 acc[10];
#pragma unroll
    for (int mt = 0; mt < 10; ++mt) acc[mt] = Z4;
#pragma unroll
    for (int ks = 0; ks < 2; ++ks)
#pragma unroll
        for (int mt = 0; mt < 9; ++mt) acc[mt] = MFMA16(ldsA(kn + (kb + 16 * mt + r16) * QS + 32 * ks + 8 * g), bq[ks], acc[mt]);
    float mx = -3.0e38f;
#pragma unroll
    for (int mt = 0; mt < 9; ++mt)
#pragma unroll
        for (int i = 0; i < 4; ++i) { const int ki = kb + 16 * mt + 4 * g + i, dist = 128 + qi - ki; const bool ok = dist >= 0 && dist <= 128 && (n > 0 || ki >= 128);
            const float lg = ok ? acc[mt][i] + bias[ok ? dist : 0] : -3.0e38f; acc[mt][i] = lg; mx = fmaxf(mx, lg); }
    mx = red4g_max(mx);
    float lsum = 0.f;
#pragma unroll
    for (int mt = 0; mt < 9; ++mt)
#pragma unroll
        for (int i = 0; i < 4; ++i) { const float lg = acc[mt][i]; const float pe = lg > -1.0e38f ? __expf(lg - mx) : 0.f; lsum += pe; acc[mt][i] = pe; }
    lsum = red4g_sum(lsum);
    f32x4 ao[4];
#pragma unroll
    for (int et = 0; et < 4; ++et) ao[et] = Z4;
    const LAS bf16* vp = vv + (kb + 4 * g + (r16 >> 2)) * QS + 4 * (r16 & 3);
#pragma unroll
    for (int ks = 0; ks < 5; ++ks) { const bf16x8 bp = pk8f(acc[2 * ks], acc[2 * ks + 1]);
#pragma unroll
        for (int et = 0; et < 4; ++et) ao[et] = MFMA16(cat4(ds_tr(vp + 32 * ks * QS + 16 * et), ds_tr(vp + (32 * ks + 16) * QS + 16 * et)), bp, ao[et]); }
    const float inv = 1.f / lsum;
#pragma unroll
    for (int et = 0; et < 4; ++et) { u32x2 o; o.x = pk2(ao[et][0] * inv, ao[et][1] * inv); o.y = pk2(ao[et][2] * inv, ao[et][3] * inv); *(u32x2*)(qrow + 16 * et + 4 * g) = o; }
    if (g == 0) wsp<float>(c, OFF_LSE)[((size_t)b * SEQ + qpos) * 12 + h] = mx + __logf(lsum);
    __syncthreads();
}
__device__ __forceinline__ void dattn_merge(const Ctx& c) {
    const int gt = c.vcu * 512 + c.tid, NT = c.G * 512;
    const float* LSE = wsp<float>(c, OFF_LSE); bf16* proj = wsp<bf16>(c, WS_PROJ);
    for (int it = gt; it < M * 96; it += NT) {
        const int m = it / 96, rr = it % 96, h = rr >> 3, c8 = (rr & 7) * 8, hg = h & 3;
        const float l0 = LSE[(size_t)m * 12 + hg], l1 = LSE[(size_t)m * 12 + 4 + hg], l2 = LSE[(size_t)m * 12 + 8 + hg], lm = LSE[(size_t)m * 12 + h];
        const float mxx = fmaxf(l0, fmaxf(l1, l2)); const float al = __expf(lm - mxx) / (__expf(l0 - mxx) + __expf(l1 - mxx) + __expf(l2 - mxx));
        u32x4* ptr = (u32x4*)(proj + (size_t)m * PP + C_AQ + h * 64 + c8); float x[8]; unpack8(*ptr, x);
#pragma unroll
        for (int e = 0; e < 8; ++e) x[e] *= al;
        *ptr = pack8(x);
    }
}

__device__ __forceinline__ void gmlp_unit(const Ctx& c, const Params& p, int l, int b, int n, int grp) {
    const int tid = c.tid, lane = c.lane, w = c.wave, r16 = lane & 15, g = lane >> 4;
    LAS bf16* Wc = (LAS bf16*)c.lds; LAS bf16* vn = Wc + 128 * LS;
    bf16* projb = wsp<bf16>(c, WS_PROJ) + ((size_t)b * SEQ + 128 * n) * PP;
    const float* ws = p.in[I_GMLP_WS] + ((size_t)l * 4 + grp) * 128 * 128; const float* gain = p.in[I_GMLP_NORM] + l * 512 + grp * 128; const float* bs = p.in[I_GMLP_BS] + (l * 4 + grp) * 128;
    {
        const int c8 = (tid & 15) * 8; u32x4 xv[4]; f32x4 wv[4][2];
#pragma unroll
        for (int a = 0; a < 4; ++a) { const int r = (tid >> 4) + 32 * a; xv[a] = *(const u32x4*)(projb + (size_t)r * PP + C_GV + grp * 128 + c8); wv[a][0] = *(const f32x4*)(ws + r * 128 + c8); wv[a][1] = *(const f32x4*)(ws + r * 128 + c8 + 4); }
        const f32x4 g0 = *(const f32x4*)(gain + c8), g1 = *(const f32x4*)(gain + c8 + 4);
#pragma unroll
        for (int a = 0; a < 4; ++a) { const int r = (tid >> 4) + 32 * a;
            float wf[8] = {wv[a][0].x, wv[a][0].y, wv[a][0].z, wv[a][0].w, wv[a][1].x, wv[a][1].y, wv[a][1].z, wv[a][1].w};
#pragma unroll
            for (int e = 0; e < 8; ++e) if (c8 + e > r) wf[e] = 0.f;
            *(LAS u32x4*)(Wc + r * LS + c8) = pack8(wf);
            float x[8]; unpack8(xv[a], x); float ss = 0.f;
#pragma unroll
            for (int e = 0; e < 8; ++e) { x[e] = gelu_tanh(x[e]); ss += x[e] * x[e]; }
            ss = red16_sum(ss); const float rs = 1.f / sqrtf(ss * (1.f / 128.f) + EPS);
            x[0] *= rs * g0.x; x[1] *= rs * g0.y; x[2] *= rs * g0.z; x[3] *= rs * g0.w; x[4] *= rs * g1.x; x[5] *= rs * g1.y; x[6] *= rs * g1.z; x[7] *= rs * g1.w;
            *(LAS u32x4*)(vn + r * LS + c8) = pack8(x); }
    }
    __syncthreads();
    const int tq = 16 * w + r16;
    f32x4 acc[8];
#pragma unroll
    for (int ct = 0; ct < 8; ++ct) acc[ct] = Z4;
    const LAS bf16* vp = vn + (8 * g + (r16 >> 2)) * LS + 4 * (r16 & 3);
#pragma unroll
    for (int ks = 0; ks < 4; ++ks) if (32 * ks <= 16 * w + 15) { const bf16x8 bw = ldsA(Wc + tq * LS + 32 * ks + 8 * g);
#pragma unroll
        for (int ct = 0; ct < 8; ++ct) acc[ct] = MFMA16(cat4(ds_tr(vp + 32 * ks * LS + 16 * ct), ds_tr(vp + (32 * ks + 4) * LS + 16 * ct)), bw, acc[ct]); }
    const float bb = bs[tq]; bf16* orow = projb + (size_t)tq * PP + C_GU + grp * 128;
#pragma unroll
    for (int ct = 0; ct < 8; ++ct) { const int c0 = 16 * ct + 4 * g; const u32x2 u = *(const u32x2*)(orow + c0);
        u32x2 o; o.x = pk2(gelu_tanh(bflo(u.x)) * (acc[ct][0] + bb), gelu_tanh(bfhi(u.x)) * (acc[ct][1] + bb)); o.y = pk2(gelu_tanh(bflo(u.y)) * (acc[ct][2] + bb), gelu_tanh(bfhi(u.y)) * (acc[ct][3] + bb));
        *(u32x2*)(orow + c0) = o; }
    __syncthreads();
}

__device__ __forceinline__ void xattn_unit(const Ctx& c, const Params& p, int l, int bh, int tp) {
    const int b = bh >> 2, h = bh & 3, tid = c.tid, lane = c.lane, w = c.wave, r16 = lane & 15, g = lane >> 4;
    LAS bf16* kn = (LAS bf16*)c.lds; LAS bf16* vv = kn + 256 * LS;
    const bf16* KV = wsp<bf16>(c, OFF_KV) + (size_t)b * MEML * 1024;
    const float* gq = p.in[I_XATTN_QKN] + l * 256; const float* gk = gq + 128;
    {
        const int c8 = (tid & 15) * 8; const f32x4 g0 = *(const f32x4*)(gk + c8), g1 = *(const f32x4*)(gk + c8 + 4);
#pragma unroll
        for (int half = 0; half < 2; ++half) { u32x4 xk[4], xv[4];
#pragma unroll
            for (int a = 0; a < 4; ++a) { const int ki = (tid >> 4) + 32 * (4 * half + a); xk[a] = *(const u32x4*)(KV + (size_t)ki * 1024 + h * 128 + c8); xv[a] = *(const u32x4*)(KV + (size_t)ki * 1024 + 512 + h * 128 + c8); }
#pragma unroll
            for (int a = 0; a < 4; ++a) { const int ki = (tid >> 4) + 32 * (4 * half + a); float x[8]; unpack8(xk[a], x); float ss = 0.f;
#pragma unroll
                for (int e = 0; e < 8; ++e) ss += x[e] * x[e];
                ss = red16_sum(ss); const float rs = 1.f / sqrtf(ss * (1.f / 128.f) + EPS);
                x[0] *= rs * g0.x; x[1] *= rs * g0.y; x[2] *= rs * g0.z; x[3] *= rs * g0.w; x[4] *= rs * g1.x; x[5] *= rs * g1.y; x[6] *= rs * g1.z; x[7] *= rs * g1.w;
                *(LAS u32x4*)(kn + ki * LS + c8) = pack8(x); *(LAS u32x4*)(vv + ki * LS + c8) = xv[a]; } }
    }
    __syncthreads();
    const LAS bf16* vp = vv + (4 * g + (r16 >> 2)) * LS + 4 * (r16 & 3);
    for (int tt = 2 * tp; tt < 2 * tp + 2; ++tt) {
        const size_t row = (size_t)b * SEQ + 128 * tt + 16 * w + r16;
        const bf16* qrow = wsp<bf16>(c, OFF_Q) + row * 512 + h * 128;
        bf16x8 bq[4];
        { float qf[4][8]; float ss = 0.f;
#pragma unroll
          for (int ks = 0; ks < 4; ++ks) { unpack8(*(const u32x4*)(qrow + 32 * ks + 8 * g), qf[ks]);
#pragma unroll
              for (int e = 0; e < 8; ++e) ss += qf[ks][e] * qf[ks][e]; }
          ss = red4g_sum(ss); const float rsq = 0.08838834764831845f / sqrtf(ss * (1.f / 128.f) + EPS);
#pragma unroll
          for (int ks = 0; ks < 4; ++ks) {
#pragma unroll
              for (int e = 0; e < 8; ++e) qf[ks][e] *= rsq * gq[32 * ks + 8 * g + e];
              bq[ks] = __builtin_bit_cast(bf16x8, pack8(qf[ks])); } }
        f32x4 acc[16];
#pragma unroll
        for (int mt = 0; mt < 16; ++mt) acc[mt] = Z4;
#pragma unroll
        for (int ks = 0; ks < 4; ++ks) {
#pragma unroll
            for (int mt = 0; mt < 16; ++mt) acc[mt] = MFMA16(ldsA(kn + (16 * mt + r16) * LS + 32 * ks + 8 * g), bq[ks], acc[mt]);
            __builtin_amdgcn_sched_barrier(0); }
        float mx = -3.0e38f;
#pragma unroll
        for (int mt = 0; mt < 16; ++mt) mx = fmaxf(fmaxf(mx, fmaxf(acc[mt][0], acc[mt][1])), fmaxf(acc[mt][2], acc[mt][3]));
        mx = red4g_max(mx);
        float lsum = 0.f;
#pragma unroll
        for (int mt = 0; mt < 16; ++mt)
#pragma unroll
            for (int i = 0; i < 4; ++i) { const float pe = __expf(acc[mt][i] - mx); lsum += pe; acc[mt][i] = pe; }
        lsum = red4g_sum(lsum);
        f32x4 ao[8];
#pragma unroll
        for (int et = 0; et < 8; ++et) ao[et] = Z4;
#pragma unroll
        for (int ks = 0; ks < 8; ++ks) { const bf16x8 bp = pk8f(acc[2 * ks], acc[2 * ks + 1]);
#pragma unroll
            for (int et = 0; et < 8; ++et) ao[et] = MFMA16(cat4(ds_tr(vp + 32 * ks * LS + 16 * et), ds_tr(vp + (32 * ks + 16) * LS + 16 * et)), bp, ao[et]);
            __builtin_amdgcn_sched_barrier(0); }
        const float inv = 1.f / lsum; bf16* orow = wsp<bf16>(c, OFF_O) + row * 512 + h * 128;
#pragma unroll
        for (int et = 0; et < 8; ++et) { u32x2 o; o.x = pk2(ao[et][0] * inv, ao[et][1] * inv); o.y = pk2(ao[et][2] * inv, ao[et][3] * inv); *(u32x2*)(orow + 16 * et + 4 * g) = o; }
    }
    __syncthreads();
}
enum { PH_PRE = 0, PH_A1, PH_MIXA, PH_MIXB, PH_MIXC, PH_GATE, PH_BR0, PH_BR1, PH_BR2, PH_WOUT, PH_RP1, PH_XQ, PH_XA, PH_XO, PH_RP2, PH_GATHER, PH_GU, PH_DOWN, PH_COMB, NPH_LAYER };

template <int PH>
__device__ __forceinline__ void run_phase(const Ctx& c, const Params& p, int l) {
    bf16* const XB = wsp<bf16>(c, WS_XB); bf16* const PROJ = wsp<bf16>(c, WS_PROJ);
    const float* Xin = (l == 0) ? p.in[I_X] : p.out;
    if constexpr (PH == PH_PRE) { phase_weights(c, p, 0); __syncthreads(); phase_rp0_input(c, p); }
    if constexpr (PH == PH_A1) {
        if (c.bx >= c.G - 16) gate_scan(c, c.bx - (c.G - 16));
        { pg8::Gemm g{XB, wsp<bf16>(c, OFF_WIN1), D, D}; pg8::StaticOrder S; S.init(M, PP, c.G, c.bx); epi::Bf16Out E{PROJ, PP};
          pg8::gemm_phase<epi::Bf16Out, pg8::StaticOrder, true>(c.lds, g, S, E); }
        { pg8::Gemm g{wsp<bf16>(c, OFF_MEMB), wsp<bf16>(c, OFF_WXKV), D, D}; pg8::StaticOrder S; S.init(MM, 1024, c.G, (c.bx + c.G - 64) % c.G); epi::Bf16Out E{wsp<bf16>(c, OFF_KV), 1024};
          pg8::gemm_phase<epi::Bf16Out, pg8::StaticOrder, true>(c.lds, g, S, E); }
    }
    if constexpr (PH == PH_MIXA) {
        for (int u = c.bx; u < 16 * NCH; u += c.G) mlstm_delta_unit(c, p, l, u / NCH, u % NCH);
        for (int u = c.bx; u < NBATCH * 32 * 4; u += c.G) gmlp_unit(c, p, l, u >> 7, (u >> 2) & 31, u & 3);
    }
    if constexpr (PH == PH_MIXB) {
        mlstm_scan(c);
        for (int u = c.bx; u < NBATCH * 12 * 32; u += c.G) { const int blk = u & 31, bh = u >> 5; dattn_unit(c, p, l, bh / 12, bh % 12, blk); }
    }
    if constexpr (PH == PH_MIXC) { for (int u = c.bx; u < 16 * NCH; u += c.G) mlstm_out_unit(c, p, l, u / NCH, u % NCH); dattn_merge(c); }
    if constexpr (PH == PH_GATE) { pg8::Gemm g{XB, wsp<bf16>(c, OFF_WG), D, D}; pg8::StaticOrder S; S.init(M, 3072, c.G, c.bx); epi::SigOut E{PROJ};
        pg8::gemm_phase<epi::SigOut, pg8::StaticOrder, true>(c.lds, g, S, E); }
    if constexpr (PH == PH_BR0) { pg8::StaticOrder S; S.init(M, 1024, c.G, c.bx); pg8::Gemm g{PROJ + C_MO, wsp<bf16>(c, OFF_WA), PP, 512}; epi::BranchOut<0> E{PROJ, wsp<bf16>(c, WS_T), XB};
        pg8::gemm_phase<epi::BranchOut<0>, pg8::StaticOrder, false>(c.lds, g, S, E); }
    if constexpr (PH == PH_BR1) { pg8::StaticOrder S; S.init(M, 1024, c.G, c.bx); pg8::Gemm g{PROJ + C_AQ, wsp<bf16>(c, OFF_WB), PP, 768}; epi::BranchOut<1> E{PROJ, wsp<bf16>(c, WS_T), XB};
        pg8::gemm_phase<epi::BranchOut<1>, pg8::StaticOrder, false>(c.lds, g, S, E); }
    if constexpr (PH == PH_BR2) { pg8::StaticOrder S; S.init(M, 1024, c.G, c.bx); pg8::Gemm g{PROJ + C_GU, wsp<bf16>(c, OFF_WC), PP, 512}; epi::BranchOut<2> E{PROJ, wsp<bf16>(c, WS_T), XB};
        pg8::gemm_phase<epi::BranchOut<2>, pg8::StaticOrder, false>(c.lds, g, S, E); }
    if constexpr (PH == PH_WOUT) { pg8::Gemm g{XB, wsp<bf16>(c, OFF_WOUT), D, D}; pg8::StaticOrder S; S.init(M, 1024, c.G, c.bx); epi::ResidOut E{Xin, p.out};
        pg8::gemm_phase<epi::ResidOut, pg8::StaticOrder, false>(c.lds, g, S, E); }
    if constexpr (PH == PH_RP1) phase_rp1(c, p.out);
    if constexpr (PH == PH_XQ) { pg8::Gemm g{XB, wsp<bf16>(c, OFF_WXQ), D, D}; pg8::StaticOrder S; S.init(M, 512, c.G, c.bx); epi::Bf16Out E{wsp<bf16>(c, OFF_Q), 512};
        pg8::gemm_phase<epi::Bf16Out, pg8::StaticOrder, false>(c.lds, g, S, E); }
    if constexpr (PH == PH_XA) { for (int u = c.bx; u < 16 * 16; u += c.G) xattn_unit(c, p, l, u >> 4, u & 15); }
    if constexpr (PH == PH_XO) { pg8::Gemm g{wsp<bf16>(c, OFF_O), wsp<bf16>(c, OFF_WXO), 512, 512}; pg8::StaticOrder S; S.init(M, 1024, c.G, c.bx); epi::ResidOut E{p.out, p.out};
        pg8::gemm_phase<epi::ResidOut, pg8::StaticOrder, false>(c.lds, g, S, E); }
    if constexpr (PH == PH_RP2) phase_rp2_route(c, p, l, p.out);
    if constexpr (PH == PH_GATHER) phase_gather(c, l);
    if constexpr (PH == PH_GU) { moe_tables<false>(c); pg8::Gemm g{wsp<bf16>(c, OFF_XG), wsp<bf16>(c, OFF_WGU), D, D}; MoeOrder S{(const LAS int*)(c.lds + LDS_TAB), c.G, c.bx}; epi::GluOut E{wsp<bf16>(c, OFF_HID)};
        pg8::gemm_phase<epi::GluOut, MoeOrder, true>(c.lds, g, S, E); }
    if constexpr (PH == PH_DOWN) { moe_tables<false>(c); pg8::Gemm g{wsp<bf16>(c, OFF_HID), wsp<bf16>(c, OFF_WD), DFF, DFF}; MoeOrder S{(const LAS int*)(c.lds + LDS_TAB), c.G, c.bx}; epi::DownOut E{wsp<bf16>(c, OFF_XG), wsp<float>(c, OFF_WROW)};
        pg8::gemm_phase<epi::DownOut, MoeOrder, true>(c.lds, g, S, E); }
    if constexpr (PH == PH_COMB) { if (l + 1 < DEPTH) { phase_combine<true>(c, p, l, p.out, p.out); __syncthreads(); phase_weights(c, p, l + 1); } else phase_combine<false>(c, p, l, p.out, p.out); }
}

__device__ __forceinline__ Ctx make_ctx(const Params& p, unsigned char* lds_raw) {
    Ctx c;
    c.lds = (LAS unsigned char*)lds_raw; c.ws = p.ws;
    int tid_ = threadIdx.x, bx = blockIdx.x, G_ = gridDim.x;
    asm volatile("" : "+v"(tid_), "+s"(bx), "+s"(G_));
    c.tid = tid_; c.lane = c.tid & 63; c.wave = __builtin_amdgcn_readfirstlane(c.tid >> 6);
    c.G = G_; c.bx = bx; c.vcu = (c.G % 8 == 0) ? (bx % 8) * (c.G / 8) + bx / 8 : bx;
    return c;
}
#ifndef MK_ONE_LAUNCH
#define MK_ONE_LAUNCH 1
#endif
#if !MK_ONE_LAUNCH
template <int PH>
__global__ void __launch_bounds__(512, 2) phase_kernel(Params p, int l) {
    extern __shared__ __attribute__((aligned(16))) unsigned char lds_raw[];
    const Ctx c = make_ctx(p, lds_raw);
    run_phase<PH>(c, p, l);
}
template <int PH> static void launch_phases(int grid, const Params& a, int l, hipStream_t stream) {
    if constexpr (PH < NPH_LAYER) {
        static bool attr_done = false;
        if (!attr_done) { (void)hipFuncSetAttribute((const void*)phase_kernel<PH>, hipFuncAttributeMaxDynamicSharedMemorySize, LDS_BYTES); attr_done = true; }
        if (!(PH == PH_PRE && l != 0)) hipLaunchKernelGGL(phase_kernel<PH>, dim3(grid), dim3(512), LDS_BYTES, stream, a, l);
        launch_phases<PH + 1>(grid, a, l, stream);
    }
}
#else
#if defined(__HIP_DEVICE_COMPILE__)
typedef const __attribute__((address_space(4))) Params* KParams;
#else
typedef const Params* KParams;
#endif
template <int PH>
__device__ __forceinline__ void phase_site(KParams kp, int l) {
    extern __shared__ __attribute__((aligned(16))) unsigned char lds_raw[];
    asm volatile("" : "+s"(kp));
    Params p;
#pragma unroll
    for (int i = 0; i < 28; ++i) p.in[i] = kp->in[i];
    p.out = kp->out; p.ws = kp->ws;
    const Ctx c = make_ctx(p, lds_raw);
    run_phase<PH>(c, p, l);
}
__device__ __forceinline__ void seam(KParams kp) {
    extern __shared__ __attribute__((aligned(16))) unsigned char lds_raw[];
    asm volatile("" : "+s"(kp));
    XcdBarrier b; b.bar = (unsigned*)(kp->ws + WS_CTL) + CW_BAR; b.x = xb_xcc_id(); b.st = (volatile LAS unsigned*)((LAS unsigned char*)lds_raw + LDS_MISC) + 8;
    xcd_barrier(b);
}
template <int PH> __device__ __forceinline__ void run_layer(KParams kp, int l) {
    if constexpr (PH < NPH_LAYER) {
        if (!(PH == PH_PRE && l != 0)) {
#ifdef PROBE_AMP
            const unsigned long long t0_ = __builtin_amdgcn_s_memrealtime();
#endif
            phase_site<PH>(kp, l); seam(kp);
#ifdef PROBE_AMP
            if ((PROBE_AMP >> PH) & 1) { const unsigned long long dt_ = __builtin_amdgcn_s_memrealtime() - t0_; const unsigned long long t1_ = __builtin_amdgcn_s_memrealtime();
                while (__builtin_amdgcn_s_memrealtime() - t1_ < 3 * dt_) __builtin_amdgcn_s_sleep(4); seam(kp); }
#endif
#ifdef PROBE_REPEAT
            if ((PROBE_REPEAT >> PH) & 1) { phase_site<PH>(kp, l); seam(kp); }
#endif
        }
        run_layer<PH + 1>(kp, l);
    }
}
__global__ void __launch_bounds__(512, 2) fwd_kernel(Params p) {
    extern __shared__ __attribute__((aligned(16))) unsigned char lds_raw[];
    volatile LAS unsigned* MISC = (volatile LAS unsigned*)((LAS unsigned char*)lds_raw + LDS_MISC);
    for (int u = threadIdx.x; u < (LDS_BYTES - LDS_MISC) / 4; u += 512) MISC[u] = 0u;
    __syncthreads();
    (void)xcd_barrier_post((unsigned*)(p.ws + WS_CTL) + CW_BAR, MISC + 8);
    KParams kp = (KParams)__builtin_amdgcn_kernarg_segment_ptr();
    run_layer<0>(kp, 0);
    run_layer<0>(kp, 1);
    static_assert(DEPTH == 2, "layers are written out");
}
#endif

extern "C" void kernel_launch(void* const* d_in, const int* in_sizes, int n_in, void* d_out, int out_size, void* d_ws, size_t ws_size, hipStream_t stream) {
    static int grid = 0;
    if (grid == 0) {
        if (n_in != 28 || in_sizes[0] != M * D || out_size != M * D || ws_size < WS_END) { fprintf(stderr, "kernel_launch: unexpected shapes (n_in %d, in0 %d, out %d, ws %zu < %zu); nothing launched\n", n_in, n_in > 0 ? in_sizes[0] : -1, out_size, ws_size, (size_t)WS_END); grid = -1; return; }
        int dev = 0, cus = 0;
        if (hipGetDevice(&dev) != hipSuccess || hipDeviceGetAttribute(&cus, hipDeviceAttributeMultiprocessorCount, dev) != hipSuccess) { grid = -1; return; }
#if MK_ONE_LAUNCH
        if (hipFuncSetAttribute((const void*)fwd_kernel, hipFuncAttributeMaxDynamicSharedMemorySize, LDS_BYTES) != hipSuccess) { fprintf(stderr, "kernel_launch: hipFuncSetAttribute failed\n"); grid = -1; return; }
        int per_cu = 0;
        if (hipOccupancyMaxActiveBlocksPerMultiprocessor(&per_cu, (const void*)fwd_kernel, 512, LDS_BYTES) != hipSuccess || per_cu < 1) { fprintf(stderr, "kernel_launch: occupancy query reports %d workgroups per CU\n", per_cu); }
        (void)hipGetLastError();
#endif
        grid = cus;
    }
    if (grid < 0) return;
    if (hipMemsetAsync((char*)d_ws + WS_CTL, 0, CTL_ZERO_BYTES, stream) != hipSuccess) return;
    Params a{};
    for (int i = 0; i < 28; ++i) a.in[i] = (const float*)d_in[i];
    a.out = (float*)d_out; a.ws = (unsigned char*)d_ws;
#if MK_ONE_LAUNCH
    hipLaunchKernelGGL(fwd_kernel, dim3(grid), dim3(512), LDS_BYTES, stream, a);
#else
    for (int l = 0; l < DEPTH; ++l) launch_phases<0>(grid, a, l, stream);
#endif
}
```

```cpp
#include <hip/hip_runtime.h>
#include <cstdio>
#include <cstdint>

#define GAS __attribute__((address_space(1)))
#define LAS __attribute__((address_space(3)))
typedef unsigned short bf16;
typedef short bf16x8 __attribute__((ext_vector_type(8)));
typedef float f32x4 __attribute__((ext_vector_type(4)));
typedef float f32x2 __attribute__((ext_vector_type(2)));
typedef unsigned u32x4 __attribute__((ext_vector_type(4)));
typedef unsigned u32x2 __attribute__((ext_vector_type(2)));
typedef int i32x4 __attribute__((ext_vector_type(4)));

constexpr int D = 1024, NBATCH = 4, SEQ = 4096, M = NBATCH * SEQ, DEPTH = 2, MEML = 256, MM = NBATCH * MEML;
constexpr int NIN = 8456;
constexpr int PP = 5376;
constexpr int C_MQ = 0, C_MK = 512, C_MV = 1024, C_MO = 1536, C_AQ = 2048, C_AK = 2816, C_AV = 3584, C_GU = 4352, C_GV = 4864;
constexpr int NEXP = 16, DFF = 512;
constexpr int LCH = 128, NCH = SEQ / LCH;
constexpr float EPS = 1e-6f;
constexpr int MAXT = 144;

constexpr size_t MiB = 1u << 20;
constexpr size_t WS_CTL = 0, CTL_ZERO_BYTES = 1 * MiB;
constexpr size_t WS_SMALL = 1 * MiB;
constexpr size_t OFF_GATES = WS_SMALL;
constexpr size_t OFF_AMA = OFF_GATES + (size_t)M * 8 * 4;
constexpr size_t OFF_AMM = OFF_AMA + 16 * SEQ * 4;
constexpr size_t OFF_AMB = OFF_AMM + 16 * SEQ * 4;
constexpr size_t OFF_LSE = OFF_AMB + 16 * SEQ * 4;
constexpr size_t OFF_BIAS = OFF_LSE + (size_t)M * 12 * 4;
constexpr size_t OFF_TOKE = OFF_BIAS + 12 * 132 * 4;
constexpr size_t OFF_TOKP = OFF_TOKE + (size_t)M * 2 * 4;
constexpr size_t OFF_TOKW = OFF_TOKP + (size_t)M * 2 * 4;
constexpr size_t OFF_SLOT = OFF_TOKW + (size_t)M * 2 * 4;
constexpr size_t OFF_WROW = OFF_SLOT + (size_t)M * 2 * 4;
constexpr size_t OFF_NST = OFF_WROW + (size_t)MAXT * 256 * 4;
constexpr size_t OFF_MEMB = OFF_NST + (size_t)16 * NCH * 128 * 4;
constexpr size_t OFF_KV = OFF_MEMB + (size_t)MM * D * 2;
constexpr size_t OFF_CNTW = OFF_KV + (size_t)MM * 1024 * 2;
constexpr size_t OFF_SSQ = OFF_CNTW + 256 * 16 * 4;
constexpr size_t OFF_SMALL_END = OFF_SSQ + (size_t)M * 16 * 4;
static_assert(OFF_SMALL_END <= 17 * MiB, "small region");
constexpr size_t WS_W = 17 * MiB;
constexpr size_t OFF_WIN1 = WS_W;
constexpr size_t OFF_WG = OFF_WIN1 + (size_t)5376 * 1024 * 2;
constexpr size_t OFF_WA = OFF_WG + (size_t)3072 * 1024 * 2;
constexpr size_t OFF_WB = OFF_WA + (size_t)1024 * 512 * 2;
constexpr size_t OFF_WC = OFF_WB + (size_t)1024 * 768 * 2;
constexpr size_t OFF_WOUT = OFF_WC + (size_t)1024 * 512 * 2;
constexpr size_t OFF_WXQ = OFF_WOUT + (size_t)1024 * 1024 * 2;
constexpr size_t OFF_WXKV = OFF_WXQ + (size_t)512 * 1024 * 2;
constexpr size_t OFF_WXO = OFF_WXKV + (size_t)1024 * 1024 * 2;
constexpr size_t OFF_WGU = OFF_WXO + (size_t)1024 * 512 * 2;
constexpr size_t OFF_WD = OFF_WGU + (size_t)16 * 1024 * 1024 * 2;
constexpr size_t OFF_W_END = OFF_WD + (size_t)16 * 1024 * 512 * 2;
static_assert(OFF_W_END <= 93 * MiB, "weight region");
constexpr size_t WS_XB = 93 * MiB;
constexpr size_t WS_PROJ = 125 * MiB;
constexpr size_t OFF_XG = WS_PROJ, OFF_HID = WS_PROJ + 72 * MiB;
constexpr size_t WS_X1B = WS_PROJ + 120 * MiB;
constexpr size_t WS_T = 293 * MiB;
constexpr size_t OFF_Q = WS_T, OFF_O = WS_T + 16 * MiB;
constexpr size_t WS_END = 327 * MiB;
constexpr int CW_TMO = 0, CW_CODE = 1;
constexpr int CW_CNT = 64;
constexpr int CW_BAR = 4096;

constexpr int LDS_BYTES = 147456;
constexpr int LDS_TAB = 145408;
constexpr int LDS_WOFF = 0;
constexpr int LDS_MISC = 146944;

#define RLX_AGENT __ATOMIC_RELAXED, __HIP_MEMORY_SCOPE_AGENT
#define LDS_WAIT() asm volatile("s_waitcnt lgkmcnt(0)" ::: "memory")
#define VM_WAIT() asm volatile("s_waitcnt vmcnt(0)" ::: "memory")
typedef __bf16 bf16x2_t __attribute__((ext_vector_type(2)));
__device__ __forceinline__ unsigned pk2(float lo, float hi) { const f32x2 v = {lo, hi}; return __builtin_bit_cast(unsigned, __builtin_convertvector(v, bf16x2_t)); }
__device__ __forceinline__ unsigned f2bf(float f) { return pk2(f, 0.f) & 0xffffu; }
__device__ __forceinline__ float bf2f(unsigned h) { return __builtin_bit_cast(float, h << 16); }
__device__ __forceinline__ float bflo(unsigned w) { return __builtin_bit_cast(float, w << 16); }
__device__ __forceinline__ float bfhi(unsigned w) { return __builtin_bit_cast(float, w & 0xffff0000u); }
__device__ __forceinline__ float wave_sum(float v) {
#pragma unroll
    for (int o = 1; o < 64; o <<= 1) v += __shfl_xor(v, o);
    return v;
}
__device__ __forceinline__ float sigmoidf_(float x) { return 1.f / (1.f + __expf(-x)); }
__device__ __forceinline__ float siluf_(float x) { return x / (1.f + __expf(-x)); }
__device__ __forceinline__ float gelu_tanh(float x) { const float u = 0.7978845608028654f * (x + 0.044715f * x * x * x); const float t = 1.f - 2.f / (1.f + __expf(2.f * u)); return 0.5f * x * (1.f + t); }
__device__ __forceinline__ void unpack8(const u32x4 w, float (&f)[8]) { f[0] = bflo(w.x); f[1] = bfhi(w.x); f[2] = bflo(w.y); f[3] = bfhi(w.y); f[4] = bflo(w.z); f[5] = bfhi(w.z); f[6] = bflo(w.w); f[7] = bfhi(w.w); }
__device__ __forceinline__ u32x4 pack8(const float (&f)[8]) { u32x4 w; w.x = pk2(f[0], f[1]); w.y = pk2(f[2], f[3]); w.z = pk2(f[4], f[5]); w.w = pk2(f[6], f[7]); return w; }

namespace pg8 {
constexpr int BM = 256, BK = 64, HALF = 128, HTB = HALF * BK * 2  , STAGE_BYTES = 8 * HTB, NXCD = 8, WGM = 8;
__host__ __device__ __forceinline__ int lds_byte(int r, int c) { const int st = (r >> 4) * 2 + (c >> 5), rr = r & 15, cc = c & 31, ob = rr * 64 + cc * 2; return st * 1024 + (ob ^ (((ob >> 9) & 1) << 5)); }
__host__ __device__ __forceinline__ void stage_rc(int b, int& R, int& C) { const int st = b / 1024, sb = b % 1024, swz = sb ^ (((sb >> 9) & 1) << 5); R = (st >> 1) * 16 + swz / 64; C = (st & 1) * 32 + (swz % 64) / 2; }
__host__ __device__ __forceinline__ int perm32(int rho) { const int n = rho >> 4, i = rho & 15; return 8 * (i >> 2) + 4 * n + (i & 3); }

struct Unit { int pm, pn; };
struct Gemm { const bf16* A; const bf16* Bt; int lda, K; };

struct StaticOrder {
    int nM, nN, nwg, G, c;
    __host__ __device__ void init(int M_, int N_, int G_, int c_) { nM = M_ / BM; nN = N_ / BM; nwg = nM * nN; G = G_; c = c_; }
    __host__ __device__ bool next(int i, Unit& u) const {
        const long L = (long)i * G + c; if (L >= nwg) return false;
        int wgid = (int)L; { const int q = nwg / NXCD, r = nwg % NXCD, xcd = wgid % NXCD, off = wgid / NXCD; wgid = (xcd < r ? xcd * (q + 1) : r * (q + 1) + (xcd - r) * q) + off; }
        const int nig = WGM * nN, gid = wgid / nig, fm = gid * WGM, gsz = (nM - fm) < WGM ? (nM - fm) : WGM;
        u.pm = fm + ((wgid % nig) % gsz); u.pn = (wgid % nig) / gsz; return true;
    }
    __device__ __forceinline__ void a_ready(const Unit&) const {}
    __device__ __forceinline__ void done(const Unit&) const {}
};

__device__ __forceinline__ unsigned cvt_pk_bf16(float lo, float hi) { unsigned r; asm volatile("v_cvt_pk_bf16_f32 %0, %1, %2" : "=v"(r) : "v"(lo), "v"(hi)); return r; }


__device__ __forceinline__ f32x4 mma16(const bf16x8 a, const bf16x8 b, const f32x4 c) { return __builtin_amdgcn_mfma_f32_16x16x32_bf16(a, b, c, 0, 0, 0); }
__device__ __forceinline__ i32x4 mma16(const bf16x8 a, const bf16x8 b, const i32x4 c) { return __builtin_amdgcn_mfma_i32_16x16x64_i8(__builtin_bit_cast(i32x4, a), __builtin_bit_cast(i32x4, b), c, 0, 0, 0); }
template <bool I8> struct AccSel { typedef f32x4 T; };
template <> struct AccSel<true> { typedef i32x4 T; };
template <class Epi, class Sched, bool ALIGN_EPI = false, bool I8 = false>
__device__ __forceinline__ void gemm_phase(LAS unsigned char* lds, const Gemm g, const Sched& S, const Epi& E) {
    int tid_ = threadIdx.x; asm volatile("" : "+v"(tid_));
    const int tid = tid_, wid = __builtin_amdgcn_readfirstlane(tid >> 6), lane = tid & 63, wr = wid >> 2, wc = wid & 3, fr = lane & 15, fq = lane >> 4;
    const int K = g.K, nt = K / BK, lda = g.lda;
    unsigned voffA[2], voffB[2];
#pragma unroll
    for (int i = 0; i < 2; ++i) { int R, C; stage_rc(tid * 16 + i * 8192, R, C); const int Rb = Epi::PERM ? ((R & ~31) + perm32(R & 31)) : R;
        voffA[i] = (unsigned)(R * lda + C) * 2u; voffB[i] = (unsigned)(Rb * K + C) * 2u; }
    const size_t kstep = (size_t)(BK * 2);
    const size_t hstepA = (size_t)HALF * lda * 2, hstepB = (size_t)HALF * K * 2;
    const size_t tstepA = 2 * hstepA, tstepB = 2 * hstepB;
    const unsigned ldsw = (unsigned)wid * 1024u;
    const int aoff = lds_byte(wr * 64 + fr, fq * 8), boff = lds_byte(wc * 32 + fr, fq * 8);
#define PG8_SA(b, h) (((b) * 2 + (h)) * HTB)
#define PG8_SB(b, h) ((4 + (b) * 2 + (h)) * HTB)
#define PG8_STAGE(bufoff, gbase, voff) do { _Pragma("unroll") for (int _i = 0; _i < 2; ++_i) \
        __builtin_amdgcn_global_load_lds((const unsigned*)((const char*)(gbase) + (voff)[_i]), (LAS unsigned*)(lds + (bufoff) + ldsw + _i * 8192), 16, 0, 0); } while (0)
#define PG8_LDA(dst, b, h) do { _Pragma("unroll") for (int m = 0; m < 4; ++m) _Pragma("unroll") for (int k = 0; k < 2; ++k) dst[m][k] = *(const LAS bf16x8*)(lds + PG8_SA(b, h) + aoff + m * 2048 + k * 1024); } while (0)
#define PG8_LDB(dst, b, h) do { _Pragma("unroll") for (int n = 0; n < 2; ++n) _Pragma("unroll") for (int k = 0; k < 2; ++k) dst[n][k] = *(const LAS bf16x8*)(lds + PG8_SB(b, h) + boff + n * 2048 + k * 1024); } while (0)
#define PG8_MMA(ai, bj, At, Bt) do { __builtin_amdgcn_s_setprio(1); _Pragma("unroll") for (int m = 0; m < 4; ++m) _Pragma("unroll") for (int n = 0; n < 2; ++n) _Pragma("unroll") for (int k = 0; k < 2; ++k) \
        acc[ai][bj][m][n] = mma16(Bt[n][k], At[m][k], acc[ai][bj][m][n]); __builtin_amdgcn_s_setprio(0); } while (0)
#define PG8_WAIT_V(n) asm volatile("s_waitcnt vmcnt(" #n ")" ::: "memory")
#define PG8_WAIT_L(n) asm volatile("s_waitcnt lgkmcnt(" #n ")" ::: "memory")
#define PG8_BAR __builtin_amdgcn_s_barrier()
#define PG8_SCHED __builtin_amdgcn_sched_barrier(0)
    Unit cur, nxt; int ui = 0;
    if (!S.next(0, cur)) return;
    typedef typename AccSel<I8>::T acc_t;
    acc_t acc[2][2][4][2];
#pragma unroll
    for (int a = 0; a < 2; ++a)
#pragma unroll
        for (int b = 0; b < 2; ++b)
#pragma unroll
            for (int m = 0; m < 4; ++m)
#pragma unroll
                for (int n = 0; n < 2; ++n) acc[a][b][m][n] = (acc_t){0, 0, 0, 0};
    bf16x8 At[4][2], B0[2][2], B1[2][2];
    const char* cA = (const char*)g.A + (size_t)cur.pm * tstepA; const char* cB = (const char*)g.Bt + (size_t)cur.pn * tstepB;
    S.a_ready(cur);
    PG8_STAGE(PG8_SB(0, 0), cB, voffB); PG8_STAGE(PG8_SB(0, 1), cB + hstepB, voffB); PG8_STAGE(PG8_SA(0, 0), cA, voffA); PG8_STAGE(PG8_SA(0, 1), cA + hstepA, voffA);
    if (wr == 1) PG8_BAR;
    PG8_WAIT_V(2); PG8_BAR;
    PG8_STAGE(PG8_SB(1, 0), cB + kstep, voffB); PG8_STAGE(PG8_SA(1, 0), cA + kstep, voffA); PG8_STAGE(PG8_SB(1, 1), cB + hstepB + kstep, voffB);
    PG8_WAIT_V(6); PG8_BAR;
    for (;;) {
        const bool has_next = S.next(ui + 1, nxt);
        const char* nA = has_next ? (const char*)g.A + (size_t)nxt.pm * tstepA : cA; const char* nB = has_next ? (const char*)g.Bt + (size_t)nxt.pn * tstepB : cB;
        for (int t = 0; t < nt; t += 2) {
            const bool last = (t == nt - 2);
            const char* a1 = cA + (size_t)(t + 1) * kstep;
            const char* a2 = last ? nA : cA + (size_t)(t + 2) * kstep; const char* b2 = last ? nB : cB + (size_t)(t + 2) * kstep;
            const char* a3 = a2 + kstep; const char* b3 = b2 + kstep;
            if (last && has_next) S.a_ready(nxt);
            PG8_LDB(B0, 0, 0); PG8_LDB(B1, 0, 1); PG8_SCHED; PG8_LDA(At, 0, 0); PG8_STAGE(PG8_SA(1, 1), a1 + hstepA, voffA);
            PG8_WAIT_V(8); PG8_WAIT_L(0); PG8_BAR; PG8_MMA(0, 0, At, B0); PG8_MMA(0, 1, At, B1); PG8_BAR; PG8_SCHED;
            PG8_LDA(At, 0, 1); PG8_STAGE(PG8_SB(0, 0), b2, voffB); PG8_STAGE(PG8_SB(0, 1), b2 + hstepB, voffB); PG8_STAGE(PG8_SA(0, 0), a2, voffA);
            PG8_WAIT_V(8); PG8_WAIT_L(0); PG8_BAR; PG8_MMA(1, 0, At, B0); PG8_MMA(1, 1, At, B1); PG8_BAR; PG8_SCHED;
            PG8_LDB(B0, 1, 0); PG8_LDB(B1, 1, 1); PG8_SCHED; PG8_LDA(At, 1, 0); PG8_STAGE(PG8_SA(0, 1), a2 + hstepA, voffA);
            PG8_WAIT_V(8); PG8_WAIT_L(0); PG8_BAR; PG8_MMA(0, 0, At, B0); PG8_MMA(0, 1, At, B1); PG8_BAR; PG8_SCHED;
            PG8_LDA(At, 1, 1); PG8_STAGE(PG8_SB(1, 0), b3, voffB); PG8_STAGE(PG8_SB(1, 1), b3 + hstepB, voffB); PG8_STAGE(PG8_SA(1, 0), a3, voffA);
            PG8_WAIT_V(8); PG8_WAIT_L(0); PG8_BAR; PG8_MMA(1, 0, At, B0); PG8_MMA(1, 1, At, B1); PG8_BAR; PG8_SCHED;
        }
        if constexpr (ALIGN_EPI) { if (wr == 0) PG8_BAR; }
        E(acc, cur, wr, wc, fr, fq); S.done(cur);
        if (!has_next) break;
#pragma unroll
        for (int a = 0; a < 2; ++a)
#pragma unroll
            for (int b = 0; b < 2; ++b)
#pragma unroll
                for (int m = 0; m < 4; ++m)
#pragma unroll
                    for (int n = 0; n < 2; ++n) acc[a][b][m][n] = (acc_t){0, 0, 0, 0};
        cur = nxt; cA = nA; cB = nB; ++ui;
        if constexpr (ALIGN_EPI) { if (wr == 1) PG8_BAR; }
    }
    PG8_WAIT_V(0);
    if constexpr (!ALIGN_EPI) { if (wr == 0) PG8_BAR; }
    PG8_BAR;
#undef PG8_SA
#undef PG8_SB
#undef PG8_STAGE
#undef PG8_LDA
#undef PG8_LDB
#undef PG8_MMA
#undef PG8_WAIT_V
#undef PG8_WAIT_L
#undef PG8_BAR
#undef PG8_SCHED
}
}

namespace epi {
using pg8::Unit; using pg8::BM; using pg8::HALF; using pg8::cvt_pk_bf16;
__device__ __forceinline__ u32x4 pk8(const f32x4 v0, const f32x4 v1) { u32x4 w; w.x = cvt_pk_bf16(v0[0], v0[1]); w.y = cvt_pk_bf16(v0[2], v0[3]); w.z = cvt_pk_bf16(v1[0], v1[1]); w.w = cvt_pk_bf16(v1[2], v1[3]); return w; }
__device__ __forceinline__ void up8(const u32x4 w, f32x4& a, f32x4& b) { a = (f32x4){bflo(w.x), bfhi(w.x), bflo(w.y), bfhi(w.y)}; b = (f32x4){bflo(w.z), bfhi(w.z), bflo(w.w), bfhi(w.w)}; }
__device__ __forceinline__ int gcol(int tg) { return tg < 6 ? 256 * tg : 2816 + 256 * (tg - 6); }

struct Bf16Out {
    static constexpr bool PERM = true;
    bf16* O; int ldc;
    __device__ __forceinline__ void operator()(const f32x4 (&acc)[2][2][4][2], const Unit& u, int wr, int wc, int fr, int fq) const {
        const int row0 = u.pm * BM + wr * 64 + fr, col0 = u.pn * BM + wc * 32 + 8 * fq;
#pragma unroll
        for (int ai = 0; ai < 2; ++ai)
#pragma unroll
            for (int m = 0; m < 4; ++m) { bf16* rowp = O + (size_t)(row0 + ai * HALF + m * 16) * ldc + col0;
#pragma unroll
                for (int bj = 0; bj < 2; ++bj) *(u32x4*)(rowp + bj * HALF) = pk8(acc[ai][bj][m][0], acc[ai][bj][m][1]); }
    }
};
struct SigOut {
    static constexpr bool PERM = true;
    bf16* PROJ;
    __device__ __forceinline__ void operator()(const f32x4 (&acc)[2][2][4][2], const Unit& u, int wr, int wc, int fr, int fq) const {
        const int row0 = u.pm * BM + wr * 64 + fr, col0 = gcol(u.pn) + wc * 32 + 8 * fq;
#pragma unroll
        for (int ai = 0; ai < 2; ++ai)
#pragma unroll
            for (int m = 0; m < 4; ++m) { bf16* rowp = PROJ + (size_t)(row0 + ai * HALF + m * 16) * PP + col0;
#pragma unroll
                for (int bj = 0; bj < 2; ++bj) { f32x4 a = acc[ai][bj][m][0], b = acc[ai][bj][m][1];
#pragma unroll
                    for (int e = 0; e < 4; ++e) { a[e] = sigmoidf_(a[e]); b[e] = sigmoidf_(b[e]); }
                    *(u32x4*)(rowp + bj * HALF) = pk8(a, b); } }
    }
};
template <int BR> struct BranchOut {
    static constexpr bool PERM = true;
    const bf16* PROJ; bf16* T; bf16* OUT;
    __device__ __forceinline__ void operator()(const f32x4 (&acc)[2][2][4][2], const Unit& u, int wr, int wc, int fr, int fq) const {
        const int row0 = u.pm * BM + wr * 64 + fr, cw = wc * 32 + 8 * fq, gc0 = gcol(BR * 4 + u.pn) + cw, col0 = u.pn * BM + cw;
#pragma unroll
        for (int ai = 0; ai < 2; ++ai)
#pragma unroll
            for (int m = 0; m < 4; ++m) { const size_t row = (size_t)(row0 + ai * HALF + m * 16);
#pragma unroll
                for (int bj = 0; bj < 2; ++bj) {
                    f32x4 g0, g1; up8(*(const u32x4*)(PROJ + row * PP + gc0 + bj * HALF), g0, g1);
                    f32x4 v0 = g0 * acc[ai][bj][m][0], v1 = g1 * acc[ai][bj][m][1];
                    if (BR > 0) { f32x4 t0, t1; up8(*(const u32x4*)(T + row * 1024 + col0 + bj * HALF), t0, t1); v0 += t0; v1 += t1; }
                    bf16* dst = (BR == 2 ? OUT : T) + row * 1024 + col0 + bj * HALF;
                    *(u32x4*)dst = pk8(v0, v1); } }
    }
};
struct ResidOut {
    static constexpr bool PERM = false;
    const float* SRC; float* DST;
    __device__ __forceinline__ void operator()(const f32x4 (&acc)[2][2][4][2], const Unit& u, int wr, int wc, int fr, int fq) const {
        const int row0 = u.pm * BM + wr * 64 + fr, col0 = u.pn * BM + wc * 32 + 4 * fq;
#pragma unroll
        for (int ai = 0; ai < 2; ++ai)
#pragma unroll
            for (int m = 0; m < 4; ++m) { const size_t off = (size_t)(row0 + ai * HALF + m * 16) * 1024 + col0;
#pragma unroll
                for (int bj = 0; bj < 2; ++bj)
#pragma unroll
                    for (int n = 0; n < 2; ++n) { const size_t o = off + bj * HALF + n * 16; *(f32x4*)(DST + o) = *(const f32x4*)(SRC + o) + acc[ai][bj][m][n]; } }
    }
};
struct ResidOutXb {
    static constexpr bool PERM = false;
    const float* SRC; float* DST; bf16* XB; float* SSQ;
    __device__ __forceinline__ void operator()(const f32x4 (&acc)[2][2][4][2], const Unit& u, int wr, int wc, int fr, int fq) const {
        const int row0 = u.pm * BM + wr * 64 + fr, col0 = u.pn * BM + wc * 32 + 4 * fq;
#pragma unroll
        for (int ai = 0; ai < 2; ++ai)
#pragma unroll
            for (int m = 0; m < 4; ++m) { const int row = row0 + ai * HALF + m * 16; const size_t off = (size_t)row * 1024 + col0; float ss = 0.f;
#pragma unroll
                for (int bj = 0; bj < 2; ++bj)
#pragma unroll
                    for (int n = 0; n < 2; ++n) { const size_t o = off + bj * HALF + n * 16; const f32x4 v = *(const f32x4*)(SRC + o) + acc[ai][bj][m][n]; *(f32x4*)(DST + o) = v;
                        ss += (v[0] * v[0] + v[1] * v[1]) + (v[2] * v[2] + v[3] * v[3]); u32x2 w; w.x = cvt_pk_bf16(v[0], v[1]); w.y = cvt_pk_bf16(v[2], v[3]); *(u32x2*)(XB + o) = w; }
                ss += __shfl_xor(ss, 16); ss += __shfl_xor(ss, 32);
                if (fq == 0) SSQ[(size_t)row * 16 + u.pn * 4 + wc] = ss; }
    }
};
struct Bf16OutRs {
    static constexpr bool PERM = true;
    bf16* O; int ldc; const float* SSQ;
    __device__ __forceinline__ void operator()(const f32x4 (&acc)[2][2][4][2], const Unit& u, int wr, int wc, int fr, int fq) const {
        const int row0 = u.pm * BM + wr * 64 + fr, col0 = u.pn * BM + wc * 32 + 8 * fq;
#pragma unroll
        for (int ai = 0; ai < 2; ++ai)
#pragma unroll
            for (int m = 0; m < 4; ++m) { const int row = row0 + ai * HALF + m * 16; const f32x4* sp = (const f32x4*)(SSQ + (size_t)row * 16);
                const f32x4 s0 = sp[0], s1 = sp[1], s2 = sp[2], s3 = sp[3]; const f32x4 st = (s0 + s1) + (s2 + s3);
                const float rs = 1.f / sqrtf(((st[0] + st[1]) + (st[2] + st[3])) * (1.f / 1024.f) + EPS); bf16* rowp = O + (size_t)row * ldc + col0;
#pragma unroll
                for (int bj = 0; bj < 2; ++bj) *(u32x4*)(rowp + bj * HALF) = pk8(acc[ai][bj][m][0] * rs, acc[ai][bj][m][1] * rs); }
    }
};
struct GluOut {
    static constexpr bool PERM = true;
    bf16* HID;
    __device__ __forceinline__ void operator()(const f32x4 (&acc)[2][2][4][2], const Unit& u, int wr, int wc, int fr, int fq) const {
        const int row0 = u.pm * BM + wr * 64 + fr, col0 = (u.pn & 3) * 128 + wc * 32 + 8 * fq;
#pragma unroll
        for (int ai = 0; ai < 2; ++ai)
#pragma unroll
            for (int m = 0; m < 4; ++m) { f32x4 a = acc[ai][0][m][0], b = acc[ai][0][m][1]; const f32x4 ua = acc[ai][1][m][0], ub = acc[ai][1][m][1];
#pragma unroll
                for (int e = 0; e < 4; ++e) { a[e] = siluf_(a[e]) * ua[e]; b[e] = siluf_(b[e]) * ub[e]; }
                *(u32x4*)(HID + (size_t)(row0 + ai * HALF + m * 16) * DFF + col0) = pk8(a, b); }
    }
};
struct DownOut {
    static constexpr bool PERM = true;
    bf16* YE; const float* WROW;
    __device__ __forceinline__ void operator()(const f32x4 (&acc)[2][2][4][2], const Unit& u, int wr, int wc, int fr, int fq) const {
        const int row0 = u.pm * BM + wr * 64 + fr, col0 = (u.pn & 3) * BM + wc * 32 + 8 * fq;
#pragma unroll
        for (int ai = 0; ai < 2; ++ai)
#pragma unroll
            for (int m = 0; m < 4; ++m) { const int row = row0 + ai * HALF + m * 16; const float w = WROW[row]; bf16* rowp = YE + (size_t)row * 1024 + col0;
#pragma unroll
                for (int bj = 0; bj < 2; ++bj) *(u32x4*)(rowp + bj * HALF) = pk8(acc[ai][bj][m][0] * w, acc[ai][bj][m][1] * w); }
    }
};
}

struct MoeOrder {
    const LAS int* tab; int G, c;
    __device__ __forceinline__ bool next(int i, pg8::Unit& u) const {
        const int L = i * G + c; const int nT = tab[176]; if (L >= 4 * nT) return false;
        const int pm = L >> 2; u.pm = pm; u.pn = tab[pm] * 4 + (L & 3); return true;
    }
    __device__ __forceinline__ void a_ready(const pg8::Unit&) const {}
    __device__ __forceinline__ void done(const pg8::Unit&) const {}
};
#define XB_TMO      128
#define XB_XCNT(j)  (256  + 64 * (j))
#define XB_XSUB(j)  (1280 + 64 * (j))
#define XB_XGEN(j)  (2304 + 64 * (j))
#define XB_TOP      3328
#define XB_TOPGEN   3392
#define XCD_BAR_WORDS 3456
#define XB_SPIN_CAP (1u << 18)

__device__ __forceinline__ unsigned xb_ld(unsigned* p)              { return __hip_atomic_load(p, __ATOMIC_RELAXED, __HIP_MEMORY_SCOPE_AGENT); }
__device__ __forceinline__ unsigned xb_add(unsigned* p, unsigned v) { return __hip_atomic_fetch_add(p, v, __ATOMIC_RELAXED, __HIP_MEMORY_SCOPE_AGENT); }
__device__ __forceinline__ unsigned xb_xcc_id() { return (unsigned)__builtin_amdgcn_s_getreg((3 << 11) | 20) & 0xFu; }
#define XB_SPIN(cond, bar) do { unsigned _sp = 0; while (cond) { __builtin_amdgcn_s_sleep(1); \
    if ((++_sp & 255u) == 0u) { if (xb_ld(&(bar)[XB_TMO])) break; if (_sp > XB_SPIN_CAP) { atomicAdd(&(bar)[XB_TMO], 1u); break; } } } } while (0)

struct XcdBarrier {
    unsigned* bar; unsigned x;
    volatile LAS unsigned* st;
};

__device__ __forceinline__ XcdBarrier xcd_barrier_post(unsigned* bar, volatile LAS unsigned* st) {
    XcdBarrier b; b.bar = bar; b.x = xb_xcc_id(); b.st = st;
    if (threadIdx.x == 0) (void)xb_add(&bar[XB_XCNT(b.x)], 1u);
    return b;
}
__device__ __forceinline__ void xcd_barrier_complete(unsigned* bar, unsigned x, unsigned& nloc, unsigned& nx) {
    const unsigned G = gridDim.x * gridDim.y * gridDim.z;
    unsigned sum, cnt, mine, sp = 0u;
    for (;;) {
        sum = 0u; cnt = 0u; mine = 0u;
#pragma unroll
        for (unsigned j = 0; j < 16; ++j) { const unsigned c = xb_ld(&bar[XB_XCNT(j)]); sum += c; cnt += (c > 0u) ? 1u : 0u; mine = (j == x) ? c : mine; }
        if (sum == G) break;
        __builtin_amdgcn_s_sleep(1);
        if ((++sp & 255u) == 0u) { if (xb_ld(&bar[XB_TMO])) break; if (sp > XB_SPIN_CAP) { atomicAdd(&bar[XB_TMO], 1u); break; } }
    }
    nloc = mine > 0u ? mine : 1u; nx = cnt > 0u ? cnt : 1u;
}

__device__ __forceinline__ void xcd_barrier(const XcdBarrier& b) {
    asm volatile("s_waitcnt vmcnt(0)" ::: "memory");
    __syncthreads();
    if (threadIdx.x == 0) {
        unsigned* bar = b.bar;
        __builtin_amdgcn_s_waitcnt(0);
        unsigned nloc = b.st[0], nx = b.st[1];
        if (nloc == 0u) { xcd_barrier_complete(bar, b.x, nloc, nx); b.st[0] = nloc; b.st[1] = nx; }
        const unsigned old = xb_add(&bar[XB_XSUB(b.x)], 1u);
        const unsigned gen = old / nloc;
        if (old + 1u == (gen + 1u) * nloc) {
            __builtin_amdgcn_fence(__ATOMIC_RELEASE, "agent");
            asm volatile("s_waitcnt vmcnt(0)" ::: "memory");
            const unsigned og = xb_add(&bar[XB_TOP], 1u);
            const unsigned tg = og / nx;
            if (og + 1u == (tg + 1u) * nx) xb_add(&bar[XB_TOPGEN], 1u);
            else XB_SPIN(xb_ld(&bar[XB_TOPGEN]) == tg, bar);
            __builtin_amdgcn_fence(__ATOMIC_ACQUIRE, "agent");
            xb_add(&bar[XB_XGEN(b.x)], 1u);
            asm volatile("s_waitcnt vmcnt(0)" ::: "memory");
        } else {
            XB_SPIN(xb_ld(&bar[XB_XGEN(b.x)]) == gen, bar);
            __builtin_amdgcn_fence(__ATOMIC_ACQUIRE, "agent");
            asm volatile("s_waitcnt vmcnt(0)" ::: "memory");
        }
    }
    __syncthreads();
}

struct Params { const float* in[28]; float* out; unsigned char* ws; };
enum { I_X = 0, I_MEM, I_NORM_MIX, I_W_IN, I_CONV, I_GATE_B, I_MLSTM_NORM, I_ATTN_QKN, I_GMLP_NORM, I_GMLP_WS, I_GMLP_BS, I_WBA, I_WBB, I_WBC, I_WOUT, I_REL_BIAS,
       I_NORM_XATTN, I_NORM_MEM, I_WXQ, I_WXKV, I_XATTN_QKN, I_WXO, I_NORM_FFN, I_ROUTER_W, I_ROUTER_B, I_EG, I_EU, I_ED };

struct Ctx {
    LAS unsigned char* lds;
    unsigned char* ws;
    int tid, lane, wave, vcu, G, bx;
};
template <class T> __device__ __forceinline__ T* wsp(const Ctx& c, size_t off) { return (T*)(c.ws + off); }

__device__ const unsigned char REL_BUCKET[3][132] = {
  {0,1,2,3,4,5,6,7,8,9,10,11,12,13,14,15,16,16,16,16,16,16,17,17,17,17,17,17,17,17,18,18,18,18,18,18,18,18,18,18,19,19,19,19,19,19,19,19,19,19,19,19,19,19,20,20,20,20,20,20,20,20,20,20,20,20,20,20,20,20,20,20,20,21,21,21,21,21,21,21,21,21,21,21,21,21,21,21,21,21,21,21,21,21,21,21,21,21,21,22,22,22,22,22,22,22,22,22,22,22,22,22,22,22,22,22,22,22,22,22,22,22,22,22,22,22,22,22,22,0,0,0},
  {0,4,8,12,16,16,17,17,18,18,19,19,19,19,20,20,20,20,20,21,21,21,21,21,21,22,22,22,22,22,22,22,22,22,23,23,23,23,23,23,23,23,23,23,23,23,24,24,24,24,24,24,24,24,24,24,24,24,24,24,24,24,25,25,25,25,25,25,25,25,25,25,25,25,25,25,25,25,25,25,25,25,25,26,26,26,26,26,26,26,26,26,26,26,26,26,26,26,26,26,26,26,26,26,26,26,26,26,26,26,26,26,26,27,27,27,27,27,27,27,27,27,27,27,27,27,27,27,27,0,0,0},
  {0,16,18,19,20,21,21,22,22,23,23,23,24,24,24,24,25,25,25,25,25,26,26,26,26,26,26,26,26,27,27,27,27,27,27,27,27,27,27,28,28,28,28,28,28,28,28,28,28,28,28,28,29,29,29,29,29,29,29,29,29,29,29,29,29,29,29,29,29,29,30,30,30,30,30,30,30,30,30,30,30,30,30,30,30,30,30,30,30,30,30,30,30,30,30,31,31,31,31,31,31,31,31,31,31,31,31,31,31,31,31,31,31,31,31,31,31,31,31,31,31,31,31,31,31,31,31,31,31,0,0,0}};

template <class RowMap>
__device__ __forceinline__ void tr_item(const float* W, int ldw, int c0, const float* gain, bf16* WT, int K, LAS float* scr, int kb, int nb, int lane, RowMap rm) {
    const int k0 = 64 * kb, n0 = 64 * nb, lr = lane >> 4, lc = 4 * (lane & 15);
    f32x4 v[16];
#pragma unroll
    for (int i = 0; i < 16; ++i) v[i] = *(const f32x4*)(W + (size_t)(k0 + 4 * i + lr) * ldw + c0 + n0 + lc);
#pragma unroll
    for (int i = 0; i < 16; ++i) { const int kk = 4 * i + lr; const float gg = gain ? gain[k0 + kk] : 1.f; LAS float* s = scr + kk * 65 + lc; s[0] = v[i].x * gg; s[1] = v[i].y * gg; s[2] = v[i].z * gg; s[3] = v[i].w * gg; }
    LDS_WAIT(); asm volatile("" ::: "memory");
    const int c = lane & 7;
#pragma unroll
    for (int j = 0; j < 8; ++j) { const int n = (lane >> 3) + 8 * j; const LAS float* s = scr + (8 * c) * 65 + n;
        u32x4 o; o.x = pk2(s[0 * 65], s[1 * 65]); o.y = pk2(s[2 * 65], s[3 * 65]); o.z = pk2(s[4 * 65], s[5 * 65]); o.w = pk2(s[6 * 65], s[7 * 65]);
        *(u32x4*)(WT + (size_t)rm(n0 + n) * K + k0 + 8 * c) = o; }
    LDS_WAIT(); asm volatile("" ::: "memory");
}
struct RmId { int off; __device__ __forceinline__ int operator()(int n) const { return off + n; } };
struct RmGate { __device__ __forceinline__ int operator()(int n) const { return (n >> 7) * 256 + (n & 127); } };
struct RmUp { __device__ __forceinline__ int operator()(int n) const { return (n >> 7) * 256 + 128 + (n & 127); } };

__device__ __forceinline__ void phase_weights(const Ctx& c, const Params& p, int l) {
    LAS float* scr = (LAS float*)(c.lds + c.wave * 16640);
    const int gw = c.vcu * 8 + c.wave, NGW = c.G * 8;
    const float* w_in = p.in[I_W_IN] + (size_t)l * D * NIN;
    constexpr int N1 = 16 * 32, N2 = 16 * 52, N3 = 16 * 48, N4 = 8 * 16, N5 = 12 * 16, N6 = 8 * 16, N7 = 16 * 16, N8 = 16 * 8, N9 = 16 * 16, N10 = 8 * 16, NE = 16 * 8, NDN = 8 * 16;
    constexpr int NITEMS = N1 + N2 + N3 + N4 + N5 + N6 + N7 + N8 + N9 + N10 + 16 * NE * 2 + 16 * NDN;
    for (int it = gw; it < NITEMS; it += NGW) {
        int r = it;
        if (r < N1) { tr_item(w_in, NIN, 0, p.in[I_NORM_MIX] + l * D, wsp<bf16>(c, OFF_WIN1), D, scr, r / 32, r % 32, c.lane, RmId{0}); continue; } r -= N1;
        if (r < N2) { tr_item(w_in, NIN, 2056, p.in[I_NORM_MIX] + l * D, wsp<bf16>(c, OFF_WIN1), D, scr, r / 52, r % 52, c.lane, RmId{2048}); continue; } r -= N2;
        if (r < N3) { tr_item(w_in, NIN, 5384, p.in[I_NORM_MIX] + l * D, wsp<bf16>(c, OFF_WG), D, scr, r / 48, r % 48, c.lane, RmId{0}); continue; } r -= N3;
        if (r < N4) { tr_item(p.in[I_WBA] + (size_t)l * 512 * 1024, 1024, 0, nullptr, wsp<bf16>(c, OFF_WA), 512, scr, r / 16, r % 16, c.lane, RmId{0}); continue; } r -= N4;
        if (r < N5) { tr_item(p.in[I_WBB] + (size_t)l * 768 * 1024, 1024, 0, nullptr, wsp<bf16>(c, OFF_WB), 768, scr, r / 16, r % 16, c.lane, RmId{0}); continue; } r -= N5;
        if (r < N6) { tr_item(p.in[I_WBC] + (size_t)l * 512 * 1024, 1024, 0, nullptr, wsp<bf16>(c, OFF_WC), 512, scr, r / 16, r % 16, c.lane, RmId{0}); continue; } r -= N6;
        if (r < N7) { tr_item(p.in[I_WOUT] + (size_t)l * 1024 * 1024, 1024, 0, nullptr, wsp<bf16>(c, OFF_WOUT), 1024, scr, r / 16, r % 16, c.lane, RmId{0}); continue; } r -= N7;
        if (r < N8) { tr_item(p.in[I_WXQ] + (size_t)l * 1024 * 512, 512, 0, p.in[I_NORM_XATTN] + l * D, wsp<bf16>(c, OFF_WXQ), 1024, scr, r / 8, r % 8, c.lane, RmId{0}); continue; } r -= N8;
        if (r < N9) { tr_item(p.in[I_WXKV] + (size_t)l * 1024 * 1024, 1024, 0, p.in[I_NORM_MEM] + l * D, wsp<bf16>(c, OFF_WXKV), 1024, scr, r / 16, r % 16, c.lane, RmId{0}); continue; } r -= N9;
        if (r < N10) { tr_item(p.in[I_WXO] + (size_t)l * 512 * 1024, 1024, 0, nullptr, wsp<bf16>(c, OFF_WXO), 512, scr, r / 16, r % 16, c.lane, RmId{0}); continue; } r -= N10;
        if (r < 16 * NE) { const int e = r / NE, rr = r % NE; tr_item(p.in[I_EG] + ((size_t)l * 16 + e) * 1024 * 512, 512, 0, p.in[I_NORM_FFN] + l * D, wsp<bf16>(c, OFF_WGU) + (size_t)e * 1024 * 1024, 1024, scr, rr / 8, rr % 8, c.lane, RmGate{}); continue; } r -= 16 * NE;
        if (r < 16 * NE) { const int e = r / NE, rr = r % NE; tr_item(p.in[I_EU] + ((size_t)l * 16 + e) * 1024 * 512, 512, 0, p.in[I_NORM_FFN] + l * D, wsp<bf16>(c, OFF_WGU) + (size_t)e * 1024 * 1024, 1024, scr, rr / 8, rr % 8, c.lane, RmUp{}); continue; } r -= 16 * NE;
        { const int e = r / NDN, rr = r % NDN; tr_item(p.in[I_ED] + ((size_t)l * 16 + e) * 512 * 1024, 1024, 0, nullptr, wsp<bf16>(c, OFF_WD) + (size_t)e * 1024 * 512, 512, scr, rr / 16, rr % 16, c.lane, RmId{0}); }
    }
}

__device__ __forceinline__ void row_norm_store(f32x4 (&v)[4], bf16* xbrow, int lane) {
    float s = 0.f;
#pragma unroll
    for (int j = 0; j < 4; ++j) s += (v[j].x * v[j].x + v[j].y * v[j].y) + (v[j].z * v[j].z + v[j].w * v[j].w);
    const float rs = 1.f / sqrtf(wave_sum(s) * (1.f / D) + EPS);
    unsigned long long* o8 = (unsigned long long*)xbrow + lane;
#pragma unroll
    for (int j = 0; j < 4; ++j) { v[j] = v[j] * rs; o8[64 * j] = (unsigned long long)pk2(v[j].x, v[j].y) | ((unsigned long long)pk2(v[j].z, v[j].w) << 32); }
}
__device__ __forceinline__ void row_gates(const f32x4 (&v)[4], const LAS float* W8t, const float* gate_b, float* gates_row, int lane) {
    float a[8];
#pragma unroll
    for (int q = 0; q < 8; ++q) { float s = 0.f;
#pragma unroll
        for (int j = 0; j < 4; ++j) { const f32x4 w = *(const LAS f32x4*)(W8t + q * 1024 + 256 * j + 4 * lane); s += (v[j].x * w.x + v[j].y * w.y) + (v[j].z * w.z + v[j].w * w.w); }
        a[q] = wave_sum(s); if ((q & 3) == 3) __builtin_amdgcn_sched_barrier(0); }
    if (lane == 0) {
#pragma unroll
        for (int q = 0; q < 8; ++q) gates_row[q] = a[q] + gate_b[q]; }
}
__device__ __forceinline__ void load_w8(const Ctx& c, const Params& p, int l) {
    LAS float* W8t = (LAS float*)c.lds; const float* w_in = p.in[I_W_IN] + (size_t)l * D * NIN; const float* g = p.in[I_NORM_MIX] + l * D;
    for (int idx = c.tid; idx < D * 8; idx += 512) { const int k = idx >> 3, q = idx & 7; W8t[q * 1024 + k] = w_in[(size_t)k * NIN + 2048 + q] * g[k]; }
    __syncthreads();
}
__device__ __forceinline__ void phase_rp0_input(const Ctx& c, const Params& p) {
    load_w8(c, p, 0);
    const int gw = c.vcu * 8 + c.wave, NGW = c.G * 8;
    const float* x = p.in[I_X];
    for (int m = gw; m < M; m += NGW) {
        f32x4 v[4]; const f32x4* xr = (const f32x4*)(x + (size_t)m * D) + c.lane;
#pragma unroll
        for (int j = 0; j < 4; ++j) v[j] = xr[64 * j];
        row_norm_store(v, wsp<bf16>(c, WS_XB) + (size_t)m * D, c.lane);
        row_gates(v, (const LAS float*)c.lds, p.in[I_GATE_B], wsp<float>(c, OFF_GATES) + (size_t)m * 8, c.lane);
    }
    const float* mem = p.in[I_MEM];
    for (int m = gw; m < MM; m += NGW) {
        f32x4 v[4]; const f32x4* xr = (const f32x4*)(mem + (size_t)m * D) + c.lane;
#pragma unroll
        for (int j = 0; j < 4; ++j) v[j] = xr[64 * j];
        row_norm_store(v, wsp<bf16>(c, OFF_MEMB) + (size_t)m * D, c.lane);
    }
    if (c.bx == 0) { float* bt = wsp<float>(c, OFF_BIAS); const float* rb = p.in[I_REL_BIAS];
        for (int idx = c.tid; idx < 12 * 132; idx += 512) { const int h = idx / 132, dist = idx % 132; bt[idx] = rb[(int)REL_BUCKET[h >> 2][dist] * 12 + h]; } }
}
__device__ __forceinline__ void phase_rp1(const Ctx& c, const float* X) {
    const int gw = c.vcu * 8 + c.wave, NGW = c.G * 8;
    for (int m = gw; m < M; m += NGW) {
        f32x4 v[4]; const f32x4* xr = (const f32x4*)(X + (size_t)m * D) + c.lane;
#pragma unroll
        for (int j = 0; j < 4; ++j) v[j] = xr[64 * j];
        row_norm_store(v, wsp<bf16>(c, WS_XB) + (size_t)m * D, c.lane);
    }
}
__device__ __forceinline__ void phase_rp2_route(const Ctx& c, const Params& p, int l, const float* X) {
    LAS float* RWt = (LAS float*)c.lds;
    { const float* rw = p.in[I_ROUTER_W]; const float* g = p.in[I_NORM_FFN] + l * D;
      for (int idx = c.tid; idx < D * 16; idx += 512) RWt[(idx & 15) * 1024 + (idx >> 4)] = rw[idx] * g[idx >> 4];
      __syncthreads(); }
    const int gw = c.vcu * 8 + c.wave, NGW = c.G * 8;
    LAS unsigned* lcnt = (LAS unsigned*)(c.lds + LDS_TAB);
    if (c.tid < 16) lcnt[c.tid] = 0u;
    __syncthreads();
    const float* rbias = p.in[I_ROUTER_B];
    for (int m = gw; m < M; m += NGW) {
        f32x4 v[4]; const f32x4* xr = (const f32x4*)(X + (size_t)m * D) + c.lane;
#pragma unroll
        for (int j = 0; j < 4; ++j) v[j] = xr[64 * j];
        row_norm_store(v, wsp<bf16>(c, WS_XB) + (size_t)m * D, c.lane);
        float a[16];
#pragma unroll
        for (int q = 0; q < 16; ++q) { float s = 0.f;
#pragma unroll
            for (int j = 0; j < 4; ++j) { const f32x4 w = *(const LAS f32x4*)(RWt + q * 1024 + 256 * j + 4 * c.lane); s += (v[j].x * w.x + v[j].y * w.y) + (v[j].z * w.z + v[j].w * w.w); }
            a[q] = s; if ((q & 3) == 3) __builtin_amdgcn_sched_barrier(0); }
        float mx = -3.0e38f;
#pragma unroll
        for (int q = 0; q < 16; ++q) { a[q] = wave_sum(a[q]) + rbias[q]; mx = fmaxf(mx, a[q]); }
#pragma unroll
        for (int q = 0; q < 16; ++q) a[q] = __expf(a[q] - mx);
        float bs = -1.f, p1 = 0.f, p2 = 0.f; int e1 = 0, e2 = 1;
#pragma unroll
        for (int g = 0; g < 4; ++g) {
            const float q0 = a[4 * g], q1 = a[4 * g + 1], q2 = a[4 * g + 2], q3 = a[4 * g + 3];
            int i1 = 0; float m1 = q0; if (q1 > m1) { m1 = q1; i1 = 1; } if (q2 > m1) { m1 = q2; i1 = 2; } if (q3 > m1) { m1 = q3; i1 = 3; }
            int i2 = -1; float m2 = -1.f;
            if (i1 != 0 && q0 > m2) { m2 = q0; i2 = 0; } if (i1 != 1 && q1 > m2) { m2 = q1; i2 = 1; } if (i1 != 2 && q2 > m2) { m2 = q2; i2 = 2; } if (i1 != 3 && q3 > m2) { m2 = q3; i2 = 3; }
            const float sc = m1 + m2;
            if (sc > bs) { bs = sc; e1 = 4 * g + i1; e2 = 4 * g + i2; p1 = m1; p2 = m2; }
        }
        if (c.lane == 0) {
            const float inv = 1.f / (p1 + p2);
            const unsigned pos1 = __hip_atomic_fetch_add(lcnt + e1, 1u, __ATOMIC_RELAXED, __HIP_MEMORY_SCOPE_WORKGROUP), pos2 = __hip_atomic_fetch_add(lcnt + e2, 1u, __ATOMIC_RELAXED, __HIP_MEMORY_SCOPE_WORKGROUP);
            int* te = wsp<int>(c, OFF_TOKE) + 2 * m; int* tp = wsp<int>(c, OFF_TOKP) + 2 * m; float* tw = wsp<float>(c, OFF_TOKW) + 2 * m;
            te[0] = e1; te[1] = e2; tp[0] = (int)pos1; tp[1] = (int)pos2; tw[0] = p1 * inv; tw[1] = p2 * inv;
        }
    }
    __syncthreads();
    if (c.tid < 16) wsp<unsigned>(c, OFF_CNTW)[c.vcu * 16 + c.tid] = lcnt[c.tid];
}
template <bool WITH_OFF>
__device__ __forceinline__ void moe_tables(const Ctx& c) {
    LAS int* tab = (LAS int*)(c.lds + LDS_TAB); LAS int* woff = (LAS int*)(c.lds + LDS_WOFF); LAS int* tot = tab + 180;
    const unsigned* cw = wsp<unsigned>(c, OFF_CNTW);
    if (c.tid < 16) { int s = 0;
#pragma unroll 8
        for (int v = 0; v < c.G; ++v) { if (WITH_OFF) woff[v * 16 + c.tid] = s; s += (int)cw[v * 16 + c.tid]; }
        tot[c.tid] = s; }
    __syncthreads();
    if (c.tid == 0) { int t = 0;
        for (int e = 0; e < 16; ++e) { const int nt = (tot[e] + 255) >> 8; tab[160 + e] = t * 256; for (int i = 0; i < nt && t < MAXT; ++i) tab[t++] = e; }
        tab[176] = t; }
    __syncthreads();
}
__device__ __forceinline__ void phase_gather(const Ctx& c, int l) {
    moe_tables<true>(c);
    const LAS int* tab = (const LAS int*)(c.lds + LDS_TAB); const LAS int* woff = (const LAS int*)(c.lds + LDS_WOFF);
    const int gw = c.vcu * 8 + c.wave, NGW = c.G * 8;
    const int* te = wsp<int>(c, OFF_TOKE); const int* tp = wsp<int>(c, OFF_TOKP); const float* tw = wsp<float>(c, OFF_TOKW);
    int* slot = wsp<int>(c, OFF_SLOT); float* wrow = wsp<float>(c, OFF_WROW);
    const bf16* XB = wsp<bf16>(c, WS_XB); bf16* XG = wsp<bf16>(c, OFF_XG);
    for (int it0 = gw * 4; it0 < 2 * M; it0 += NGW * 4) {
        int s[4]; u32x4 r0[4], r1[4];
#pragma unroll
        for (int a = 0; a < 4; ++a) { const int it = it0 + a; const int e = te[it], m_ = it >> 1; s[a] = tab[160 + e] + woff[((m_ % (c.G * 8)) >> 3) * 16 + e] + tp[it];     const u32x4* src = (const u32x4*)(XB + (size_t)(it >> 1) * D) + c.lane; r0[a] = src[0]; r1[a] = src[64]; }
#pragma unroll
        for (int a = 0; a < 4; ++a) { const int it = it0 + a; u32x4* dst = (u32x4*)(XG + (size_t)s[a] * D) + c.lane; dst[0] = r0[a]; dst[64] = r1[a];
            if (c.lane == 0) { slot[it] = s[a]; wrow[s[a]] = tw[it]; } }
    }
}
template <bool NEXT>
__device__ __forceinline__ void phase_combine(const Ctx& c, const Params& p, int l, const float* Xsrc, float* Xdst) {
    if (NEXT) load_w8(c, p, l + 1);
    const int gw = c.vcu * 8 + c.wave, NGW = c.G * 8;
    const int* slot = wsp<int>(c, OFF_SLOT); const bf16* YE = wsp<bf16>(c, OFF_XG);
    for (int m = gw; m < M; m += NGW) {
        const int s0 = slot[2 * m], s1 = slot[2 * m + 1];
        f32x4 v[4]; const f32x4* xr = (const f32x4*)(Xsrc + (size_t)m * D) + c.lane;
        const u32x2* y0 = (const u32x2*)(YE + (size_t)s0 * D) + c.lane; const u32x2* y1 = (const u32x2*)(YE + (size_t)s1 * D) + c.lane;
#pragma unroll
        for (int j = 0; j < 4; ++j) { const u32x2 a = y0[64 * j], b = y1[64 * j]; v[j] = xr[64 * j];
            v[j].x = (v[j].x + bflo(a.x)) + bflo(b.x); v[j].y = (v[j].y + bfhi(a.x)) + bfhi(b.x); v[j].z = (v[j].z + bflo(a.y)) + bflo(b.y); v[j].w = (v[j].w + bfhi(a.y)) + bfhi(b.y); }
        f32x4* xo = (f32x4*)(Xdst + (size_t)m * D) + c.lane;
#pragma unroll
        for (int j = 0; j < 4; ++j) xo[64 * j] = v[j];
        if (NEXT) {
            row_norm_store(v, wsp<bf16>(c, WS_XB) + (size_t)m * D, c.lane);
            row_gates(v, (const LAS float*)c.lds, p.in[I_GATE_B] + 8 * (l + 1), wsp<float>(c, OFF_GATES) + (size_t)m * 8, c.lane);
        }
    }
}
__device__ __forceinline__ void gate_scan(const Ctx& c, int bh) {
    const int b = bh >> 2, h = bh & 3, tid = c.tid, lane = c.lane, w = c.wave;
    LAS float* ws_ = (LAS float*)c.lds;
    const float* G = wsp<float>(c, OFF_GATES) + ((size_t)b * SEQ + 8 * tid) * 8;
    float* Aa = wsp<float>(c, OFF_AMA) + bh * SEQ + 8 * tid; float* Am = wsp<float>(c, OFF_AMM) + bh * SEQ + 8 * tid; float* Ab = wsp<float>(c, OFF_AMB) + bh * SEQ + 8 * tid;
    float lf[8], ip[8];
#pragma unroll
    for (int i = 0; i < 8; ++i) { const float f = G[i * 8 + 4 + h]; ip[i] = G[i * 8 + h]; lf[i] = fminf(f, 0.f) - log1pf(__expf(-fabsf(f))); }
    float s = 0.f;
#pragma unroll
    for (int i = 0; i < 8; ++i) { s += lf[i]; lf[i] = s; }
    float incl = s;
#pragma unroll
    for (int o = 1; o < 64; o <<= 1) { const float t = __shfl_up(incl, o); if (lane >= o) incl += t; }
    if (lane == 63) ws_[w] = incl;
    __syncthreads();
    float base = incl - s;
    for (int ww = 0; ww < w; ++ww) base += ws_[ww];
    float av[8], mxl = -3.0e38f;
#pragma unroll
    for (int i = 0; i < 8; ++i) { const float Bc = base + lf[i]; lf[i] = Bc; av[i] = ip[i] - Bc; mxl = fmaxf(mxl, av[i]); }
    float inm = mxl;
#pragma unroll
    for (int o = 1; o < 64; o <<= 1) { const float t = __shfl_up(inm, o); if (lane >= o) inm = fmaxf(inm, t); }
    if (lane == 63) ws_[8 + w] = inm;
    __syncthreads();
    float run = __shfl_up(inm, 1); if (lane == 0) run = 0.f;
    run = fmaxf(run, 0.f);
    for (int ww = 0; ww < w; ++ww) run = fmaxf(run, ws_[8 + ww]);
    float mv[8];
#pragma unroll
    for (int i = 0; i < 8; ++i) { run = fmaxf(run, av[i]); mv[i] = run; }
    *(f32x4*)(Aa) = (f32x4){av[0], av[1], av[2], av[3]}; *(f32x4*)(Aa + 4) = (f32x4){av[4], av[5], av[6], av[7]};
    *(f32x4*)(Am) = (f32x4){mv[0], mv[1], mv[2], mv[3]}; *(f32x4*)(Am + 4) = (f32x4){mv[4], mv[5], mv[6], mv[7]};
    *(f32x4*)(Ab) = (f32x4){lf[0], lf[1], lf[2], lf[3]}; *(f32x4*)(Ab + 4) = (f32x4){lf[4], lf[5], lf[6], lf[7]};
    __syncthreads();
}

typedef short s16x4 __attribute__((ext_vector_type(4)));
__device__ __forceinline__ s16x4 ds_tr(const LAS bf16* p) { return __builtin_bit_cast(s16x4, __builtin_amdgcn_ds_read_tr16_b64_v4i16((LAS s16x4*)p)); }
__device__ __forceinline__ bf16x8 cat4(const s16x4 lo, const s16x4 hi) { return (bf16x8){lo[0], lo[1], lo[2], lo[3], hi[0], hi[1], hi[2], hi[3]}; }
__device__ __forceinline__ bf16x8 ldsA(const LAS bf16* p) { return *(const LAS bf16x8*)p; }
__device__ __forceinline__ bf16x8 pk8f(const f32x4 a, const f32x4 b) { u32x4 w; w.x = pk2(a[0], a[1]); w.y = pk2(a[2], a[3]); w.z = pk2(b[0], b[1]); w.w = pk2(b[2], b[3]); return __builtin_bit_cast(bf16x8, w); }
#define MFMA16(a, b, c) __builtin_amdgcn_mfma_f32_16x16x32_bf16((a), (b), (c), 0, 0, 0)
__device__ __forceinline__ float red4g_sum(float v) { v += __shfl_xor(v, 16); v += __shfl_xor(v, 32); return v; }
__device__ __forceinline__ float red4g_max(float v) { v = fmaxf(v, __shfl_xor(v, 16)); v = fmaxf(v, __shfl_xor(v, 32)); return v; }
__device__ __forceinline__ float red16_sum(float v) { v += __shfl_xor(v, 1); v += __shfl_xor(v, 2); v += __shfl_xor(v, 4); v += __shfl_xor(v, 8); return v; }
constexpr f32x4 Z4 = {0.f, 0.f, 0.f, 0.f};

constexpr int LS = 136;
constexpr int QS = 72;

__device__ __forceinline__ void conv4_silu(const u32x4 (&x)[7], const float* cw, float (&o)[4][8]) {
    float w[4][8];
#pragma unroll
    for (int jj = 0; jj < 4; ++jj) { const f32x4 w0 = *(const f32x4*)(cw + jj * 1024), w1 = *(const f32x4*)(cw + jj * 1024 + 4);
        w[jj][0] = w0.x; w[jj][1] = w0.y; w[jj][2] = w0.z; w[jj][3] = w0.w; w[jj][4] = w1.x; w[jj][5] = w1.y; w[jj][6] = w1.z; w[jj][7] = w1.w; }
    float xf[7][8];
#pragma unroll
    for (int a = 0; a < 7; ++a) unpack8(x[a], xf[a]);
#pragma unroll
    for (int rr = 0; rr < 4; ++rr)
#pragma unroll
        for (int e = 0; e < 8; ++e) { const float s = (w[0][e] * xf[rr][e] + w[1][e] * xf[rr + 1][e]) + (w[2][e] * xf[rr + 2][e] + w[3][e] * xf[rr + 3][e]); o[rr][e] = siluf_(s); }
}
__device__ __forceinline__ void load7(const bf16* colp, int t0, u32x4 (&x)[7]) {
#pragma unroll
    for (int a = 0; a < 7; ++a) { const int t = t0 - 3 + a; x[a] = (t >= 0) ? *(const u32x4*)(colp + (size_t)t * PP) : (u32x4){0u, 0u, 0u, 0u}; }
}

__device__ __forceinline__ void mlstm_delta_unit(const Ctx& c, const Params& p, int l, int bh, int j) {
    const int b = bh >> 2, h = bh & 3, tid = c.tid, lane = c.lane, w = c.wave, r16 = lane & 15, g = lane >> 4;
    LAS bf16* vv = (LAS bf16*)c.lds; LAS bf16* kw = vv + 128 * LS;
    const bf16* projb = wsp<bf16>(c, WS_PROJ) + (size_t)b * SEQ * PP;
    const float* Aa = wsp<float>(c, OFF_AMA) + bh * SEQ + LCH * j; const float Mend = wsp<float>(c, OFF_AMM)[bh * SEQ + LCH * j + LCH - 1];
    {
        const int rg = tid >> 4, c8 = (tid & 15) * 8, t0 = LCH * j + 4 * rg;
        u32x4 xk[7], xv[4];
        load7(projb + C_MK + h * 128 + c8, t0, xk);
#pragma unroll
        for (int rr = 0; rr < 4; ++rr) xv[rr] = *(const u32x4*)(projb + (size_t)(t0 + rr) * PP + C_MV + h * 128 + c8);
        const f32x4 a4 = *(const f32x4*)(Aa + 4 * rg);
        float k[4][8]; conv4_silu(xk, p.in[I_CONV] + (size_t)l * 4 * 1024 + 512 + h * 128 + c8, k);
#pragma unroll
        for (int rr = 0; rr < 4; ++rr) { const float wgt = __expf(a4[rr] - Mend) * 0.08838834764831845f;
#pragma unroll
            for (int e = 0; e < 8; ++e) k[rr][e] *= wgt;
            *(LAS u32x4*)(kw + (4 * rg + rr) * LS + c8) = pack8(k[rr]); *(LAS u32x4*)(vv + (4 * rg + rr) * LS + c8) = xv[rr]; }
    }
    __syncthreads();
    f32x4 acc[8];
#pragma unroll
    for (int nt = 0; nt < 8; ++nt) acc[nt] = Z4;
    const LAS bf16* ap = vv + (8 * g + (r16 >> 2)) * LS + 16 * w + 4 * (r16 & 3); const LAS bf16* bp = kw + (8 * g + (r16 >> 2)) * LS + 4 * (r16 & 3);
#pragma unroll
    for (int ks = 0; ks < 4; ++ks) { const bf16x8 a = cat4(ds_tr(ap + 32 * ks * LS), ds_tr(ap + (32 * ks + 4) * LS));
#pragma unroll
        for (int nt = 0; nt < 8; ++nt) { const bf16x8 bb = cat4(ds_tr(bp + 32 * ks * LS + 16 * nt), ds_tr(bp + (32 * ks + 4) * LS + 16 * nt)); acc[nt] = MFMA16(a, bb, acc[nt]); } }
    float* st = wsp<float>(c, WS_T) + (size_t)(bh * NCH + j) * (128 * 128);
#pragma unroll
    for (int nt = 0; nt < 8; ++nt)
#pragma unroll
        for (int i = 0; i < 4; ++i) st[(16 * w + 4 * g + i) * 128 + 16 * nt + r16] = acc[nt][i];
    if (tid < 128) { float s = 0.f;
#pragma unroll 8
        for (int r = 0; r < 128; ++r) s += bf2f(kw[r * LS + tid]);
        wsp<float>(c, OFF_NST)[(bh * NCH + j) * 128 + tid] = s; }
    __syncthreads();
}
__device__ __forceinline__ void mlstm_scan(const Ctx& c) {
    constexpr int EL4 = (128 * 128 + 128) / 4;
    const int gt = c.vcu * 512 + c.tid, NT = c.G * 512;
    for (int idx = gt; idx < 16 * EL4; idx += NT) {
        const int bh = idx / EL4, el = idx % EL4;
        const float* Am = wsp<float>(c, OFF_AMM) + bh * SEQ;
        f32x4* base = el < 4096 ? (f32x4*)(wsp<float>(c, WS_T) + (size_t)bh * NCH * 16384) + el : (f32x4*)(wsp<float>(c, OFF_NST) + bh * NCH * 128) + (el - 4096);
        const int stride = el < 4096 ? 4096 : 32;
        f32x4 cs = {0.f, 0.f, 0.f, 0.f}; float Mprev = 0.f;
#pragma unroll 1
        for (int j0 = 0; j0 < NCH; j0 += 8) {
            f32x4 dl[8]; float gg[8];
#pragma unroll
            for (int a = 0; a < 8; ++a) { dl[a] = base[(size_t)(j0 + a) * stride]; const float Mend = Am[LCH * (j0 + a) + LCH - 1]; gg[a] = __expf(Mprev - Mend); Mprev = Mend; }
#pragma unroll
            for (int a = 0; a < 8; ++a) { cs = cs * gg[a] + dl[a]; base[(size_t)(j0 + a) * stride] = cs; }
        }
    }
}
__device__ __forceinline__ void mlstm_out_unit(const Ctx& c, const Params& p, int l, int bh, int j) {
    const int b = bh >> 2, h = bh & 3, tid = c.tid, lane = c.lane, w = c.wave, r16 = lane & 15, g = lane >> 4;
    LAS bf16* qq = (LAS bf16*)c.lds; LAS bf16* kk = qq + 128 * LS; LAS bf16* vv = kk + 128 * LS; LAS bf16* CTb = vv + 128 * LS;
    LAS float* fa = (LAS float*)(CTb + 144 * LS); LAS float* fM = fa + 128; LAS float* fB = fM + 128;
    bf16* projb = wsp<bf16>(c, WS_PROJ) + (size_t)b * SEQ * PP;
    {
        const int rg = tid >> 4, c8 = (tid & 15) * 8, t0 = LCH * j + 4 * rg;
        u32x4 xq[7], xk[7], xv[4];
        load7(projb + C_MQ + h * 128 + c8, t0, xq); load7(projb + C_MK + h * 128 + c8, t0, xk);
#pragma unroll
        for (int rr = 0; rr < 4; ++rr) xv[rr] = *(const u32x4*)(projb + (size_t)(t0 + rr) * PP + C_MV + h * 128 + c8);
        const int e = tid >> 2, d0 = (tid & 3) * 32;
        f32x4 sv[8];
        if (j > 0) { const f32x4* sp = (const f32x4*)(wsp<float>(c, WS_T) + (size_t)(bh * NCH + j - 1) * 16384 + e * 128 + d0);
#pragma unroll
            for (int a = 0; a < 8; ++a) sv[a] = sp[a]; }
        else {
#pragma unroll
            for (int a = 0; a < 8; ++a) sv[a] = Z4; }
        const float* cwq = p.in[I_CONV] + (size_t)l * 4 * 1024 + h * 128 + c8;
        float o[4][8];
        conv4_silu(xq, cwq, o);
#pragma unroll
        for (int rr = 0; rr < 4; ++rr) *(LAS u32x4*)(qq + (4 * rg + rr) * LS + c8) = pack8(o[rr]);
        conv4_silu(xk, cwq + 512, o);
#pragma unroll
        for (int rr = 0; rr < 4; ++rr) {
#pragma unroll
            for (int e2 = 0; e2 < 8; ++e2) o[rr][e2] *= 0.08838834764831845f;
            *(LAS u32x4*)(kk + (4 * rg + rr) * LS + c8) = pack8(o[rr]); *(LAS u32x4*)(vv + (4 * rg + rr) * LS + c8) = xv[rr]; }
#pragma unroll
        for (int a = 0; a < 4; ++a) *(LAS bf16x8*)(CTb + e * LS + d0 + 8 * a) = pk8f(sv[2 * a], sv[2 * a + 1]);
    }
    if (tid < 256) { const int e = 128 + (tid >> 4), c8 = (tid & 15) * 8; float s8[8];
#pragma unroll
        for (int i = 0; i < 8; ++i) s8[i] = 0.f;
        if (e == 128 && j > 0) { const float* nn = wsp<float>(c, OFF_NST) + (bh * NCH + j - 1) * 128 + c8;
#pragma unroll
            for (int i = 0; i < 8; ++i) s8[i] = nn[i]; }
        *(LAS u32x4*)(CTb + e * LS + c8) = pack8(s8); }
    if (tid < 128) { const int t = bh * SEQ + LCH * j + tid; fa[tid] = wsp<float>(c, OFF_AMA)[t]; fM[tid] = wsp<float>(c, OFF_AMM)[t]; fB[tid] = wsp<float>(c, OFF_AMB)[t]; }
    __syncthreads();
    const float Mprev = j > 0 ? wsp<float>(c, OFF_AMM)[bh * SEQ + LCH * j - 1] : 0.f;
    const int tq = 16 * w + r16;
    f32x4 as[8], ai[9];
#pragma unroll
    for (int a = 0; a < 8; ++a) as[a] = Z4;
#pragma unroll
    for (int a = 0; a < 9; ++a) ai[a] = Z4;
#pragma unroll
    for (int ks = 0; ks < 4; ++ks) { const bf16x8 bq = ldsA(qq + tq * LS + 32 * ks + 8 * g);
#pragma unroll
        for (int mt = 0; mt < 8; ++mt) if (mt <= w) as[mt] = MFMA16(ldsA(kk + (16 * mt + r16) * LS + 32 * ks + 8 * g), bq, as[mt]);
#pragma unroll
        for (int et = 0; et < 9; ++et) ai[et] = MFMA16(ldsA(CTb + (16 * et + r16) * LS + 32 * ks + 8 * g), bq, ai[et]);
        __builtin_amdgcn_sched_barrier(0); }
    const float Mt = fM[tq], winter = __expf(Mprev - Mt);
    float den = 0.f;
#pragma unroll
    for (int mt = 0; mt < 8; ++mt)
#pragma unroll
        for (int i = 0; i < 4; ++i) { const int r = 16 * mt + 4 * g + i; const float wg = (mt <= w && r <= tq) ? __expf(fa[r] - Mt) : 0.f; const float sw = as[mt][i] * wg; as[mt][i] = sw; den += sw; }
    den = red4g_sum(den);
    const float dinter = __shfl(ai[8][0], r16);
    const float dd = den + winter * dinter;
    const float dn = fmaxf(fabsf(dd), __expf(-(fB[tq] + Mt)));
    f32x4 ao[8];
#pragma unroll
    for (int et = 0; et < 8; ++et) ao[et] = ai[et] * winter;
    const LAS bf16* vp = vv + (4 * g + (r16 >> 2)) * LS + 4 * (r16 & 3);
#pragma unroll
    for (int ks = 0; ks < 4; ++ks) if (2 * ks <= w) { const bf16x8 bp = pk8f(as[2 * ks], as[2 * ks + 1]);
#pragma unroll
        for (int et = 0; et < 8; ++et) ao[et] = MFMA16(cat4(ds_tr(vp + 32 * ks * LS + 16 * et), ds_tr(vp + (32 * ks + 16) * LS + 16 * et)), bp, ao[et]);
        __builtin_amdgcn_sched_barrier(0); }
    const float inv = 1.f / dn; float ss = 0.f;
#pragma unroll
    for (int et = 0; et < 8; ++et) { ao[et] = ao[et] * inv; ss += (ao[et][0] * ao[et][0] + ao[et][1] * ao[et][1]) + (ao[et][2] * ao[et][2] + ao[et][3] * ao[et][3]); }
    ss = red4g_sum(ss); const float rs = 1.f / sqrtf(ss * (1.f / 128.f) + EPS);
    const float* gain = p.in[I_MLSTM_NORM] + l * 512 + h * 128; bf16* orow = projb + (size_t)(LCH * j + tq) * PP + C_MO + h * 128;
#pragma unroll
    for (int et = 0; et < 8; ++et) { const int e0 = 16 * et + 4 * g; const u32x2 mo = *(const u32x2*)(orow + e0); const f32x4 gn = *(const f32x4*)(gain + e0);
        u32x2 o; o.x = pk2(ao[et][0] * rs * gn[0] * sigmoidf_(bflo(mo.x)), ao[et][1] * rs * gn[1] * sigmoidf_(bfhi(mo.x))); o.y = pk2(ao[et][2] * rs * gn[2] * sigmoidf_(bflo(mo.y)), ao[et][3] * rs * gn[3] * sigmoidf_(bfhi(mo.y)));
        *(u32x2*)(orow + e0) = o; }
    __syncthreads();
}

__device__ __forceinline__ void dattn_unit(const Ctx& c, const Params& p, int l, int b, int h, int blk) {
    const int tid = c.tid, lane = c.lane, w = c.wave, r16 = lane & 15, g = lane >> 4;
    const int grp = h >> 2, dil = grp == 0 ? 1 : (grp == 1 ? 4 : 16), nb = 32 / dil, res = blk / nb, n = blk % nb;
    LAS bf16* kn = (LAS bf16*)c.lds; LAS bf16* vv = kn + 256 * QS; LAS float* bias = (LAS float*)(vv + 272 * QS);
    bf16* projb = wsp<bf16>(c, WS_PROJ) + (size_t)b * SEQ * PP;
    const float* gq = p.in[I_ATTN_QKN] + l * 128; const float* gk = gq + 64;
    {
        const int c8 = (tid & 7) * 8; u32x4 xk[4], xv[4];
#pragma unroll
        for (int a = 0; a < 4; ++a) { const int ki = (tid >> 3) + 64 * a, s = 128 * (n - 1) + ki;
            if (s >= 0) { const size_t pos = (size_t)(s * dil + res); xk[a] = *(const u32x4*)(projb + pos * PP + C_AK + h * 64 + c8); xv[a] = *(const u32x4*)(projb + pos * PP + C_AV + h * 64 + c8); }
            else { xk[a] = (u32x4){0u, 0u, 0u, 0u}; xv[a] = (u32x4){0u, 0u, 0u, 0u}; } }
        const f32x4 g0 = *(const f32x4*)(gk + c8), g1 = *(const f32x4*)(gk + c8 + 4);
#pragma unroll
        for (int a = 0; a < 4; ++a) { const int ki = (tid >> 3) + 64 * a; float x[8]; unpack8(xk[a], x);
            float ss = 0.f;
#pragma unroll
            for (int e = 0; e < 8; ++e) ss += x[e] * x[e];
            ss += __shfl_xor(ss, 1); ss += __shfl_xor(ss, 2); ss += __shfl_xor(ss, 4);
            const float rs = 1.f / sqrtf(ss * (1.f / 64.f) + EPS);
            x[0] *= rs * g0.x; x[1] *= rs * g0.y; x[2] *= rs * g0.z; x[3] *= rs * g0.w; x[4] *= rs * g1.x; x[5] *= rs * g1.y; x[6] *= rs * g1.z; x[7] *= rs * g1.w;
            *(LAS u32x4*)(kn + ki * QS + c8) = pack8(x); *(LAS u32x4*)(vv + ki * QS + c8) = xv[a]; }
        if (tid < 144) *(LAS u32x4*)(vv + 256 * QS + tid * 8) = (u32x4){0u, 0u, 0u, 0u};
        if (tid < 132) bias[tid] = wsp<float>(c, OFF_BIAS)[h * 132 + tid];
    }
    const int qi = 16 * w + r16; const size_t qpos = (size_t)((128 * n + qi) * dil + res);
    bf16* qrow = projb + qpos * PP + C_AQ + h * 64;
    bf16x8 bq[2];
    { float x0[8], x1[8]; unpack8(*(const u32x4*)(qrow + 8 * g), x0); unpack8(*(const u32x4*)(qrow + 32 + 8 * g), x1);
      float ss = 0.f;
#pragma unroll
      for (int e = 0; e < 8; ++e) ss += x0[e] * x0[e] + x1[e] * x1[e];
      ss = red4g_sum(ss); const float rs = 0.125f / sqrtf(ss * (1.f / 64.f) + EPS);
#pragma unroll
      for (int e = 0; e < 8; ++e) { x0[e] *= rs * gq[8 * g + e]; x1[e] *= rs * gq[32 + 8 * g + e]; }
      bq[0] = __builtin_bit_cast(bf16x8, pack8(x0)); bq[1] = __builtin_bit_cast(bf16x8, pack8(x1)); }
    __syncthreads();
    const int kb = 16 * w;
    f32x4 acc[10];
#pragma unroll
    for (int mt = 0; mt < 10; ++mt) acc[mt] = Z4;
#pragma unroll
    for (int ks = 0; ks < 2; ++ks)
#pragma unroll
        for (int mt = 0; mt < 9; ++mt) acc[mt] = MFMA16(ldsA(kn + (kb + 16 * mt + r16) * QS + 32 * ks + 8 * g), bq[ks], acc[mt]);
    float mx = -3.0e38f;
#pragma unroll
    for (int mt = 0; mt < 9; ++mt)
#pragma unroll
        for (int i = 0; i < 4; ++i) { const int ki = kb + 16 * mt + 4 * g + i, dist = 128 + qi - ki; const bool ok = dist >= 0 && dist <= 128 && (n > 0 || ki >= 128);
            const float lg = ok ? acc[mt][i] + bias[ok ? dist : 0] : -3.0e38f; acc[mt][i] = lg; mx = fmaxf(mx, lg); }
    mx = red4g_max(mx);
    float lsum = 0.f;
#pragma unroll
    for (int mt = 0; mt < 9; ++mt)
#pragma unroll
        for (int i = 0; i < 4; ++i) { const float lg = acc[mt][i]; const float pe = lg > -1.0e38f ? __expf(lg - mx) : 0.f; lsum += pe; acc[mt][i] = pe; }
    lsum = red4g_sum(lsum);
    f32x4 ao[4];
#pragma unroll
    for (int et = 0; et < 4; ++et) ao[et] = Z4;
    const LAS bf16* vp = vv + (kb + 4 * g + (r16 >> 2)) * QS + 4 * (r16 & 3);
#pragma unroll
    for (int ks = 0; ks < 5; ++ks) { const bf16x8 bp = pk8f(acc[2 * ks], acc[2 * ks + 1]);
#pragma unroll
        for (int et = 0; et < 4; ++et) ao[et] = MFMA16(cat4(ds_tr(vp + 32 * ks * QS + 16 * et), ds_tr(vp + (32 * ks + 16) * QS + 16 * et)), bp, ao[et]); }
    const float inv = 1.f / lsum;
#pragma unroll
    for (int et = 0; et < 4; ++et) { u32x2 o; o.x = pk2(ao[et][0] * inv, ao[et][1] * inv); o.y = pk2(ao[et][2] * inv, ao[et][3] * inv); *(u32x2*)(qrow + 16 * et + 4 * g) = o; }
    if (g == 0) wsp<float>(c, OFF_LSE)[((size_t)b * SEQ + qpos) * 12 + h] = mx + __logf(lsum);
    __syncthreads();
}
__device__ __forceinline__ void dattn_merge(const Ctx& c) {
    const int gt = c.vcu * 512 + c.tid, NT = c.G * 512;
    const float* LSE = wsp<float>(c, OFF_LSE); bf16* proj = wsp<bf16>(c, WS_PROJ);
    for (int it = gt; it < M * 96; it += NT) {
        const int m = it / 96, rr = it % 96, h = rr >> 3, c8 = (rr & 7) * 8, hg = h & 3;
        const float l0 = LSE[(size_t)m * 12 + hg], l1 = LSE[(size_t)m * 12 + 4 + hg], l2 = LSE[(size_t)m * 12 + 8 + hg], lm = LSE[(size_t)m * 12 + h];
        const float mxx = fmaxf(l0, fmaxf(l1, l2)); const float al = __expf(lm - mxx) / (__expf(l0 - mxx) + __expf(l1 - mxx) + __expf(l2 - mxx));
        u32x4* ptr = (u32x4*)(proj + (size_t)m * PP + C_AQ + h * 64 + c8); float x[8]; unpack8(*ptr, x);
#pragma unroll
        for (int e = 0; e < 8; ++e) x[e] *= al;
        *ptr = pack8(x);
    }
}

__device__ __forceinline__ void gmlp_unit(const Ctx& c, const Params& p, int l, int b, int n, int grp) {
    const int tid = c.tid, lane = c.lane, w = c.wave, r16 = lane & 15, g = lane >> 4;
    LAS bf16* Wc = (LAS bf16*)c.lds; LAS bf16* vn = Wc + 128 * LS;
    bf16* projb = wsp<bf16>(c, WS_PROJ) + ((size_t)b * SEQ + 128 * n) * PP;
    const float* ws = p.in[I_GMLP_WS] + ((size_t)l * 4 + grp) * 128 * 128; const float* gain = p.in[I_GMLP_NORM] + l * 512 + grp * 128; const float* bs = p.in[I_GMLP_BS] + (l * 4 + grp) * 128;
    {
        const int c8 = (tid & 15) * 8; u32x4 xv[4]; f32x4 wv[4][2];
#pragma unroll
        for (int a = 0; a < 4; ++a) { const int r = (tid >> 4) + 32 * a; xv[a] = *(const u32x4*)(projb + (size_t)r * PP + C_GV + grp * 128 + c8); wv[a][0] = *(const f32x4*)(ws + r * 128 + c8); wv[a][1] = *(const f32x4*)(ws + r * 128 + c8 + 4); }
        const f32x4 g0 = *(const f32x4*)(gain + c8), g1 = *(const f32x4*)(gain + c8 + 4);
#pragma unroll
        for (int a = 0; a < 4; ++a) { const int r = (tid >> 4) + 32 * a;
            float wf[8] = {wv[a][0].x, wv[a][0].y, wv[a][0].z, wv[a][0].w, wv[a][1].x, wv[a][1].y, wv[a][1].z, wv[a][1].w};
#pragma unroll
            for (int e = 0; e < 8; ++e) if (c8 + e > r) wf[e] = 0.f;
            *(LAS u32x4*)(Wc + r * LS + c8) = pack8(wf);
            float x[8]; unpack8(xv[a], x); float ss = 0.f;
#pragma unroll
            for (int e = 0; e < 8; ++e) { x[e] = gelu_tanh(x[e]); ss += x[e] * x[e]; }
            ss = red16_sum(ss); const float rs = 1.f / sqrtf(ss * (1.f / 128.f) + EPS);
            x[0] *= rs * g0.x; x[1] *= rs * g0.y; x[2] *= rs * g0.z; x[3] *= rs * g0.w; x[4] *= rs * g1.x; x[5] *= rs * g1.y; x[6] *= rs * g1.z; x[7] *= rs * g1.w;
            *(LAS u32x4*)(vn + r * LS + c8) = pack8(x); }
    }
    __syncthreads();
    const int tq = 16 * w + r16;
    f32x4 acc[8];
#pragma unroll
    for (int ct = 0; ct < 8; ++ct) acc[ct] = Z4;
    const LAS bf16* vp = vn + (8 * g + (r16 >> 2)) * LS + 4 * (r16 & 3);
#pragma unroll
    for (int ks = 0; ks < 4; ++ks) if (32 * ks <= 16 * w + 15) { const bf16x8 bw = ldsA(Wc + tq * LS + 32 * ks + 8 * g);
#pragma unroll
        for (int ct = 0; ct < 8; ++ct) acc[ct] = MFMA16(cat4(ds_tr(vp + 32 * ks * LS + 16 * ct), ds_tr(vp + (32 * ks + 4) * LS + 16 * ct)), bw, acc[ct]); }
    const float bb = bs[tq]; bf16* orow = projb + (size_t)tq * PP + C_GU + grp * 128;
#pragma unroll
    for (int ct = 0; ct < 8; ++ct) { const int c0 = 16 * ct + 4 * g; const u32x2 u = *(const u32x2*)(orow + c0);
        u32x2 o; o.x = pk2(gelu_tanh(bflo(u.x)) * (acc[ct][0] + bb), gelu_tanh(bfhi(u.x)) * (acc[ct][1] + bb)); o.y = pk2(gelu_tanh(bflo(u.y)) * (acc[ct][2] + bb), gelu_tanh(bfhi(u.y)) * (acc[ct][3] + bb));
        *(u32x2*)(orow + c0) = o; }
    __syncthreads();
}

__device__ __forceinline__ void xattn_unit(const Ctx& c, const Params& p, int l, int bh, int tp) {
    const int b = bh >> 2, h = bh & 3, tid = c.tid, lane = c.lane, w = c.wave, r16 = lane & 15, g = lane >> 4;
    LAS bf16* kn = (LAS bf16*)c.lds; LAS bf16* vv = kn + 256 * LS;
    const bf16* KV = wsp<bf16>(c, OFF_KV) + (size_t)b * MEML * 1024;
    const float* gq = p.in[I_XATTN_QKN] + l * 256; const float* gk = gq + 128;
    {
        const int c8 = (tid & 15) * 8; const f32x4 g0 = *(const f32x4*)(gk + c8), g1 = *(const f32x4*)(gk + c8 + 4);
#pragma unroll
        for (int half = 0; half < 2; ++half) { u32x4 xk[4], xv[4];
#pragma unroll
            for (int a = 0; a < 4; ++a) { const int ki = (tid >> 4) + 32 * (4 * half + a); xk[a] = *(const u32x4*)(KV + (size_t)ki * 1024 + h * 128 + c8); xv[a] = *(const u32x4*)(KV + (size_t)ki * 1024 + 512 + h * 128 + c8); }
#pragma unroll
            for (int a = 0; a < 4; ++a) { const int ki = (tid >> 4) + 32 * (4 * half + a); float x[8]; unpack8(xk[a], x); float ss = 0.f;
#pragma unroll
                for (int e = 0; e < 8; ++e) ss += x[e] * x[e];
                ss = red16_sum(ss); const float rs = 1.f / sqrtf(ss * (1.f / 128.f) + EPS);
                x[0] *= rs * g0.x; x[1] *= rs * g0.y; x[2] *= rs * g0.z; x[3] *= rs * g0.w; x[4] *= rs * g1.x; x[5] *= rs * g1.y; x[6] *= rs * g1.z; x[7] *= rs * g1.w;
                *(LAS u32x4*)(kn + ki * LS + c8) = pack8(x); *(LAS u32x4*)(vv + ki * LS + c8) = xv[a]; } }
    }
    __syncthreads();
    const LAS bf16* vp = vv + (4 * g + (r16 >> 2)) * LS + 4 * (r16 & 3);
    for (int tt = 2 * tp; tt < 2 * tp + 2; ++tt) {
        const size_t row = (size_t)b * SEQ + 128 * tt + 16 * w + r16;
        const bf16* qrow = wsp<bf16>(c, OFF_Q) + row * 512 + h * 128;
        bf16x8 bq[4];
        { float qf[4][8]; float ss = 0.f;
#pragma unroll
          for (int ks = 0; ks < 4; ++ks) { unpack8(*(const u32x4*)(qrow + 32 * ks + 8 * g), qf[ks]);
#pragma unroll
              for (int e = 0; e < 8; ++e) ss += qf[ks][e] * qf[ks][e]; }
          ss = red4g_sum(ss); const float rsq = 0.08838834764831845f / sqrtf(ss * (1.f / 128.f) + EPS);
#pragma unroll
          for (int ks = 0; ks < 4; ++ks) {
#pragma unroll
              for (int e = 0; e < 8; ++e) qf[ks][e] *= rsq * gq[32 * ks + 8 * g + e];
              bq[ks] = __builtin_bit_cast(bf16x8, pack8(qf[ks])); } }
        f32x4 acc[16];
#pragma unroll
        for (int mt = 0; mt < 16; ++mt) acc[mt] = Z4;
#pragma unroll
        for (int ks = 0; ks < 4; ++ks) {
#pragma unroll
            for (int mt = 0; mt < 16; ++mt) acc[mt] = MFMA16(ldsA(kn + (16 * mt + r16) * LS + 32 * ks + 8 * g), bq[ks], acc[mt]);
            __builtin_amdgcn_sched_barrier(0); }
        float mx = -3.0e38f;
#pragma unroll
        for (int mt = 0; mt < 16; ++mt) mx = fmaxf(fmaxf(mx, fmaxf(acc[mt][0], acc[mt][1])), fmaxf(acc[mt][2], acc[mt][3]));
        mx = red4g_max(mx);
        float lsum = 0.f;
#pragma unroll
        for (int mt = 0; mt < 16; ++mt)
#pragma unroll
            for (int i = 0; i < 4; ++i) { const float pe = __expf(acc[mt][i] - mx); lsum += pe; acc[mt][i] = pe; }
        lsum = red4g_sum(lsum);
        f32x4 ao[8];
#pragma unroll
        for (int et = 0; et < 8; ++et) ao[et] = Z4;
#pragma unroll
        for (int ks = 0; ks < 8; ++ks) { const bf16x8 bp = pk8f(acc[2 * ks], acc[2 * ks + 1]);
#pragma unroll
            for (int et = 0; et < 8; ++et) ao[et] = MFMA16(cat4(ds_tr(vp + 32 * ks * LS + 16 * et), ds_tr(vp + (32 * ks + 16) * LS + 16 * et)), bp, ao[et]);
            __builtin_amdgcn_sched_barrier(0); }
        const float inv = 1.f / lsum; bf16* orow = wsp<bf16>(c, OFF_O) + row * 512 + h * 128;
#pragma unroll
        for (int et = 0; et < 8; ++et) { u32x2 o; o.x = pk2(ao[et][0] * inv, ao[et][1] * inv); o.y = pk2(ao[et][2] * inv, ao[et][3] * inv); *(u32x2*)(orow + 16 * et + 4 * g) = o; }
    }
    __syncthreads();
}
enum { PH_PRE = 0, PH_A1, PH_MIXA, PH_MIXB, PH_MIXC, PH_GATE, PH_BR0, PH_BR1, PH_BR2, PH_WOUT, PH_XQ, PH_XA, PH_XO, PH_RP2, PH_GATHER, PH_GU, PH_DOWN, PH_COMB, NPH_LAYER };

template <int PH>
__device__ __forceinline__ void run_phase(const Ctx& c, const Params& p, int l) {
    bf16* const XB = wsp<bf16>(c, WS_XB); bf16* const PROJ = wsp<bf16>(c, WS_PROJ);
    const float* Xin = (l == 0) ? p.in[I_X] : p.out;
    if constexpr (PH == PH_PRE) { phase_weights(c, p, 0); __syncthreads(); phase_rp0_input(c, p); }
    if constexpr (PH == PH_A1) {
        if (c.bx >= c.G - 16) gate_scan(c, c.bx - (c.G - 16));
        { pg8::Gemm g{XB, wsp<bf16>(c, OFF_WIN1), D, D}; pg8::StaticOrder S; S.init(M, PP, c.G, c.bx); epi::Bf16Out E{PROJ, PP};
          pg8::gemm_phase<epi::Bf16Out, pg8::StaticOrder, true>(c.lds, g, S, E); }
        { pg8::Gemm g{wsp<bf16>(c, OFF_MEMB), wsp<bf16>(c, OFF_WXKV), D, D}; pg8::StaticOrder S; S.init(MM, 1024, c.G, (c.bx + c.G - 64) % c.G); epi::Bf16Out E{wsp<bf16>(c, OFF_KV), 1024};
          pg8::gemm_phase<epi::Bf16Out, pg8::StaticOrder, true>(c.lds, g, S, E); }
    }
    if constexpr (PH == PH_MIXA) {
        for (int u = c.bx; u < 16 * NCH; u += c.G) mlstm_delta_unit(c, p, l, u / NCH, u % NCH);
        for (int u = c.bx; u < NBATCH * 32 * 4; u += c.G) gmlp_unit(c, p, l, u >> 7, (u >> 2) & 31, u & 3);
    }
    if constexpr (PH == PH_MIXB) {
        mlstm_scan(c);
        for (int u = c.bx; u < NBATCH * 12 * 32; u += c.G) { const int blk = u & 31, bh = u >> 5; dattn_unit(c, p, l, bh / 12, bh % 12, blk); }
    }
    if constexpr (PH == PH_MIXC) { for (int u = c.bx; u < 16 * NCH; u += c.G) mlstm_out_unit(c, p, l, u / NCH, u % NCH); dattn_merge(c); }
    if constexpr (PH == PH_GATE) { pg8::Gemm g{XB, wsp<bf16>(c, OFF_WG), D, D}; pg8::StaticOrder S; S.init(M, 3072, c.G, c.bx); epi::SigOut E{PROJ};
        pg8::gemm_phase<epi::SigOut, pg8::StaticOrder, true>(c.lds, g, S, E); }
    if constexpr (PH == PH_BR0) { pg8::StaticOrder S; S.init(M, 1024, c.G, c.bx); pg8::Gemm g{PROJ + C_MO, wsp<bf16>(c, OFF_WA), PP, 512}; epi::BranchOut<0> E{PROJ, wsp<bf16>(c, WS_T), XB};
        pg8::gemm_phase<epi::BranchOut<0>, pg8::StaticOrder, false>(c.lds, g, S, E); }
    if constexpr (PH == PH_BR1) { pg8::StaticOrder S; S.init(M, 1024, c.G, c.bx); pg8::Gemm g{PROJ + C_AQ, wsp<bf16>(c, OFF_WB), PP, 768}; epi::BranchOut<1> E{PROJ, wsp<bf16>(c, WS_T), XB};
        pg8::gemm_phase<epi::BranchOut<1>, pg8::StaticOrder, false>(c.lds, g, S, E); }
    if constexpr (PH == PH_BR2) { pg8::StaticOrder S; S.init(M, 1024, c.G, c.bx); pg8::Gemm g{PROJ + C_GU, wsp<bf16>(c, OFF_WC), PP, 512}; epi::BranchOut<2> E{PROJ, wsp<bf16>(c, WS_T), XB};
        pg8::gemm_phase<epi::BranchOut<2>, pg8::StaticOrder, false>(c.lds, g, S, E); }
    if constexpr (PH == PH_WOUT) { pg8::Gemm g{XB, wsp<bf16>(c, OFF_WOUT), D, D}; pg8::StaticOrder S; S.init(M, 1024, c.G, c.bx); epi::ResidOutXb E{Xin, p.out, wsp<bf16>(c, WS_X1B), wsp<float>(c, OFF_SSQ)};
        pg8::gemm_phase<epi::ResidOutXb, pg8::StaticOrder, false>(c.lds, g, S, E); }
    if constexpr (PH == PH_XQ) { pg8::Gemm g{wsp<bf16>(c, WS_X1B), wsp<bf16>(c, OFF_WXQ), D, D}; pg8::StaticOrder S; S.init(M, 512, c.G, c.bx); epi::Bf16OutRs E{wsp<bf16>(c, OFF_Q), 512, wsp<float>(c, OFF_SSQ)};
        pg8::gemm_phase<epi::Bf16OutRs, pg8::StaticOrder, false>(c.lds, g, S, E); }
    if constexpr (PH == PH_XA) { for (int u = c.bx; u < 16 * 16; u += c.G) xattn_unit(c, p, l, u >> 4, u & 15); }
    if constexpr (PH == PH_XO) { pg8::Gemm g{wsp<bf16>(c, OFF_O), wsp<bf16>(c, OFF_WXO), 512, 512}; pg8::StaticOrder S; S.init(M, 1024, c.G, c.bx); epi::ResidOut E{p.out, p.out};
        pg8::gemm_phase<epi::ResidOut, pg8::StaticOrder, false>(c.lds, g, S, E); }
    if constexpr (PH == PH_RP2) phase_rp2_route(c, p, l, p.out);
    if constexpr (PH == PH_GATHER) phase_gather(c, l);
    if constexpr (PH == PH_GU) { moe_tables<false>(c); pg8::Gemm g{wsp<bf16>(c, OFF_XG), wsp<bf16>(c, OFF_WGU), D, D}; MoeOrder S{(const LAS int*)(c.lds + LDS_TAB), c.G, c.bx}; epi::GluOut E{wsp<bf16>(c, OFF_HID)};
        pg8::gemm_phase<epi::GluOut, MoeOrder, true>(c.lds, g, S, E); }
    if constexpr (PH == PH_DOWN) { moe_tables<false>(c); pg8::Gemm g{wsp<bf16>(c, OFF_HID), wsp<bf16>(c, OFF_WD), DFF, DFF}; MoeOrder S{(const LAS int*)(c.lds + LDS_TAB), c.G, c.bx}; epi::DownOut E{wsp<bf16>(c, OFF_XG), wsp<float>(c, OFF_WROW)};
        pg8::gemm_phase<epi::DownOut, MoeOrder, true>(c.lds, g, S, E); }
    if constexpr (PH == PH_COMB) { if (l + 1 < DEPTH) { phase_combine<true>(c, p, l, p.out, p.out); __syncthreads(); phase_weights(c, p, l + 1); } else phase_combine<false>(c, p, l, p.out, p.out); }
}

__device__ __forceinline__ Ctx make_ctx(const Params& p, unsigned char* lds_raw) {
    Ctx c;
    c.lds = (LAS unsigned char*)lds_raw; c.ws = p.ws;
    int tid_ = threadIdx.x, bx = blockIdx.x, G_ = gridDim.x;
    asm volatile("" : "+v"(tid_), "+s"(bx), "+s"(G_));
    c.tid = tid_; c.lane = c.tid & 63; c.wave = __builtin_amdgcn_readfirstlane(c.tid >> 6);
    c.G = G_; c.bx = bx; c.vcu = (c.G % 8 == 0) ? (bx % 8) * (c.G / 8) + bx / 8 : bx;
    return c;
}
#ifndef MK_ONE_LAUNCH
#define MK_ONE_LAUNCH 1
#endif
#if !MK_ONE_LAUNCH
template <int PH>
__global__ void __launch_bounds__(512, 2) phase_kernel(Params p, int l) {
    extern __shared__ __attribute__((aligned(16))) unsigned char lds_raw[];
    const Ctx c = make_ctx(p, lds_raw);
    run_phase<PH>(c, p, l);
}
template <int PH> static void launch_phases(int grid, const Params& a, int l, hipStream_t stream) {
    if constexpr (PH < NPH_LAYER) {
        static bool attr_done = false;
        if (!attr_done) { (void)hipFuncSetAttribute((const void*)phase_kernel<PH>, hipFuncAttributeMaxDynamicSharedMemorySize, LDS_BYTES); attr_done = true; }
        if (!(PH == PH_PRE && l != 0)) hipLaunchKernelGGL(phase_kernel<PH>, dim3(grid), dim3(512), LDS_BYTES, stream, a, l);
        launch_phases<PH + 1>(grid, a, l, stream);
    }
}
#else
#if defined(__HIP_DEVICE_COMPILE__)
typedef const __attribute__((address_space(4))) Params* KParams;
#else
typedef const Params* KParams;
#endif
template <int PH>
__device__ __forceinline__ void phase_site(KParams kp, int l) {
    extern __shared__ __attribute__((aligned(16))) unsigned char lds_raw[];
    asm volatile("" : "+s"(kp));
    Params p;
#pragma unroll
    for (int i = 0; i < 28; ++i) p.in[i] = kp->in[i];
    p.out = kp->out; p.ws = kp->ws;
    const Ctx c = make_ctx(p, lds_raw);
    run_phase<PH>(c, p, l);
}
__device__ __forceinline__ void seam(KParams kp) {
    extern __shared__ __attribute__((aligned(16))) unsigned char lds_raw[];
    asm volatile("" : "+s"(kp));
    XcdBarrier b; b.bar = (unsigned*)(kp->ws + WS_CTL) + CW_BAR; b.x = xb_xcc_id(); b.st = (volatile LAS unsigned*)((LAS unsigned char*)lds_raw + LDS_MISC) + 8;
    xcd_barrier(b);
}
template <int PH> __device__ __forceinline__ void run_layer(KParams kp, int l) {
    if constexpr (PH < NPH_LAYER) {
        if (!(PH == PH_PRE && l != 0)) {
#ifdef PROBE_AMP
            const unsigned long long t0_ = __builtin_amdgcn_s_memrealtime();
#endif
            phase_site<PH>(kp, l); seam(kp);
#ifdef PROBE_AMP
            if ((PROBE_AMP >> PH) & 1) { const unsigned long long dt_ = __builtin_amdgcn_s_memrealtime() - t0_; const unsigned long long t1_ = __builtin_amdgcn_s_memrealtime();
                while (__builtin_amdgcn_s_memrealtime() - t1_ < 3 * dt_) __builtin_amdgcn_s_sleep(4); seam(kp); }
#endif
#ifdef PROBE_REPEAT
            if ((PROBE_REPEAT >> PH) & 1) { phase_site<PH>(kp, l); seam(kp); }
#endif
        }
        run_layer<PH + 1>(kp, l);
    }
}
__global__ void __launch_bounds__(512, 2) fwd_kernel(Params p) {
    extern __shared__ __attribute__((aligned(16))) unsigned char lds_raw[];
    volatile LAS unsigned* MISC = (volatile LAS unsigned*)((LAS unsigned char*)lds_raw + LDS_MISC);
    for (int u = threadIdx.x; u < (LDS_BYTES - LDS_MISC) / 4; u += 512) MISC[u] = 0u;
    __syncthreads();
    (void)xcd_barrier_post((unsigned*)(p.ws + WS_CTL) + CW_BAR, MISC + 8);
    KParams kp = (KParams)__builtin_amdgcn_kernarg_segment_ptr();
    run_layer<0>(kp, 0);
    run_layer<0>(kp, 1);
    static_assert(DEPTH == 2, "layers are written out");
}
#endif

extern "C" void kernel_launch(void* const* d_in, const int* in_sizes, int n_in, void* d_out, int out_size, void* d_ws, size_t ws_size, hipStream_t stream) {
    static int grid = 0;
    if (grid == 0) {
        if (n_in != 28 || in_sizes[0] != M * D || out_size != M * D || ws_size < WS_END) { fprintf(stderr, "kernel_launch: unexpected shapes (n_in %d, in0 %d, out %d, ws %zu < %zu); nothing launched\n", n_in, n_in > 0 ? in_sizes[0] : -1, out_size, ws_size, (size_t)WS_END); grid = -1; return; }
        int dev = 0, cus = 0;
        if (hipGetDevice(&dev) != hipSuccess || hipDeviceGetAttribute(&cus, hipDeviceAttributeMultiprocessorCount, dev) != hipSuccess) { grid = -1; return; }
#if MK_ONE_LAUNCH
        if (hipFuncSetAttribute((const void*)fwd_kernel, hipFuncAttributeMaxDynamicSharedMemorySize, LDS_BYTES) != hipSuccess) { fprintf(stderr, "kernel_launch: hipFuncSetAttribute failed\n"); grid = -1; return; }
        int per_cu = 0;
        if (hipOccupancyMaxActiveBlocksPerMultiprocessor(&per_cu, (const void*)fwd_kernel, 512, LDS_BYTES) != hipSuccess || per_cu < 1) { fprintf(stderr, "kernel_launch: occupancy query reports %d workgroups per CU\n", per_cu); }
        (void)hipGetLastError();
#endif
        grid = cus;
    }
    if (grid < 0) return;
    if (hipMemsetAsync((char*)d_ws + WS_CTL, 0, CTL_ZERO_BYTES, stream) != hipSuccess) return;
    Params a{};
    for (int i = 0; i < 28; ++i) a.in[i] = (const float*)d_in[i];
    a.out = (float*)d_out; a.ws = (unsigned char*)d_ws;
#if MK_ONE_LAUNCH
    hipLaunchKernelGGL(fwd_kernel, dim3(grid), dim3(512), LDS_BYTES, stream, a);
#else
    for (int l = 0; l < DEPTH; ++l) launch_phases<0>(grid, a, l, stream);
#endif
}
```

```cpp
#include <hip/hip_runtime.h>
#include <cstdio>
#include <cstdint>

#define GAS __attribute__((address_space(1)))
#define LAS __attribute__((address_space(3)))
typedef unsigned short bf16;
typedef short bf16x8 __attribute__((ext_vector_type(8)));
typedef float f32x4 __attribute__((ext_vector_type(4)));
typedef float f32x2 __attribute__((ext_vector_type(2)));
typedef unsigned u32x4 __attribute__((ext_vector_type(4)));
typedef unsigned u32x2 __attribute__((ext_vector_type(2)));
typedef int i32x4 __attribute__((ext_vector_type(4)));

constexpr int D = 1024, NBATCH = 4, SEQ = 4096, M = NBATCH * SEQ, DEPTH = 2, MEML = 256, MM = NBATCH * MEML;
constexpr int NIN = 8456;
constexpr int PP = 5376;
constexpr int C_MQ = 0, C_MK = 512, C_MV = 1024, C_MO = 1536, C_AQ = 2048, C_AK = 2816, C_AV = 3584, C_GU = 4352, C_GV = 4864;
constexpr int NEXP = 16, DFF = 512;
constexpr int LCH = 128, NCH = SEQ / LCH;
constexpr float EPS = 1e-6f;
constexpr int MAXT = 144;

constexpr size_t MiB = 1u << 20;
constexpr size_t WS_CTL = 0, CTL_ZERO_BYTES = 1 * MiB;
constexpr size_t WS_SMALL = 1 * MiB;
constexpr size_t OFF_GATES = WS_SMALL;
constexpr size_t OFF_AMA = OFF_GATES + (size_t)M * 8 * 4;
constexpr size_t OFF_AMM = OFF_AMA + 16 * SEQ * 4;
constexpr size_t OFF_AMB = OFF_AMM + 16 * SEQ * 4;
constexpr size_t OFF_LSE = OFF_AMB + 16 * SEQ * 4;
constexpr size_t OFF_BIAS = OFF_LSE + (size_t)M * 12 * 4;
constexpr size_t OFF_TOKE = OFF_BIAS + 12 * 132 * 4;
constexpr size_t OFF_TOKP = OFF_TOKE + (size_t)M * 2 * 4;
constexpr size_t OFF_TOKW = OFF_TOKP + (size_t)M * 2 * 4;
constexpr size_t OFF_SLOT = OFF_TOKW + (size_t)M * 2 * 4;
constexpr size_t OFF_WROW = OFF_SLOT + (size_t)M * 2 * 4;
constexpr size_t OFF_NST = OFF_WROW + (size_t)MAXT * 256 * 4;
constexpr size_t OFF_MEMB = OFF_NST + (size_t)16 * NCH * 128 * 4;
constexpr size_t OFF_KV = OFF_MEMB + (size_t)MM * D * 2;
constexpr size_t OFF_CNTW = OFF_KV + (size_t)MM * 1024 * 2;
constexpr size_t OFF_SSQ = OFF_CNTW + 256 * 16 * 4;
constexpr size_t OFF_SMALL_END = OFF_SSQ + (size_t)M * 16 * 4;
static_assert(OFF_SMALL_END <= 17 * MiB, "small region");
constexpr size_t WS_W = 17 * MiB;
constexpr size_t OFF_WIN1 = WS_W;
constexpr size_t OFF_WG = OFF_WIN1 + (size_t)5376 * 1024 * 2;
constexpr size_t OFF_WA = OFF_WG + (size_t)3072 * 1024 * 2;
constexpr size_t OFF_WB = OFF_WA + (size_t)1024 * 512 * 2;
constexpr size_t OFF_WC = OFF_WB + (size_t)1024 * 768 * 2;
constexpr size_t OFF_WOUT = OFF_WC + (size_t)1024 * 512 * 2;
constexpr size_t OFF_WXQ = OFF_WOUT + (size_t)1024 * 1024 * 2;
constexpr size_t OFF_WXKV = OFF_WXQ + (size_t)512 * 1024 * 2;
constexpr size_t OFF_WXO = OFF_WXKV + (size_t)1024 * 1024 * 2;
constexpr size_t OFF_WGU = OFF_WXO + (size_t)1024 * 512 * 2;
constexpr size_t OFF_WD = OFF_WGU + (size_t)16 * 1024 * 1024 * 2;
constexpr size_t OFF_W_END = OFF_WD + (size_t)16 * 1024 * 512 * 2;
static_assert(OFF_W_END <= 93 * MiB, "weight region");
constexpr size_t WS_XB = 93 * MiB;
constexpr size_t WS_PROJ = 125 * MiB;
constexpr size_t OFF_XG = WS_PROJ, OFF_HID = WS_PROJ + 72 * MiB;
constexpr size_t WS_X1B = WS_PROJ + 120 * MiB;
constexpr size_t WS_T = 293 * MiB;
constexpr size_t OFF_Q = WS_T, OFF_O = WS_T + 16 * MiB;
constexpr size_t WS_YA = 327 * MiB, WS_YC = 343 * MiB;
constexpr size_t WS_END = 359 * MiB;
constexpr int CW_TMO = 0, CW_CODE = 1;
constexpr int CW_CNT = 64;
constexpr int CW_BAR = 4096;

constexpr int LDS_BYTES = 147456;
constexpr int LDS_TAB = 145408;
constexpr int LDS_WOFF = 0;
constexpr int LDS_MISC = 146944;

#define RLX_AGENT __ATOMIC_RELAXED, __HIP_MEMORY_SCOPE_AGENT
#define LDS_WAIT() asm volatile("s_waitcnt lgkmcnt(0)" ::: "memory")
#define VM_WAIT() asm volatile("s_waitcnt vmcnt(0)" ::: "memory")
typedef __bf16 bf16x2_t __attribute__((ext_vector_type(2)));
__device__ __forceinline__ unsigned pk2(float lo, float hi) { const f32x2 v = {lo, hi}; return __builtin_bit_cast(unsigned, __builtin_convertvector(v, bf16x2_t)); }
__device__ __forceinline__ unsigned f2bf(float f) { return pk2(f, 0.f) & 0xffffu; }
__device__ __forceinline__ float bf2f(unsigned h) { return __builtin_bit_cast(float, h << 16); }
__device__ __forceinline__ float bflo(unsigned w) { return __builtin_bit_cast(float, w << 16); }
__device__ __forceinline__ float bfhi(unsigned w) { return __builtin_bit_cast(float, w & 0xffff0000u); }
__device__ __forceinline__ float wave_sum(float v) {
#pragma unroll
    for (int o = 1; o < 64; o <<= 1) v += __shfl_xor(v, o);
    return v;
}
__device__ __forceinline__ float sigmoidf_(float x) { return __builtin_amdgcn_rcpf(1.f + __expf(-x)); }
__device__ __forceinline__ float siluf_(float x) { return x * __builtin_amdgcn_rcpf(1.f + __expf(-x)); }
__device__ __forceinline__ float gelu_tanh(float x) { const float u = 0.7978845608028654f * (x + 0.044715f * x * x * x); return x * __builtin_amdgcn_rcpf(1.f + __expf(-2.f * u)); }
__device__ __forceinline__ void unpack8(const u32x4 w, float (&f)[8]) { f[0] = bflo(w.x); f[1] = bfhi(w.x); f[2] = bflo(w.y); f[3] = bfhi(w.y); f[4] = bflo(w.z); f[5] = bfhi(w.z); f[6] = bflo(w.w); f[7] = bfhi(w.w); }
__device__ __forceinline__ u32x4 pack8(const float (&f)[8]) { u32x4 w; w.x = pk2(f[0], f[1]); w.y = pk2(f[2], f[3]); w.z = pk2(f[4], f[5]); w.w = pk2(f[6], f[7]); return w; }

namespace pg8 {
constexpr int BM = 256, BK = 64, HALF = 128, HTB = HALF * BK * 2  , STAGE_BYTES = 8 * HTB, NXCD = 8, WGM = 8;
__host__ __device__ __forceinline__ int lds_byte(int r, int c) { const int st = (r >> 4) * 2 + (c >> 5), rr = r & 15, cc = c & 31, ob = rr * 64 + cc * 2; return st * 1024 + (ob ^ (((ob >> 9) & 1) << 5)); }
__host__ __device__ __forceinline__ void stage_rc(int b, int& R, int& C) { const int st = b / 1024, sb = b % 1024, swz = sb ^ (((sb >> 9) & 1) << 5); R = (st >> 1) * 16 + swz / 64; C = (st & 1) * 32 + (swz % 64) / 2; }
__host__ __device__ __forceinline__ int perm32(int rho) { const int n = rho >> 4, i = rho & 15; return 8 * (i >> 2) + 4 * n + (i & 3); }

struct Unit { int pm, pn; };
struct Gemm { const bf16* A; const bf16* Bt; int lda, K; };

struct StaticOrder {
    int nM, nN, nwg, G, c;
    __host__ __device__ __forceinline__ void init(int M_, int N_, int G_, int c_) { nM = M_ / BM; nN = N_ / BM; nwg = nM * nN; G = G_; c = c_; }
    __host__ __device__ __forceinline__ bool next(int i, Unit& u) const {
        const long L = (long)i * G + c; if (L >= nwg) return false;
        int wgid = (int)L; { const int q = nwg / NXCD, r = nwg % NXCD, xcd = wgid % NXCD, off = wgid / NXCD; wgid = (xcd < r ? xcd * (q + 1) : r * (q + 1) + (xcd - r) * q) + off; }
        const int nig = WGM * nN, gid = wgid / nig, fm = gid * WGM, gsz = (nM - fm) < WGM ? (nM - fm) : WGM;
        u.pm = fm + ((wgid % nig) % gsz); u.pn = (wgid % nig) / gsz; return true;
    }
    __device__ __forceinline__ void a_ready(const Unit&) const {}
    __device__ __forceinline__ void done(const Unit&) const {}
};


__device__ __forceinline__ f32x4 mma16(const bf16x8 a, const bf16x8 b, const f32x4 c) { return __builtin_amdgcn_mfma_f32_16x16x32_bf16(a, b, c, 0, 0, 0); }
__device__ __forceinline__ i32x4 mma16(const bf16x8 a, const bf16x8 b, const i32x4 c) { return __builtin_amdgcn_mfma_i32_16x16x64_i8(__builtin_bit_cast(i32x4, a), __builtin_bit_cast(i32x4, b), c, 0, 0, 0); }
template <bool I8> struct AccSel { typedef f32x4 T; };
template <> struct AccSel<true> { typedef i32x4 T; };
template <class Epi, class Sched, bool ALIGN_EPI = false, bool I8 = false>
__device__ __forceinline__ void gemm_phase(LAS unsigned char* lds, const Gemm g, const Sched& S, const Epi& E) {
    int tid_ = threadIdx.x; asm volatile("" : "+v"(tid_));
    const int tid = tid_, wid = __builtin_amdgcn_readfirstlane(tid >> 6), lane = tid & 63, wr = wid >> 2, wc = wid & 3, fr = lane & 15, fq = lane >> 4;
    const int K = g.K, nt = K / BK, lda = g.lda;
    unsigned voffA[2], voffB[2];
#pragma unroll
    for (int i = 0; i < 2; ++i) { int R, C; stage_rc(tid * 16 + i * 8192, R, C); const int Rb = Epi::PERM ? ((R & ~31) + perm32(R & 31)) : R;
        voffA[i] = (unsigned)(R * lda + C) * 2u; voffB[i] = (unsigned)(Rb * K + C) * 2u; }
    const size_t kstep = (size_t)(BK * 2);
    const size_t hstepA = (size_t)HALF * lda * 2, hstepB = (size_t)HALF * K * 2;
    const size_t tstepA = 2 * hstepA, tstepB = 2 * hstepB;
    const unsigned ldsw = (unsigned)wid * 1024u;
    const int aoff = lds_byte(wr * 64 + fr, fq * 8), boff = lds_byte(wc * 32 + fr, fq * 8);
#define PG8_SA(b, h) (((b) * 2 + (h)) * HTB)
#define PG8_SB(b, h) ((4 + (b) * 2 + (h)) * HTB)
#define PG8_STAGE(bufoff, gbase, voff) do { _Pragma("unroll") for (int _i = 0; _i < 2; ++_i) \
        __builtin_amdgcn_global_load_lds((const unsigned*)((const char*)(gbase) + (voff)[_i]), (LAS unsigned*)(lds + (bufoff) + ldsw + _i * 8192), 16, 0, 0); } while (0)
#define PG8_LDA(dst, b, h) do { _Pragma("unroll") for (int m = 0; m < 4; ++m) _Pragma("unroll") for (int k = 0; k < 2; ++k) dst[m][k] = *(const LAS bf16x8*)(lds + PG8_SA(b, h) + aoff + m * 2048 + k * 1024); } while (0)
#define PG8_LDB(dst, b, h) do { _Pragma("unroll") for (int n = 0; n < 2; ++n) _Pragma("unroll") for (int k = 0; k < 2; ++k) dst[n][k] = *(const LAS bf16x8*)(lds + PG8_SB(b, h) + boff + n * 2048 + k * 1024); } while (0)
#define PG8_MMA(ai, bj, At, Bt) do { __builtin_amdgcn_s_setprio(1); _Pragma("unroll") for (int m = 0; m < 4; ++m) _Pragma("unroll") for (int n = 0; n < 2; ++n) _Pragma("unroll") for (int k = 0; k < 2; ++k) \
        acc[ai][bj][m][n] = mma16(Bt[n][k], At[m][k], acc[ai][bj][m][n]); __builtin_amdgcn_s_setprio(0); } while (0)
#define PG8_WAIT_V(n) asm volatile("s_waitcnt vmcnt(" #n ")" ::: "memory")
#define PG8_WAIT_L(n) asm volatile("s_waitcnt lgkmcnt(" #n ")" ::: "memory")
#define PG8_BAR __builtin_amdgcn_s_barrier()
#define PG8_SCHED __builtin_amdgcn_sched_barrier(0)
    Unit cur, nxt; int ui = 0;
    if (!S.next(0, cur)) return;
    typedef typename AccSel<I8>::T acc_t;
    acc_t acc[2][2][4][2];
#pragma unroll
    for (int a = 0; a < 2; ++a)
#pragma unroll
        for (int b = 0; b < 2; ++b)
#pragma unroll
            for (int m = 0; m < 4; ++m)
#pragma unroll
                for (int n = 0; n < 2; ++n) acc[a][b][m][n] = (acc_t){0, 0, 0, 0};
    bf16x8 At[4][2], B0[2][2], B1[2][2];
    const char* cA = (const char*)g.A + (size_t)cur.pm * tstepA; const char* cB = (const char*)g.Bt + (size_t)cur.pn * tstepB;
    S.a_ready(cur);
    PG8_STAGE(PG8_SB(0, 0), cB, voffB); PG8_STAGE(PG8_SB(0, 1), cB + hstepB, voffB); PG8_STAGE(PG8_SA(0, 0), cA, voffA); PG8_STAGE(PG8_SA(0, 1), cA + hstepA, voffA);
    if (wr == 1) PG8_BAR;
    PG8_WAIT_V(2); PG8_BAR;
    PG8_STAGE(PG8_SB(1, 0), cB + kstep, voffB); PG8_STAGE(PG8_SA(1, 0), cA + kstep, voffA); PG8_STAGE(PG8_SB(1, 1), cB + hstepB + kstep, voffB);
    PG8_WAIT_V(6); PG8_BAR;
    for (;;) {
        const bool has_next = S.next(ui + 1, nxt);
        const char* nA = has_next ? (const char*)g.A + (size_t)nxt.pm * tstepA : cA; const char* nB = has_next ? (const char*)g.Bt + (size_t)nxt.pn * tstepB : cB;
        for (int t = 0; t < nt; t += 2) {
            const bool last = (t == nt - 2);
            const char* a1 = cA + (size_t)(t + 1) * kstep;
            const char* a2 = last ? nA : cA + (size_t)(t + 2) * kstep; const char* b2 = last ? nB : cB + (size_t)(t + 2) * kstep;
            const char* a3 = a2 + kstep; const char* b3 = b2 + kstep;
            if (last && has_next) S.a_ready(nxt);
            PG8_LDB(B0, 0, 0); PG8_LDB(B1, 0, 1); PG8_SCHED; PG8_LDA(At, 0, 0); PG8_STAGE(PG8_SA(1, 1), a1 + hstepA, voffA);
            PG8_WAIT_V(8); PG8_WAIT_L(0); PG8_BAR; PG8_MMA(0, 0, At, B0); PG8_MMA(0, 1, At, B1); PG8_BAR; PG8_SCHED;
            PG8_LDA(At, 0, 1); PG8_STAGE(PG8_SB(0, 0), b2, voffB); PG8_STAGE(PG8_SB(0, 1), b2 + hstepB, voffB); PG8_STAGE(PG8_SA(0, 0), a2, voffA);
            PG8_WAIT_V(8); PG8_WAIT_L(0); PG8_BAR; PG8_MMA(1, 0, At, B0); PG8_MMA(1, 1, At, B1); PG8_BAR; PG8_SCHED;
            PG8_LDB(B0, 1, 0); PG8_LDB(B1, 1, 1); PG8_SCHED; PG8_LDA(At, 1, 0); PG8_STAGE(PG8_SA(0, 1), a2 + hstepA, voffA);
            PG8_WAIT_V(8); PG8_WAIT_L(0); PG8_BAR; PG8_MMA(0, 0, At, B0); PG8_MMA(0, 1, At, B1); PG8_BAR; PG8_SCHED;
            PG8_LDA(At, 1, 1); PG8_STAGE(PG8_SB(1, 0), b3, voffB); PG8_STAGE(PG8_SB(1, 1), b3 + hstepB, voffB); PG8_STAGE(PG8_SA(1, 0), a3, voffA);
            PG8_WAIT_V(8); PG8_WAIT_L(0); PG8_BAR; PG8_MMA(1, 0, At, B0); PG8_MMA(1, 1, At, B1); PG8_BAR; PG8_SCHED;
        }
        if constexpr (ALIGN_EPI) { if (wr == 0) PG8_BAR; }
        E(acc, cur, wr, wc, fr, fq); S.done(cur);
        if (!has_next) break;
#pragma unroll
        for (int a = 0; a < 2; ++a)
#pragma unroll
            for (int b = 0; b < 2; ++b)
#pragma unroll
                for (int m = 0; m < 4; ++m)
#pragma unroll
                    for (int n = 0; n < 2; ++n) acc[a][b][m][n] = (acc_t){0, 0, 0, 0};
        cur = nxt; cA = nA; cB = nB; ++ui;
        if constexpr (ALIGN_EPI) { if (wr == 1) PG8_BAR; }
    }
    PG8_WAIT_V(0);
    if constexpr (!ALIGN_EPI) { if (wr == 0) PG8_BAR; }
    PG8_BAR;
#undef PG8_SA
#undef PG8_SB
#undef PG8_STAGE
#undef PG8_LDA
#undef PG8_LDB
#undef PG8_MMA
#undef PG8_WAIT_V
#undef PG8_WAIT_L
#undef PG8_BAR
#undef PG8_SCHED
}

struct SUnit { int pm, pn, kind; const char* a; const char* b; int lda, K; };
template <class Epi, class Sched, bool ALIGN_EPI = false>
__device__ __forceinline__ void gemm_stream(LAS unsigned char* lds, const Sched& S, const Epi& E) {
    int tid_ = threadIdx.x; asm volatile("" : "+v"(tid_));
    const int tid = tid_, wid = __builtin_amdgcn_readfirstlane(tid >> 6), lane = tid & 63, wr = wid >> 2, wc = wid & 3, fr = lane & 15, fq = lane >> 4;
    int R0, C0; stage_rc(tid * 16, R0, C0); const int Rb0 = Epi::PERM ? ((R0 & ~31) + perm32(R0 & 31)) : R0;
    const size_t kstep = (size_t)(BK * 2);
    const unsigned ldsw = (unsigned)wid * 1024u;
    const int aoff = lds_byte(wr * 64 + fr, fq * 8), boff = lds_byte(wc * 32 + fr, fq * 8);
#define PG8_SA(b, h) (((b) * 2 + (h)) * HTB)
#define PG8_SB(b, h) ((4 + (b) * 2 + (h)) * HTB)
#define PG8_STG(bufoff, gbase, v0, p64) do { _Pragma("unroll") for (int _i = 0; _i < 2; ++_i) \
        __builtin_amdgcn_global_load_lds((const unsigned*)((const char*)(gbase) + (v0) + (size_t)_i * (p64)), (LAS unsigned*)(lds + (bufoff) + ldsw + _i * 8192), 16, 0, 0); } while (0)
#define PG8_LDA(dst, b, h) do { _Pragma("unroll") for (int m = 0; m < 4; ++m) _Pragma("unroll") for (int k = 0; k < 2; ++k) dst[m][k] = *(const LAS bf16x8*)(lds + PG8_SA(b, h) + aoff + m * 2048 + k * 1024); } while (0)
#define PG8_LDB(dst, b, h) do { _Pragma("unroll") for (int n = 0; n < 2; ++n) _Pragma("unroll") for (int k = 0; k < 2; ++k) dst[n][k] = *(const LAS bf16x8*)(lds + PG8_SB(b, h) + boff + n * 2048 + k * 1024); } while (0)
#define PG8_MMA(ai, bj, At, Bt) do { __builtin_amdgcn_s_setprio(1); _Pragma("unroll") for (int m = 0; m < 4; ++m) _Pragma("unroll") for (int n = 0; n < 2; ++n) _Pragma("unroll") for (int k = 0; k < 2; ++k) \
        acc[ai][bj][m][n] = mma16(Bt[n][k], At[m][k], acc[ai][bj][m][n]); __builtin_amdgcn_s_setprio(0); } while (0)
#define PG8_WAIT_V(n) asm volatile("s_waitcnt vmcnt(" #n ")" ::: "memory")
#define PG8_WAIT_L(n) asm volatile("s_waitcnt lgkmcnt(" #n ")" ::: "memory")
#define PG8_BAR __builtin_amdgcn_s_barrier()
#define PG8_SCHED __builtin_amdgcn_sched_barrier(0)
    SUnit cur, nxt; int ui = 0;
    if (!S.next(0, cur)) return;
    f32x4 acc[2][2][4][2];
#pragma unroll
    for (int a = 0; a < 2; ++a)
#pragma unroll
        for (int b = 0; b < 2; ++b)
#pragma unroll
            for (int m = 0; m < 4; ++m)
#pragma unroll
                for (int n = 0; n < 2; ++n) acc[a][b][m][n] = (f32x4){0.f, 0.f, 0.f, 0.f};
    bf16x8 At[4][2], B0[2][2], B1[2][2];
    const char* cA = cur.a; const char* cB = cur.b;
    unsigned vAc = (unsigned)(R0 * cur.lda + C0) * 2u, vBc = (unsigned)(Rb0 * cur.K + C0) * 2u;
    size_t pAc = (size_t)cur.lda * 128, pBc = (size_t)cur.K * 128;
    PG8_STG(PG8_SB(0, 0), cB, vBc, pBc); PG8_STG(PG8_SB(0, 1), cB + 2 * pBc, vBc, pBc); PG8_STG(PG8_SA(0, 0), cA, vAc, pAc); PG8_STG(PG8_SA(0, 1), cA + 2 * pAc, vAc, pAc);
    if (wr == 1) PG8_BAR;
    PG8_WAIT_V(2); PG8_BAR;
    PG8_STG(PG8_SB(1, 0), cB + kstep, vBc, pBc); PG8_STG(PG8_SA(1, 0), cA + kstep, vAc, pAc); PG8_STG(PG8_SB(1, 1), cB + 2 * pBc + kstep, vBc, pBc);
    PG8_WAIT_V(6); PG8_BAR;
    for (;;) {
        const bool has_next = S.next(ui + 1, nxt);
        const char* nA = has_next ? nxt.a : cA; const char* nB = has_next ? nxt.b : cB;
        const unsigned vAn = has_next ? (unsigned)(R0 * nxt.lda + C0) * 2u : vAc, vBn = has_next ? (unsigned)(Rb0 * nxt.K + C0) * 2u : vBc;
        const size_t pAn = has_next ? (size_t)nxt.lda * 128 : pAc, pBn = has_next ? (size_t)nxt.K * 128 : pBc;
        const int nt = cur.K / BK;
        for (int t = 0; t < nt; t += 2) {
            const bool last = (t == nt - 2);
            const char* a1 = cA + (size_t)(t + 1) * kstep;
            const char* a2 = last ? nA : cA + (size_t)(t + 2) * kstep; const char* b2 = last ? nB : cB + (size_t)(t + 2) * kstep;
            const char* a3 = a2 + kstep; const char* b3 = b2 + kstep;
            const unsigned va2 = last ? vAn : vAc, vb2 = last ? vBn : vBc; const size_t pa2 = last ? pAn : pAc, pb2 = last ? pBn : pBc;
            PG8_LDB(B0, 0, 0); PG8_LDB(B1, 0, 1); PG8_SCHED; PG8_LDA(At, 0, 0); PG8_STG(PG8_SA(1, 1), a1 + 2 * pAc, vAc, pAc);
            PG8_WAIT_V(8); PG8_WAIT_L(0); PG8_BAR; PG8_MMA(0, 0, At, B0); PG8_MMA(0, 1, At, B1); PG8_BAR; PG8_SCHED;
            PG8_LDA(At, 0, 1); PG8_STG(PG8_SB(0, 0), b2, vb2, pb2); PG8_STG(PG8_SB(0, 1), b2 + 2 * pb2, vb2, pb2); PG8_STG(PG8_SA(0, 0), a2, va2, pa2);
            PG8_WAIT_V(8); PG8_WAIT_L(0); PG8_BAR; PG8_MMA(1, 0, At, B0); PG8_MMA(1, 1, At, B1); PG8_BAR; PG8_SCHED;
            PG8_LDB(B0, 1, 0); PG8_LDB(B1, 1, 1); PG8_SCHED; PG8_LDA(At, 1, 0); PG8_STG(PG8_SA(0, 1), a2 + 2 * pa2, va2, pa2);
            PG8_WAIT_V(8); PG8_WAIT_L(0); PG8_BAR; PG8_MMA(0, 0, At, B0); PG8_MMA(0, 1, At, B1); PG8_BAR; PG8_SCHED;
            PG8_LDA(At, 1, 1); PG8_STG(PG8_SB(1, 0), b3, vb2, pb2); PG8_STG(PG8_SB(1, 1), b3 + 2 * pb2, vb2, pb2); PG8_STG(PG8_SA(1, 0), a3, va2, pa2);
            PG8_WAIT_V(8); PG8_WAIT_L(0); PG8_BAR; PG8_MMA(1, 0, At, B0); PG8_MMA(1, 1, At, B1); PG8_BAR; PG8_SCHED;
        }
        if constexpr (ALIGN_EPI) { if (wr == 0) PG8_BAR; }
#if defined(PROBE_EPI)
        { const unsigned long long te0_ = __builtin_amdgcn_s_memrealtime();
          E(acc, cur, wr, wc, fr, fq);
#if PROBE_EPI == 2
          asm volatile("s_waitcnt vmcnt(0)" ::: "memory");
#endif
          const unsigned long long dte_ = __builtin_amdgcn_s_memrealtime() - te0_, te1_ = __builtin_amdgcn_s_memrealtime();
          while (__builtin_amdgcn_s_memrealtime() - te1_ < 3 * dte_) __builtin_amdgcn_s_sleep(2); }
#else
        E(acc, cur, wr, wc, fr, fq);
#endif
        if (!has_next) break;
#pragma unroll
        for (int a = 0; a < 2; ++a)
#pragma unroll
            for (int b = 0; b < 2; ++b)
#pragma unroll
                for (int m = 0; m < 4; ++m)
#pragma unroll
                    for (int n = 0; n < 2; ++n) acc[a][b][m][n] = (f32x4){0.f, 0.f, 0.f, 0.f};
        cur = nxt; cA = nA; cB = nB; vAc = vAn; vBc = vBn; pAc = pAn; pBc = pBn; ++ui;
        if constexpr (ALIGN_EPI) { if (wr == 1) PG8_BAR; }
    }
    PG8_WAIT_V(0);
    if constexpr (!ALIGN_EPI) { if (wr == 0) PG8_BAR; }
    PG8_BAR;
#undef PG8_SA
#undef PG8_SB
#undef PG8_STG
#undef PG8_LDA
#undef PG8_LDB
#undef PG8_MMA
#undef PG8_WAIT_V
#undef PG8_WAIT_L
#undef PG8_BAR
#undef PG8_SCHED
}
}

namespace epi {
using pg8::Unit; using pg8::BM; using pg8::HALF;
__device__ __forceinline__ u32x4 pk8(const f32x4 v0, const f32x4 v1) { u32x4 w; w.x = pk2(v0[0], v0[1]); w.y = pk2(v0[2], v0[3]); w.z = pk2(v1[0], v1[1]); w.w = pk2(v1[2], v1[3]); return w; }
__device__ __forceinline__ void up8(const u32x4 w, f32x4& a, f32x4& b) { a = (f32x4){bflo(w.x), bfhi(w.x), bflo(w.y), bfhi(w.y)}; b = (f32x4){bflo(w.z), bfhi(w.z), bflo(w.w), bfhi(w.w)}; }
__device__ __forceinline__ int gcol(int tg) { return tg < 6 ? 256 * tg : 2816 + 256 * (tg - 6); }

struct Bf16Out {
    static constexpr bool PERM = true;
    bf16* O; int ldc;
    __device__ __forceinline__ void operator()(const f32x4 (&acc)[2][2][4][2], const Unit& u, int wr, int wc, int fr, int fq) const {
        const int row0 = u.pm * BM + wr * 64 + fr, col0 = u.pn * BM + wc * 32 + 8 * fq;
#pragma unroll
        for (int ai = 0; ai < 2; ++ai)
#pragma unroll
            for (int m = 0; m < 4; ++m) { bf16* rowp = O + (size_t)(row0 + ai * HALF + m * 16) * ldc + col0;
#pragma unroll
                for (int bj = 0; bj < 2; ++bj) *(u32x4*)(rowp + bj * HALF) = pk8(acc[ai][bj][m][0], acc[ai][bj][m][1]); }
    }
};
struct SigOut {
    static constexpr bool PERM = true;
    bf16* PROJ;
    __device__ __forceinline__ void operator()(const f32x4 (&acc)[2][2][4][2], const Unit& u, int wr, int wc, int fr, int fq) const {
        const int row0 = u.pm * BM + wr * 64 + fr, col0 = gcol(u.pn) + wc * 32 + 8 * fq;
#pragma unroll
        for (int ai = 0; ai < 2; ++ai)
#pragma unroll
            for (int m = 0; m < 4; ++m) { bf16* rowp = PROJ + (size_t)(row0 + ai * HALF + m * 16) * PP + col0;
#pragma unroll
                for (int bj = 0; bj < 2; ++bj) { f32x4 a = acc[ai][bj][m][0], b = acc[ai][bj][m][1];
#pragma unroll
                    for (int e = 0; e < 4; ++e) { a[e] = sigmoidf_(a[e]); b[e] = sigmoidf_(b[e]); }
                    *(u32x4*)(rowp + bj * HALF) = pk8(a, b); } }
    }
};
template <int BR> struct BranchOut {
    static constexpr bool PERM = true;
    const bf16* PROJ; bf16* T; bf16* OUT;
    __device__ __forceinline__ void operator()(const f32x4 (&acc)[2][2][4][2], const Unit& u, int wr, int wc, int fr, int fq) const {
        const int row0 = u.pm * BM + wr * 64 + fr, cw = wc * 32 + 8 * fq, gc0 = gcol(BR * 4 + u.pn) + cw, col0 = u.pn * BM + cw;
#pragma unroll
        for (int ai = 0; ai < 2; ++ai)
#pragma unroll
            for (int m = 0; m < 4; ++m) { const size_t row = (size_t)(row0 + ai * HALF + m * 16);
#pragma unroll
                for (int bj = 0; bj < 2; ++bj) {
                    f32x4 g0, g1; up8(*(const u32x4*)(PROJ + row * PP + gc0 + bj * HALF), g0, g1);
                    f32x4 v0 = g0 * acc[ai][bj][m][0], v1 = g1 * acc[ai][bj][m][1];
                    if (BR > 0) { f32x4 t0, t1; up8(*(const u32x4*)(T + row * 1024 + col0 + bj * HALF), t0, t1); v0 += t0; v1 += t1; }
                    bf16* dst = (BR == 2 ? OUT : T) + row * 1024 + col0 + bj * HALF;
                    *(u32x4*)dst = pk8(v0, v1); } }
    }
};
struct GateBranchOut {
    static constexpr bool PERM = true;
    bf16* PROJ; bf16* T;
    __device__ __forceinline__ void operator()(const f32x4 (&acc)[2][2][4][2], const pg8::SUnit& u, int wr, int wc, int fr, int fq) const {
        const int row0 = u.pm * BM + wr * 64 + fr, cw = wc * 32 + 8 * fq;
        if (u.kind < 3) {
            const int col0 = gcol(u.kind * 4 + u.pn) + cw;
#pragma unroll
            for (int ai = 0; ai < 2; ++ai)
#pragma unroll
                for (int m = 0; m < 4; ++m) { bf16* rowp = PROJ + (size_t)(row0 + ai * HALF + m * 16) * PP + col0;
#pragma unroll
                    for (int bj = 0; bj < 2; ++bj) { f32x4 a = acc[ai][bj][m][0], b = acc[ai][bj][m][1];
#pragma unroll
                        for (int e = 0; e < 4; ++e) { a[e] = sigmoidf_(a[e]); b[e] = sigmoidf_(b[e]); }
                        *(u32x4*)(rowp + bj * HALF) = pk8(a, b); } }
        } else {
            const int br = u.kind - 3, gc0 = gcol(br * 4 + u.pn) + cw, col0 = u.pn * BM + cw;
#pragma unroll
            for (int ai = 0; ai < 2; ++ai)
#pragma unroll
                for (int m = 0; m < 4; ++m) { const size_t row = (size_t)(row0 + ai * HALF + m * 16);
#pragma unroll
                    for (int bj = 0; bj < 2; ++bj) {
                        f32x4 g0, g1; up8(*(const u32x4*)(PROJ + row * PP + gc0 + bj * HALF), g0, g1);
                        f32x4 v0 = g0 * acc[ai][bj][m][0], v1 = g1 * acc[ai][bj][m][1];
                        bf16* tp = T + row * 1024 + col0 + bj * HALF;
                        if (br > 0) { f32x4 t0, t1; up8(*(const u32x4*)tp, t0, t1); v0 += t0; v1 += t1; }
                        *(u32x4*)tp = pk8(v0, v1); } }
        }
    }
};
struct ResidOut {
    static constexpr bool PERM = false;
    const float* SRC; float* DST;
    __device__ __forceinline__ void operator()(const f32x4 (&acc)[2][2][4][2], const Unit& u, int wr, int wc, int fr, int fq) const {
        const int row0 = u.pm * BM + wr * 64 + fr, col0 = u.pn * BM + wc * 32 + 4 * fq;
#pragma unroll
        for (int ai = 0; ai < 2; ++ai)
#pragma unroll
            for (int m = 0; m < 4; ++m) { const size_t off = (size_t)(row0 + ai * HALF + m * 16) * 1024 + col0;
#pragma unroll
                for (int bj = 0; bj < 2; ++bj)
#pragma unroll
                    for (int n = 0; n < 2; ++n) { const size_t o = off + bj * HALF + n * 16; *(f32x4*)(DST + o) = *(const f32x4*)(SRC + o) + acc[ai][bj][m][n]; } }
    }
};
struct ResidOutXb {
    static constexpr bool PERM = false;
    const float* SRC; float* DST; bf16* XB; float* SSQ;
    __device__ __forceinline__ void operator()(const f32x4 (&acc)[2][2][4][2], const Unit& u, int wr, int wc, int fr, int fq) const {
        const int row0 = u.pm * BM + wr * 64 + fr, col0 = u.pn * BM + wc * 32 + 4 * fq;
#pragma unroll
        for (int ai = 0; ai < 2; ++ai)
#pragma unroll
            for (int m = 0; m < 4; ++m) { const int row = row0 + ai * HALF + m * 16; const size_t off = (size_t)row * 1024 + col0; float ss = 0.f;
#pragma unroll
                for (int bj = 0; bj < 2; ++bj)
#pragma unroll
                    for (int n = 0; n < 2; ++n) { const size_t o = off + bj * HALF + n * 16; const f32x4 v = *(const f32x4*)(SRC + o) + acc[ai][bj][m][n]; *(f32x4*)(DST + o) = v;
                        ss += (v[0] * v[0] + v[1] * v[1]) + (v[2] * v[2] + v[3] * v[3]); u32x2 w; w.x = pk2(v[0], v[1]); w.y = pk2(v[2], v[3]); *(u32x2*)(XB + o) = w; }
                ss += __shfl_xor(ss, 16); ss += __shfl_xor(ss, 32);
                if (fq == 0) SSQ[(size_t)row * 16 + u.pn * 4 + wc] = ss; }
    }
};
struct Bf16OutRs {
    static constexpr bool PERM = true;
    bf16* O; int ldc; const float* SSQ;
    __device__ __forceinline__ void operator()(const f32x4 (&acc)[2][2][4][2], const Unit& u, int wr, int wc, int fr, int fq) const {
        const int row0 = u.pm * BM + wr * 64 + fr, col0 = u.pn * BM + wc * 32 + 8 * fq;
#pragma unroll
        for (int ai = 0; ai < 2; ++ai)
#pragma unroll
            for (int m = 0; m < 4; ++m) { const int row = row0 + ai * HALF + m * 16; const f32x4* sp = (const f32x4*)(SSQ + (size_t)row * 16);
                const f32x4 s0 = sp[0], s1 = sp[1], s2 = sp[2], s3 = sp[3]; const f32x4 st = (s0 + s1) + (s2 + s3);
                const float rs = 1.f / sqrtf(((st[0] + st[1]) + (st[2] + st[3])) * (1.f / 1024.f) + EPS); bf16* rowp = O + (size_t)row * ldc + col0;
#pragma unroll
                for (int bj = 0; bj < 2; ++bj) *(u32x4*)(rowp + bj * HALF) = pk8(acc[ai][bj][m][0] * rs, acc[ai][bj][m][1] * rs); }
    }
};
struct GluOut {
    static constexpr bool PERM = true;
    bf16* HID;
    __device__ __forceinline__ void operator()(const f32x4 (&acc)[2][2][4][2], const Unit& u, int wr, int wc, int fr, int fq) const {
        const int row0 = u.pm * BM + wr * 64 + fr, col0 = (u.pn & 3) * 128 + wc * 32 + 8 * fq;
#pragma unroll
        for (int ai = 0; ai < 2; ++ai)
#pragma unroll
            for (int m = 0; m < 4; ++m) { f32x4 a = acc[ai][0][m][0], b = acc[ai][0][m][1]; const f32x4 ua = acc[ai][1][m][0], ub = acc[ai][1][m][1];
#pragma unroll
                for (int e = 0; e < 4; ++e) { a[e] = siluf_(a[e]) * ua[e]; b[e] = siluf_(b[e]) * ub[e]; }
                *(u32x4*)(HID + (size_t)(row0 + ai * HALF + m * 16) * DFF + col0) = pk8(a, b); }
    }
};
struct DownOut {
    static constexpr bool PERM = true;
    bf16* YE; const float* WROW;
    __device__ __forceinline__ void operator()(const f32x4 (&acc)[2][2][4][2], const Unit& u, int wr, int wc, int fr, int fq) const {
        const int row0 = u.pm * BM + wr * 64 + fr, col0 = (u.pn & 3) * BM + wc * 32 + 8 * fq;
#pragma unroll
        for (int ai = 0; ai < 2; ++ai)
#pragma unroll
            for (int m = 0; m < 4; ++m) { const int row = row0 + ai * HALF + m * 16; const float w = WROW[row]; bf16* rowp = YE + (size_t)row * 1024 + col0;
#pragma unroll
                for (int bj = 0; bj < 2; ++bj) *(u32x4*)(rowp + bj * HALF) = pk8(acc[ai][bj][m][0] * w, acc[ai][bj][m][1] * w); }
    }
};
}

struct MoeOrder {
    const LAS int* tab; int G, c;
    __device__ __forceinline__ bool next(int i, pg8::Unit& u) const {
        const int L = i * G + c; const int nT = tab[176]; if (L >= 4 * nT) return false;
        const int pm = L >> 2; u.pm = pm; u.pn = tab[pm] * 4 + (L & 3); return true;
    }
    __device__ __forceinline__ void a_ready(const pg8::Unit&) const {}
    __device__ __forceinline__ void done(const pg8::Unit&) const {}
};
#define XB_TMO      128
#define XB_XCNT(j)  (256  + 64 * (j))
#define XB_XSUB(j)  (1280 + 64 * (j))
#define XB_XGEN(j)  (2304 + 64 * (j))
#define XB_TOP      3328
#define XB_TOPGEN   3392
#define XCD_BAR_WORDS 3456
#define XB_SPIN_CAP (1u << 18)

__device__ __forceinline__ unsigned xb_ld(unsigned* p)              { return __hip_atomic_load(p, __ATOMIC_RELAXED, __HIP_MEMORY_SCOPE_AGENT); }
__device__ __forceinline__ unsigned xb_add(unsigned* p, unsigned v) { return __hip_atomic_fetch_add(p, v, __ATOMIC_RELAXED, __HIP_MEMORY_SCOPE_AGENT); }
__device__ __forceinline__ unsigned xb_xcc_id() { return (unsigned)__builtin_amdgcn_s_getreg((3 << 11) | 20) & 0xFu; }
#define XB_SPIN(cond, bar) do { unsigned _sp = 0; while (cond) { __builtin_amdgcn_s_sleep(1); \
    if ((++_sp & 255u) == 0u) { if (xb_ld(&(bar)[XB_TMO])) break; if (_sp > XB_SPIN_CAP) { atomicAdd(&(bar)[XB_TMO], 1u); break; } } } } while (0)

struct XcdBarrier {
    unsigned* bar; unsigned x;
    volatile LAS unsigned* st;
};

__device__ __forceinline__ XcdBarrier xcd_barrier_post(unsigned* bar, volatile LAS unsigned* st) {
    XcdBarrier b; b.bar = bar; b.x = xb_xcc_id(); b.st = st;
    if (threadIdx.x == 0) (void)xb_add(&bar[XB_XCNT(b.x)], 1u);
    return b;
}
__device__ __forceinline__ void xcd_barrier_complete(unsigned* bar, unsigned x, unsigned& nloc, unsigned& nx) {
    const unsigned G = gridDim.x * gridDim.y * gridDim.z;
    unsigned sum, cnt, mine, sp = 0u;
    for (;;) {
        sum = 0u; cnt = 0u; mine = 0u;
#pragma unroll
        for (unsigned j = 0; j < 16; ++j) { const unsigned c = xb_ld(&bar[XB_XCNT(j)]); sum += c; cnt += (c > 0u) ? 1u : 0u; mine = (j == x) ? c : mine; }
        if (sum == G) break;
        __builtin_amdgcn_s_sleep(1);
        if ((++sp & 255u) == 0u) { if (xb_ld(&bar[XB_TMO])) break; if (sp > XB_SPIN_CAP) { atomicAdd(&bar[XB_TMO], 1u); break; } }
    }
    nloc = mine > 0u ? mine : 1u; nx = cnt > 0u ? cnt : 1u;
}

__device__ __forceinline__ void xcd_barrier(const XcdBarrier& b) {
    asm volatile("s_waitcnt vmcnt(0)" ::: "memory");
    __syncthreads();
    if (threadIdx.x == 0) {
        unsigned* bar = b.bar;
        __builtin_amdgcn_s_waitcnt(0);
        unsigned nloc = b.st[0], nx = b.st[1];
        if (nloc == 0u) { xcd_barrier_complete(bar, b.x, nloc, nx); b.st[0] = nloc; b.st[1] = nx; }
        const unsigned old = xb_add(&bar[XB_XSUB(b.x)], 1u);
        const unsigned gen = old / nloc;
        if (old + 1u == (gen + 1u) * nloc) {
            __builtin_amdgcn_fence(__ATOMIC_RELEASE, "agent");
            asm volatile("s_waitcnt vmcnt(0)" ::: "memory");
            const unsigned og = xb_add(&bar[XB_TOP], 1u);
            const unsigned tg = og / nx;
            if (og + 1u == (tg + 1u) * nx) xb_add(&bar[XB_TOPGEN], 1u);
            else XB_SPIN(xb_ld(&bar[XB_TOPGEN]) == tg, bar);
            __builtin_amdgcn_fence(__ATOMIC_ACQUIRE, "agent");
            xb_add(&bar[XB_XGEN(b.x)], 1u);
            asm volatile("s_waitcnt vmcnt(0)" ::: "memory");
        } else {
            XB_SPIN(xb_ld(&bar[XB_XGEN(b.x)]) == gen, bar);
            __builtin_amdgcn_fence(__ATOMIC_ACQUIRE, "agent");
            asm volatile("s_waitcnt vmcnt(0)" ::: "memory");
        }
    }
    __syncthreads();
}

struct Params { const float* in[28]; float* out; unsigned char* ws; };
enum { I_X = 0, I_MEM, I_NORM_MIX, I_W_IN, I_CONV, I_GATE_B, I_MLSTM_NORM, I_ATTN_QKN, I_GMLP_NORM, I_GMLP_WS, I_GMLP_BS, I_WBA, I_WBB, I_WBC, I_WOUT, I_REL_BIAS,
       I_NORM_XATTN, I_NORM_MEM, I_WXQ, I_WXKV, I_XATTN_QKN, I_WXO, I_NORM_FFN, I_ROUTER_W, I_ROUTER_B, I_EG, I_EU, I_ED };

struct Ctx {
    LAS unsigned char* lds;
    unsigned char* ws;
    int tid, lane, wave, vcu, G, bx;
};
template <class T> __device__ __forceinline__ T* wsp(const Ctx& c, size_t off) { return (T*)(c.ws + off); }

__device__ const unsigned char REL_BUCKET[3][132] = {
  {0,1,2,3,4,5,6,7,8,9,10,11,12,13,14,15,16,16,16,16,16,16,17,17,17,17,17,17,17,17,18,18,18,18,18,18,18,18,18,18,19,19,19,19,19,19,19,19,19,19,19,19,19,19,20,20,20,20,20,20,20,20,20,20,20,20,20,20,20,20,20,20,20,21,21,21,21,21,21,21,21,21,21,21,21,21,21,21,21,21,21,21,21,21,21,21,21,21,21,22,22,22,22,22,22,22,22,22,22,22,22,22,22,22,22,22,22,22,22,22,22,22,22,22,22,22,22,22,22,0,0,0},
  {0,4,8,12,16,16,17,17,18,18,19,19,19,19,20,20,20,20,20,21,21,21,21,21,21,22,22,22,22,22,22,22,22,22,23,23,23,23,23,23,23,23,23,23,23,23,24,24,24,24,24,24,24,24,24,24,24,24,24,24,24,24,25,25,25,25,25,25,25,25,25,25,25,25,25,25,25,25,25,25,25,25,25,26,26,26,26,26,26,26,26,26,26,26,26,26,26,26,26,26,26,26,26,26,26,26,26,26,26,26,26,26,26,27,27,27,27,27,27,27,27,27,27,27,27,27,27,27,27,0,0,0},
  {0,16,18,19,20,21,21,22,22,23,23,23,24,24,24,24,25,25,25,25,25,26,26,26,26,26,26,26,26,27,27,27,27,27,27,27,27,27,27,28,28,28,28,28,28,28,28,28,28,28,28,28,29,29,29,29,29,29,29,29,29,29,29,29,29,29,29,29,29,29,30,30,30,30,30,30,30,30,30,30,30,30,30,30,30,30,30,30,30,30,30,30,30,30,30,31,31,31,31,31,31,31,31,31,31,31,31,31,31,31,31,31,31,31,31,31,31,31,31,31,31,31,31,31,31,31,31,31,31,0,0,0}};

template <class RowMap>
__device__ __forceinline__ void tr_item(const float* W, int ldw, int c0, const float* gain, bf16* WT, int K, LAS float* scr, int kb, int nb, int lane, RowMap rm) {
    const int k0 = 64 * kb, n0 = 64 * nb, lr = lane >> 4, lc = 4 * (lane & 15);
    f32x4 v[16];
#pragma unroll
    for (int i = 0; i < 16; ++i) v[i] = *(const f32x4*)(W + (size_t)(k0 + 4 * i + lr) * ldw + c0 + n0 + lc);
#pragma unroll
    for (int i = 0; i < 16; ++i) { const int kk = 4 * i + lr; const float gg = gain ? gain[k0 + kk] : 1.f; LAS float* s = scr + kk * 65 + lc; s[0] = v[i].x * gg; s[1] = v[i].y * gg; s[2] = v[i].z * gg; s[3] = v[i].w * gg; }
    LDS_WAIT(); asm volatile("" ::: "memory");
    const int c = lane & 7;
#pragma unroll
    for (int j = 0; j < 8; ++j) { const int n = (lane >> 3) + 8 * j; const LAS float* s = scr + (8 * c) * 65 + n;
        u32x4 o; o.x = pk2(s[0 * 65], s[1 * 65]); o.y = pk2(s[2 * 65], s[3 * 65]); o.z = pk2(s[4 * 65], s[5 * 65]); o.w = pk2(s[6 * 65], s[7 * 65]);
        *(u32x4*)(WT + (size_t)rm(n0 + n) * K + k0 + 8 * c) = o; }
    LDS_WAIT(); asm volatile("" ::: "memory");
}
struct RmId { int off; __device__ __forceinline__ int operator()(int n) const { return off + n; } };
struct RmGate { __device__ __forceinline__ int operator()(int n) const { return (n >> 7) * 256 + (n & 127); } };
struct RmUp { __device__ __forceinline__ int operator()(int n) const { return (n >> 7) * 256 + 128 + (n & 127); } };

__device__ __forceinline__ void phase_weights(const Ctx& c, const Params& p, int l) {
    LAS float* scr = (LAS float*)(c.lds + c.wave * 16640);
    const int gw = c.vcu * 8 + c.wave, NGW = c.G * 8;
    const float* w_in = p.in[I_W_IN] + (size_t)l * D * NIN;
    constexpr int N1 = 16 * 32, N2 = 16 * 52, N3 = 16 * 48, N4 = 8 * 16, N5 = 12 * 16, N6 = 8 * 16, N7 = 16 * 16, N8 = 16 * 8, N9 = 16 * 16, N10 = 8 * 16, NE = 16 * 8, NDN = 8 * 16;
    constexpr int NITEMS = N1 + N2 + N3 + N4 + N5 + N6 + N7 + N8 + N9 + N10 + 16 * NE * 2 + 16 * NDN;
    for (int it = gw; it < NITEMS; it += NGW) {
        int r = it;
        if (r < N1) { tr_item(w_in, NIN, 0, p.in[I_NORM_MIX] + l * D, wsp<bf16>(c, OFF_WIN1), D, scr, r / 32, r % 32, c.lane, RmId{0}); continue; } r -= N1;
        if (r < N2) { tr_item(w_in, NIN, 2056, p.in[I_NORM_MIX] + l * D, wsp<bf16>(c, OFF_WIN1), D, scr, r / 52, r % 52, c.lane, RmId{2048}); continue; } r -= N2;
        if (r < N3) { tr_item(w_in, NIN, 5384, p.in[I_NORM_MIX] + l * D, wsp<bf16>(c, OFF_WG), D, scr, r / 48, r % 48, c.lane, RmId{0}); continue; } r -= N3;
        if (r < N4) { tr_item(p.in[I_WBA] + (size_t)l * 512 * 1024, 1024, 0, nullptr, wsp<bf16>(c, OFF_WA), 512, scr, r / 16, r % 16, c.lane, RmId{0}); continue; } r -= N4;
        if (r < N5) { tr_item(p.in[I_WBB] + (size_t)l * 768 * 1024, 1024, 0, nullptr, wsp<bf16>(c, OFF_WB), 768, scr, r / 16, r % 16, c.lane, RmId{0}); continue; } r -= N5;
        if (r < N6) { tr_item(p.in[I_WBC] + (size_t)l * 512 * 1024, 1024, 0, nullptr, wsp<bf16>(c, OFF_WC), 512, scr, r / 16, r % 16, c.lane, RmId{0}); continue; } r -= N6;
        if (r < N7) { tr_item(p.in[I_WOUT] + (size_t)l * 1024 * 1024, 1024, 0, nullptr, wsp<bf16>(c, OFF_WOUT), 1024, scr, r / 16, r % 16, c.lane, RmId{0}); continue; } r -= N7;
        if (r < N8) { tr_item(p.in[I_WXQ] + (size_t)l * 1024 * 512, 512, 0, p.in[I_NORM_XATTN] + l * D, wsp<bf16>(c, OFF_WXQ), 1024, scr, r / 8, r % 8, c.lane, RmId{0}); continue; } r -= N8;
        if (r < N9) { tr_item(p.in[I_WXKV] + (size_t)l * 1024 * 1024, 1024, 0, p.in[I_NORM_MEM] + l * D, wsp<bf16>(c, OFF_WXKV), 1024, scr, r / 16, r % 16, c.lane, RmId{0}); continue; } r -= N9;
        if (r < N10) { tr_item(p.in[I_WXO] + (size_t)l * 512 * 1024, 1024, 0, nullptr, wsp<bf16>(c, OFF_WXO), 512, scr, r / 16, r % 16, c.lane, RmId{0}); continue; } r -= N10;
        if (r < 16 * NE) { const int e = r / NE, rr = r % NE; tr_item(p.in[I_EG] + ((size_t)l * 16 + e) * 1024 * 512, 512, 0, p.in[I_NORM_FFN] + l * D, wsp<bf16>(c, OFF_WGU) + (size_t)e * 1024 * 1024, 1024, scr, rr / 8, rr % 8, c.lane, RmGate{}); continue; } r -= 16 * NE;
        if (r < 16 * NE) { const int e = r / NE, rr = r % NE; tr_item(p.in[I_EU] + ((size_t)l * 16 + e) * 1024 * 512, 512, 0, p.in[I_NORM_FFN] + l * D, wsp<bf16>(c, OFF_WGU) + (size_t)e * 1024 * 1024, 1024, scr, rr / 8, rr % 8, c.lane, RmUp{}); continue; } r -= 16 * NE;
        { const int e = r / NDN, rr = r % NDN; tr_item(p.in[I_ED] + ((size_t)l * 16 + e) * 512 * 1024, 1024, 0, nullptr, wsp<bf16>(c, OFF_WD) + (size_t)e * 1024 * 512, 512, scr, rr / 16, rr % 16, c.lane, RmId{0}); }
    }
}

__device__ __forceinline__ void row_norm_store(f32x4 (&v)[4], bf16* xbrow, int lane) {
    float s = 0.f;
#pragma unroll
    for (int j = 0; j < 4; ++j) s += (v[j].x * v[j].x + v[j].y * v[j].y) + (v[j].z * v[j].z + v[j].w * v[j].w);
    const float rs = 1.f / sqrtf(wave_sum(s) * (1.f / D) + EPS);
    unsigned long long* o8 = (unsigned long long*)xbrow + lane;
#pragma unroll
    for (int j = 0; j < 4; ++j) { v[j] = v[j] * rs; o8[64 * j] = (unsigned long long)pk2(v[j].x, v[j].y) | ((unsigned long long)pk2(v[j].z, v[j].w) << 32); }
}
__device__ __forceinline__ void row_gates(const f32x4 (&v)[4], const LAS float* W8t, const float* gate_b, float* gates_row, int lane) {
    float a[8];
#pragma unroll
    for (int q = 0; q < 8; ++q) { float s = 0.f;
#pragma unroll
        for (int j = 0; j < 4; ++j) { const f32x4 w = *(const LAS f32x4*)(W8t + q * 1024 + 256 * j + 4 * lane); s += (v[j].x * w.x + v[j].y * w.y) + (v[j].z * w.z + v[j].w * w.w); }
        a[q] = wave_sum(s); if ((q & 3) == 3) __builtin_amdgcn_sched_barrier(0); }
    if (lane == 0) {
#pragma unroll
        for (int q = 0; q < 8; ++q) gates_row[q] = a[q] + gate_b[q]; }
}
__device__ __forceinline__ void load_w8(const Ctx& c, const Params& p, int l) {
    LAS float* W8t = (LAS float*)c.lds; const float* w_in = p.in[I_W_IN] + (size_t)l * D * NIN; const float* g = p.in[I_NORM_MIX] + l * D;
    for (int idx = c.tid; idx < D * 8; idx += 512) { const int k = idx >> 3, q = idx & 7; W8t[q * 1024 + k] = w_in[(size_t)k * NIN + 2048 + q] * g[k]; }
    __syncthreads();
}
__device__ __forceinline__ void phase_rp0_input(const Ctx& c, const Params& p) {
    load_w8(c, p, 0);
    const int gw = c.vcu * 8 + c.wave, NGW = c.G * 8;
    const float* x = p.in[I_X];
    for (int m = gw; m < M; m += NGW) {
        f32x4 v[4]; const f32x4* xr = (const f32x4*)(x + (size_t)m * D) + c.lane;
#pragma unroll
        for (int j = 0; j < 4; ++j) v[j] = xr[64 * j];
        row_norm_store(v, wsp<bf16>(c, WS_XB) + (size_t)m * D, c.lane);
        row_gates(v, (const LAS float*)c.lds, p.in[I_GATE_B], wsp<float>(c, OFF_GATES) + (size_t)m * 8, c.lane);
    }
    const float* mem = p.in[I_MEM];
    for (int m = gw; m < MM; m += NGW) {
        f32x4 v[4]; const f32x4* xr = (const f32x4*)(mem + (size_t)m * D) + c.lane;
#pragma unroll
        for (int j = 0; j < 4; ++j) v[j] = xr[64 * j];
        row_norm_store(v, wsp<bf16>(c, OFF_MEMB) + (size_t)m * D, c.lane);
    }
    if (c.bx == 0) { float* bt = wsp<float>(c, OFF_BIAS); const float* rb = p.in[I_REL_BIAS];
        for (int idx = c.tid; idx < 12 * 132; idx += 512) { const int h = idx / 132, dist = idx % 132; bt[idx] = rb[(int)REL_BUCKET[h >> 2][dist] * 12 + h]; } }
}
__device__ __forceinline__ void phase_rp1(const Ctx& c, const float* X) {
    const int gw = c.vcu * 8 + c.wave, NGW = c.G * 8;
    for (int m = gw; m < M; m += NGW) {
        f32x4 v[4]; const f32x4* xr = (const f32x4*)(X + (size_t)m * D) + c.lane;
#pragma unroll
        for (int j = 0; j < 4; ++j) v[j] = xr[64 * j];
        row_norm_store(v, wsp<bf16>(c, WS_XB) + (size_t)m * D, c.lane);
    }
}
__device__ __forceinline__ void phase_rp2_route(const Ctx& c, const Params& p, int l, const float* X) {
    LAS float* RWt = (LAS float*)c.lds;
    { const float* rw = p.in[I_ROUTER_W]; const float* g = p.in[I_NORM_FFN] + l * D;
      for (int idx = c.tid; idx < D * 16; idx += 512) RWt[(idx & 15) * 1024 + (idx >> 4)] = rw[idx] * g[idx >> 4];
      __syncthreads(); }
    const int gw = c.vcu * 8 + c.wave, NGW = c.G * 8;
    LAS unsigned* lcnt = (LAS unsigned*)(c.lds + LDS_TAB);
    if (c.tid < 16) lcnt[c.tid] = 0u;
    __syncthreads();
    const float* rbias = p.in[I_ROUTER_B];
    for (int m = gw; m < M; m += NGW) {
        f32x4 v[4]; const f32x4* xr = (const f32x4*)(X + (size_t)m * D) + c.lane;
#pragma unroll
        for (int j = 0; j < 4; ++j) v[j] = xr[64 * j];
        row_norm_store(v, wsp<bf16>(c, WS_XB) + (size_t)m * D, c.lane);
        float a[16];
#pragma unroll
        for (int q = 0; q < 16; ++q) { float s = 0.f;
#pragma unroll
            for (int j = 0; j < 4; ++j) { const f32x4 w = *(const LAS f32x4*)(RWt + q * 1024 + 256 * j + 4 * c.lane); s += (v[j].x * w.x + v[j].y * w.y) + (v[j].z * w.z + v[j].w * w.w); }
            a[q] = s; if ((q & 3) == 3) __builtin_amdgcn_sched_barrier(0); }
        float mx = -3.0e38f;
#pragma unroll
        for (int q = 0; q < 16; ++q) { a[q] = wave_sum(a[q]) + rbias[q]; mx = fmaxf(mx, a[q]); }
#pragma unroll
        for (int q = 0; q < 16; ++q) a[q] = __expf(a[q] - mx);
        float bs = -1.f, p1 = 0.f, p2 = 0.f; int e1 = 0, e2 = 1;
#pragma unroll
        for (int g = 0; g < 4; ++g) {
            const float q0 = a[4 * g], q1 = a[4 * g + 1], q2 = a[4 * g + 2], q3 = a[4 * g + 3];
            int i1 = 0; float m1 = q0; if (q1 > m1) { m1 = q1; i1 = 1; } if (q2 > m1) { m1 = q2; i1 = 2; } if (q3 > m1) { m1 = q3; i1 = 3; }
            int i2 = -1; float m2 = -1.f;
            if (i1 != 0 && q0 > m2) { m2 = q0; i2 = 0; } if (i1 != 1 && q1 > m2) { m2 = q1; i2 = 1; } if (i1 != 2 && q2 > m2) { m2 = q2; i2 = 2; } if (i1 != 3 && q3 > m2) { m2 = q3; i2 = 3; }
            const float sc = m1 + m2;
            if (sc > bs) { bs = sc; e1 = 4 * g + i1; e2 = 4 * g + i2; p1 = m1; p2 = m2; }
        }
        if (c.lane == 0) {
            const float inv = 1.f / (p1 + p2);
            const unsigned pos1 = __hip_atomic_fetch_add(lcnt + e1, 1u, __ATOMIC_RELAXED, __HIP_MEMORY_SCOPE_WORKGROUP), pos2 = __hip_atomic_fetch_add(lcnt + e2, 1u, __ATOMIC_RELAXED, __HIP_MEMORY_SCOPE_WORKGROUP);
            int* te = wsp<int>(c, OFF_TOKE) + 2 * m; int* tp = wsp<int>(c, OFF_TOKP) + 2 * m; float* tw = wsp<float>(c, OFF_TOKW) + 2 * m;
            te[0] = e1; te[1] = e2; tp[0] = (int)pos1; tp[1] = (int)pos2; tw[0] = p1 * inv; tw[1] = p2 * inv;
        }
    }
    __syncthreads();
    if (c.tid < 16) wsp<unsigned>(c, OFF_CNTW)[c.vcu * 16 + c.tid] = lcnt[c.tid];
}
template <bool WITH_OFF>
__device__ __forceinline__ void moe_tables(const Ctx& c) {
    LAS int* tab = (LAS int*)(c.lds + LDS_TAB); LAS int* woff = (LAS int*)(c.lds + LDS_WOFF); LAS int* tot = tab + 180;
    const unsigned* cw = wsp<unsigned>(c, OFF_CNTW);
    if (c.tid < 16) { int s = 0;
#pragma unroll 8
        for (int v = 0; v < c.G; ++v) { if (WITH_OFF) woff[v * 16 + c.tid] = s; s += (int)cw[v * 16 + c.tid]; }
        tot[c.tid] = s; }
    __syncthreads();
    if (c.tid == 0) { int t = 0;
        for (int e = 0; e < 16; ++e) { const int nt = (tot[e] + 255) >> 8; tab[160 + e] = t * 256; for (int i = 0; i < nt && t < MAXT; ++i) tab[t++] = e; }
        tab[176] = t; }
    __syncthreads();
}
__device__ __forceinline__ void phase_gather(const Ctx& c, int l) {
    moe_tables<true>(c);
    const LAS int* tab = (const LAS int*)(c.lds + LDS_TAB); const LAS int* woff = (const LAS int*)(c.lds + LDS_WOFF);
    const int gw = c.vcu * 8 + c.wave, NGW = c.G * 8;
    const int* te = wsp<int>(c, OFF_TOKE); const int* tp = wsp<int>(c, OFF_TOKP); const float* tw = wsp<float>(c, OFF_TOKW);
    int* slot = wsp<int>(c, OFF_SLOT); float* wrow = wsp<float>(c, OFF_WROW);
    const bf16* XB = wsp<bf16>(c, WS_XB); bf16* XG = wsp<bf16>(c, OFF_XG);
    for (int it0 = gw * 4; it0 < 2 * M; it0 += NGW * 4) {
        int s[4]; u32x4 r0[4], r1[4];
#pragma unroll
        for (int a = 0; a < 4; ++a) { const int it = it0 + a; const int e = te[it], m_ = it >> 1; s[a] = tab[160 + e] + woff[((m_ % (c.G * 8)) >> 3) * 16 + e] + tp[it];     const u32x4* src = (const u32x4*)(XB + (size_t)(it >> 1) * D) + c.lane; r0[a] = src[0]; r1[a] = src[64]; }
#pragma unroll
        for (int a = 0; a < 4; ++a) { const int it = it0 + a; u32x4* dst = (u32x4*)(XG + (size_t)s[a] * D) + c.lane; dst[0] = r0[a]; dst[64] = r1[a];
            if (c.lane == 0) { slot[it] = s[a]; wrow[s[a]] = tw[it]; } }
    }
}
template <bool NEXT>
__device__ __forceinline__ void phase_combine(const Ctx& c, const Params& p, int l, const float* Xsrc, float* Xdst) {
    if (NEXT) load_w8(c, p, l + 1);
    const int gw = c.vcu * 8 + c.wave, NGW = c.G * 8;
    const int* slot = wsp<int>(c, OFF_SLOT); const bf16* YE = wsp<bf16>(c, OFF_XG);
    for (int m = gw; m < M; m += NGW) {
        const int s0 = slot[2 * m], s1 = slot[2 * m + 1];
        f32x4 v[4]; const f32x4* xr = (const f32x4*)(Xsrc + (size_t)m * D) + c.lane;
        const u32x2* y0 = (const u32x2*)(YE + (size_t)s0 * D) + c.lane; const u32x2* y1 = (const u32x2*)(YE + (size_t)s1 * D) + c.lane;
#pragma unroll
        for (int j = 0; j < 4; ++j) { const u32x2 a = y0[64 * j], b = y1[64 * j]; v[j] = xr[64 * j];
            v[j].x = (v[j].x + bflo(a.x)) + bflo(b.x); v[j].y = (v[j].y + bfhi(a.x)) + bfhi(b.x); v[j].z = (v[j].z + bflo(a.y)) + bflo(b.y); v[j].w = (v[j].w + bfhi(a.y)) + bfhi(b.y); }
        f32x4* xo = (f32x4*)(Xdst + (size_t)m * D) + c.lane;
#pragma unroll
        for (int j = 0; j < 4; ++j) xo[64 * j] = v[j];
        if (NEXT) {
            row_norm_store(v, wsp<bf16>(c, WS_XB) + (size_t)m * D, c.lane);
            row_gates(v, (const LAS float*)c.lds, p.in[I_GATE_B] + 8 * (l + 1), wsp<float>(c, OFF_GATES) + (size_t)m * 8, c.lane);
        }
    }
}
__device__ __forceinline__ void gate_scan(const Ctx& c, int bh) {
    const int b = bh >> 2, h = bh & 3, tid = c.tid, lane = c.lane, w = c.wave;
    LAS float* ws_ = (LAS float*)c.lds;
    const float* G = wsp<float>(c, OFF_GATES) + ((size_t)b * SEQ + 8 * tid) * 8;
    float* Aa = wsp<float>(c, OFF_AMA) + bh * SEQ + 8 * tid; float* Am = wsp<float>(c, OFF_AMM) + bh * SEQ + 8 * tid; float* Ab = wsp<float>(c, OFF_AMB) + bh * SEQ + 8 * tid;
    float lf[8], ip[8];
#pragma unroll
    for (int i = 0; i < 8; ++i) { const float f = G[i * 8 + 4 + h]; ip[i] = G[i * 8 + h]; lf[i] = fminf(f, 0.f) - log1pf(__expf(-fabsf(f))); }
    float s = 0.f;
#pragma unroll
    for (int i = 0; i < 8; ++i) { s += lf[i]; lf[i] = s; }
    float incl = s;
#pragma unroll
    for (int o = 1; o < 64; o <<= 1) { const float t = __shfl_up(incl, o); if (lane >= o) incl += t; }
    if (lane == 63) ws_[w] = incl;
    __syncthreads();
    float base = incl - s;
    for (int ww = 0; ww < w; ++ww) base += ws_[ww];
    float av[8], mxl = -3.0e38f;
#pragma unroll
    for (int i = 0; i < 8; ++i) { const float Bc = base + lf[i]; lf[i] = Bc; av[i] = ip[i] - Bc; mxl = fmaxf(mxl, av[i]); }
    float inm = mxl;
#pragma unroll
    for (int o = 1; o < 64; o <<= 1) { const float t = __shfl_up(inm, o); if (lane >= o) inm = fmaxf(inm, t); }
    if (lane == 63) ws_[8 + w] = inm;
    __syncthreads();
    float run = __shfl_up(inm, 1); if (lane == 0) run = 0.f;
    run = fmaxf(run, 0.f);
    for (int ww = 0; ww < w; ++ww) run = fmaxf(run, ws_[8 + ww]);
    float mv[8];
#pragma unroll
    for (int i = 0; i < 8; ++i) { run = fmaxf(run, av[i]); mv[i] = run; }
    *(f32x4*)(Aa) = (f32x4){av[0], av[1], av[2], av[3]}; *(f32x4*)(Aa + 4) = (f32x4){av[4], av[5], av[6], av[7]};
    *(f32x4*)(Am) = (f32x4){mv[0], mv[1], mv[2], mv[3]}; *(f32x4*)(Am + 4) = (f32x4){mv[4], mv[5], mv[6], mv[7]};
    *(f32x4*)(Ab) = (f32x4){lf[0], lf[1], lf[2], lf[3]}; *(f32x4*)(Ab + 4) = (f32x4){lf[4], lf[5], lf[6], lf[7]};
    __syncthreads();
}

typedef short s16x4 __attribute__((ext_vector_type(4)));
__device__ __forceinline__ s16x4 ds_tr(const LAS bf16* p) { return __builtin_bit_cast(s16x4, __builtin_amdgcn_ds_read_tr16_b64_v4i16((LAS s16x4*)p)); }
__device__ __forceinline__ bf16x8 cat4(const s16x4 lo, const s16x4 hi) { return (bf16x8){lo[0], lo[1], lo[2], lo[3], hi[0], hi[1], hi[2], hi[3]}; }
__device__ __forceinline__ bf16x8 ldsA(const LAS bf16* p) { return *(const LAS bf16x8*)p; }
__device__ __forceinline__ bf16x8 pk8f(const f32x4 a, const f32x4 b) { u32x4 w; w.x = pk2(a[0], a[1]); w.y = pk2(a[2], a[3]); w.z = pk2(b[0], b[1]); w.w = pk2(b[2], b[3]); return __builtin_bit_cast(bf16x8, w); }
#define MFMA16(a, b, c) __builtin_amdgcn_mfma_f32_16x16x32_bf16((a), (b), (c), 0, 0, 0)
__device__ __forceinline__ float red4g_sum(float v) { v += __shfl_xor(v, 16); v += __shfl_xor(v, 32); return v; }
__device__ __forceinline__ float red4g_max(float v) { v = fmaxf(v, __shfl_xor(v, 16)); v = fmaxf(v, __shfl_xor(v, 32)); return v; }
__device__ __forceinline__ float red16_sum(float v) { v += __shfl_xor(v, 1); v += __shfl_xor(v, 2); v += __shfl_xor(v, 4); v += __shfl_xor(v, 8); return v; }
constexpr f32x4 Z4 = {0.f, 0.f, 0.f, 0.f};

constexpr int LS = 136;
constexpr int QS = 72;

__device__ __forceinline__ void conv4_silu(const u32x4 (&x)[7], const float* cw, float (&o)[4][8]) {
    float w[4][8];
#pragma unroll
    for (int jj = 0; jj < 4; ++jj) { const f32x4 w0 = *(const f32x4*)(cw + jj * 1024), w1 = *(const f32x4*)(cw + jj * 1024 + 4);
        w[jj][0] = w0.x; w[jj][1] = w0.y; w[jj][2] = w0.z; w[jj][3] = w0.w; w[jj][4] = w1.x; w[jj][5] = w1.y; w[jj][6] = w1.z; w[jj][7] = w1.w; }
    float xf[7][8];
#pragma unroll
    for (int a = 0; a < 7; ++a) unpack8(x[a], xf[a]);
#pragma unroll
    for (int rr = 0; rr < 4; ++rr)
#pragma unroll
        for (int e = 0; e < 8; ++e) { const float s = (w[0][e] * xf[rr][e] + w[1][e] * xf[rr + 1][e]) + (w[2][e] * xf[rr + 2][e] + w[3][e] * xf[rr + 3][e]); o[rr][e] = siluf_(s); }
}
__device__ __forceinline__ void load7(const bf16* colp, int t0, u32x4 (&x)[7]) {
#pragma unroll
    for (int a = 0; a < 7; ++a) { const int t = t0 - 3 + a; x[a] = (t >= 0) ? *(const u32x4*)(colp + (size_t)t * PP) : (u32x4){0u, 0u, 0u, 0u}; }
}

__device__ __forceinline__ void mlstm_delta_unit(const Ctx& c, const Params& p, int l, int bh, int j) {
    const int b = bh >> 2, h = bh & 3, tid = c.tid, lane = c.lane, w = c.wave, r16 = lane & 15, g = lane >> 4;
    LAS bf16* vv = (LAS bf16*)c.lds; LAS bf16* kw = vv + 128 * LS;
    const bf16* projb = wsp<bf16>(c, WS_PROJ) + (size_t)b * SEQ * PP;
    const float* Aa = wsp<float>(c, OFF_AMA) + bh * SEQ + LCH * j; const float Mend = wsp<float>(c, OFF_AMM)[bh * SEQ + LCH * j + LCH - 1];
    {
        const int rg = tid >> 4, c8 = (tid & 15) * 8, t0 = LCH * j + 4 * rg;
        u32x4 xk[7], xv[4];
        load7(projb + C_MK + h * 128 + c8, t0, xk);
#pragma unroll
        for (int rr = 0; rr < 4; ++rr) xv[rr] = *(const u32x4*)(projb + (size_t)(t0 + rr) * PP + C_MV + h * 128 + c8);
        const f32x4 a4 = *(const f32x4*)(Aa + 4 * rg);
        float k[4][8]; conv4_silu(xk, p.in[I_CONV] + (size_t)l * 4 * 1024 + 512 + h * 128 + c8, k);
#pragma unroll
        for (int rr = 0; rr < 4; ++rr) { const float wgt = __expf(a4[rr] - Mend) * 0.08838834764831845f;
#pragma unroll
            for (int e = 0; e < 8; ++e) k[rr][e] *= wgt;
            *(LAS u32x4*)(kw + (4 * rg + rr) * LS + c8) = pack8(k[rr]); *(LAS u32x4*)(vv + (4 * rg + rr) * LS + c8) = xv[rr]; }
    }
    __syncthreads();
    f32x4 acc[8];
#pragma unroll
    for (int nt = 0; nt < 8; ++nt) acc[nt] = Z4;
    const LAS bf16* ap = vv + (8 * g + (r16 >> 2)) * LS + 16 * w + 4 * (r16 & 3); const LAS bf16* bp = kw + (8 * g + (r16 >> 2)) * LS + 4 * (r16 & 3);
#pragma unroll
    for (int ks = 0; ks < 4; ++ks) { const bf16x8 a = cat4(ds_tr(ap + 32 * ks * LS), ds_tr(ap + (32 * ks + 4) * LS));
#pragma unroll
        for (int nt = 0; nt < 8; ++nt) { const bf16x8 bb = cat4(ds_tr(bp + 32 * ks * LS + 16 * nt), ds_tr(bp + (32 * ks + 4) * LS + 16 * nt)); acc[nt] = MFMA16(a, bb, acc[nt]); } }
    float* st = wsp<float>(c, WS_T) + (size_t)(bh * NCH + j) * (128 * 128);
#pragma unroll
    for (int nt = 0; nt < 8; ++nt)
#pragma unroll
        for (int i = 0; i < 4; ++i) st[(16 * w + 4 * g + i) * 128 + 16 * nt + r16] = acc[nt][i];
    if (tid < 128) { float s = 0.f;
#pragma unroll 8
        for (int r = 0; r < 128; ++r) s += bf2f(kw[r * LS + tid]);
        wsp<float>(c, OFF_NST)[(bh * NCH + j) * 128 + tid] = s; }
    __syncthreads();
}
__device__ __forceinline__ void mlstm_scan(const Ctx& c) {
    constexpr int EL4 = (128 * 128 + 128) / 4;
    const int gt = c.vcu * 512 + c.tid, NT = c.G * 512;
    for (int idx = gt; idx < 16 * EL4; idx += NT) {
        const int bh = idx / EL4, el = idx % EL4;
        const float* Am = wsp<float>(c, OFF_AMM) + bh * SEQ;
        f32x4* base = el < 4096 ? (f32x4*)(wsp<float>(c, WS_T) + (size_t)bh * NCH * 16384) + el : (f32x4*)(wsp<float>(c, OFF_NST) + bh * NCH * 128) + (el - 4096);
        const int stride = el < 4096 ? 4096 : 32;
        f32x4 cs = {0.f, 0.f, 0.f, 0.f}; float Mprev = 0.f;
#pragma unroll 1
        for (int j0 = 0; j0 < NCH; j0 += 8) {
            f32x4 dl[8]; float gg[8];
#pragma unroll
            for (int a = 0; a < 8; ++a) { dl[a] = base[(size_t)(j0 + a) * stride]; const float Mend = Am[LCH * (j0 + a) + LCH - 1]; gg[a] = __expf(Mprev - Mend); Mprev = Mend; }
#pragma unroll
            for (int a = 0; a < 8; ++a) { cs = cs * gg[a] + dl[a]; base[(size_t)(j0 + a) * stride] = cs; }
        }
    }
}
__device__ __forceinline__ void mlstm_out_unit(const Ctx& c, const Params& p, int l, int bh, int j) {
    const int b = bh >> 2, h = bh & 3, tid = c.tid, lane = c.lane, w = c.wave, r16 = lane & 15, g = lane >> 4;
    LAS bf16* qq = (LAS bf16*)c.lds; LAS bf16* kk = qq + 128 * LS; LAS bf16* vv = kk + 128 * LS; LAS bf16* CTb = vv + 128 * LS;
    LAS float* fa = (LAS float*)(CTb + 144 * LS); LAS float* fM = fa + 128; LAS float* fB = fM + 128;
    bf16* projb = wsp<bf16>(c, WS_PROJ) + (size_t)b * SEQ * PP;
    {
        const int rg = tid >> 4, c8 = (tid & 15) * 8, t0 = LCH * j + 4 * rg;
        u32x4 xq[7], xk[7], xv[4];
        load7(projb + C_MQ + h * 128 + c8, t0, xq); load7(projb + C_MK + h * 128 + c8, t0, xk);
#pragma unroll
        for (int rr = 0; rr < 4; ++rr) xv[rr] = *(const u32x4*)(projb + (size_t)(t0 + rr) * PP + C_MV + h * 128 + c8);
        const int e = tid >> 2, d0 = (tid & 3) * 32;
        f32x4 sv[8];
        if (j > 0) { const f32x4* sp = (const f32x4*)(wsp<float>(c, WS_T) + (size_t)(bh * NCH + j - 1) * 16384 + e * 128 + d0);
#pragma unroll
            for (int a = 0; a < 8; ++a) sv[a] = sp[a]; }
        else {
#pragma unroll
            for (int a = 0; a < 8; ++a) sv[a] = Z4; }
        const float* cwq = p.in[I_CONV] + (size_t)l * 4 * 1024 + h * 128 + c8;
        float o[4][8];
        conv4_silu(xq, cwq, o);
#pragma unroll
        for (int rr = 0; rr < 4; ++rr) *(LAS u32x4*)(qq + (4 * rg + rr) * LS + c8) = pack8(o[rr]);
        conv4_silu(xk, cwq + 512, o);
#pragma unroll
        for (int rr = 0; rr < 4; ++rr) {
#pragma unroll
            for (int e2 = 0; e2 < 8; ++e2) o[rr][e2] *= 0.08838834764831845f;
            *(LAS u32x4*)(kk + (4 * rg + rr) * LS + c8) = pack8(o[rr]); *(LAS u32x4*)(vv + (4 * rg + rr) * LS + c8) = xv[rr]; }
#pragma unroll
        for (int a = 0; a < 4; ++a) *(LAS bf16x8*)(CTb + e * LS + d0 + 8 * a) = pk8f(sv[2 * a], sv[2 * a + 1]);
    }
    if (tid < 256) { const int e = 128 + (tid >> 4), c8 = (tid & 15) * 8; float s8[8];
#pragma unroll
        for (int i = 0; i < 8; ++i) s8[i] = 0.f;
        if (e == 128 && j > 0) { const float* nn = wsp<float>(c, OFF_NST) + (bh * NCH + j - 1) * 128 + c8;
#pragma unroll
            for (int i = 0; i < 8; ++i) s8[i] = nn[i]; }
        *(LAS u32x4*)(CTb + e * LS + c8) = pack8(s8); }
    if (tid < 128) { const int t = bh * SEQ + LCH * j + tid; fa[tid] = wsp<float>(c, OFF_AMA)[t]; fM[tid] = wsp<float>(c, OFF_AMM)[t]; fB[tid] = wsp<float>(c, OFF_AMB)[t]; }
    __syncthreads();
    const float Mprev = j > 0 ? wsp<float>(c, OFF_AMM)[bh * SEQ + LCH * j - 1] : 0.f;
    const int tq = 16 * w + r16;
    f32x4 as[8], ai[9];
#pragma unroll
    for (int a = 0; a < 8; ++a) as[a] = Z4;
#pragma unroll
    for (int a = 0; a < 9; ++a) ai[a] = Z4;
#pragma unroll
    for (int ks = 0; ks < 4; ++ks) { const bf16x8 bq = ldsA(qq + tq * LS + 32 * ks + 8 * g);
#pragma unroll
        for (int mt = 0; mt < 8; ++mt) if (mt <= w) as[mt] = MFMA16(ldsA(kk + (16 * mt + r16) * LS + 32 * ks + 8 * g), bq, as[mt]);
#pragma unroll
        for (int et = 0; et < 9; ++et) ai[et] = MFMA16(ldsA(CTb + (16 * et + r16) * LS + 32 * ks + 8 * g), bq, ai[et]);
        __builtin_amdgcn_sched_barrier(0); }
    const float Mt = fM[tq], winter = __expf(Mprev - Mt);
    float den = 0.f;
#pragma unroll
    for (int mt = 0; mt < 8; ++mt)
#pragma unroll
        for (int i = 0; i < 4; ++i) { const int r = 16 * mt + 4 * g + i; const float wg = (mt <= w && r <= tq) ? __expf(fa[r] - Mt) : 0.f; const float sw = as[mt][i] * wg; as[mt][i] = sw; den += sw; }
    den = red4g_sum(den);
    const float dinter = __shfl(ai[8][0], r16);
    const float dd = den + winter * dinter;
    const float dn = fmaxf(fabsf(dd), __expf(-(fB[tq] + Mt)));
    f32x4 ao[8];
#pragma unroll
    for (int et = 0; et < 8; ++et) ao[et] = ai[et] * winter;
    const LAS bf16* vp = vv + (4 * g + (r16 >> 2)) * LS + 4 * (r16 & 3);
#pragma unroll
    for (int ks = 0; ks < 4; ++ks) if (2 * ks <= w) { const bf16x8 bp = pk8f(as[2 * ks], as[2 * ks + 1]);
#pragma unroll
        for (int et = 0; et < 8; ++et) ao[et] = MFMA16(cat4(ds_tr(vp + 32 * ks * LS + 16 * et), ds_tr(vp + (32 * ks + 16) * LS + 16 * et)), bp, ao[et]);
        __builtin_amdgcn_sched_barrier(0); }
    const float inv = 1.f / dn; float ss = 0.f;
#pragma unroll
    for (int et = 0; et < 8; ++et) { ao[et] = ao[et] * inv; ss += (ao[et][0] * ao[et][0] + ao[et][1] * ao[et][1]) + (ao[et][2] * ao[et][2] + ao[et][3] * ao[et][3]); }
    ss = red4g_sum(ss); const float rs = 1.f / sqrtf(ss * (1.f / 128.f) + EPS);
    const float* gain = p.in[I_MLSTM_NORM] + l * 512 + h * 128; const bf16* mrow = projb + (size_t)(LCH * j + tq) * PP + C_MO + h * 128;
    bf16* orow = wsp<bf16>(c, WS_YA) + ((size_t)b * SEQ + LCH * j + tq) * 512 + h * 128;
#pragma unroll
    for (int et = 0; et < 8; ++et) { const int e0 = 16 * et + 4 * g; const u32x2 mo = *(const u32x2*)(mrow + e0); const f32x4 gn = *(const f32x4*)(gain + e0);
        u32x2 o; o.x = pk2(ao[et][0] * rs * gn[0] * sigmoidf_(bflo(mo.x)), ao[et][1] * rs * gn[1] * sigmoidf_(bfhi(mo.x))); o.y = pk2(ao[et][2] * rs * gn[2] * sigmoidf_(bflo(mo.y)), ao[et][3] * rs * gn[3] * sigmoidf_(bfhi(mo.y)));
        *(u32x2*)(orow + e0) = o; }
    __syncthreads();
}

__device__ __forceinline__ void dattn_unit(const Ctx& c, const Params& p, int l, int b, int h, int blk) {
    const int tid = c.tid, lane = c.lane, w = c.wave, r16 = lane & 15, g = lane >> 4;
    const int grp = h >> 2, dil = grp == 0 ? 1 : (grp == 1 ? 4 : 16), nb = 32 / dil, res = blk / nb, n = blk % nb;
    LAS bf16* kn = (LAS bf16*)c.lds; LAS bf16* vv = kn + 256 * QS; LAS float* bias = (LAS float*)(vv + 272 * QS);
    bf16* projb = wsp<bf16>(c, WS_PROJ) + (size_t)b * SEQ * PP;
    const float* gq = p.in[I_ATTN_QKN] + l * 128; const float* gk = gq + 64;
    {
        const int c8 = (tid & 7) * 8; u32x4 xk[4], xv[4];
#pragma unroll
        for (int a = 0; a < 4; ++a) { const int ki = (tid >> 3) + 64 * a, s = 128 * (n - 1) + ki;
            if (s >= 0) { const size_t pos = (size_t)(s * dil + res); xk[a] = *(const u32x4*)(projb + pos * PP + C_AK + h * 64 + c8); xv[a] = *(const u32x4*)(projb + pos * PP + C_AV + h * 64 + c8); }
            else { xk[a] = (u32x4){0u, 0u, 0u, 0u}; xv[a] = (u32x4){0u, 0u, 0u, 0u}; } }
        const f32x4 g0 = *(const f32x4*)(gk + c8), g1 = *(const f32x4*)(gk + c8 + 4);
#pragma unroll
        for (int a = 0; a < 4; ++a) { const int ki = (tid >> 3) + 64 * a; float x[8]; unpack8(xk[a], x);
            float ss = 0.f;
#pragma unroll
            for (int e = 0; e < 8; ++e) ss += x[e] * x[e];
            ss += __shfl_xor(ss, 1); ss += __shfl_xor(ss, 2); ss += __shfl_xor(ss, 4);
            const float rs = 1.f / sqrtf(ss * (1.f / 64.f) + EPS);
            x[0] *= rs * g0.x; x[1] *= rs * g0.y; x[2] *= rs * g0.z; x[3] *= rs * g0.w; x[4] *= rs * g1.x; x[5] *= rs * g1.y; x[6] *= rs * g1.z; x[7] *= rs * g1.w;
            *(LAS u32x4*)(kn + ki * QS + c8) = pack8(x); *(LAS u32x4*)(vv + ki * QS + c8) = xv[a]; }
        if (tid < 144) *(LAS u32x4*)(vv + 256 * QS + tid * 8) = (u32x4){0u, 0u, 0u, 0u};
        if (tid < 132) bias[tid] = wsp<float>(c, OFF_BIAS)[h * 132 + tid];
    }
    const int qi = 16 * w + r16; const size_t qpos = (size_t)((128 * n + qi) * dil + res);
    bf16* qrow = projb + qpos * PP + C_AQ + h * 64;
    bf16x8 bq[2];
    { float x0[8], x1[8]; unpack8(*(const u32x4*)(qrow + 8 * g), x0); unpack8(*(const u32x4*)(qrow + 32 + 8 * g), x1);
      float ss = 0.f;
#pragma unroll
      for (int e = 0; e < 8; ++e) ss += x0[e] * x0[e] + x1[e] * x1[e];
      ss = red4g_sum(ss); const float rs = 0.125f / sqrtf(ss * (1.f / 64.f) + EPS);
#pragma unroll
      for (int e = 0; e < 8; ++e) { x0[e] *= rs * gq[8 * g + e]; x1[e] *= rs * gq[32 + 8 * g + e]; }
      bq[0] = __builtin_bit_cast(bf16x8, pack8(x0)); bq[1] = __builtin_bit_cast(bf16x8, pack8(x1)); }
    __syncthreads();
    const int kb = 16 * w;
    f32x4 acc[10];
#pragma unroll
    for (int mt = 0; mt < 10; ++mt) acc[mt] = Z4;
#pragma unroll
    for (int ks = 0; ks < 2; ++ks)
#pragma unroll
        for (int mt = 0; mt < 9; ++mt) acc[mt] = MFMA16(ldsA(kn + (kb + 16 * mt + r16) * QS + 32 * ks + 8 * g), bq[ks], acc[mt]);
    float mx = -3.0e38f;
#pragma unroll
    for (int mt = 0; mt < 9; ++mt)
#pragma unroll
        for (int i = 0; i < 4; ++i) { const int ki = kb + 16 * mt + 4 * g + i, dist = 128 + qi - ki; const bool ok = dist >= 0 && dist <= 128 && (n > 0 || ki >= 128);
            const float lg = ok ? acc[mt][i] + bias[ok ? dist : 0] : -3.0e38f; acc[mt][i] = lg; mx = fmaxf(mx, lg); }
    mx = red4g_max(mx);
    float lsum = 0.f;
#pragma unroll
    for (int mt = 0; mt < 9; ++mt)
#pragma unroll
        for (int i = 0; i < 4; ++i) { const float lg = acc[mt][i]; const float pe = lg > -1.0e38f ? __expf(lg - mx) : 0.f; lsum += pe; acc[mt][i] = pe; }
    lsum = red4g_sum(lsum);
    f32x4 ao[4];
#pragma unroll
    for (int et = 0; et < 4; ++et) ao[et] = Z4;
    const LAS bf16* vp = vv + (kb + 4 * g + (r16 >> 2)) * QS + 4 * (r16 & 3);
#pragma unroll
    for (int ks = 0; ks < 5; ++ks) { const bf16x8 bp = pk8f(acc[2 * ks], acc[2 * ks + 1]);
#pragma unroll
        for (int et = 0; et < 4; ++et) ao[et] = MFMA16(cat4(ds_tr(vp + 32 * ks * QS + 16 * et), ds_tr(vp + (32 * ks + 16) * QS + 16 * et)), bp, ao[et]); }
    const float inv = 1.f / lsum;
#pragma unroll
    for (int et = 0; et < 4; ++et) { u32x2 o; o.x = pk2(ao[et][0] * inv, ao[et][1] * inv); o.y = pk2(ao[et][2] * inv, ao[et][3] * inv); *(u32x2*)(qrow + 16 * et + 4 * g) = o; }
    if (g == 0) wsp<float>(c, OFF_LSE)[((size_t)b * SEQ + qpos) * 12 + h] = mx + __logf(lsum);
    __syncthreads();
}
__device__ __forceinline__ void dattn_merge(const Ctx& c) {
    const int gt = c.vcu * 512 + c.tid, NT = c.G * 512;
    const float* LSE = wsp<float>(c, OFF_LSE); bf16* proj = wsp<bf16>(c, WS_PROJ);
    for (int it = gt; it < M * 96; it += NT) {
        const int m = it / 96, rr = it % 96, h = rr >> 3, c8 = (rr & 7) * 8, hg = h & 3;
        const float l0 = LSE[(size_t)m * 12 + hg], l1 = LSE[(size_t)m * 12 + 4 + hg], l2 = LSE[(size_t)m * 12 + 8 + hg], lm = LSE[(size_t)m * 12 + h];
        const float mxx = fmaxf(l0, fmaxf(l1, l2)); const float al = __expf(lm - mxx) / (__expf(l0 - mxx) + __expf(l1 - mxx) + __expf(l2 - mxx));
        u32x4* ptr = (u32x4*)(proj + (size_t)m * PP + C_AQ + h * 64 + c8); float x[8]; unpack8(*ptr, x);
#pragma unroll
        for (int e = 0; e < 8; ++e) x[e] *= al;
        *ptr = pack8(x);
    }
}

__device__ __forceinline__ void gmlp_unit(const Ctx& c, const Params& p, int l, int b, int n, int grp) {
    const int tid = c.tid, lane = c.lane, w = c.wave, r16 = lane & 15, g = lane >> 4;
    LAS bf16* Wc = (LAS bf16*)c.lds; LAS bf16* vn = Wc + 128 * LS;
    bf16* projb = wsp<bf16>(c, WS_PROJ) + ((size_t)b * SEQ + 128 * n) * PP;
    const float* ws = p.in[I_GMLP_WS] + ((size_t)l * 4 + grp) * 128 * 128; const float* gain = p.in[I_GMLP_NORM] + l * 512 + grp * 128; const float* bs = p.in[I_GMLP_BS] + (l * 4 + grp) * 128;
    {
        const int c8 = (tid & 15) * 8; u32x4 xv[4]; f32x4 wv[4][2];
#pragma unroll
        for (int a = 0; a < 4; ++a) { const int r = (tid >> 4) + 32 * a; xv[a] = *(const u32x4*)(projb + (size_t)r * PP + C_GV + grp * 128 + c8); wv[a][0] = *(const f32x4*)(ws + r * 128 + c8); wv[a][1] = *(const f32x4*)(ws + r * 128 + c8 + 4); }
        const f32x4 g0 = *(const f32x4*)(gain + c8), g1 = *(const f32x4*)(gain + c8 + 4);
#pragma unroll
        for (int a = 0; a < 4; ++a) { const int r = (tid >> 4) + 32 * a;
            float wf[8] = {wv[a][0].x, wv[a][0].y, wv[a][0].z, wv[a][0].w, wv[a][1].x, wv[a][1].y, wv[a][1].z, wv[a][1].w};
#pragma unroll
            for (int e = 0; e < 8; ++e) if (c8 + e > r) wf[e] = 0.f;
            *(LAS u32x4*)(Wc + r * LS + c8) = pack8(wf);
            float x[8]; unpack8(xv[a], x); float ss = 0.f;
#pragma unroll
            for (int e = 0; e < 8; ++e) { x[e] = gelu_tanh(x[e]); ss += x[e] * x[e]; }
            ss = red16_sum(ss); const float rs = 1.f / sqrtf(ss * (1.f / 128.f) + EPS);
            x[0] *= rs * g0.x; x[1] *= rs * g0.y; x[2] *= rs * g0.z; x[3] *= rs * g0.w; x[4] *= rs * g1.x; x[5] *= rs * g1.y; x[6] *= rs * g1.z; x[7] *= rs * g1.w;
            *(LAS u32x4*)(vn + r * LS + c8) = pack8(x); }
    }
    __syncthreads();
    const int tq = 16 * w + r16;
    f32x4 acc[8];
#pragma unroll
    for (int ct = 0; ct < 8; ++ct) acc[ct] = Z4;
    const LAS bf16* vp = vn + (8 * g + (r16 >> 2)) * LS + 4 * (r16 & 3);
#pragma unroll
    for (int ks = 0; ks < 4; ++ks) if (32 * ks <= 16 * w + 15) { const bf16x8 bw = ldsA(Wc + tq * LS + 32 * ks + 8 * g);
#pragma unroll
        for (int ct = 0; ct < 8; ++ct) acc[ct] = MFMA16(cat4(ds_tr(vp + 32 * ks * LS + 16 * ct), ds_tr(vp + (32 * ks + 4) * LS + 16 * ct)), bw, acc[ct]); }
    const float bb = bs[tq]; const bf16* urow = projb + (size_t)tq * PP + C_GU + grp * 128; bf16* orow = wsp<bf16>(c, WS_YC) + ((size_t)b * SEQ + 128 * n + tq) * 512 + grp * 128;
#pragma unroll
    for (int ct = 0; ct < 8; ++ct) { const int c0 = 16 * ct + 4 * g; const u32x2 u = *(const u32x2*)(urow + c0);
        u32x2 o; o.x = pk2(gelu_tanh(bflo(u.x)) * (acc[ct][0] + bb), gelu_tanh(bfhi(u.x)) * (acc[ct][1] + bb)); o.y = pk2(gelu_tanh(bflo(u.y)) * (acc[ct][2] + bb), gelu_tanh(bfhi(u.y)) * (acc[ct][3] + bb));
        *(u32x2*)(orow + c0) = o; }
    __syncthreads();
}

__device__ __forceinline__ void xattn_unit(const Ctx& c, const Params& p, int l, int bh, int tp) {
    const int b = bh >> 2, h = bh & 3, tid = c.tid, lane = c.lane, w = c.wave, r16 = lane & 15, g = lane >> 4;
    LAS bf16* kn = (LAS bf16*)c.lds; LAS bf16* vv = kn + 256 * LS;
    const bf16* KV = wsp<bf16>(c, OFF_KV) + (size_t)b * MEML * 1024;
    const float* gq = p.in[I_XATTN_QKN] + l * 256; const float* gk = gq + 128;
    {
        const int c8 = (tid & 15) * 8; const f32x4 g0 = *(const f32x4*)(gk + c8), g1 = *(const f32x4*)(gk + c8 + 4);
#pragma unroll
        for (int half = 0; half < 2; ++half) { u32x4 xk[4], xv[4];
#pragma unroll
            for (int a = 0; a < 4; ++a) { const int ki = (tid >> 4) + 32 * (4 * half + a); xk[a] = *(const u32x4*)(KV + (size_t)ki * 1024 + h * 128 + c8); xv[a] = *(const u32x4*)(KV + (size_t)ki * 1024 + 512 + h * 128 + c8); }
#pragma unroll
            for (int a = 0; a < 4; ++a) { const int ki = (tid >> 4) + 32 * (4 * half + a); float x[8]; unpack8(xk[a], x); float ss = 0.f;
#pragma unroll
                for (int e = 0; e < 8; ++e) ss += x[e] * x[e];
                ss = red16_sum(ss); const float rs = 1.f / sqrtf(ss * (1.f / 128.f) + EPS);
                x[0] *= rs * g0.x; x[1] *= rs * g0.y; x[2] *= rs * g0.z; x[3] *= rs * g0.w; x[4] *= rs * g1.x; x[5] *= rs * g1.y; x[6] *= rs * g1.z; x[7] *= rs * g1.w;
                *(LAS u32x4*)(kn + ki * LS + c8) = pack8(x); *(LAS u32x4*)(vv + ki * LS + c8) = xv[a]; } }
    }
    __syncthreads();
    const LAS bf16* vp = vv + (4 * g + (r16 >> 2)) * LS + 4 * (r16 & 3);
    for (int tt = 2 * tp; tt < 2 * tp + 2; ++tt) {
        const size_t row = (size_t)b * SEQ + 128 * tt + 16 * w + r16;
        const bf16* qrow = wsp<bf16>(c, OFF_Q) + row * 512 + h * 128;
        bf16x8 bq[4];
        { float qf[4][8]; float ss = 0.f;
#pragma unroll
          for (int ks = 0; ks < 4; ++ks) { unpack8(*(const u32x4*)(qrow + 32 * ks + 8 * g), qf[ks]);
#pragma unroll
              for (int e = 0; e < 8; ++e) ss += qf[ks][e] * qf[ks][e]; }
          ss = red4g_sum(ss); const float rsq = 0.08838834764831845f / sqrtf(ss * (1.f / 128.f) + EPS);
#pragma unroll
          for (int ks = 0; ks < 4; ++ks) {
#pragma unroll
              for (int e = 0; e < 8; ++e) qf[ks][e] *= rsq * gq[32 * ks + 8 * g + e];
              bq[ks] = __builtin_bit_cast(bf16x8, pack8(qf[ks])); } }
        f32x4 acc[16];
#pragma unroll
        for (int mt = 0; mt < 16; ++mt) acc[mt] = Z4;
#pragma unroll
        for (int ks = 0; ks < 4; ++ks) {
#pragma unroll
            for (int mt = 0; mt < 16; ++mt) acc[mt] = MFMA16(ldsA(kn + (16 * mt + r16) * LS + 32 * ks + 8 * g), bq[ks], acc[mt]);
            __builtin_amdgcn_sched_barrier(0); }
        float mx = -3.0e38f;
#pragma unroll
        for (int mt = 0; mt < 16; ++mt) mx = fmaxf(fmaxf(mx, fmaxf(acc[mt][0], acc[mt][1])), fmaxf(acc[mt][2], acc[mt][3]));
        mx = red4g_max(mx);
        float lsum = 0.f;
#pragma unroll
        for (int mt = 0; mt < 16; ++mt)
#pragma unroll
            for (int i = 0; i < 4; ++i) { const float pe = __expf(acc[mt][i] - mx); lsum += pe; acc[mt][i] = pe; }
        lsum = red4g_sum(lsum);
        f32x4 ao[8];
#pragma unroll
        for (int et = 0; et < 8; ++et) ao[et] = Z4;
#pragma unroll
        for (int ks = 0; ks < 8; ++ks) { const bf16x8 bp = pk8f(acc[2 * ks], acc[2 * ks + 1]);
#pragma unroll
            for (int et = 0; et < 8; ++et) ao[et] = MFMA16(cat4(ds_tr(vp + 32 * ks * LS + 16 * et), ds_tr(vp + (32 * ks + 16) * LS + 16 * et)), bp, ao[et]);
            __builtin_amdgcn_sched_barrier(0); }
        const float inv = 1.f / lsum; bf16* orow = wsp<bf16>(c, OFF_O) + row * 512 + h * 128;
#pragma unroll
        for (int et = 0; et < 8; ++et) { u32x2 o; o.x = pk2(ao[et][0] * inv, ao[et][1] * inv); o.y = pk2(ao[et][2] * inv, ao[et][3] * inv); *(u32x2*)(orow + 16 * et + 4 * g) = o; }
    }
    __syncthreads();
}
enum { PH_PRE = 0, PH_A1, PH_MIXA, PH_MIXB, PH_MIXC, PH_GB, PH_WOUT, PH_XQ, PH_XA, PH_XO, PH_RP2, PH_GATHER, PH_GU, PH_DOWN, PH_COMB, NPH_LAYER };

struct GbOrder {
    pg8::StaticOrder so; const char* ws;
    __device__ __forceinline__ bool next(int i, pg8::SUnit& u) const {
        pg8::Unit t; if (!so.next(i / 6, t)) return false;
        const int k6 = i % 6, k = (k6 & 1) * 3 + (k6 >> 1); u.pm = t.pm; u.pn = t.pn; u.kind = k;
        if (k < 3) { u.a = ws + WS_XB + (size_t)t.pm * 256 * D * 2; u.lda = D; u.K = D; u.b = ws + OFF_WG + ((size_t)k * 1024 + t.pn * 256) * D * 2; }
        else { const int br = k - 3; const size_t ccol = br == 0 ? (size_t)C_MO : (br == 1 ? (size_t)C_AQ : (size_t)C_GU); const int kk = br == 1 ? 768 : 512;
            const size_t woff = br == 0 ? OFF_WA : (br == 1 ? OFF_WB : OFF_WC);
            if (br == 1) { u.a = ws + WS_PROJ + ((size_t)t.pm * 256 * PP + ccol) * 2; u.lda = PP; } else { u.a = ws + (br == 0 ? WS_YA : WS_YC) + (size_t)t.pm * 256 * 512 * 2; u.lda = 512; }
            u.K = kk; u.b = ws + woff + (size_t)t.pn * 256 * kk * 2; }
        return true;
    }
};

template <int PH>
__device__ __forceinline__ void run_phase(const Ctx& c, const Params& p, int l) {
    bf16* const XB = wsp<bf16>(c, WS_XB); bf16* const PROJ = wsp<bf16>(c, WS_PROJ);
    const float* Xin = (l == 0) ? p.in[I_X] : p.out;
    if constexpr (PH == PH_PRE) { phase_weights(c, p, 0); __syncthreads(); phase_rp0_input(c, p); }
    if constexpr (PH == PH_A1) {
        if (c.bx >= c.G - 16) gate_scan(c, c.bx - (c.G - 16));
        { pg8::Gemm g{XB, wsp<bf16>(c, OFF_WIN1), D, D}; pg8::StaticOrder S; S.init(M, PP, c.G, c.bx); epi::Bf16Out E{PROJ, PP};
          pg8::gemm_phase<epi::Bf16Out, pg8::StaticOrder, true>(c.lds, g, S, E); }
        { pg8::Gemm g{wsp<bf16>(c, OFF_MEMB), wsp<bf16>(c, OFF_WXKV), D, D}; pg8::StaticOrder S; S.init(MM, 1024, c.G, (c.bx + c.G - 64) % c.G); epi::Bf16Out E{wsp<bf16>(c, OFF_KV), 1024};
          pg8::gemm_phase<epi::Bf16Out, pg8::StaticOrder, true>(c.lds, g, S, E); }
    }
    if constexpr (PH == PH_MIXA) {
        for (int u = c.bx; u < 16 * NCH; u += c.G) mlstm_delta_unit(c, p, l, u / NCH, u % NCH);
        for (int u = c.bx; u < NBATCH * 32 * 4; u += c.G) gmlp_unit(c, p, l, u >> 7, (u >> 2) & 31, u & 3);
    }
    if constexpr (PH == PH_MIXB) {
        mlstm_scan(c);
        for (int u = c.bx; u < NBATCH * 12 * 32; u += c.G) { const int blk = u & 31, bh = u >> 5; dattn_unit(c, p, l, bh / 12, bh % 12, blk); }
    }
    if constexpr (PH == PH_MIXC) { for (int u = c.bx; u < 16 * NCH; u += c.G) mlstm_out_unit(c, p, l, u / NCH, u % NCH); dattn_merge(c); }
    if constexpr (PH == PH_GB) { GbOrder S; S.so.init(M, 1024, c.G, c.bx); S.ws = (const char*)c.ws;
        epi::GateBranchOut E{PROJ, wsp<bf16>(c, WS_T)};
        pg8::gemm_stream<epi::GateBranchOut, GbOrder, true>(c.lds, S, E); }
    if constexpr (PH == PH_WOUT) { pg8::Gemm g{wsp<bf16>(c, WS_T), wsp<bf16>(c, OFF_WOUT), D, D}; pg8::StaticOrder S; S.init(M, 1024, c.G, c.bx); epi::ResidOutXb E{Xin, p.out, wsp<bf16>(c, WS_X1B), wsp<float>(c, OFF_SSQ)};
        pg8::gemm_phase<epi::ResidOutXb, pg8::StaticOrder, false>(c.lds, g, S, E); }
    if constexpr (PH == PH_XQ) { pg8::Gemm g{wsp<bf16>(c, WS_X1B), wsp<bf16>(c, OFF_WXQ), D, D}; pg8::StaticOrder S; S.init(M, 512, c.G, c.bx); epi::Bf16OutRs E{wsp<bf16>(c, OFF_Q), 512, wsp<float>(c, OFF_SSQ)};
        pg8::gemm_phase<epi::Bf16OutRs, pg8::StaticOrder, false>(c.lds, g, S, E); }
    if constexpr (PH == PH_XA) { for (int u = c.bx; u < 16 * 16; u += c.G) xattn_unit(c, p, l, u >> 4, u & 15); }
    if constexpr (PH == PH_XO) { pg8::Gemm g{wsp<bf16>(c, OFF_O), wsp<bf16>(c, OFF_WXO), 512, 512}; pg8::StaticOrder S; S.init(M, 1024, c.G, c.bx); epi::ResidOut E{p.out, p.out};
        pg8::gemm_phase<epi::ResidOut, pg8::StaticOrder, false>(c.lds, g, S, E); }
    if constexpr (PH == PH_RP2) phase_rp2_route(c, p, l, p.out);
    if constexpr (PH == PH_GATHER) phase_gather(c, l);
    if constexpr (PH == PH_GU) { moe_tables<false>(c); pg8::Gemm g{wsp<bf16>(c, OFF_XG), wsp<bf16>(c, OFF_WGU), D, D}; MoeOrder S{(const LAS int*)(c.lds + LDS_TAB), c.G, c.bx}; epi::GluOut E{wsp<bf16>(c, OFF_HID)};
        pg8::gemm_phase<epi::GluOut, MoeOrder, true>(c.lds, g, S, E); }
    if constexpr (PH == PH_DOWN) { moe_tables<false>(c); pg8::Gemm g{wsp<bf16>(c, OFF_HID), wsp<bf16>(c, OFF_WD), DFF, DFF}; MoeOrder S{(const LAS int*)(c.lds + LDS_TAB), c.G, c.bx}; epi::DownOut E{wsp<bf16>(c, OFF_XG), wsp<float>(c, OFF_WROW)};
        pg8::gemm_phase<epi::DownOut, MoeOrder, true>(c.lds, g, S, E); }
    if constexpr (PH == PH_COMB) { if (l + 1 < DEPTH) { phase_combine<true>(c, p, l, p.out, p.out); __syncthreads(); phase_weights(c, p, l + 1); } else phase_combine<false>(c, p, l, p.out, p.out); }
}

__device__ __forceinline__ Ctx make_ctx(const Params& p, unsigned char* lds_raw) {
    Ctx c;
    c.lds = (LAS unsigned char*)lds_raw; c.ws = p.ws;
    int tid_ = threadIdx.x, bx = blockIdx.x, G_ = gridDim.x;
    asm volatile("" : "+v"(tid_), "+s"(bx), "+s"(G_));
    c.tid = tid_; c.lane = c.tid & 63; c.wave = __builtin_amdgcn_readfirstlane(c.tid >> 6);
    c.G = G_; c.bx = bx; c.vcu = (c.G % 8 == 0) ? (bx % 8) * (c.G / 8) + bx / 8 : bx;
    return c;
}
#ifndef MK_ONE_LAUNCH
#define MK_ONE_LAUNCH 1
#endif
#if !MK_ONE_LAUNCH
template <int PH>
__global__ void __launch_bounds__(512, 2) phase_kernel(Params p, int l) {
    extern __shared__ __attribute__((aligned(16))) unsigned char lds_raw[];
    const Ctx c = make_ctx(p, lds_raw);
    run_phase<PH>(c, p, l);
}
template <int PH> static void launch_phases(int grid, const Params& a, int l, hipStream_t stream) {
    if constexpr (PH < NPH_LAYER) {
        static bool attr_done = false;
        if (!attr_done) { (void)hipFuncSetAttribute((const void*)phase_kernel<PH>, hipFuncAttributeMaxDynamicSharedMemorySize, LDS_BYTES); attr_done = true; }
        if (!(PH == PH_PRE && l != 0)) hipLaunchKernelGGL(phase_kernel<PH>, dim3(grid), dim3(512), LDS_BYTES, stream, a, l);
        launch_phases<PH + 1>(grid, a, l, stream);
    }
}
#else
#if defined(__HIP_DEVICE_COMPILE__)
typedef const __attribute__((address_space(4))) Params* KParams;
#else
typedef const Params* KParams;
#endif
template <int PH>
__device__ __forceinline__ void phase_site(KParams kp, int l) {
    extern __shared__ __attribute__((aligned(16))) unsigned char lds_raw[];
    asm volatile("" : "+s"(kp));
    Params p;
#pragma unroll
    for (int i = 0; i < 28; ++i) p.in[i] = kp->in[i];
    p.out = kp->out; p.ws = kp->ws;
    const Ctx c = make_ctx(p, lds_raw);
    run_phase<PH>(c, p, l);
}
__device__ __forceinline__ void seam(KParams kp) {
    extern __shared__ __attribute__((aligned(16))) unsigned char lds_raw[];
    asm volatile("" : "+s"(kp));
    XcdBarrier b; b.bar = (unsigned*)(kp->ws + WS_CTL) + CW_BAR; b.x = xb_xcc_id(); b.st = (volatile LAS unsigned*)((LAS unsigned char*)lds_raw + LDS_MISC) + 8;
    xcd_barrier(b);
}
template <int PH> __device__ __forceinline__ void run_layer(KParams kp, int l) {
    if constexpr (PH < NPH_LAYER) {
        if (!(PH == PH_PRE && l != 0)) {
#ifdef PROBE_AMP
            const unsigned long long t0_ = __builtin_amdgcn_s_memrealtime();
#endif
            phase_site<PH>(kp, l); seam(kp);
#ifdef PROBE_AMP
            if ((PROBE_AMP >> PH) & 1) { const unsigned long long dt_ = __builtin_amdgcn_s_memrealtime() - t0_; const unsigned long long t1_ = __builtin_amdgcn_s_memrealtime();
                while (__builtin_amdgcn_s_memrealtime() - t1_ < 3 * dt_) __builtin_amdgcn_s_sleep(4); seam(kp); }
#endif
#ifdef PROBE_REPEAT
            if ((PROBE_REPEAT >> PH) & 1) { phase_site<PH>(kp, l); seam(kp); }
#endif
        }
        run_layer<PH + 1>(kp, l);
    }
}
__global__ void __launch_bounds__(512, 2) fwd_kernel(Params p) {
    extern __shared__ __attribute__((aligned(16))) unsigned char lds_raw[];
    volatile LAS unsigned* MISC = (volatile LAS unsigned*)((LAS unsigned char*)lds_raw + LDS_MISC);
    for (int u = threadIdx.x; u < (LDS_BYTES - LDS_MISC) / 4; u += 512) MISC[u] = 0u;
    __syncthreads();
    (void)xcd_barrier_post((unsigned*)(p.ws + WS_CTL) + CW_BAR, MISC + 8);
    KParams kp = (KParams)__builtin_amdgcn_kernarg_segment_ptr();
    run_layer<0>(kp, 0);
    run_layer<0>(kp, 1);
    static_assert(DEPTH == 2, "layers are written out");
}
#endif

extern "C" void kernel_launch(void* const* d_in, const int* in_sizes, int n_in, void* d_out, int out_size, void* d_ws, size_t ws_size, hipStream_t stream) {
    static int grid = 0;
    if (grid == 0) {
        if (n_in != 28 || in_sizes[0] != M * D || out_size != M * D || ws_size < WS_END) { fprintf(stderr, "kernel_launch: unexpected shapes (n_in %d, in0 %d, out %d, ws %zu < %zu); nothing launched\n", n_in, n_in > 0 ? in_sizes[0] : -1, out_size, ws_size, (size_t)WS_END); grid = -1; return; }
        int dev = 0, cus = 0;
        if (hipGetDevice(&dev) != hipSuccess || hipDeviceGetAttribute(&cus, hipDeviceAttributeMultiprocessorCount, dev) != hipSuccess) { grid = -1; return; }
#if MK_ONE_LAUNCH
        if (hipFuncSetAttribute((const void*)fwd_kernel, hipFuncAttributeMaxDynamicSharedMemorySize, LDS_BYTES) != hipSuccess) { fprintf(stderr, "kernel_launch: hipFuncSetAttribute failed\n"); grid = -1; return; }
        int per_cu = 0;
        if (hipOccupancyMaxActiveBlocksPerMultiprocessor(&per_cu, (const void*)fwd_kernel, 512, LDS_BYTES) != hipSuccess || per_cu < 1) { fprintf(stderr, "kernel_launch: occupancy query reports %d workgroups per CU\n", per_cu); }
        (void)hipGetLastError();
#endif
        grid = cus;
    }
    if (grid < 0) return;
    if (hipMemsetAsync((char*)d_ws + WS_CTL, 0, CTL_ZERO_BYTES, stream) != hipSuccess) return;
    Params a{};
    for (int i = 0; i < 28; ++i) a.in[i] = (const float*)d_in[i];
    a.out = (float*)d_out; a.ws = (unsigned char*)d_ws;
#if MK_ONE_LAUNCH
    hipLaunchKernelGGL(fwd_kernel, dim3(grid), dim3(512), LDS_BYTES, stream, a);
#else
    for (int l = 0; l < DEPTH; ++l) launch_phases<0>(grid, a, l, stream);
#endif
}
```

```cpp
#include <hip/hip_runtime.h>
#include <cstdio>
#include <cstdint>

#define GAS __attribute__((address_space(1)))
#define LAS __attribute__((address_space(3)))
typedef unsigned short bf16;
typedef short bf16x8 __attribute__((ext_vector_type(8)));
typedef float f32x4 __attribute__((ext_vector_type(4)));
typedef float f32x2 __attribute__((ext_vector_type(2)));
typedef unsigned u32x4 __attribute__((ext_vector_type(4)));
typedef unsigned u32x2 __attribute__((ext_vector_type(2)));
typedef int i32x4 __attribute__((ext_vector_type(4)));

constexpr int D = 1024, NBATCH = 4, SEQ = 4096, M = NBATCH * SEQ, DEPTH = 2, MEML = 256, MM = NBATCH * MEML;
constexpr int NIN = 8456;
constexpr int PP = 5376;
constexpr int C_MQ = 0, C_MK = 512, C_MV = 1024, C_MO = 1536, C_AQ = 2048, C_AK = 2816, C_AV = 3584, C_GU = 4352, C_GV = 4864;
constexpr int NEXP = 16, DFF = 512;
constexpr int LCH = 128, NCH = SEQ / LCH;
constexpr float EPS = 1e-6f;
constexpr int MAXT = 144;

constexpr size_t MiB = 1u << 20;
constexpr size_t WS_CTL = 0, CTL_ZERO_BYTES = 1 * MiB;
constexpr size_t WS_SMALL = 1 * MiB;
constexpr size_t OFF_GATES = WS_SMALL;
constexpr size_t OFF_AMA = OFF_GATES + (size_t)M * 8 * 4;
constexpr size_t OFF_AMM = OFF_AMA + 16 * SEQ * 4;
constexpr size_t OFF_AMB = OFF_AMM + 16 * SEQ * 4;
constexpr size_t OFF_LSE = OFF_AMB + 16 * SEQ * 4;
constexpr size_t OFF_BIAS = OFF_LSE + (size_t)M * 12 * 4;
constexpr size_t OFF_TOKE = OFF_BIAS + 12 * 132 * 4;
constexpr size_t OFF_TOKP = OFF_TOKE + (size_t)M * 2 * 4;
constexpr size_t OFF_TOKW = OFF_TOKP + (size_t)M * 2 * 4;
constexpr size_t OFF_SLOT = OFF_TOKW + (size_t)M * 2 * 4;
constexpr size_t OFF_WROW = OFF_SLOT + (size_t)M * 2 * 4;
constexpr size_t OFF_NST = OFF_WROW + (size_t)MAXT * 256 * 4;
constexpr size_t OFF_MEMB = OFF_NST + (size_t)16 * NCH * 128 * 4;
constexpr size_t OFF_KV = OFF_MEMB + (size_t)MM * D * 2;
constexpr size_t OFF_CNTW = OFF_KV + (size_t)MM * 1024 * 2;
constexpr size_t OFF_SSQ = OFF_CNTW + 256 * 16 * 4;
constexpr size_t OFF_ROWTOK = OFF_SSQ + (size_t)M * 16 * 4;
constexpr size_t OFF_SMALL_END = OFF_ROWTOK + (size_t)MAXT * 256 * 4;
static_assert(OFF_SMALL_END <= 17 * MiB, "small region");
constexpr size_t WS_W = 17 * MiB;
constexpr size_t OFF_WIN1 = WS_W;
constexpr size_t OFF_WG = OFF_WIN1 + (size_t)5376 * 1024 * 2;
constexpr size_t OFF_WA = OFF_WG + (size_t)3072 * 1024 * 2;
constexpr size_t OFF_WB = OFF_WA + (size_t)1024 * 512 * 2;
constexpr size_t OFF_WC = OFF_WB + (size_t)1024 * 768 * 2;
constexpr size_t OFF_WOUT = OFF_WC + (size_t)1024 * 512 * 2;
constexpr size_t OFF_WXQ = OFF_WOUT + (size_t)1024 * 1024 * 2;
constexpr size_t OFF_WXKV = OFF_WXQ + (size_t)512 * 1024 * 2;
constexpr size_t OFF_WXO = OFF_WXKV + (size_t)1024 * 1024 * 2;
constexpr size_t OFF_WGU = OFF_WXO + (size_t)1024 * 512 * 2;
constexpr size_t OFF_WD = OFF_WGU + (size_t)16 * 1024 * 1024 * 2;
constexpr size_t OFF_W_END = OFF_WD + (size_t)16 * 1024 * 512 * 2;
static_assert(OFF_W_END <= 93 * MiB, "weight region");
constexpr size_t WS_XB = 93 * MiB;
constexpr size_t WS_PROJ = 125 * MiB;
constexpr size_t OFF_XG = WS_PROJ, OFF_HID = WS_PROJ + 72 * MiB;
constexpr size_t WS_X1B = WS_PROJ + 120 * MiB;
constexpr size_t WS_T = 293 * MiB;
constexpr size_t OFF_Q = WS_T, OFF_O = WS_T + 16 * MiB;
constexpr size_t WS_YA = 327 * MiB, WS_YC = 343 * MiB;
constexpr size_t WS_END = 359 * MiB;
constexpr int CW_TMO = 0, CW_CODE = 1;
constexpr int CW_CNT = 64;
constexpr int CW_BAR = 4096;

constexpr int LDS_BYTES = 147456;
constexpr int LDS_TAB = 145408;
constexpr int LDS_WOFF = 0;
constexpr int LDS_ROWL = 131072;
constexpr int LDS_MISC = 146944;

#define RLX_AGENT __ATOMIC_RELAXED, __HIP_MEMORY_SCOPE_AGENT
#define LDS_WAIT() asm volatile("s_waitcnt lgkmcnt(0)" ::: "memory")
#define VM_WAIT() asm volatile("s_waitcnt vmcnt(0)" ::: "memory")
typedef __bf16 bf16x2_t __attribute__((ext_vector_type(2)));
__device__ __forceinline__ unsigned pk2(float lo, float hi) { const f32x2 v = {lo, hi}; return __builtin_bit_cast(unsigned, __builtin_convertvector(v, bf16x2_t)); }
__device__ __forceinline__ unsigned f2bf(float f) { return pk2(f, 0.f) & 0xffffu; }
__device__ __forceinline__ float bf2f(unsigned h) { return __builtin_bit_cast(float, h << 16); }
__device__ __forceinline__ float bflo(unsigned w) { return __builtin_bit_cast(float, w << 16); }
__device__ __forceinline__ float bfhi(unsigned w) { return __builtin_bit_cast(float, w & 0xffff0000u); }
__device__ __forceinline__ float wave_sum(float v) {
#pragma unroll
    for (int o = 1; o < 64; o <<= 1) v += __shfl_xor(v, o);
    return v;
}
__device__ __forceinline__ float sigmoidf_(float x) { return __builtin_amdgcn_rcpf(1.f + __expf(-x)); }
__device__ __forceinline__ float siluf_(float x) { return x * __builtin_amdgcn_rcpf(1.f + __expf(-x)); }
__device__ __forceinline__ float gelu_tanh(float x) { const float u = 0.7978845608028654f * (x + 0.044715f * x * x * x); return x * __builtin_amdgcn_rcpf(1.f + __expf(-2.f * u)); }
__device__ __forceinline__ void unpack8(const u32x4 w, float (&f)[8]) { f[0] = bflo(w.x); f[1] = bfhi(w.x); f[2] = bflo(w.y); f[3] = bfhi(w.y); f[4] = bflo(w.z); f[5] = bfhi(w.z); f[6] = bflo(w.w); f[7] = bfhi(w.w); }
__device__ __forceinline__ u32x4 pack8(const float (&f)[8]) { u32x4 w; w.x = pk2(f[0], f[1]); w.y = pk2(f[2], f[3]); w.z = pk2(f[4], f[5]); w.w = pk2(f[6], f[7]); return w; }

namespace pg8 {
constexpr int BM = 256, BK = 64, HALF = 128, HTB = HALF * BK * 2  , STAGE_BYTES = 8 * HTB, NXCD = 8, WGM = 8;
__host__ __device__ __forceinline__ int lds_byte(int r, int c) { const int st = (r >> 4) * 2 + (c >> 5), rr = r & 15, cc = c & 31, ob = rr * 64 + cc * 2; return st * 1024 + (ob ^ (((ob >> 9) & 1) << 5)); }
__host__ __device__ __forceinline__ void stage_rc(int b, int& R, int& C) { const int st = b / 1024, sb = b % 1024, swz = sb ^ (((sb >> 9) & 1) << 5); R = (st >> 1) * 16 + swz / 64; C = (st & 1) * 32 + (swz % 64) / 2; }
__host__ __device__ __forceinline__ int perm32(int rho) { const int n = rho >> 4, i = rho & 15; return 8 * (i >> 2) + 4 * n + (i & 3); }

struct Unit { int pm, pn; };
struct Gemm { const bf16* A; const bf16* Bt; int lda, K; };

struct StaticOrder {
    int nM, nN, nwg, G, c;
    __host__ __device__ __forceinline__ void init(int M_, int N_, int G_, int c_) { nM = M_ / BM; nN = N_ / BM; nwg = nM * nN; G = G_; c = c_; }
    __host__ __device__ __forceinline__ bool next(int i, Unit& u) const {
        const long L = (long)i * G + c; if (L >= nwg) return false;
        int wgid = (int)L; { const int q = nwg / NXCD, r = nwg % NXCD, xcd = wgid % NXCD, off = wgid / NXCD; wgid = (xcd < r ? xcd * (q + 1) : r * (q + 1) + (xcd - r) * q) + off; }
        const int nig = WGM * nN, gid = wgid / nig, fm = gid * WGM, gsz = (nM - fm) < WGM ? (nM - fm) : WGM;
        u.pm = fm + ((wgid % nig) % gsz); u.pn = (wgid % nig) / gsz; return true;
    }
    __device__ __forceinline__ void a_ready(const Unit&) const {}
    __device__ __forceinline__ void done(const Unit&) const {}
};


__device__ __forceinline__ f32x4 mma16(const bf16x8 a, const bf16x8 b, const f32x4 c) { return __builtin_amdgcn_mfma_f32_16x16x32_bf16(a, b, c, 0, 0, 0); }
__device__ __forceinline__ i32x4 mma16(const bf16x8 a, const bf16x8 b, const i32x4 c) { return __builtin_amdgcn_mfma_i32_16x16x64_i8(__builtin_bit_cast(i32x4, a), __builtin_bit_cast(i32x4, b), c, 0, 0, 0); }
template <bool I8> struct AccSel { typedef f32x4 T; };
template <> struct AccSel<true> { typedef i32x4 T; };
template <class Epi, class Sched, bool ALIGN_EPI = false, bool I8 = false>
__device__ __forceinline__ void gemm_phase(LAS unsigned char* lds, const Gemm g, const Sched& S, const Epi& E) {
    int tid_ = threadIdx.x; asm volatile("" : "+v"(tid_));
    const int tid = tid_, wid = __builtin_amdgcn_readfirstlane(tid >> 6), lane = tid & 63, wr = wid >> 2, wc = wid & 3, fr = lane & 15, fq = lane >> 4;
    const int K = g.K, nt = K / BK, lda = g.lda;
    unsigned voffA[2], voffB[2];
#pragma unroll
    for (int i = 0; i < 2; ++i) { int R, C; stage_rc(tid * 16 + i * 8192, R, C); const int Rb = Epi::PERM ? ((R & ~31) + perm32(R & 31)) : R;
        voffA[i] = (unsigned)(R * lda + C) * 2u; voffB[i] = (unsigned)(Rb * K + C) * 2u; }
    const size_t kstep = (size_t)(BK * 2);
    const size_t hstepA = (size_t)HALF * lda * 2, hstepB = (size_t)HALF * K * 2;
    const size_t tstepA = 2 * hstepA, tstepB = 2 * hstepB;
    const unsigned ldsw = (unsigned)wid * 1024u;
    const int aoff = lds_byte(wr * 64 + fr, fq * 8), boff = lds_byte(wc * 32 + fr, fq * 8);
#define PG8_SA(b, h) (((b) * 2 + (h)) * HTB)
#define PG8_SB(b, h) ((4 + (b) * 2 + (h)) * HTB)
#define PG8_STAGE(bufoff, gbase, voff) do { _Pragma("unroll") for (int _i = 0; _i < 2; ++_i) \
        __builtin_amdgcn_global_load_lds((const unsigned*)((const char*)(gbase) + (voff)[_i]), (LAS unsigned*)(lds + (bufoff) + ldsw + _i * 8192), 16, 0, 0); } while (0)
#define PG8_LDA(dst, b, h) do { _Pragma("unroll") for (int m = 0; m < 4; ++m) _Pragma("unroll") for (int k = 0; k < 2; ++k) dst[m][k] = *(const LAS bf16x8*)(lds + PG8_SA(b, h) + aoff + m * 2048 + k * 1024); } while (0)
#define PG8_LDB(dst, b, h) do { _Pragma("unroll") for (int n = 0; n < 2; ++n) _Pragma("unroll") for (int k = 0; k < 2; ++k) dst[n][k] = *(const LAS bf16x8*)(lds + PG8_SB(b, h) + boff + n * 2048 + k * 1024); } while (0)
#define PG8_MMA(ai, bj, At, Bt) do { __builtin_amdgcn_s_setprio(1); _Pragma("unroll") for (int m = 0; m < 4; ++m) _Pragma("unroll") for (int n = 0; n < 2; ++n) _Pragma("unroll") for (int k = 0; k < 2; ++k) \
        acc[ai][bj][m][n] = mma16(Bt[n][k], At[m][k], acc[ai][bj][m][n]); __builtin_amdgcn_s_setprio(0); } while (0)
#define PG8_WAIT_V(n) asm volatile("s_waitcnt vmcnt(" #n ")" ::: "memory")
#define PG8_WAIT_L(n) asm volatile("s_waitcnt lgkmcnt(" #n ")" ::: "memory")
#define PG8_BAR __builtin_amdgcn_s_barrier()
#define PG8_SCHED __builtin_amdgcn_sched_barrier(0)
    Unit cur, nxt; int ui = 0;
    if (!S.next(0, cur)) return;
    typedef typename AccSel<I8>::T acc_t;
    acc_t acc[2][2][4][2];
#pragma unroll
    for (int a = 0; a < 2; ++a)
#pragma unroll
        for (int b = 0; b < 2; ++b)
#pragma unroll
            for (int m = 0; m < 4; ++m)
#pragma unroll
                for (int n = 0; n < 2; ++n) acc[a][b][m][n] = (acc_t){0, 0, 0, 0};
    bf16x8 At[4][2], B0[2][2], B1[2][2];
    const char* cA = (const char*)g.A + (size_t)cur.pm * tstepA; const char* cB = (const char*)g.Bt + (size_t)cur.pn * tstepB;
    S.a_ready(cur);
    PG8_STAGE(PG8_SB(0, 0), cB, voffB); PG8_STAGE(PG8_SB(0, 1), cB + hstepB, voffB); PG8_STAGE(PG8_SA(0, 0), cA, voffA); PG8_STAGE(PG8_SA(0, 1), cA + hstepA, voffA);
    if (wr == 1) PG8_BAR;
    PG8_WAIT_V(2); PG8_BAR;
    PG8_STAGE(PG8_SB(1, 0), cB + kstep, voffB); PG8_STAGE(PG8_SA(1, 0), cA + kstep, voffA); PG8_STAGE(PG8_SB(1, 1), cB + hstepB + kstep, voffB);
    PG8_WAIT_V(6); PG8_BAR;
    for (;;) {
        const bool has_next = S.next(ui + 1, nxt);
        const char* nA = has_next ? (const char*)g.A + (size_t)nxt.pm * tstepA : cA; const char* nB = has_next ? (const char*)g.Bt + (size_t)nxt.pn * tstepB : cB;
        for (int t = 0; t < nt; t += 2) {
            const bool last = (t == nt - 2);
            const char* a1 = cA + (size_t)(t + 1) * kstep;
            const char* a2 = last ? nA : cA + (size_t)(t + 2) * kstep; const char* b2 = last ? nB : cB + (size_t)(t + 2) * kstep;
            const char* a3 = a2 + kstep; const char* b3 = b2 + kstep;
            if (last && has_next) S.a_ready(nxt);
            PG8_LDB(B0, 0, 0); PG8_LDB(B1, 0, 1); PG8_SCHED; PG8_LDA(At, 0, 0); PG8_STAGE(PG8_SA(1, 1), a1 + hstepA, voffA);
            PG8_WAIT_V(8); PG8_WAIT_L(0); PG8_BAR; PG8_MMA(0, 0, At, B0); PG8_MMA(0, 1, At, B1); PG8_BAR; PG8_SCHED;
            PG8_LDA(At, 0, 1); PG8_STAGE(PG8_SB(0, 0), b2, voffB); PG8_STAGE(PG8_SB(0, 1), b2 + hstepB, voffB); PG8_STAGE(PG8_SA(0, 0), a2, voffA);
            PG8_WAIT_V(8); PG8_WAIT_L(0); PG8_BAR; PG8_MMA(1, 0, At, B0); PG8_MMA(1, 1, At, B1); PG8_BAR; PG8_SCHED;
            PG8_LDB(B0, 1, 0); PG8_LDB(B1, 1, 1); PG8_SCHED; PG8_LDA(At, 1, 0); PG8_STAGE(PG8_SA(0, 1), a2 + hstepA, voffA);
            PG8_WAIT_V(8); PG8_WAIT_L(0); PG8_BAR; PG8_MMA(0, 0, At, B0); PG8_MMA(0, 1, At, B1); PG8_BAR; PG8_SCHED;
            PG8_LDA(At, 1, 1); PG8_STAGE(PG8_SB(1, 0), b3, voffB); PG8_STAGE(PG8_SB(1, 1), b3 + hstepB, voffB); PG8_STAGE(PG8_SA(1, 0), a3, voffA);
            PG8_WAIT_V(8); PG8_WAIT_L(0); PG8_BAR; PG8_MMA(1, 0, At, B0); PG8_MMA(1, 1, At, B1); PG8_BAR; PG8_SCHED;
        }
        if constexpr (ALIGN_EPI) { if (wr == 0) PG8_BAR; }
        E(acc, cur, wr, wc, fr, fq); S.done(cur);
        if (!has_next) break;
#pragma unroll
        for (int a = 0; a < 2; ++a)
#pragma unroll
            for (int b = 0; b < 2; ++b)
#pragma unroll
                for (int m = 0; m < 4; ++m)
#pragma unroll
                    for (int n = 0; n < 2; ++n) acc[a][b][m][n] = (acc_t){0, 0, 0, 0};
        cur = nxt; cA = nA; cB = nB; ++ui;
        if constexpr (ALIGN_EPI) { if (wr == 1) PG8_BAR; }
    }
    PG8_WAIT_V(0);
    if constexpr (!ALIGN_EPI) { if (wr == 0) PG8_BAR; }
    PG8_BAR;
#undef PG8_SA
#undef PG8_SB
#undef PG8_STAGE
#undef PG8_LDA
#undef PG8_LDB
#undef PG8_MMA
#undef PG8_WAIT_V
#undef PG8_WAIT_L
#undef PG8_BAR
#undef PG8_SCHED
}

template <class Epi, class Sched, bool ALIGN_EPI = false>
__device__ __forceinline__ void gemm_phase_g(LAS unsigned char* lds, const Gemm g, const LAS int* rowl, const Sched& S, const Epi& E) {
    constexpr bool I8 = false;
    int tid_ = threadIdx.x; asm volatile("" : "+v"(tid_));
    const int tid = tid_, wid = __builtin_amdgcn_readfirstlane(tid >> 6), lane = tid & 63, wr = wid >> 2, wc = wid & 3, fr = lane & 15, fq = lane >> 4;
    const int K = g.K, nt = K / BK, lda = g.lda;
    unsigned voffB[2]; int RA[2], CA;
#pragma unroll
    for (int i = 0; i < 2; ++i) { int R, C; stage_rc(tid * 16 + i * 8192, R, C); const int Rb = Epi::PERM ? ((R & ~31) + perm32(R & 31)) : R;
        RA[i] = R; CA = C; voffB[i] = (unsigned)(Rb * K + C) * 2u; }
    size_t gc[2][2], gn[2][2];
#define PG8_GOFF(dst, ord) do { _Pragma("unroll") for (int h = 0; h < 2; ++h) _Pragma("unroll") for (int i = 0; i < 2; ++i) dst[h][i] = ((size_t)rowl[(ord) * BM + h * HALF + RA[i]] * lda + CA) * 2; } while (0)
#define PG8_STAGEG(bufoff, gbase, goffh) do { _Pragma("unroll") for (int _i = 0; _i < 2; ++_i) \
        __builtin_amdgcn_global_load_lds((const unsigned*)((const char*)(gbase) + (goffh)[_i]), (LAS unsigned*)(lds + (bufoff) + ldsw + _i * 8192), 16, 0, 0); } while (0)
    const size_t kstep = (size_t)(BK * 2);
    const size_t hstepA = (size_t)HALF * lda * 2, hstepB = (size_t)HALF * K * 2;
    const size_t tstepA = 2 * hstepA, tstepB = 2 * hstepB;
    const unsigned ldsw = (unsigned)wid * 1024u;
    const int aoff = lds_byte(wr * 64 + fr, fq * 8), boff = lds_byte(wc * 32 + fr, fq * 8);
#define PG8_SA(b, h) (((b) * 2 + (h)) * HTB)
#define PG8_SB(b, h) ((4 + (b) * 2 + (h)) * HTB)
#define PG8_STAGE(bufoff, gbase, voff) do { _Pragma("unroll") for (int _i = 0; _i < 2; ++_i) \
        __builtin_amdgcn_global_load_lds((const unsigned*)((const char*)(gbase) + (voff)[_i]), (LAS unsigned*)(lds + (bufoff) + ldsw + _i * 8192), 16, 0, 0); } while (0)
#define PG8_LDA(dst, b, h) do { _Pragma("unroll") for (int m = 0; m < 4; ++m) _Pragma("unroll") for (int k = 0; k < 2; ++k) dst[m][k] = *(const LAS bf16x8*)(lds + PG8_SA(b, h) + aoff + m * 2048 + k * 1024); } while (0)
#define PG8_LDB(dst, b, h) do { _Pragma("unroll") for (int n = 0; n < 2; ++n) _Pragma("unroll") for (int k = 0; k < 2; ++k) dst[n][k] = *(const LAS bf16x8*)(lds + PG8_SB(b, h) + boff + n * 2048 + k * 1024); } while (0)
#define PG8_MMA(ai, bj, At, Bt) do { __builtin_amdgcn_s_setprio(1); _Pragma("unroll") for (int m = 0; m < 4; ++m) _Pragma("unroll") for (int n = 0; n < 2; ++n) _Pragma("unroll") for (int k = 0; k < 2; ++k) \
        acc[ai][bj][m][n] = mma16(Bt[n][k], At[m][k], acc[ai][bj][m][n]); __builtin_amdgcn_s_setprio(0); } while (0)
#define PG8_WAIT_V(n) asm volatile("s_waitcnt vmcnt(" #n ")" ::: "memory")
#define PG8_WAIT_L(n) asm volatile("s_waitcnt lgkmcnt(" #n ")" ::: "memory")
#define PG8_BAR __builtin_amdgcn_s_barrier()
#define PG8_SCHED __builtin_amdgcn_sched_barrier(0)
    Unit cur, nxt; int ui = 0;
    if (!S.next(0, cur)) return;
    typedef typename AccSel<I8>::T acc_t;
    acc_t acc[2][2][4][2];
#pragma unroll
    for (int a = 0; a < 2; ++a)
#pragma unroll
        for (int b = 0; b < 2; ++b)
#pragma unroll
            for (int m = 0; m < 4; ++m)
#pragma unroll
                for (int n = 0; n < 2; ++n) acc[a][b][m][n] = (acc_t){0, 0, 0, 0};
    bf16x8 At[4][2], B0[2][2], B1[2][2];
    const char* const cA = (const char*)g.A; const char* cB = (const char*)g.Bt + (size_t)cur.pn * tstepB;
    PG8_GOFF(gc, 0);
    S.a_ready(cur);
    PG8_STAGE(PG8_SB(0, 0), cB, voffB); PG8_STAGE(PG8_SB(0, 1), cB + hstepB, voffB); PG8_STAGEG(PG8_SA(0, 0), cA, gc[0]); PG8_STAGEG(PG8_SA(0, 1), cA, gc[1]);
    if (wr == 1) PG8_BAR;
    PG8_WAIT_V(2); PG8_BAR;
    PG8_STAGE(PG8_SB(1, 0), cB + kstep, voffB); PG8_STAGEG(PG8_SA(1, 0), cA + kstep, gc[0]); PG8_STAGE(PG8_SB(1, 1), cB + hstepB + kstep, voffB);
    PG8_WAIT_V(6); PG8_BAR;
    for (;;) {
        const bool has_next = S.next(ui + 1, nxt);
        const char* nB = has_next ? (const char*)g.Bt + (size_t)nxt.pn * tstepB : cB;
        if (has_next) PG8_GOFF(gn, ui + 1); else {
#pragma unroll
            for (int h = 0; h < 2; ++h)
#pragma unroll
                for (int i = 0; i < 2; ++i) gn[h][i] = gc[h][i]; }
        for (int t = 0; t < nt; t += 2) {
            const bool last = (t == nt - 2);
            const char* a1 = cA + (size_t)(t + 1) * kstep;
            const char* a2 = last ? cA : cA + (size_t)(t + 2) * kstep; const char* b2 = last ? nB : cB + (size_t)(t + 2) * kstep;
            size_t g2[2][2];
#pragma unroll
            for (int h = 0; h < 2; ++h)
#pragma unroll
                for (int i = 0; i < 2; ++i) g2[h][i] = last ? gn[h][i] : gc[h][i];
            const char* a3 = a2 + kstep; const char* b3 = b2 + kstep;
            if (last && has_next) S.a_ready(nxt);
            PG8_LDB(B0, 0, 0); PG8_LDB(B1, 0, 1); PG8_SCHED; PG8_LDA(At, 0, 0); PG8_STAGEG(PG8_SA(1, 1), a1, gc[1]);
            PG8_WAIT_V(8); PG8_WAIT_L(0); PG8_BAR; PG8_MMA(0, 0, At, B0); PG8_MMA(0, 1, At, B1); PG8_BAR; PG8_SCHED;
            PG8_LDA(At, 0, 1); PG8_STAGE(PG8_SB(0, 0), b2, voffB); PG8_STAGE(PG8_SB(0, 1), b2 + hstepB, voffB); PG8_STAGEG(PG8_SA(0, 0), a2, g2[0]);
            PG8_WAIT_V(8); PG8_WAIT_L(0); PG8_BAR; PG8_MMA(1, 0, At, B0); PG8_MMA(1, 1, At, B1); PG8_BAR; PG8_SCHED;
            PG8_LDB(B0, 1, 0); PG8_LDB(B1, 1, 1); PG8_SCHED; PG8_LDA(At, 1, 0); PG8_STAGEG(PG8_SA(0, 1), a2, g2[1]);
            PG8_WAIT_V(8); PG8_WAIT_L(0); PG8_BAR; PG8_MMA(0, 0, At, B0); PG8_MMA(0, 1, At, B1); PG8_BAR; PG8_SCHED;
            PG8_LDA(At, 1, 1); PG8_STAGE(PG8_SB(1, 0), b3, voffB); PG8_STAGE(PG8_SB(1, 1), b3 + hstepB, voffB); PG8_STAGEG(PG8_SA(1, 0), a3, g2[0]);
            PG8_WAIT_V(8); PG8_WAIT_L(0); PG8_BAR; PG8_MMA(1, 0, At, B0); PG8_MMA(1, 1, At, B1); PG8_BAR; PG8_SCHED;
        }
        if constexpr (ALIGN_EPI) { if (wr == 0) PG8_BAR; }
        E(acc, cur, wr, wc, fr, fq); S.done(cur);
        if (!has_next) break;
#pragma unroll
        for (int a = 0; a < 2; ++a)
#pragma unroll
            for (int b = 0; b < 2; ++b)
#pragma unroll
                for (int m = 0; m < 4; ++m)
#pragma unroll
                    for (int n = 0; n < 2; ++n) acc[a][b][m][n] = (acc_t){0, 0, 0, 0};
        cur = nxt; cB = nB; ++ui;
#pragma unroll
        for (int h = 0; h < 2; ++h)
#pragma unroll
            for (int i = 0; i < 2; ++i) gc[h][i] = gn[h][i];
        if constexpr (ALIGN_EPI) { if (wr == 1) PG8_BAR; }
    }
    PG8_WAIT_V(0);
    if constexpr (!ALIGN_EPI) { if (wr == 0) PG8_BAR; }
    PG8_BAR;
#undef PG8_SA
#undef PG8_SB
#undef PG8_STAGE
#undef PG8_STAGEG
#undef PG8_GOFF
#undef PG8_LDA
#undef PG8_LDB
#undef PG8_MMA
#undef PG8_WAIT_V
#undef PG8_WAIT_L
#undef PG8_BAR
#undef PG8_SCHED
}

struct SUnit { int pm, pn, kind; const char* a; const char* b; int lda, K; };
template <class Epi, class Sched, bool ALIGN_EPI = false>
__device__ __forceinline__ void gemm_stream(LAS unsigned char* lds, const Sched& S, const Epi& E) {
    int tid_ = threadIdx.x; asm volatile("" : "+v"(tid_));
    const int tid = tid_, wid = __builtin_amdgcn_readfirstlane(tid >> 6), lane = tid & 63, wr = wid >> 2, wc = wid & 3, fr = lane & 15, fq = lane >> 4;
    int R0, C0; stage_rc(tid * 16, R0, C0); const int Rb0 = Epi::PERM ? ((R0 & ~31) + perm32(R0 & 31)) : R0;
    const size_t kstep = (size_t)(BK * 2);
    const unsigned ldsw = (unsigned)wid * 1024u;
    const int aoff = lds_byte(wr * 64 + fr, fq * 8), boff = lds_byte(wc * 32 + fr, fq * 8);
#define PG8_SA(b, h) (((b) * 2 + (h)) * HTB)
#define PG8_SB(b, h) ((4 + (b) * 2 + (h)) * HTB)
#define PG8_STG(bufoff, gbase, v0, p64) do { _Pragma("unroll") for (int _i = 0; _i < 2; ++_i) \
        __builtin_amdgcn_global_load_lds((const unsigned*)((const char*)(gbase) + (v0) + (size_t)_i * (p64)), (LAS unsigned*)(lds + (bufoff) + ldsw + _i * 8192), 16, 0, 0); } while (0)
#define PG8_LDA(dst, b, h) do { _Pragma("unroll") for (int m = 0; m < 4; ++m) _Pragma("unroll") for (int k = 0; k < 2; ++k) dst[m][k] = *(const LAS bf16x8*)(lds + PG8_SA(b, h) + aoff + m * 2048 + k * 1024); } while (0)
#define PG8_LDB(dst, b, h) do { _Pragma("unroll") for (int n = 0; n < 2; ++n) _Pragma("unroll") for (int k = 0; k < 2; ++k) dst[n][k] = *(const LAS bf16x8*)(lds + PG8_SB(b, h) + boff + n * 2048 + k * 1024); } while (0)
#define PG8_MMA(ai, bj, At, Bt) do { __builtin_amdgcn_s_setprio(1); _Pragma("unroll") for (int m = 0; m < 4; ++m) _Pragma("unroll") for (int n = 0; n < 2; ++n) _Pragma("unroll") for (int k = 0; k < 2; ++k) \
        acc[ai][bj][m][n] = mma16(Bt[n][k], At[m][k], acc[ai][bj][m][n]); __builtin_amdgcn_s_setprio(0); } while (0)
#define PG8_WAIT_V(n) asm volatile("s_waitcnt vmcnt(" #n ")" ::: "memory")
#define PG8_WAIT_L(n) asm volatile("s_waitcnt lgkmcnt(" #n ")" ::: "memory")
#define PG8_BAR __builtin_amdgcn_s_barrier()
#define PG8_SCHED __builtin_amdgcn_sched_barrier(0)
    SUnit cur, nxt; int ui = 0;
    if (!S.next(0, cur)) return;
    f32x4 acc[2][2][4][2];
#pragma unroll
    for (int a = 0; a < 2; ++a)
#pragma unroll
        for (int b = 0; b < 2; ++b)
#pragma unroll
            for (int m = 0; m < 4; ++m)
#pragma unroll
                for (int n = 0; n < 2; ++n) acc[a][b][m][n] = (f32x4){0.f, 0.f, 0.f, 0.f};
    bf16x8 At[4][2], B0[2][2], B1[2][2];
    const char* cA = cur.a; const char* cB = cur.b;
    unsigned vAc = (unsigned)(R0 * cur.lda + C0) * 2u, vBc = (unsigned)(Rb0 * cur.K + C0) * 2u;
    size_t pAc = (size_t)cur.lda * 128, pBc = (size_t)cur.K * 128;
    PG8_STG(PG8_SB(0, 0), cB, vBc, pBc); PG8_STG(PG8_SB(0, 1), cB + 2 * pBc, vBc, pBc); PG8_STG(PG8_SA(0, 0), cA, vAc, pAc); PG8_STG(PG8_SA(0, 1), cA + 2 * pAc, vAc, pAc);
    if (wr == 1) PG8_BAR;
    PG8_WAIT_V(2); PG8_BAR;
    PG8_STG(PG8_SB(1, 0), cB + kstep, vBc, pBc); PG8_STG(PG8_SA(1, 0), cA + kstep, vAc, pAc); PG8_STG(PG8_SB(1, 1), cB + 2 * pBc + kstep, vBc, pBc);
    PG8_WAIT_V(6); PG8_BAR;
    for (;;) {
        const bool has_next = S.next(ui + 1, nxt);
        const char* nA = has_next ? nxt.a : cA; const char* nB = has_next ? nxt.b : cB;
        const unsigned vAn = has_next ? (unsigned)(R0 * nxt.lda + C0) * 2u : vAc, vBn = has_next ? (unsigned)(Rb0 * nxt.K + C0) * 2u : vBc;
        const size_t pAn = has_next ? (size_t)nxt.lda * 128 : pAc, pBn = has_next ? (size_t)nxt.K * 128 : pBc;
        const int nt = cur.K / BK;
        for (int t = 0; t < nt; t += 2) {
            const bool last = (t == nt - 2);
            const char* a1 = cA + (size_t)(t + 1) * kstep;
            const char* a2 = last ? nA : cA + (size_t)(t + 2) * kstep; const char* b2 = last ? nB : cB + (size_t)(t + 2) * kstep;
            const char* a3 = a2 + kstep; const char* b3 = b2 + kstep;
            const unsigned va2 = last ? vAn : vAc, vb2 = last ? vBn : vBc; const size_t pa2 = last ? pAn : pAc, pb2 = last ? pBn : pBc;
            PG8_LDB(B0, 0, 0); PG8_LDB(B1, 0, 1); PG8_SCHED; PG8_LDA(At, 0, 0); PG8_STG(PG8_SA(1, 1), a1 + 2 * pAc, vAc, pAc);
            PG8_WAIT_V(8); PG8_WAIT_L(0); PG8_BAR; PG8_MMA(0, 0, At, B0); PG8_MMA(0, 1, At, B1); PG8_BAR; PG8_SCHED;
            PG8_LDA(At, 0, 1); PG8_STG(PG8_SB(0, 0), b2, vb2, pb2); PG8_STG(PG8_SB(0, 1), b2 + 2 * pb2, vb2, pb2); PG8_STG(PG8_SA(0, 0), a2, va2, pa2);
            PG8_WAIT_V(8); PG8_WAIT_L(0); PG8_BAR; PG8_MMA(1, 0, At, B0); PG8_MMA(1, 1, At, B1); PG8_BAR; PG8_SCHED;
            PG8_LDB(B0, 1, 0); PG8_LDB(B1, 1, 1); PG8_SCHED; PG8_LDA(At, 1, 0); PG8_STG(PG8_SA(0, 1), a2 + 2 * pa2, va2, pa2);
            PG8_WAIT_V(8); PG8_WAIT_L(0); PG8_BAR; PG8_MMA(0, 0, At, B0); PG8_MMA(0, 1, At, B1); PG8_BAR; PG8_SCHED;
            PG8_LDA(At, 1, 1); PG8_STG(PG8_SB(1, 0), b3, vb2, pb2); PG8_STG(PG8_SB(1, 1), b3 + 2 * pb2, vb2, pb2); PG8_STG(PG8_SA(1, 0), a3, va2, pa2);
            PG8_WAIT_V(8); PG8_WAIT_L(0); PG8_BAR; PG8_MMA(1, 0, At, B0); PG8_MMA(1, 1, At, B1); PG8_BAR; PG8_SCHED;
        }
        if constexpr (ALIGN_EPI) { if (wr == 0) PG8_BAR; }
#if defined(PROBE_EPI)
        { const unsigned long long te0_ = __builtin_amdgcn_s_memrealtime();
          E(acc, cur, wr, wc, fr, fq);
#if PROBE_EPI == 2
          asm volatile("s_waitcnt vmcnt(0)" ::: "memory");
#endif
          const unsigned long long dte_ = __builtin_amdgcn_s_memrealtime() - te0_, te1_ = __builtin_amdgcn_s_memrealtime();
          while (__builtin_amdgcn_s_memrealtime() - te1_ < 3 * dte_) __builtin_amdgcn_s_sleep(2); }
#else
        E(acc, cur, wr, wc, fr, fq);
#endif
        if (!has_next) break;
#pragma unroll
        for (int a = 0; a < 2; ++a)
#pragma unroll
            for (int b = 0; b < 2; ++b)
#pragma unroll
                for (int m = 0; m < 4; ++m)
#pragma unroll
                    for (int n = 0; n < 2; ++n) acc[a][b][m][n] = (f32x4){0.f, 0.f, 0.f, 0.f};
        cur = nxt; cA = nA; cB = nB; vAc = vAn; vBc = vBn; pAc = pAn; pBc = pBn; ++ui;
        if constexpr (ALIGN_EPI) { if (wr == 1) PG8_BAR; }
    }
    PG8_WAIT_V(0);
    if constexpr (!ALIGN_EPI) { if (wr == 0) PG8_BAR; }
    PG8_BAR;
#undef PG8_SA
#undef PG8_SB
#undef PG8_STG
#undef PG8_LDA
#undef PG8_LDB
#undef PG8_MMA
#undef PG8_WAIT_V
#undef PG8_WAIT_L
#undef PG8_BAR
#undef PG8_SCHED
}
}

namespace epi {
using pg8::Unit; using pg8::BM; using pg8::HALF;
__device__ __forceinline__ u32x4 pk8(const f32x4 v0, const f32x4 v1) { u32x4 w; w.x = pk2(v0[0], v0[1]); w.y = pk2(v0[2], v0[3]); w.z = pk2(v1[0], v1[1]); w.w = pk2(v1[2], v1[3]); return w; }
__device__ __forceinline__ void up8(const u32x4 w, f32x4& a, f32x4& b) { a = (f32x4){bflo(w.x), bfhi(w.x), bflo(w.y), bfhi(w.y)}; b = (f32x4){bflo(w.z), bfhi(w.z), bflo(w.w), bfhi(w.w)}; }
__device__ __forceinline__ int gcol(int tg) { return tg < 6 ? 256 * tg : 2816 + 256 * (tg - 6); }

struct Bf16Out {
    static constexpr bool PERM = true;
    bf16* O; int ldc;
    __device__ __forceinline__ void operator()(const f32x4 (&acc)[2][2][4][2], const Unit& u, int wr, int wc, int fr, int fq) const {
        const int row0 = u.pm * BM + wr * 64 + fr, col0 = u.pn * BM + wc * 32 + 8 * fq;
#pragma unroll
        for (int ai = 0; ai < 2; ++ai)
#pragma unroll
            for (int m = 0; m < 4; ++m) { bf16* rowp = O + (size_t)(row0 + ai * HALF + m * 16) * ldc + col0;
#pragma unroll
                for (int bj = 0; bj < 2; ++bj) *(u32x4*)(rowp + bj * HALF) = pk8(acc[ai][bj][m][0], acc[ai][bj][m][1]); }
    }
};
struct SigOut {
    static constexpr bool PERM = true;
    bf16* PROJ;
    __device__ __forceinline__ void operator()(const f32x4 (&acc)[2][2][4][2], const Unit& u, int wr, int wc, int fr, int fq) const {
        const int row0 = u.pm * BM + wr * 64 + fr, col0 = gcol(u.pn) + wc * 32 + 8 * fq;
#pragma unroll
        for (int ai = 0; ai < 2; ++ai)
#pragma unroll
            for (int m = 0; m < 4; ++m) { bf16* rowp = PROJ + (size_t)(row0 + ai * HALF + m * 16) * PP + col0;
#pragma unroll
                for (int bj = 0; bj < 2; ++bj) { f32x4 a = acc[ai][bj][m][0], b = acc[ai][bj][m][1];
#pragma unroll
                    for (int e = 0; e < 4; ++e) { a[e] = sigmoidf_(a[e]); b[e] = sigmoidf_(b[e]); }
                    *(u32x4*)(rowp + bj * HALF) = pk8(a, b); } }
    }
};
template <int BR> struct BranchOut {
    static constexpr bool PERM = true;
    const bf16* PROJ; bf16* T; bf16* OUT;
    __device__ __forceinline__ void operator()(const f32x4 (&acc)[2][2][4][2], const Unit& u, int wr, int wc, int fr, int fq) const {
        const int row0 = u.pm * BM + wr * 64 + fr, cw = wc * 32 + 8 * fq, gc0 = gcol(BR * 4 + u.pn) + cw, col0 = u.pn * BM + cw;
#pragma unroll
        for (int ai = 0; ai < 2; ++ai)
#pragma unroll
            for (int m = 0; m < 4; ++m) { const size_t row = (size_t)(row0 + ai * HALF + m * 16);
#pragma unroll
                for (int bj = 0; bj < 2; ++bj) {
                    f32x4 g0, g1; up8(*(const u32x4*)(PROJ + row * PP + gc0 + bj * HALF), g0, g1);
                    f32x4 v0 = g0 * acc[ai][bj][m][0], v1 = g1 * acc[ai][bj][m][1];
                    if (BR > 0) { f32x4 t0, t1; up8(*(const u32x4*)(T + row * 1024 + col0 + bj * HALF), t0, t1); v0 += t0; v1 += t1; }
                    bf16* dst = (BR == 2 ? OUT : T) + row * 1024 + col0 + bj * HALF;
                    *(u32x4*)dst = pk8(v0, v1); } }
    }
};
struct GateBranchOut {
    static constexpr bool PERM = true;
    bf16* PROJ; bf16* T;
    __device__ __forceinline__ void operator()(const f32x4 (&acc)[2][2][4][2], const pg8::SUnit& u, int wr, int wc, int fr, int fq) const {
        const int row0 = u.pm * BM + wr * 64 + fr, cw = wc * 32 + 8 * fq;
        if (u.kind < 3) {
            const int col0 = gcol(u.kind * 4 + u.pn) + cw;
#pragma unroll
            for (int ai = 0; ai < 2; ++ai)
#pragma unroll
                for (int m = 0; m < 4; ++m) { bf16* rowp = PROJ + (size_t)(row0 + ai * HALF + m * 16) * PP + col0;
#pragma unroll
                    for (int bj = 0; bj < 2; ++bj) { f32x4 a = acc[ai][bj][m][0], b = acc[ai][bj][m][1];
#pragma unroll
                        for (int e = 0; e < 4; ++e) { a[e] = sigmoidf_(a[e]); b[e] = sigmoidf_(b[e]); }
                        *(u32x4*)(rowp + bj * HALF) = pk8(a, b); } }
        } else {
            const int br = u.kind - 3, gc0 = gcol(br * 4 + u.pn) + cw, col0 = u.pn * BM + cw;
#pragma unroll
            for (int ai = 0; ai < 2; ++ai)
#pragma unroll
                for (int m = 0; m < 4; ++m) { const size_t row = (size_t)(row0 + ai * HALF + m * 16);
#pragma unroll
                    for (int bj = 0; bj < 2; ++bj) {
                        f32x4 g0, g1; up8(*(const u32x4*)(PROJ + row * PP + gc0 + bj * HALF), g0, g1);
                        f32x4 v0 = g0 * acc[ai][bj][m][0], v1 = g1 * acc[ai][bj][m][1];
                        bf16* tp = T + row * 1024 + col0 + bj * HALF;
                        if (br > 0) { f32x4 t0, t1; up8(*(const u32x4*)tp, t0, t1); v0 += t0; v1 += t1; }
                        *(u32x4*)tp = pk8(v0, v1); } }
        }
    }
};
struct ResidOut {
    static constexpr bool PERM = false;
    const float* SRC; float* DST;
    __device__ __forceinline__ void operator()(const f32x4 (&acc)[2][2][4][2], const Unit& u, int wr, int wc, int fr, int fq) const {
        const int row0 = u.pm * BM + wr * 64 + fr, col0 = u.pn * BM + wc * 32 + 4 * fq;
#pragma unroll
        for (int ai = 0; ai < 2; ++ai)
#pragma unroll
            for (int m = 0; m < 4; ++m) { const size_t off = (size_t)(row0 + ai * HALF + m * 16) * 1024 + col0;
#pragma unroll
                for (int bj = 0; bj < 2; ++bj)
#pragma unroll
                    for (int n = 0; n < 2; ++n) { const size_t o = off + bj * HALF + n * 16; *(f32x4*)(DST + o) = *(const f32x4*)(SRC + o) + acc[ai][bj][m][n]; } }
    }
};
template <bool SRC_F32> struct ResidBfOut {
    static constexpr bool PERM = true;
    const void* SRC; bf16* DST; float* SSQ;
    __device__ __forceinline__ void operator()(const f32x4 (&acc)[2][2][4][2], const Unit& u, int wr, int wc, int fr, int fq) const {
        const int row0 = u.pm * BM + wr * 64 + fr, col0 = u.pn * BM + wc * 32 + 8 * fq;
#pragma unroll
        for (int ai = 0; ai < 2; ++ai)
#pragma unroll
            for (int m = 0; m < 4; ++m) { const int row = row0 + ai * HALF + m * 16; const size_t off = (size_t)row * 1024 + col0; float ss = 0.f;
#pragma unroll
                for (int bj = 0; bj < 2; ++bj) { const size_t o = off + bj * HALF; f32x4 s0, s1;
                    if (SRC_F32) { s0 = *(const f32x4*)((const float*)SRC + o); s1 = *(const f32x4*)((const float*)SRC + o + 4); } else up8(*(const u32x4*)((const bf16*)SRC + o), s0, s1);
                    const f32x4 v0 = s0 + acc[ai][bj][m][0], v1 = s1 + acc[ai][bj][m][1];
                    ss += ((v0[0] * v0[0] + v0[1] * v0[1]) + (v0[2] * v0[2] + v0[3] * v0[3])) + ((v1[0] * v1[0] + v1[1] * v1[1]) + (v1[2] * v1[2] + v1[3] * v1[3]));
                    *(u32x4*)(DST + o) = pk8(v0, v1); }
                if (SSQ) { ss += __shfl_xor(ss, 16); ss += __shfl_xor(ss, 32); if (fq == 0) SSQ[(size_t)row * 16 + u.pn * 4 + wc] = ss; } }
    }
};
struct Bf16OutRs {
    static constexpr bool PERM = true;
    bf16* O; int ldc; const float* SSQ;
    __device__ __forceinline__ void operator()(const f32x4 (&acc)[2][2][4][2], const Unit& u, int wr, int wc, int fr, int fq) const {
        const int row0 = u.pm * BM + wr * 64 + fr, col0 = u.pn * BM + wc * 32 + 8 * fq;
#pragma unroll
        for (int ai = 0; ai < 2; ++ai)
#pragma unroll
            for (int m = 0; m < 4; ++m) { const int row = row0 + ai * HALF + m * 16; const f32x4* sp = (const f32x4*)(SSQ + (size_t)row * 16);
                const f32x4 s0 = sp[0], s1 = sp[1], s2 = sp[2], s3 = sp[3]; const f32x4 st = (s0 + s1) + (s2 + s3);
                const float rs = 1.f / sqrtf(((st[0] + st[1]) + (st[2] + st[3])) * (1.f / 1024.f) + EPS); bf16* rowp = O + (size_t)row * ldc + col0;
#pragma unroll
                for (int bj = 0; bj < 2; ++bj) *(u32x4*)(rowp + bj * HALF) = pk8(acc[ai][bj][m][0] * rs, acc[ai][bj][m][1] * rs); }
    }
};
struct GluOut {
    static constexpr bool PERM = true;
    bf16* HID;
    __device__ __forceinline__ void operator()(const f32x4 (&acc)[2][2][4][2], const Unit& u, int wr, int wc, int fr, int fq) const {
        const int row0 = u.pm * BM + wr * 64 + fr, col0 = (u.pn & 3) * 128 + wc * 32 + 8 * fq;
#pragma unroll
        for (int ai = 0; ai < 2; ++ai)
#pragma unroll
            for (int m = 0; m < 4; ++m) { f32x4 a = acc[ai][0][m][0], b = acc[ai][0][m][1]; const f32x4 ua = acc[ai][1][m][0], ub = acc[ai][1][m][1];
#pragma unroll
                for (int e = 0; e < 4; ++e) { a[e] = siluf_(a[e]) * ua[e]; b[e] = siluf_(b[e]) * ub[e]; }
                *(u32x4*)(HID + (size_t)(row0 + ai * HALF + m * 16) * DFF + col0) = pk8(a, b); }
    }
};
struct DownOut {
    static constexpr bool PERM = true;
    bf16* YE; const float* WROW;
    __device__ __forceinline__ void operator()(const f32x4 (&acc)[2][2][4][2], const Unit& u, int wr, int wc, int fr, int fq) const {
        const int row0 = u.pm * BM + wr * 64 + fr, col0 = (u.pn & 3) * BM + wc * 32 + 8 * fq;
#pragma unroll
        for (int ai = 0; ai < 2; ++ai)
#pragma unroll
            for (int m = 0; m < 4; ++m) { const int row = row0 + ai * HALF + m * 16; const float w = WROW[row]; bf16* rowp = YE + (size_t)row * 1024 + col0;
#pragma unroll
                for (int bj = 0; bj < 2; ++bj) *(u32x4*)(rowp + bj * HALF) = pk8(acc[ai][bj][m][0] * w, acc[ai][bj][m][1] * w); }
    }
};
}

struct MoeOrder {
    const LAS int* tab; int G, c;
    __device__ __forceinline__ bool next(int i, pg8::Unit& u) const {
        const int nT = tab[176];
        if (G % 8 != 0) { const int L = i * G + c; if (L >= 4 * nT) return false; const int pm = L >> 2; u.pm = pm; u.pn = tab[pm] * 4 + (L & 3); return true; }
        const int x = c & 7, j = c >> 3, per = G >> 3;
        const int t0 = (nT * x) >> 3, t1 = (nT * (x + 1)) >> 3;
        const int idx = i * per + j; if (idx >= 4 * (t1 - t0)) return false;
        const int pm = t0 + (idx >> 2); u.pm = pm; u.pn = tab[pm] * 4 + (idx & 3); return true;
    }
    __device__ __forceinline__ void a_ready(const pg8::Unit&) const {}
    __device__ __forceinline__ void done(const pg8::Unit&) const {}
};
#define XB_TMO      128
#define XB_XCNT(j)  (256  + 64 * (j))
#define XB_XSUB(j)  (1280 + 64 * (j))
#define XB_XGEN(j)  (2304 + 64 * (j))
#define XB_TOP      3328
#define XB_TOPGEN   3392
#define XCD_BAR_WORDS 3456
#define XB_SPIN_CAP (1u << 18)

__device__ __forceinline__ unsigned xb_ld(unsigned* p)              { return __hip_atomic_load(p, __ATOMIC_RELAXED, __HIP_MEMORY_SCOPE_AGENT); }
__device__ __forceinline__ unsigned xb_add(unsigned* p, unsigned v) { return __hip_atomic_fetch_add(p, v, __ATOMIC_RELAXED, __HIP_MEMORY_SCOPE_AGENT); }
__device__ __forceinline__ unsigned xb_xcc_id() { return (unsigned)__builtin_amdgcn_s_getreg((3 << 11) | 20) & 0xFu; }
#define XB_SPIN(cond, bar) do { unsigned _sp = 0; while (cond) { __builtin_amdgcn_s_sleep(1); \
    if ((++_sp & 255u) == 0u) { if (xb_ld(&(bar)[XB_TMO])) break; if (_sp > XB_SPIN_CAP) { atomicAdd(&(bar)[XB_TMO], 1u); break; } } } } while (0)

struct XcdBarrier {
    unsigned* bar; unsigned x;
    volatile LAS unsigned* st;
};

__device__ __forceinline__ XcdBarrier xcd_barrier_post(unsigned* bar, volatile LAS unsigned* st) {
    XcdBarrier b; b.bar = bar; b.x = xb_xcc_id(); b.st = st;
    if (threadIdx.x == 0) (void)xb_add(&bar[XB_XCNT(b.x)], 1u);
    return b;
}
__device__ __forceinline__ void xcd_barrier_complete(unsigned* bar, unsigned x, unsigned& nloc, unsigned& nx) {
    const unsigned G = gridDim.x * gridDim.y * gridDim.z;
    unsigned sum, cnt, mine, sp = 0u;
    for (;;) {
        sum = 0u; cnt = 0u; mine = 0u;
#pragma unroll
        for (unsigned j = 0; j < 16; ++j) { const unsigned c = xb_ld(&bar[XB_XCNT(j)]); sum += c; cnt += (c > 0u) ? 1u : 0u; mine = (j == x) ? c : mine; }
        if (sum == G) break;
        __builtin_amdgcn_s_sleep(1);
        if ((++sp & 255u) == 0u) { if (xb_ld(&bar[XB_TMO])) break; if (sp > XB_SPIN_CAP) { atomicAdd(&bar[XB_TMO], 1u); break; } }
    }
    nloc = mine > 0u ? mine : 1u; nx = cnt > 0u ? cnt : 1u;
}

__device__ __forceinline__ void xcd_barrier(const XcdBarrier& b) {
    asm volatile("s_waitcnt vmcnt(0)" ::: "memory");
    __syncthreads();
    if (threadIdx.x == 0) {
        unsigned* bar = b.bar;
        __builtin_amdgcn_s_waitcnt(0);
        unsigned nloc = b.st[0], nx = b.st[1];
        if (nloc == 0u) { xcd_barrier_complete(bar, b.x, nloc, nx); b.st[0] = nloc; b.st[1] = nx; }
        const unsigned old = xb_add(&bar[XB_XSUB(b.x)], 1u);
        const unsigned gen = old / nloc;
        if (old + 1u == (gen + 1u) * nloc) {
            __builtin_amdgcn_fence(__ATOMIC_RELEASE, "agent");
            asm volatile("s_waitcnt vmcnt(0)" ::: "memory");
            const unsigned og = xb_add(&bar[XB_TOP], 1u);
            const unsigned tg = og / nx;
            if (og + 1u == (tg + 1u) * nx) xb_add(&bar[XB_TOPGEN], 1u);
            else XB_SPIN(xb_ld(&bar[XB_TOPGEN]) == tg, bar);
            __builtin_amdgcn_fence(__ATOMIC_ACQUIRE, "agent");
            xb_add(&bar[XB_XGEN(b.x)], 1u);
            asm volatile("s_waitcnt vmcnt(0)" ::: "memory");
        } else {
            XB_SPIN(xb_ld(&bar[XB_XGEN(b.x)]) == gen, bar);
            __builtin_amdgcn_fence(__ATOMIC_ACQUIRE, "agent");
            asm volatile("s_waitcnt vmcnt(0)" ::: "memory");
        }
    }
    __syncthreads();
}

struct Params { const float* in[28]; float* out; unsigned char* ws; };
enum { I_X = 0, I_MEM, I_NORM_MIX, I_W_IN, I_CONV, I_GATE_B, I_MLSTM_NORM, I_ATTN_QKN, I_GMLP_NORM, I_GMLP_WS, I_GMLP_BS, I_WBA, I_WBB, I_WBC, I_WOUT, I_REL_BIAS,
       I_NORM_XATTN, I_NORM_MEM, I_WXQ, I_WXKV, I_XATTN_QKN, I_WXO, I_NORM_FFN, I_ROUTER_W, I_ROUTER_B, I_EG, I_EU, I_ED };

struct Ctx {
    LAS unsigned char* lds;
    unsigned char* ws;
    int tid, lane, wave, vcu, G, bx;
};
template <class T> __device__ __forceinline__ T* wsp(const Ctx& c, size_t off) { return (T*)(c.ws + off); }

__device__ const unsigned char REL_BUCKET[3][132] = {
  {0,1,2,3,4,5,6,7,8,9,10,11,12,13,14,15,16,16,16,16,16,16,17,17,17,17,17,17,17,17,18,18,18,18,18,18,18,18,18,18,19,19,19,19,19,19,19,19,19,19,19,19,19,19,20,20,20,20,20,20,20,20,20,20,20,20,20,20,20,20,20,20,20,21,21,21,21,21,21,21,21,21,21,21,21,21,21,21,21,21,21,21,21,21,21,21,21,21,21,22,22,22,22,22,22,22,22,22,22,22,22,22,22,22,22,22,22,22,22,22,22,22,22,22,22,22,22,22,22,0,0,0},
  {0,4,8,12,16,16,17,17,18,18,19,19,19,19,20,20,20,20,20,21,21,21,21,21,21,22,22,22,22,22,22,22,22,22,23,23,23,23,23,23,23,23,23,23,23,23,24,24,24,24,24,24,24,24,24,24,24,24,24,24,24,24,25,25,25,25,25,25,25,25,25,25,25,25,25,25,25,25,25,25,25,25,25,26,26,26,26,26,26,26,26,26,26,26,26,26,26,26,26,26,26,26,26,26,26,26,26,26,26,26,26,26,26,27,27,27,27,27,27,27,27,27,27,27,27,27,27,27,27,0,0,0},
  {0,16,18,19,20,21,21,22,22,23,23,23,24,24,24,24,25,25,25,25,25,26,26,26,26,26,26,26,26,27,27,27,27,27,27,27,27,27,27,28,28,28,28,28,28,28,28,28,28,28,28,28,29,29,29,29,29,29,29,29,29,29,29,29,29,29,29,29,29,29,30,30,30,30,30,30,30,30,30,30,30,30,30,30,30,30,30,30,30,30,30,30,30,30,30,31,31,31,31,31,31,31,31,31,31,31,31,31,31,31,31,31,31,31,31,31,31,31,31,31,31,31,31,31,31,31,31,31,31,0,0,0}};

template <class RowMap>
__device__ __forceinline__ void tr_item(const float* W, int ldw, int c0, const float* gain, bf16* WT, int K, LAS float* scr, int kb, int nb, int lane, RowMap rm) {
    const int k0 = 64 * kb, n0 = 64 * nb, lr = lane >> 4, lc = 4 * (lane & 15);
    f32x4 v[16];
#pragma unroll
    for (int i = 0; i < 16; ++i) v[i] = *(const f32x4*)(W + (size_t)(k0 + 4 * i + lr) * ldw + c0 + n0 + lc);
#pragma unroll
    for (int i = 0; i < 16; ++i) { const int kk = 4 * i + lr; const float gg = gain ? gain[k0 + kk] : 1.f; LAS float* s = scr + kk * 65 + lc; s[0] = v[i].x * gg; s[1] = v[i].y * gg; s[2] = v[i].z * gg; s[3] = v[i].w * gg; }
    LDS_WAIT(); asm volatile("" ::: "memory");
    const int c = lane & 7;
#pragma unroll
    for (int j = 0; j < 8; ++j) { const int n = (lane >> 3) + 8 * j; const LAS float* s = scr + (8 * c) * 65 + n;
        u32x4 o; o.x = pk2(s[0 * 65], s[1 * 65]); o.y = pk2(s[2 * 65], s[3 * 65]); o.z = pk2(s[4 * 65], s[5 * 65]); o.w = pk2(s[6 * 65], s[7 * 65]);
        *(u32x4*)(WT + (size_t)rm(n0 + n) * K + k0 + 8 * c) = o; }
    LDS_WAIT(); asm volatile("" ::: "memory");
}
struct RmId { int off; __device__ __forceinline__ int operator()(int n) const { return off + n; } };
struct RmGate { __device__ __forceinline__ int operator()(int n) const { return (n >> 7) * 256 + (n & 127); } };
struct RmUp { __device__ __forceinline__ int operator()(int n) const { return (n >> 7) * 256 + 128 + (n & 127); } };

__device__ __forceinline__ void phase_weights(const Ctx& c, const Params& p, int l) {
    LAS float* scr = (LAS float*)(c.lds + c.wave * 16640);
    const int gw = c.vcu * 8 + c.wave, NGW = c.G * 8;
    const float* w_in = p.in[I_W_IN] + (size_t)l * D * NIN;
    constexpr int N1 = 16 * 32, N2 = 16 * 52, N3 = 16 * 48, N4 = 8 * 16, N5 = 12 * 16, N6 = 8 * 16, N7 = 16 * 16, N8 = 16 * 8, N9 = 16 * 16, N10 = 8 * 16, NE = 16 * 8, NDN = 8 * 16;
    constexpr int NITEMS = N1 + N2 + N3 + N4 + N5 + N6 + N7 + N8 + N9 + N10 + 16 * NE * 2 + 16 * NDN;
    for (int it = gw; it < NITEMS; it += NGW) {
        int r = it;
        if (r < N1) { tr_item(w_in, NIN, 0, p.in[I_NORM_MIX] + l * D, wsp<bf16>(c, OFF_WIN1), D, scr, r / 32, r % 32, c.lane, RmId{0}); continue; } r -= N1;
        if (r < N2) { tr_item(w_in, NIN, 2056, p.in[I_NORM_MIX] + l * D, wsp<bf16>(c, OFF_WIN1), D, scr, r / 52, r % 52, c.lane, RmId{2048}); continue; } r -= N2;
        if (r < N3) { tr_item(w_in, NIN, 5384, p.in[I_NORM_MIX] + l * D, wsp<bf16>(c, OFF_WG), D, scr, r / 48, r % 48, c.lane, RmId{0}); continue; } r -= N3;
        if (r < N4) { tr_item(p.in[I_WBA] + (size_t)l * 512 * 1024, 1024, 0, nullptr, wsp<bf16>(c, OFF_WA), 512, scr, r / 16, r % 16, c.lane, RmId{0}); continue; } r -= N4;
        if (r < N5) { tr_item(p.in[I_WBB] + (size_t)l * 768 * 1024, 1024, 0, nullptr, wsp<bf16>(c, OFF_WB), 768, scr, r / 16, r % 16, c.lane, RmId{0}); continue; } r -= N5;
        if (r < N6) { tr_item(p.in[I_WBC] + (size_t)l * 512 * 1024, 1024, 0, nullptr, wsp<bf16>(c, OFF_WC), 512, scr, r / 16, r % 16, c.lane, RmId{0}); continue; } r -= N6;
        if (r < N7) { tr_item(p.in[I_WOUT] + (size_t)l * 1024 * 1024, 1024, 0, nullptr, wsp<bf16>(c, OFF_WOUT), 1024, scr, r / 16, r % 16, c.lane, RmId{0}); continue; } r -= N7;
        if (r < N8) { tr_item(p.in[I_WXQ] + (size_t)l * 1024 * 512, 512, 0, p.in[I_NORM_XATTN] + l * D, wsp<bf16>(c, OFF_WXQ), 1024, scr, r / 8, r % 8, c.lane, RmId{0}); continue; } r -= N8;
        if (r < N9) { tr_item(p.in[I_WXKV] + (size_t)l * 1024 * 1024, 1024, 0, p.in[I_NORM_MEM] + l * D, wsp<bf16>(c, OFF_WXKV), 1024, scr, r / 16, r % 16, c.lane, RmId{0}); continue; } r -= N9;
        if (r < N10) { tr_item(p.in[I_WXO] + (size_t)l * 512 * 1024, 1024, 0, nullptr, wsp<bf16>(c, OFF_WXO), 512, scr, r / 16, r % 16, c.lane, RmId{0}); continue; } r -= N10;
        if (r < 16 * NE) { const int e = r / NE, rr = r % NE; tr_item(p.in[I_EG] + ((size_t)l * 16 + e) * 1024 * 512, 512, 0, p.in[I_NORM_FFN] + l * D, wsp<bf16>(c, OFF_WGU) + (size_t)e * 1024 * 1024, 1024, scr, rr / 8, rr % 8, c.lane, RmGate{}); continue; } r -= 16 * NE;
        if (r < 16 * NE) { const int e = r / NE, rr = r % NE; tr_item(p.in[I_EU] + ((size_t)l * 16 + e) * 1024 * 512, 512, 0, p.in[I_NORM_FFN] + l * D, wsp<bf16>(c, OFF_WGU) + (size_t)e * 1024 * 1024, 1024, scr, rr / 8, rr % 8, c.lane, RmUp{}); continue; } r -= 16 * NE;
        { const int e = r / NDN, rr = r % NDN; tr_item(p.in[I_ED] + ((size_t)l * 16 + e) * 512 * 1024, 1024, 0, nullptr, wsp<bf16>(c, OFF_WD) + (size_t)e * 1024 * 512, 512, scr, rr / 16, rr % 16, c.lane, RmId{0}); }
    }
}

__device__ __forceinline__ void row_norm_store(f32x4 (&v)[4], bf16* xbrow, int lane) {
    float s = 0.f;
#pragma unroll
    for (int j = 0; j < 4; ++j) s += (v[j].x * v[j].x + v[j].y * v[j].y) + (v[j].z * v[j].z + v[j].w * v[j].w);
    const float rs = 1.f / sqrtf(wave_sum(s) * (1.f / D) + EPS);
    unsigned long long* o8 = (unsigned long long*)xbrow + lane;
#pragma unroll
    for (int j = 0; j < 4; ++j) { v[j] = v[j] * rs; o8[64 * j] = (unsigned long long)pk2(v[j].x, v[j].y) | ((unsigned long long)pk2(v[j].z, v[j].w) << 32); }
}
__device__ __forceinline__ void row_gates(const f32x4 (&v)[4], const LAS float* W8t, const float* gate_b, float* gates_row, int lane) {
    float a[8];
#pragma unroll
    for (int q = 0; q < 8; ++q) { float s = 0.f;
#pragma unroll
        for (int j = 0; j < 4; ++j) { const f32x4 w = *(const LAS f32x4*)(W8t + q * 1024 + 256 * j + 4 * lane); s += (v[j].x * w.x + v[j].y * w.y) + (v[j].z * w.z + v[j].w * w.w); }
        a[q] = wave_sum(s); if ((q & 3) == 3) __builtin_amdgcn_sched_barrier(0); }
    if (lane == 0) {
#pragma unroll
        for (int q = 0; q < 8; ++q) gates_row[q] = a[q] + gate_b[q]; }
}
__device__ __forceinline__ void load_w8(const Ctx& c, const Params& p, int l) {
    LAS float* W8t = (LAS float*)c.lds; const float* w_in = p.in[I_W_IN] + (size_t)l * D * NIN; const float* g = p.in[I_NORM_MIX] + l * D;
    for (int idx = c.tid; idx < D * 8; idx += 512) { const int k = idx >> 3, q = idx & 7; W8t[q * 1024 + k] = w_in[(size_t)k * NIN + 2048 + q] * g[k]; }
    __syncthreads();
}
__device__ __forceinline__ void phase_rp0_input(const Ctx& c, const Params& p) {
    load_w8(c, p, 0);
    const int gw = c.vcu * 8 + c.wave, NGW = c.G * 8;
    const float* x = p.in[I_X];
    for (int m = gw; m < M; m += NGW) {
        f32x4 v[4]; const f32x4* xr = (const f32x4*)(x + (size_t)m * D) + c.lane;
#pragma unroll
        for (int j = 0; j < 4; ++j) v[j] = xr[64 * j];
        row_norm_store(v, wsp<bf16>(c, WS_XB) + (size_t)m * D, c.lane);
        row_gates(v, (const LAS float*)c.lds, p.in[I_GATE_B], wsp<float>(c, OFF_GATES) + (size_t)m * 8, c.lane);
    }
    const float* mem = p.in[I_MEM];
    for (int m = gw; m < MM; m += NGW) {
        f32x4 v[4]; const f32x4* xr = (const f32x4*)(mem + (size_t)m * D) + c.lane;
#pragma unroll
        for (int j = 0; j < 4; ++j) v[j] = xr[64 * j];
        row_norm_store(v, wsp<bf16>(c, OFF_MEMB) + (size_t)m * D, c.lane);
    }
    if (c.bx == 0) { float* bt = wsp<float>(c, OFF_BIAS); const float* rb = p.in[I_REL_BIAS];
        for (int idx = c.tid; idx < 12 * 132; idx += 512) { const int h = idx / 132, dist = idx % 132; bt[idx] = rb[(int)REL_BUCKET[h >> 2][dist] * 12 + h]; } }
}
__device__ __forceinline__ void phase_rp1(const Ctx& c, const float* X) {
    const int gw = c.vcu * 8 + c.wave, NGW = c.G * 8;
    for (int m = gw; m < M; m += NGW) {
        f32x4 v[4]; const f32x4* xr = (const f32x4*)(X + (size_t)m * D) + c.lane;
#pragma unroll
        for (int j = 0; j < 4; ++j) v[j] = xr[64 * j];
        row_norm_store(v, wsp<bf16>(c, WS_XB) + (size_t)m * D, c.lane);
    }
}
__device__ __forceinline__ void phase_rp2_route(const Ctx& c, const Params& p, int l, const bf16* X) {
    LAS float* RWt = (LAS float*)c.lds;
    { const float* rw = p.in[I_ROUTER_W]; const float* g = p.in[I_NORM_FFN] + l * D;
      for (int idx = c.tid; idx < D * 16; idx += 512) RWt[(idx & 15) * 1024 + (idx >> 4)] = rw[idx] * g[idx >> 4];
      __syncthreads(); }
    const int gw = c.vcu * 8 + c.wave, NGW = c.G * 8;
    LAS unsigned* lcnt = (LAS unsigned*)(c.lds + LDS_TAB);
    if (c.tid < 16) lcnt[c.tid] = 0u;
    __syncthreads();
    const float* rbias = p.in[I_ROUTER_B];
    for (int m = gw; m < M; m += NGW) {
        f32x4 v[4]; const u32x2* xr = (const u32x2*)(X + (size_t)m * D) + c.lane;
#pragma unroll
        for (int j = 0; j < 4; ++j) { const u32x2 w = xr[64 * j]; v[j] = (f32x4){bflo(w.x), bfhi(w.x), bflo(w.y), bfhi(w.y)}; }
        row_norm_store(v, wsp<bf16>(c, WS_XB) + (size_t)m * D, c.lane);
        float a[16];
#pragma unroll
        for (int q = 0; q < 16; ++q) { float s = 0.f;
#pragma unroll
            for (int j = 0; j < 4; ++j) { const f32x4 w = *(const LAS f32x4*)(RWt + q * 1024 + 256 * j + 4 * c.lane); s += (v[j].x * w.x + v[j].y * w.y) + (v[j].z * w.z + v[j].w * w.w); }
            a[q] = s; if ((q & 3) == 3) __builtin_amdgcn_sched_barrier(0); }
        float mx = -3.0e38f;
#pragma unroll
        for (int q = 0; q < 16; ++q) { a[q] = wave_sum(a[q]) + rbias[q]; mx = fmaxf(mx, a[q]); }
#pragma unroll
        for (int q = 0; q < 16; ++q) a[q] = __expf(a[q] - mx);
        float bs = -1.f, p1 = 0.f, p2 = 0.f; int e1 = 0, e2 = 1;
#pragma unroll
        for (int g = 0; g < 4; ++g) {
            const float q0 = a[4 * g], q1 = a[4 * g + 1], q2 = a[4 * g + 2], q3 = a[4 * g + 3];
            int i1 = 0; float m1 = q0; if (q1 > m1) { m1 = q1; i1 = 1; } if (q2 > m1) { m1 = q2; i1 = 2; } if (q3 > m1) { m1 = q3; i1 = 3; }
            int i2 = -1; float m2 = -1.f;
            if (i1 != 0 && q0 > m2) { m2 = q0; i2 = 0; } if (i1 != 1 && q1 > m2) { m2 = q1; i2 = 1; } if (i1 != 2 && q2 > m2) { m2 = q2; i2 = 2; } if (i1 != 3 && q3 > m2) { m2 = q3; i2 = 3; }
            const float sc = m1 + m2;
            if (sc > bs) { bs = sc; e1 = 4 * g + i1; e2 = 4 * g + i2; p1 = m1; p2 = m2; }
        }
        if (c.lane == 0) {
            const float inv = 1.f / (p1 + p2);
            const unsigned pos1 = __hip_atomic_fetch_add(lcnt + e1, 1u, __ATOMIC_RELAXED, __HIP_MEMORY_SCOPE_WORKGROUP), pos2 = __hip_atomic_fetch_add(lcnt + e2, 1u, __ATOMIC_RELAXED, __HIP_MEMORY_SCOPE_WORKGROUP);
            int* te = wsp<int>(c, OFF_TOKE) + 2 * m; int* tp = wsp<int>(c, OFF_TOKP) + 2 * m; float* tw = wsp<float>(c, OFF_TOKW) + 2 * m;
            te[0] = e1; te[1] = e2; tp[0] = (int)pos1; tp[1] = (int)pos2; tw[0] = p1 * inv; tw[1] = p2 * inv;
        }
    }
    __syncthreads();
    if (c.tid < 16) wsp<unsigned>(c, OFF_CNTW)[c.vcu * 16 + c.tid] = lcnt[c.tid];
}
template <bool WITH_OFF>
__device__ __forceinline__ void moe_tables(const Ctx& c) {
    LAS int* tab = (LAS int*)(c.lds + LDS_TAB); LAS int* woff = (LAS int*)(c.lds + LDS_WOFF); LAS int* tot = tab + 180;
    const unsigned* cw = wsp<unsigned>(c, OFF_CNTW);
    if (c.tid < 16) { int s = 0;
#pragma unroll 8
        for (int v = 0; v < c.G; ++v) { if (WITH_OFF) woff[v * 16 + c.tid] = s; s += (int)cw[v * 16 + c.tid]; }
        tot[c.tid] = s; }
    __syncthreads();
    if (c.tid == 0) { int t = 0;
        for (int e = 0; e < 16; ++e) { const int nt = (tot[e] + 255) >> 8; tab[160 + e] = t * 256; for (int i = 0; i < nt && t < MAXT; ++i) tab[t++] = e; }
        tab[176] = t; }
    __syncthreads();
}
__device__ __forceinline__ void phase_assign(const Ctx& c) {
    moe_tables<true>(c);
    const LAS int* tab = (const LAS int*)(c.lds + LDS_TAB); const LAS int* woff = (const LAS int*)(c.lds + LDS_WOFF);
    const int gt = c.vcu * 512 + c.tid, NT = c.G * 512;
    const int* te = wsp<int>(c, OFF_TOKE); const int* tp = wsp<int>(c, OFF_TOKP); const float* tw = wsp<float>(c, OFF_TOKW);
    int* slot = wsp<int>(c, OFF_SLOT); float* wrow = wsp<float>(c, OFF_WROW); int* rowtok = wsp<int>(c, OFF_ROWTOK);
    for (int it = gt; it < 2 * M; it += NT) { const int e = te[it], m_ = it >> 1; const int s = tab[160 + e] + woff[((m_ % (c.G * 8)) >> 3) * 16 + e] + tp[it];
        slot[it] = s; wrow[s] = tw[it]; rowtok[s] = m_; }
    for (int it = gt; it < 16 * 256; it += NT) { const int e = it >> 8, r = it & 255; const int n = tab[180 + e], s = tab[160 + e] + n + r; if (r < ((256 - (n & 255)) & 255)) rowtok[s] = 0; }
}
template <bool NEXT>
__device__ __forceinline__ void phase_combine(const Ctx& c, const Params& p, int l, const bf16* Xsrc, bf16* Xnext, float* Xout) {
    if (NEXT) load_w8(c, p, l + 1);
    const int gw = c.vcu * 8 + c.wave, NGW = c.G * 8;
    const int* slot = wsp<int>(c, OFF_SLOT); const bf16* YE = wsp<bf16>(c, OFF_XG);
    for (int m = gw; m < M; m += NGW) {
        const int s0 = slot[2 * m], s1 = slot[2 * m + 1];
        f32x4 v[4]; const u32x2* xr = (const u32x2*)(Xsrc + (size_t)m * D) + c.lane;
        const u32x2* y0 = (const u32x2*)(YE + (size_t)s0 * D) + c.lane; const u32x2* y1 = (const u32x2*)(YE + (size_t)s1 * D) + c.lane;
#pragma unroll
        for (int j = 0; j < 4; ++j) { const u32x2 a = y0[64 * j], b = y1[64 * j], x = xr[64 * j];
            v[j].x = (bflo(x.x) + bflo(a.x)) + bflo(b.x); v[j].y = (bfhi(x.x) + bfhi(a.x)) + bfhi(b.x); v[j].z = (bflo(x.y) + bflo(a.y)) + bflo(b.y); v[j].w = (bfhi(x.y) + bfhi(a.y)) + bfhi(b.y); }
        if (NEXT) {
            unsigned long long* xo = (unsigned long long*)(Xnext + (size_t)m * D) + c.lane;
#pragma unroll
            for (int j = 0; j < 4; ++j) xo[64 * j] = (unsigned long long)pk2(v[j].x, v[j].y) | ((unsigned long long)pk2(v[j].z, v[j].w) << 32);
            row_norm_store(v, wsp<bf16>(c, WS_XB) + (size_t)m * D, c.lane);
            row_gates(v, (const LAS float*)c.lds, p.in[I_GATE_B] + 8 * (l + 1), wsp<float>(c, OFF_GATES) + (size_t)m * 8, c.lane);
        } else {
            f32x4* xo = (f32x4*)(Xout + (size_t)m * D) + c.lane;
#pragma unroll
            for (int j = 0; j < 4; ++j) xo[64 * j] = v[j];
        }
    }
}
__device__ __forceinline__ void gate_scan(const Ctx& c, int bh) {
    const int b = bh >> 2, h = bh & 3, tid = c.tid, lane = c.lane, w = c.wave;
    LAS float* ws_ = (LAS float*)c.lds;
    const float* G = wsp<float>(c, OFF_GATES) + ((size_t)b * SEQ + 8 * tid) * 8;
    float* Aa = wsp<float>(c, OFF_AMA) + bh * SEQ + 8 * tid; float* Am = wsp<float>(c, OFF_AMM) + bh * SEQ + 8 * tid; float* Ab = wsp<float>(c, OFF_AMB) + bh * SEQ + 8 * tid;
    float lf[8], ip[8];
#pragma unroll
    for (int i = 0; i < 8; ++i) { const float f = G[i * 8 + 4 + h]; ip[i] = G[i * 8 + h]; lf[i] = fminf(f, 0.f) - log1pf(__expf(-fabsf(f))); }
    float s = 0.f;
#pragma unroll
    for (int i = 0; i < 8; ++i) { s += lf[i]; lf[i] = s; }
    float incl = s;
#pragma unroll
    for (int o = 1; o < 64; o <<= 1) { const float t = __shfl_up(incl, o); if (lane >= o) incl += t; }
    if (lane == 63) ws_[w] = incl;
    __syncthreads();
    float base = incl - s;
    for (int ww = 0; ww < w; ++ww) base += ws_[ww];
    float av[8], mxl = -3.0e38f;
#pragma unroll
    for (int i = 0; i < 8; ++i) { const float Bc = base + lf[i]; lf[i] = Bc; av[i] = ip[i] - Bc; mxl = fmaxf(mxl, av[i]); }
    float inm = mxl;
#pragma unroll
    for (int o = 1; o < 64; o <<= 1) { const float t = __shfl_up(inm, o); if (lane >= o) inm = fmaxf(inm, t); }
    if (lane == 63) ws_[8 + w] = inm;
    __syncthreads();
    float run = __shfl_up(inm, 1); if (lane == 0) run = 0.f;
    run = fmaxf(run, 0.f);
    for (int ww = 0; ww < w; ++ww) run = fmaxf(run, ws_[8 + ww]);
    float mv[8];
#pragma unroll
    for (int i = 0; i < 8; ++i) { run = fmaxf(run, av[i]); mv[i] = run; }
    *(f32x4*)(Aa) = (f32x4){av[0], av[1], av[2], av[3]}; *(f32x4*)(Aa + 4) = (f32x4){av[4], av[5], av[6], av[7]};
    *(f32x4*)(Am) = (f32x4){mv[0], mv[1], mv[2], mv[3]}; *(f32x4*)(Am + 4) = (f32x4){mv[4], mv[5], mv[6], mv[7]};
    *(f32x4*)(Ab) = (f32x4){lf[0], lf[1], lf[2], lf[3]}; *(f32x4*)(Ab + 4) = (f32x4){lf[4], lf[5], lf[6], lf[7]};
    __syncthreads();
}

typedef short s16x4 __attribute__((ext_vector_type(4)));
__device__ __forceinline__ s16x4 ds_tr(const LAS bf16* p) { return __builtin_bit_cast(s16x4, __builtin_amdgcn_ds_read_tr16_b64_v4i16((LAS s16x4*)p)); }
__device__ __forceinline__ bf16x8 cat4(const s16x4 lo, const s16x4 hi) { return (bf16x8){lo[0], lo[1], lo[2], lo[3], hi[0], hi[1], hi[2], hi[3]}; }
__device__ __forceinline__ bf16x8 ldsA(const LAS bf16* p) { return *(const LAS bf16x8*)p; }
__device__ __forceinline__ bf16x8 pk8f(const f32x4 a, const f32x4 b) { u32x4 w; w.x = pk2(a[0], a[1]); w.y = pk2(a[2], a[3]); w.z = pk2(b[0], b[1]); w.w = pk2(b[2], b[3]); return __builtin_bit_cast(bf16x8, w); }
#define MFMA16(a, b, c) __builtin_amdgcn_mfma_f32_16x16x32_bf16((a), (b), (c), 0, 0, 0)
__device__ __forceinline__ float red4g_sum(float v) { v += __shfl_xor(v, 16); v += __shfl_xor(v, 32); return v; }
__device__ __forceinline__ float red4g_max(float v) { v = fmaxf(v, __shfl_xor(v, 16)); v = fmaxf(v, __shfl_xor(v, 32)); return v; }
__device__ __forceinline__ float red16_sum(float v) { v += __shfl_xor(v, 1); v += __shfl_xor(v, 2); v += __shfl_xor(v, 4); v += __shfl_xor(v, 8); return v; }
constexpr f32x4 Z4 = {0.f, 0.f, 0.f, 0.f};

constexpr int LS = 136;
constexpr int QS = 72;

__device__ __forceinline__ void conv4_silu(const u32x4 (&x)[7], const float* cw, float (&o)[4][8]) {
    float w[4][8];
#pragma unroll
    for (int jj = 0; jj < 4; ++jj) { const f32x4 w0 = *(const f32x4*)(cw + jj * 1024), w1 = *(const f32x4*)(cw + jj * 1024 + 4);
        w[jj][0] = w0.x; w[jj][1] = w0.y; w[jj][2] = w0.z; w[jj][3] = w0.w; w[jj][4] = w1.x; w[jj][5] = w1.y; w[jj][6] = w1.z; w[jj][7] = w1.w; }
    float xf[7][8];
#pragma unroll
    for (int a = 0; a < 7; ++a) unpack8(x[a], xf[a]);
#pragma unroll
    for (int rr = 0; rr < 4; ++rr)
#pragma unroll
        for (int e = 0; e < 8; ++e) { const float s = (w[0][e] * xf[rr][e] + w[1][e] * xf[rr + 1][e]) + (w[2][e] * xf[rr + 2][e] + w[3][e] * xf[rr + 3][e]); o[rr][e] = siluf_(s); }
}
__device__ __forceinline__ void load7(const bf16* colp, int t0, u32x4 (&x)[7]) {
#pragma unroll
    for (int a = 0; a < 7; ++a) { const int t = t0 - 3 + a; x[a] = (t >= 0) ? *(const u32x4*)(colp + (size_t)t * PP) : (u32x4){0u, 0u, 0u, 0u}; }
}

__device__ __forceinline__ void mlstm_delta_unit(const Ctx& c, const Params& p, int l, int bh, int j) {
    const int b = bh >> 2, h = bh & 3, tid = c.tid, lane = c.lane, w = c.wave, r16 = lane & 15, g = lane >> 4;
    LAS bf16* vv = (LAS bf16*)c.lds; LAS bf16* kw = vv + 128 * LS;
    const bf16* projb = wsp<bf16>(c, WS_PROJ) + (size_t)b * SEQ * PP;
    const float* Aa = wsp<float>(c, OFF_AMA) + bh * SEQ + LCH * j; const float Mend = wsp<float>(c, OFF_AMM)[bh * SEQ + LCH * j + LCH - 1];
    {
        const int rg = tid >> 4, c8 = (tid & 15) * 8, t0 = LCH * j + 4 * rg;
        u32x4 xk[7], xv[4];
        load7(projb + C_MK + h * 128 + c8, t0, xk);
#pragma unroll
        for (int rr = 0; rr < 4; ++rr) xv[rr] = *(const u32x4*)(projb + (size_t)(t0 + rr) * PP + C_MV + h * 128 + c8);
        const f32x4 a4 = *(const f32x4*)(Aa + 4 * rg);
        float k[4][8]; conv4_silu(xk, p.in[I_CONV] + (size_t)l * 4 * 1024 + 512 + h * 128 + c8, k);
#pragma unroll
        for (int rr = 0; rr < 4; ++rr) { const float wgt = __expf(a4[rr] - Mend) * 0.08838834764831845f;
#pragma unroll
            for (int e = 0; e < 8; ++e) k[rr][e] *= wgt;
            *(LAS u32x4*)(kw + (4 * rg + rr) * LS + c8) = pack8(k[rr]); *(LAS u32x4*)(vv + (4 * rg + rr) * LS + c8) = xv[rr]; }
    }
    __syncthreads();
    f32x4 acc[8];
#pragma unroll
    for (int nt = 0; nt < 8; ++nt) acc[nt] = Z4;
    const LAS bf16* ap = vv + (8 * g + (r16 >> 2)) * LS + 16 * w + 4 * (r16 & 3); const LAS bf16* bp = kw + (8 * g + (r16 >> 2)) * LS + 4 * (r16 & 3);
#pragma unroll
    for (int ks = 0; ks < 4; ++ks) { const bf16x8 a = cat4(ds_tr(ap + 32 * ks * LS), ds_tr(ap + (32 * ks + 4) * LS));
#pragma unroll
        for (int nt = 0; nt < 8; ++nt) { const bf16x8 bb = cat4(ds_tr(bp + 32 * ks * LS + 16 * nt), ds_tr(bp + (32 * ks + 4) * LS + 16 * nt)); acc[nt] = MFMA16(a, bb, acc[nt]); } }
    float* st = wsp<float>(c, WS_T) + (size_t)(bh * NCH + j) * (128 * 128);
#pragma unroll
    for (int nt = 0; nt < 8; ++nt)
#pragma unroll
        for (int i = 0; i < 4; ++i) st[(16 * w + 4 * g + i) * 128 + 16 * nt + r16] = acc[nt][i];
    if (tid < 128) { float s = 0.f;
#pragma unroll 8
        for (int r = 0; r < 128; ++r) s += bf2f(kw[r * LS + tid]);
        wsp<float>(c, OFF_NST)[(bh * NCH + j) * 128 + tid] = s; }
    __syncthreads();
}
__device__ __forceinline__ void mlstm_scan(const Ctx& c) {
    constexpr int EL4 = (128 * 128 + 128) / 4;
    const int gt = c.vcu * 512 + c.tid, NT = c.G * 512;
    for (int idx = gt; idx < 16 * EL4; idx += NT) {
        const int bh = idx / EL4, el = idx % EL4;
        const float* Am = wsp<float>(c, OFF_AMM) + bh * SEQ;
        f32x4* base = el < 4096 ? (f32x4*)(wsp<float>(c, WS_T) + (size_t)bh * NCH * 16384) + el : (f32x4*)(wsp<float>(c, OFF_NST) + bh * NCH * 128) + (el - 4096);
        const int stride = el < 4096 ? 4096 : 32;
        f32x4 cs = {0.f, 0.f, 0.f, 0.f}; float Mprev = 0.f;
#pragma unroll 1
        for (int j0 = 0; j0 < NCH; j0 += 8) {
            f32x4 dl[8]; float gg[8];
#pragma unroll
            for (int a = 0; a < 8; ++a) { dl[a] = base[(size_t)(j0 + a) * stride]; const float Mend = Am[LCH * (j0 + a) + LCH - 1]; gg[a] = __expf(Mprev - Mend); Mprev = Mend; }
#pragma unroll
            for (int a = 0; a < 8; ++a) { cs = cs * gg[a] + dl[a]; base[(size_t)(j0 + a) * stride] = cs; }
        }
    }
}
__device__ __forceinline__ void mlstm_out_unit(const Ctx& c, const Params& p, int l, int bh, int j) {
    const int b = bh >> 2, h = bh & 3, tid = c.tid, lane = c.lane, w = c.wave, r16 = lane & 15, g = lane >> 4;
    LAS bf16* qq = (LAS bf16*)c.lds; LAS bf16* kk = qq + 128 * LS; LAS bf16* vv = kk + 128 * LS; LAS bf16* CTb = vv + 128 * LS;
    LAS float* fa = (LAS float*)(CTb + 144 * LS); LAS float* fM = fa + 128; LAS float* fB = fM + 128;
    bf16* projb = wsp<bf16>(c, WS_PROJ) + (size_t)b * SEQ * PP;
    {
        const int rg = tid >> 4, c8 = (tid & 15) * 8, t0 = LCH * j + 4 * rg;
        u32x4 xq[7], xk[7], xv[4];
        load7(projb + C_MQ + h * 128 + c8, t0, xq); load7(projb + C_MK + h * 128 + c8, t0, xk);
#pragma unroll
        for (int rr = 0; rr < 4; ++rr) xv[rr] = *(const u32x4*)(projb + (size_t)(t0 + rr) * PP + C_MV + h * 128 + c8);
        const int e = tid >> 2, d0 = (tid & 3) * 32;
        f32x4 sv[8];
        if (j > 0) { const f32x4* sp = (const f32x4*)(wsp<float>(c, WS_T) + (size_t)(bh * NCH + j - 1) * 16384 + e * 128 + d0);
#pragma unroll
            for (int a = 0; a < 8; ++a) sv[a] = sp[a]; }
        else {
#pragma unroll
            for (int a = 0; a < 8; ++a) sv[a] = Z4; }
        const float* cwq = p.in[I_CONV] + (size_t)l * 4 * 1024 + h * 128 + c8;
        float o[4][8];
        conv4_silu(xq, cwq, o);
#pragma unroll
        for (int rr = 0; rr < 4; ++rr) *(LAS u32x4*)(qq + (4 * rg + rr) * LS + c8) = pack8(o[rr]);
        conv4_silu(xk, cwq + 512, o);
#pragma unroll
        for (int rr = 0; rr < 4; ++rr) {
#pragma unroll
            for (int e2 = 0; e2 < 8; ++e2) o[rr][e2] *= 0.08838834764831845f;
            *(LAS u32x4*)(kk + (4 * rg + rr) * LS + c8) = pack8(o[rr]); *(LAS u32x4*)(vv + (4 * rg + rr) * LS + c8) = xv[rr]; }
#pragma unroll
        for (int a = 0; a < 4; ++a) *(LAS bf16x8*)(CTb + e * LS + d0 + 8 * a) = pk8f(sv[2 * a], sv[2 * a + 1]);
    }
    if (tid < 256) { const int e = 128 + (tid >> 4), c8 = (tid & 15) * 8; float s8[8];
#pragma unroll
        for (int i = 0; i < 8; ++i) s8[i] = 0.f;
        if (e == 128 && j > 0) { const float* nn = wsp<float>(c, OFF_NST) + (bh * NCH + j - 1) * 128 + c8;
#pragma unroll
            for (int i = 0; i < 8; ++i) s8[i] = nn[i]; }
        *(LAS u32x4*)(CTb + e * LS + c8) = pack8(s8); }
    if (tid < 128) { const int t = bh * SEQ + LCH * j + tid; fa[tid] = wsp<float>(c, OFF_AMA)[t]; fM[tid] = wsp<float>(c, OFF_AMM)[t]; fB[tid] = wsp<float>(c, OFF_AMB)[t]; }
    __syncthreads();
    const float Mprev = j > 0 ? wsp<float>(c, OFF_AMM)[bh * SEQ + LCH * j - 1] : 0.f;
    const int tq = 16 * w + r16;
    f32x4 as[8], ai[9];
#pragma unroll
    for (int a = 0; a < 8; ++a) as[a] = Z4;
#pragma unroll
    for (int a = 0; a < 9; ++a) ai[a] = Z4;
#pragma unroll
    for (int ks = 0; ks < 4; ++ks) { const bf16x8 bq = ldsA(qq + tq * LS + 32 * ks + 8 * g);
#pragma unroll
        for (int mt = 0; mt < 8; ++mt) if (mt <= w) as[mt] = MFMA16(ldsA(kk + (16 * mt + r16) * LS + 32 * ks + 8 * g), bq, as[mt]);
#pragma unroll
        for (int et = 0; et < 9; ++et) ai[et] = MFMA16(ldsA(CTb + (16 * et + r16) * LS + 32 * ks + 8 * g), bq, ai[et]);
        __builtin_amdgcn_sched_barrier(0); }
    const float Mt = fM[tq], winter = __expf(Mprev - Mt);
    float den = 0.f;
#pragma unroll
    for (int mt = 0; mt < 8; ++mt)
#pragma unroll
        for (int i = 0; i < 4; ++i) { const int r = 16 * mt + 4 * g + i; const float wg = (mt <= w && r <= tq) ? __expf(fa[r] - Mt) : 0.f; const float sw = as[mt][i] * wg; as[mt][i] = sw; den += sw; }
    den = red4g_sum(den);
    const float dinter = __shfl(ai[8][0], r16);
    const float dd = den + winter * dinter;
    const float dn = fmaxf(fabsf(dd), __expf(-(fB[tq] + Mt)));
    f32x4 ao[8];
#pragma unroll
    for (int et = 0; et < 8; ++et) ao[et] = ai[et] * winter;
    const LAS bf16* vp = vv + (4 * g + (r16 >> 2)) * LS + 4 * (r16 & 3);
#pragma unroll
    for (int ks = 0; ks < 4; ++ks) if (2 * ks <= w) { const bf16x8 bp = pk8f(as[2 * ks], as[2 * ks + 1]);
#pragma unroll
        for (int et = 0; et < 8; ++et) ao[et] = MFMA16(cat4(ds_tr(vp + 32 * ks * LS + 16 * et), ds_tr(vp + (32 * ks + 16) * LS + 16 * et)), bp, ao[et]);
        __builtin_amdgcn_sched_barrier(0); }
    const float inv = 1.f / dn; float ss = 0.f;
#pragma unroll
    for (int et = 0; et < 8; ++et) { ao[et] = ao[et] * inv; ss += (ao[et][0] * ao[et][0] + ao[et][1] * ao[et][1]) + (ao[et][2] * ao[et][2] + ao[et][3] * ao[et][3]); }
    ss = red4g_sum(ss); const float rs = 1.f / sqrtf(ss * (1.f / 128.f) + EPS);
    const float* gain = p.in[I_MLSTM_NORM] + l * 512 + h * 128; const bf16* mrow = projb + (size_t)(LCH * j + tq) * PP + C_MO + h * 128;
    bf16* orow = wsp<bf16>(c, WS_YA) + ((size_t)b * SEQ + LCH * j + tq) * 512 + h * 128;
#pragma unroll
    for (int et = 0; et < 8; ++et) { const int e0 = 16 * et + 4 * g; const u32x2 mo = *(const u32x2*)(mrow + e0); const f32x4 gn = *(const f32x4*)(gain + e0);
        u32x2 o; o.x = pk2(ao[et][0] * rs * gn[0] * sigmoidf_(bflo(mo.x)), ao[et][1] * rs * gn[1] * sigmoidf_(bfhi(mo.x))); o.y = pk2(ao[et][2] * rs * gn[2] * sigmoidf_(bflo(mo.y)), ao[et][3] * rs * gn[3] * sigmoidf_(bfhi(mo.y)));
        *(u32x2*)(orow + e0) = o; }
    __syncthreads();
}

__device__ __forceinline__ void dattn_unit(const Ctx& c, const Params& p, int l, int b, int h, int blk) {
    const int tid = c.tid, lane = c.lane, w = c.wave, r16 = lane & 15, g = lane >> 4;
    const int grp = h >> 2, dil = grp == 0 ? 1 : (grp == 1 ? 4 : 16), nb = 32 / dil, res = blk / nb, n = blk % nb;
    LAS bf16* kn = (LAS bf16*)c.lds; LAS bf16* vv = kn + 256 * QS; LAS float* bias = (LAS float*)(vv + 272 * QS);
    bf16* projb = wsp<bf16>(c, WS_PROJ) + (size_t)b * SEQ * PP;
    const float* gq = p.in[I_ATTN_QKN] + l * 128; const float* gk = gq + 64;
    {
        const int c8 = (tid & 7) * 8; u32x4 xk[4], xv[4];
#pragma unroll
        for (int a = 0; a < 4; ++a) { const int ki = (tid >> 3) + 64 * a, s = 128 * (n - 1) + ki;
            if (s >= 0) { const size_t pos = (size_t)(s * dil + res); xk[a] = *(const u32x4*)(projb + pos * PP + C_AK + h * 64 + c8); xv[a] = *(const u32x4*)(projb + pos * PP + C_AV + h * 64 + c8); }
            else { xk[a] = (u32x4){0u, 0u, 0u, 0u}; xv[a] = (u32x4){0u, 0u, 0u, 0u}; } }
        const f32x4 g0 = *(const f32x4*)(gk + c8), g1 = *(const f32x4*)(gk + c8 + 4);
#pragma unroll
        for (int a = 0; a < 4; ++a) { const int ki = (tid >> 3) + 64 * a; float x[8]; unpack8(xk[a], x);
            float ss = 0.f;
#pragma unroll
            for (int e = 0; e < 8; ++e) ss += x[e] * x[e];
            ss += __shfl_xor(ss, 1); ss += __shfl_xor(ss, 2); ss += __shfl_xor(ss, 4);
            const float rs = 1.f / sqrtf(ss * (1.f / 64.f) + EPS);
            x[0] *= rs * g0.x; x[1] *= rs * g0.y; x[2] *= rs * g0.z; x[3] *= rs * g0.w; x[4] *= rs * g1.x; x[5] *= rs * g1.y; x[6] *= rs * g1.z; x[7] *= rs * g1.w;
            *(LAS u32x4*)(kn + ki * QS + c8) = pack8(x); *(LAS u32x4*)(vv + ki * QS + c8) = xv[a]; }
        if (tid < 144) *(LAS u32x4*)(vv + 256 * QS + tid * 8) = (u32x4){0u, 0u, 0u, 0u};
        if (tid < 132) bias[tid] = wsp<float>(c, OFF_BIAS)[h * 132 + tid];
    }
    const int qi = 16 * w + r16; const size_t qpos = (size_t)((128 * n + qi) * dil + res);
    bf16* qrow = projb + qpos * PP + C_AQ + h * 64;
    bf16x8 bq[2];
    { float x0[8], x1[8]; unpack8(*(const u32x4*)(qrow + 8 * g), x0); unpack8(*(const u32x4*)(qrow + 32 + 8 * g), x1);
      float ss = 0.f;
#pragma unroll
      for (int e = 0; e < 8; ++e) ss += x0[e] * x0[e] + x1[e] * x1[e];
      ss = red4g_sum(ss); const float rs = 0.125f / sqrtf(ss * (1.f / 64.f) + EPS);
#pragma unroll
      for (int e = 0; e < 8; ++e) { x0[e] *= rs * gq[8 * g + e]; x1[e] *= rs * gq[32 + 8 * g + e]; }
      bq[0] = __builtin_bit_cast(bf16x8, pack8(x0)); bq[1] = __builtin_bit_cast(bf16x8, pack8(x1)); }
    __syncthreads();
    const int kb = 16 * w;
    f32x4 acc[10];
#pragma unroll
    for (int mt = 0; mt < 10; ++mt) acc[mt] = Z4;
#pragma unroll
    for (int ks = 0; ks < 2; ++ks)
#pragma unroll
        for (int mt = 0; mt < 9; ++mt) acc[mt] = MFMA16(ldsA(kn + (kb + 16 * mt + r16) * QS + 32 * ks + 8 * g), bq[ks], acc[mt]);
    float mx = -3.0e38f;
#pragma unroll
    for (int mt = 0; mt < 9; ++mt)
#pragma unroll
        for (int i = 0; i < 4; ++i) { const int ki = kb + 16 * mt + 4 * g + i, dist = 128 + qi - ki; const bool ok = dist >= 0 && dist <= 128 && (n > 0 || ki >= 128);
            const float lg = ok ? acc[mt][i] + bias[ok ? dist : 0] : -3.0e38f; acc[mt][i] = lg; mx = fmaxf(mx, lg); }
    mx = red4g_max(mx);
    float lsum = 0.f;
#pragma unroll
    for (int mt = 0; mt < 9; ++mt)
#pragma unroll
        for (int i = 0; i < 4; ++i) { const float lg = acc[mt][i]; const float pe = lg > -1.0e38f ? __expf(lg - mx) : 0.f; lsum += pe; acc[mt][i] = pe; }
    lsum = red4g_sum(lsum);
    f32x4 ao[4];
#pragma unroll
    for (int et = 0; et < 4; ++et) ao[et] = Z4;
    const LAS bf16* vp = vv + (kb + 4 * g + (r16 >> 2)) * QS + 4 * (r16 & 3);
#pragma unroll
    for (int ks = 0; ks < 5; ++ks) { const bf16x8 bp = pk8f(acc[2 * ks], acc[2 * ks + 1]);
#pragma unroll
        for (int et = 0; et < 4; ++et) ao[et] = MFMA16(cat4(ds_tr(vp + 32 * ks * QS + 16 * et), ds_tr(vp + (32 * ks + 16) * QS + 16 * et)), bp, ao[et]); }
    const float inv = 1.f / lsum;
#pragma unroll
    for (int et = 0; et < 4; ++et) { u32x2 o; o.x = pk2(ao[et][0] * inv, ao[et][1] * inv); o.y = pk2(ao[et][2] * inv, ao[et][3] * inv); *(u32x2*)(qrow + 16 * et + 4 * g) = o; }
    if (g == 0) wsp<float>(c, OFF_LSE)[((size_t)b * SEQ + qpos) * 12 + h] = mx + __logf(lsum);
    __syncthreads();
}
__device__ __forceinline__ void dattn_merge(const Ctx& c) {
    const int gt = c.vcu * 512 + c.tid, NT = c.G * 512;
    const float* LSE = wsp<float>(c, OFF_LSE); bf16* proj = wsp<bf16>(c, WS_PROJ);
    for (int it = gt; it < M * 96; it += NT) {
        const int m = it / 96, rr = it % 96, h = rr >> 3, c8 = (rr & 7) * 8, hg = h & 3;
        const float l0 = LSE[(size_t)m * 12 + hg], l1 = LSE[(size_t)m * 12 + 4 + hg], l2 = LSE[(size_t)m * 12 + 8 + hg], lm = LSE[(size_t)m * 12 + h];
        const float mxx = fmaxf(l0, fmaxf(l1, l2)); const float al = __expf(lm - mxx) / (__expf(l0 - mxx) + __expf(l1 - mxx) + __expf(l2 - mxx));
        u32x4* ptr = (u32x4*)(proj + (size_t)m * PP + C_AQ + h * 64 + c8); float x[8]; unpack8(*ptr, x);
#pragma unroll
        for (int e = 0; e < 8; ++e) x[e] *= al;
        *ptr = pack8(x);
    }
}

__device__ __forceinline__ void gmlp_unit(const Ctx& c, const Params& p, int l, int b, int n, int grp) {
    const int tid = c.tid, lane = c.lane, w = c.wave, r16 = lane & 15, g = lane >> 4;
    LAS bf16* Wc = (LAS bf16*)c.lds; LAS bf16* vn = Wc + 128 * LS;
    bf16* projb = wsp<bf16>(c, WS_PROJ) + ((size_t)b * SEQ + 128 * n) * PP;
    const float* ws = p.in[I_GMLP_WS] + ((size_t)l * 4 + grp) * 128 * 128; const float* gain = p.in[I_GMLP_NORM] + l * 512 + grp * 128; const float* bs = p.in[I_GMLP_BS] + (l * 4 + grp) * 128;
    {
        const int c8 = (tid & 15) * 8; u32x4 xv[4]; f32x4 wv[4][2];
#pragma unroll
        for (int a = 0; a < 4; ++a) { const int r = (tid >> 4) + 32 * a; xv[a] = *(const u32x4*)(projb + (size_t)r * PP + C_GV + grp * 128 + c8); wv[a][0] = *(const f32x4*)(ws + r * 128 + c8); wv[a][1] = *(const f32x4*)(ws + r * 128 + c8 + 4); }
        const f32x4 g0 = *(const f32x4*)(gain + c8), g1 = *(const f32x4*)(gain + c8 + 4);
#pragma unroll
        for (int a = 0; a < 4; ++a) { const int r = (tid >> 4) + 32 * a;
            float wf[8] = {wv[a][0].x, wv[a][0].y, wv[a][0].z, wv[a][0].w, wv[a][1].x, wv[a][1].y, wv[a][1].z, wv[a][1].w};
#pragma unroll
            for (int e = 0; e < 8; ++e) if (c8 + e > r) wf[e] = 0.f;
            *(LAS u32x4*)(Wc + r * LS + c8) = pack8(wf);
            float x[8]; unpack8(xv[a], x); float ss = 0.f;
#pragma unroll
            for (int e = 0; e < 8; ++e) { x[e] = gelu_tanh(x[e]); ss += x[e] * x[e]; }
            ss = red16_sum(ss); const float rs = 1.f / sqrtf(ss * (1.f / 128.f) + EPS);
            x[0] *= rs * g0.x; x[1] *= rs * g0.y; x[2] *= rs * g0.z; x[3] *= rs * g0.w; x[4] *= rs * g1.x; x[5] *= rs * g1.y; x[6] *= rs * g1.z; x[7] *= rs * g1.w;
            *(LAS u32x4*)(vn + r * LS + c8) = pack8(x); }
    }
    __syncthreads();
    const int tq = 16 * w + r16;
    f32x4 acc[8];
#pragma unroll
    for (int ct = 0; ct < 8; ++ct) acc[ct] = Z4;
    const LAS bf16* vp = vn + (8 * g + (r16 >> 2)) * LS + 4 * (r16 & 3);
#pragma unroll
    for (int ks = 0; ks < 4; ++ks) if (32 * ks <= 16 * w + 15) { const bf16x8 bw = ldsA(Wc + tq * LS + 32 * ks + 8 * g);
#pragma unroll
        for (int ct = 0; ct < 8; ++ct) acc[ct] = MFMA16(cat4(ds_tr(vp + 32 * ks * LS + 16 * ct), ds_tr(vp + (32 * ks + 4) * LS + 16 * ct)), bw, acc[ct]); }
    const float bb = bs[tq]; const bf16* urow = projb + (size_t)tq * PP + C_GU + grp * 128; bf16* orow = wsp<bf16>(c, WS_YC) + ((size_t)b * SEQ + 128 * n + tq) * 512 + grp * 128;
#pragma unroll
    for (int ct = 0; ct < 8; ++ct) { const int c0 = 16 * ct + 4 * g; const u32x2 u = *(const u32x2*)(urow + c0);
        u32x2 o; o.x = pk2(gelu_tanh(bflo(u.x)) * (acc[ct][0] + bb), gelu_tanh(bfhi(u.x)) * (acc[ct][1] + bb)); o.y = pk2(gelu_tanh(bflo(u.y)) * (acc[ct][2] + bb), gelu_tanh(bfhi(u.y)) * (acc[ct][3] + bb));
        *(u32x2*)(orow + c0) = o; }
    __syncthreads();
}

__device__ __forceinline__ void xattn_unit(const Ctx& c, const Params& p, int l, int bh, int tp) {
    const int b = bh >> 2, h = bh & 3, tid = c.tid, lane = c.lane, w = c.wave, r16 = lane & 15, g = lane >> 4;
    LAS bf16* kn = (LAS bf16*)c.lds; LAS bf16* vv = kn + 256 * LS;
    const bf16* KV = wsp<bf16>(c, OFF_KV) + (size_t)b * MEML * 1024;
    const float* gq = p.in[I_XATTN_QKN] + l * 256; const float* gk = gq + 128;
    {
        const int c8 = (tid & 15) * 8; const f32x4 g0 = *(const f32x4*)(gk + c8), g1 = *(const f32x4*)(gk + c8 + 4);
#pragma unroll
        for (int half = 0; half < 2; ++half) { u32x4 xk[4], xv[4];
#pragma unroll
            for (int a = 0; a < 4; ++a) { const int ki = (tid >> 4) + 32 * (4 * half + a); xk[a] = *(const u32x4*)(KV + (size_t)ki * 1024 + h * 128 + c8); xv[a] = *(const u32x4*)(KV + (size_t)ki * 1024 + 512 + h * 128 + c8); }
#pragma unroll
            for (int a = 0; a < 4; ++a) { const int ki = (tid >> 4) + 32 * (4 * half + a); float x[8]; unpack8(xk[a], x); float ss = 0.f;
#pragma unroll
                for (int e = 0; e < 8; ++e) ss += x[e] * x[e];
                ss = red16_sum(ss); const float rs = 1.f / sqrtf(ss * (1.f / 128.f) + EPS);
                x[0] *= rs * g0.x; x[1] *= rs * g0.y; x[2] *= rs * g0.z; x[3] *= rs * g0.w; x[4] *= rs * g1.x; x[5] *= rs * g1.y; x[6] *= rs * g1.z; x[7] *= rs * g1.w;
                *(LAS u32x4*)(kn + ki * LS + c8) = pack8(x); *(LAS u32x4*)(vv + ki * LS + c8) = xv[a]; } }
    }
    __syncthreads();
    const LAS bf16* vp = vv + (4 * g + (r16 >> 2)) * LS + 4 * (r16 & 3);
    for (int tt = 2 * tp; tt < 2 * tp + 2; ++tt) {
        const size_t row = (size_t)b * SEQ + 128 * tt + 16 * w + r16;
        const bf16* qrow = wsp<bf16>(c, OFF_Q) + row * 512 + h * 128;
        bf16x8 bq[4];
        { float qf[4][8]; float ss = 0.f;
#pragma unroll
          for (int ks = 0; ks < 4; ++ks) { unpack8(*(const u32x4*)(qrow + 32 * ks + 8 * g), qf[ks]);
#pragma unroll
              for (int e = 0; e < 8; ++e) ss += qf[ks][e] * qf[ks][e]; }
          ss = red4g_sum(ss); const float rsq = 0.08838834764831845f / sqrtf(ss * (1.f / 128.f) + EPS);
#pragma unroll
          for (int ks = 0; ks < 4; ++ks) {
#pragma unroll
              for (int e = 0; e < 8; ++e) qf[ks][e] *= rsq * gq[32 * ks + 8 * g + e];
              bq[ks] = __builtin_bit_cast(bf16x8, pack8(qf[ks])); } }
        f32x4 acc[16];
#pragma unroll
        for (int mt = 0; mt < 16; ++mt) acc[mt] = Z4;
#pragma unroll
        for (int ks = 0; ks < 4; ++ks) {
#pragma unroll
            for (int mt = 0; mt < 16; ++mt) acc[mt] = MFMA16(ldsA(kn + (16 * mt + r16) * LS + 32 * ks + 8 * g), bq[ks], acc[mt]);
            __builtin_amdgcn_sched_barrier(0); }
        float mx = -3.0e38f;
#pragma unroll
        for (int mt = 0; mt < 16; ++mt) mx = fmaxf(fmaxf(mx, fmaxf(acc[mt][0], acc[mt][1])), fmaxf(acc[mt][2], acc[mt][3]));
        mx = red4g_max(mx);
        float lsum = 0.f;
#pragma unroll
        for (int mt = 0; mt < 16; ++mt)
#pragma unroll
            for (int i = 0; i < 4; ++i) { const float pe = __expf(acc[mt][i] - mx); lsum += pe; acc[mt][i] = pe; }
        lsum = red4g_sum(lsum);
        f32x4 ao[8];
#pragma unroll
        for (int et = 0; et < 8; ++et) ao[et] = Z4;
#pragma unroll
        for (int ks = 0; ks < 8; ++ks) { const bf16x8 bp = pk8f(acc[2 * ks], acc[2 * ks + 1]);
#pragma unroll
            for (int et = 0; et < 8; ++et) ao[et] = MFMA16(cat4(ds_tr(vp + 32 * ks * LS + 16 * et), ds_tr(vp + (32 * ks + 16) * LS + 16 * et)), bp, ao[et]);
            __builtin_amdgcn_sched_barrier(0); }
        const float inv = 1.f / lsum; bf16* orow = wsp<bf16>(c, OFF_O) + row * 512 + h * 128;
#pragma unroll
        for (int et = 0; et < 8; ++et) { u32x2 o; o.x = pk2(ao[et][0] * inv, ao[et][1] * inv); o.y = pk2(ao[et][2] * inv, ao[et][3] * inv); *(u32x2*)(orow + 16 * et + 4 * g) = o; }
    }
    __syncthreads();
}
enum { PH_PRE = 0, PH_A1, PH_MIXA, PH_MIXB, PH_MIXC, PH_GB, PH_WOUT, PH_XQ, PH_XA, PH_XO, PH_RP2, PH_GATHER, PH_GU, PH_DOWN, PH_COMB, NPH_LAYER };

struct GbOrder {
    pg8::StaticOrder so; const char* ws;
    __device__ __forceinline__ bool next(int i, pg8::SUnit& u) const {
        pg8::Unit t; if (!so.next(i / 6, t)) return false;
        const int k6 = i % 6, k = (k6 & 1) * 3 + (k6 >> 1); u.pm = t.pm; u.pn = t.pn; u.kind = k;
        if (k < 3) { u.a = ws + WS_XB + (size_t)t.pm * 256 * D * 2; u.lda = D; u.K = D; u.b = ws + OFF_WG + ((size_t)k * 1024 + t.pn * 256) * D * 2; }
        else { const int br = k - 3; const size_t ccol = br == 0 ? (size_t)C_MO : (br == 1 ? (size_t)C_AQ : (size_t)C_GU); const int kk = br == 1 ? 768 : 512;
            const size_t woff = br == 0 ? OFF_WA : (br == 1 ? OFF_WB : OFF_WC);
            if (br == 1) { u.a = ws + WS_PROJ + ((size_t)t.pm * 256 * PP + ccol) * 2; u.lda = PP; } else { u.a = ws + (br == 0 ? WS_YA : WS_YC) + (size_t)t.pm * 256 * 512 * 2; u.lda = 512; }
            u.K = kk; u.b = ws + woff + (size_t)t.pn * 256 * kk * 2; }
        return true;
    }
};

template <int PH>
__device__ __forceinline__ void run_phase(const Ctx& c, const Params& p, int l) {
    bf16* const XB = wsp<bf16>(c, WS_XB); bf16* const PROJ = wsp<bf16>(c, WS_PROJ);
    bf16* const XR = wsp<bf16>(c, WS_X1B);
    if constexpr (PH == PH_PRE) { phase_weights(c, p, 0); __syncthreads(); phase_rp0_input(c, p); }
    if constexpr (PH == PH_A1) {
        if (c.bx >= c.G - 16) gate_scan(c, c.bx - (c.G - 16));
        { pg8::Gemm g{XB, wsp<bf16>(c, OFF_WIN1), D, D}; pg8::StaticOrder S; S.init(M, PP, c.G, c.bx); epi::Bf16Out E{PROJ, PP};
          pg8::gemm_phase<epi::Bf16Out, pg8::StaticOrder, true>(c.lds, g, S, E); }
        { pg8::Gemm g{wsp<bf16>(c, OFF_MEMB), wsp<bf16>(c, OFF_WXKV), D, D}; pg8::StaticOrder S; S.init(MM, 1024, c.G, (c.bx + c.G - 64) % c.G); epi::Bf16Out E{wsp<bf16>(c, OFF_KV), 1024};
          pg8::gemm_phase<epi::Bf16Out, pg8::StaticOrder, true>(c.lds, g, S, E); }
    }
    if constexpr (PH == PH_MIXA) {
        for (int u = c.bx; u < 16 * NCH; u += c.G) mlstm_delta_unit(c, p, l, u / NCH, u % NCH);
        for (int u = c.bx; u < NBATCH * 32 * 4; u += c.G) gmlp_unit(c, p, l, u >> 7, (u >> 2) & 31, u & 3);
    }
    if constexpr (PH == PH_MIXB) {
        mlstm_scan(c);
        for (int u = c.bx; u < NBATCH * 12 * 32; u += c.G) { const int blk = u & 31, bh = u >> 5; dattn_unit(c, p, l, bh / 12, bh % 12, blk); }
    }
    if constexpr (PH == PH_MIXC) { for (int u = c.bx; u < 16 * NCH; u += c.G) mlstm_out_unit(c, p, l, u / NCH, u % NCH); dattn_merge(c); }
    if constexpr (PH == PH_GB) { GbOrder S; S.so.init(M, 1024, c.G, c.bx); S.ws = (const char*)c.ws;
        epi::GateBranchOut E{PROJ, wsp<bf16>(c, WS_T)};
        pg8::gemm_stream<epi::GateBranchOut, GbOrder, true>(c.lds, S, E); }
    if constexpr (PH == PH_WOUT) { pg8::Gemm g{wsp<bf16>(c, WS_T), wsp<bf16>(c, OFF_WOUT), D, D}; pg8::StaticOrder S; S.init(M, 1024, c.G, c.bx);
        if (l == 0) { epi::ResidBfOut<true> E{p.in[I_X], XR, wsp<float>(c, OFF_SSQ)}; pg8::gemm_phase<epi::ResidBfOut<true>, pg8::StaticOrder, false>(c.lds, g, S, E); }
        else { epi::ResidBfOut<false> E{(const bf16*)p.out, XR, wsp<float>(c, OFF_SSQ)}; pg8::gemm_phase<epi::ResidBfOut<false>, pg8::StaticOrder, false>(c.lds, g, S, E); } }
    if constexpr (PH == PH_XQ) { pg8::Gemm g{wsp<bf16>(c, WS_X1B), wsp<bf16>(c, OFF_WXQ), D, D}; pg8::StaticOrder S; S.init(M, 512, c.G, c.bx); epi::Bf16OutRs E{wsp<bf16>(c, OFF_Q), 512, wsp<float>(c, OFF_SSQ)};
        pg8::gemm_phase<epi::Bf16OutRs, pg8::StaticOrder, false>(c.lds, g, S, E); }
    if constexpr (PH == PH_XA) { for (int u = c.bx; u < 16 * 16; u += c.G) xattn_unit(c, p, l, u >> 4, u & 15); }
    if constexpr (PH == PH_XO) { pg8::Gemm g{wsp<bf16>(c, OFF_O), wsp<bf16>(c, OFF_WXO), 512, 512}; pg8::StaticOrder S; S.init(M, 1024, c.G, c.bx); epi::ResidBfOut<false> E{XR, XR, nullptr};
        pg8::gemm_phase<epi::ResidBfOut<false>, pg8::StaticOrder, false>(c.lds, g, S, E); }
    if constexpr (PH == PH_RP2) phase_rp2_route(c, p, l, XR);
    if constexpr (PH == PH_GATHER) phase_assign(c);
    if constexpr (PH == PH_GU) { moe_tables<false>(c); pg8::Gemm g{XB, wsp<bf16>(c, OFF_WGU), D, D}; MoeOrder S{(const LAS int*)(c.lds + LDS_TAB), c.G, c.bx}; epi::GluOut E{wsp<bf16>(c, OFF_HID)};
        LAS int* rowl = (LAS int*)(c.lds + LDS_ROWL); const int* rowtok = wsp<int>(c, OFF_ROWTOK);
        for (int i = 0; i < 4; ++i) { pg8::Unit u; if (S.next(i, u) && c.tid < 256) rowl[i * 256 + c.tid] = rowtok[u.pm * 256 + c.tid]; }
        __syncthreads();
        pg8::gemm_phase_g<epi::GluOut, MoeOrder, true>(c.lds, g, rowl, S, E); }
    if constexpr (PH == PH_DOWN) { moe_tables<false>(c); pg8::Gemm g{wsp<bf16>(c, OFF_HID), wsp<bf16>(c, OFF_WD), DFF, DFF}; MoeOrder S{(const LAS int*)(c.lds + LDS_TAB), c.G, c.bx}; epi::DownOut E{wsp<bf16>(c, OFF_XG), wsp<float>(c, OFF_WROW)};
        pg8::gemm_phase<epi::DownOut, MoeOrder, true>(c.lds, g, S, E); }
    if constexpr (PH == PH_COMB) { if (l + 1 < DEPTH) { phase_combine<true>(c, p, l, XR, (bf16*)p.out, nullptr); __syncthreads(); phase_weights(c, p, l + 1); } else phase_combine<false>(c, p, l, XR, nullptr, p.out); }
}

__device__ __forceinline__ Ctx make_ctx(const Params& p, unsigned char* lds_raw) {
    Ctx c;
    c.lds = (LAS unsigned char*)lds_raw; c.ws = p.ws;
    int tid_ = threadIdx.x, bx = blockIdx.x, G_ = gridDim.x;
    asm volatile("" : "+v"(tid_), "+s"(bx), "+s"(G_));
    c.tid = tid_; c.lane = c.tid & 63; c.wave = __builtin_amdgcn_readfirstlane(c.tid >> 6);
    c.G = G_; c.bx = bx; c.vcu = (c.G % 8 == 0) ? (bx % 8) * (c.G / 8) + bx / 8 : bx;
    return c;
}
#ifndef MK_ONE_LAUNCH
#define MK_ONE_LAUNCH 1
#endif
#if !MK_ONE_LAUNCH
template <int PH>
__global__ void __launch_bounds__(512, 2) phase_kernel(Params p, int l) {
    extern __shared__ __attribute__((aligned(16))) unsigned char lds_raw[];
    const Ctx c = make_ctx(p, lds_raw);
    run_phase<PH>(c, p, l);
}
template <int PH> static void launch_phases(int grid, const Params& a, int l, hipStream_t stream) {
    if constexpr (PH < NPH_LAYER) {
        static bool attr_done = false;
        if (!attr_done) { (void)hipFuncSetAttribute((const void*)phase_kernel<PH>, hipFuncAttributeMaxDynamicSharedMemorySize, LDS_BYTES); attr_done = true; }
        if (!(PH == PH_PRE && l != 0)) hipLaunchKernelGGL(phase_kernel<PH>, dim3(grid), dim3(512), LDS_BYTES, stream, a, l);
        launch_phases<PH + 1>(grid, a, l, stream);
    }
}
#else
#if defined(__HIP_DEVICE_COMPILE__)
typedef const __attribute__((address_space(4))) Params* KParams;
#else
typedef const Params* KParams;
#endif
template <int PH>
__device__ __forceinline__ void phase_site(KParams kp, int l) {
    extern __shared__ __attribute__((aligned(16))) unsigned char lds_raw[];
    asm volatile("" : "+s"(kp));
    Params p;
#pragma unroll
    for (int i = 0; i < 28; ++i) p.in[i] = kp->in[i];
    p.out = kp->out; p.ws = kp->ws;
    const Ctx c = make_ctx(p, lds_raw);
    run_phase<PH>(c, p, l);
}
__device__ __forceinline__ void seam(KParams kp) {
    extern __shared__ __attribute__((aligned(16))) unsigned char lds_raw[];
    asm volatile("" : "+s"(kp));
    XcdBarrier b; b.bar = (unsigned*)(kp->ws + WS_CTL) + CW_BAR; b.x = xb_xcc_id(); b.st = (volatile LAS unsigned*)((LAS unsigned char*)lds_raw + LDS_MISC) + 8;
    xcd_barrier(b);
}
template <int PH> __device__ __forceinline__ void run_layer(KParams kp, int l) {
    if constexpr (PH < NPH_LAYER) {
        if (!(PH == PH_PRE && l != 0)) {
#ifdef PROBE_AMP
            const unsigned long long t0_ = __builtin_amdgcn_s_memrealtime();
#endif
            phase_site<PH>(kp, l); seam(kp);
#ifdef PROBE_AMP
            if ((PROBE_AMP >> PH) & 1) { const unsigned long long dt_ = __builtin_amdgcn_s_memrealtime() - t0_; const unsigned long long t1_ = __builtin_amdgcn_s_memrealtime();
                while (__builtin_amdgcn_s_memrealtime() - t1_ < 3 * dt_) __builtin_amdgcn_s_sleep(4); seam(kp); }
#endif
#ifdef PROBE_REPEAT
            if ((PROBE_REPEAT >> PH) & 1) { phase_site<PH>(kp, l); seam(kp); }
#endif
        }
        run_layer<PH + 1>(kp, l);
    }
}
__global__ void __launch_bounds__(512, 2) fwd_kernel(Params p) {
    extern __shared__ __attribute__((aligned(16))) unsigned char lds_raw[];
    volatile LAS unsigned* MISC = (volatile LAS unsigned*)((LAS unsigned char*)lds_raw + LDS_MISC);
    for (int u = threadIdx.x; u < (LDS_BYTES - LDS_MISC) / 4; u += 512) MISC[u] = 0u;
    __syncthreads();
    (void)xcd_barrier_post((unsigned*)(p.ws + WS_CTL) + CW_BAR, MISC + 8);
    KParams kp = (KParams)__builtin_amdgcn_kernarg_segment_ptr();
    run_layer<0>(kp, 0);
    run_layer<0>(kp, 1);
    static_assert(DEPTH == 2, "layers are written out");
}
#endif

extern "C" void kernel_launch(void* const* d_in, const int* in_sizes, int n_in, void* d_out, int out_size, void* d_ws, size_t ws_size, hipStream_t stream) {
    static int grid = 0;
    if (grid == 0) {
        if (n_in != 28 || in_sizes[0] != M * D || out_size != M * D || ws_size < WS_END) { fprintf(stderr, "kernel_launch: unexpected shapes (n_in %d, in0 %d, out %d, ws %zu < %zu); nothing launched\n", n_in, n_in > 0 ? in_sizes[0] : -1, out_size, ws_size, (size_t)WS_END); grid = -1; return; }
        int dev = 0, cus = 0;
        if (hipGetDevice(&dev) != hipSuccess || hipDeviceGetAttribute(&cus, hipDeviceAttributeMultiprocessorCount, dev) != hipSuccess) { grid = -1; return; }
#if MK_ONE_LAUNCH
        if (hipFuncSetAttribute((const void*)fwd_kernel, hipFuncAttributeMaxDynamicSharedMemorySize, LDS_BYTES) != hipSuccess) { fprintf(stderr, "kernel_launch: hipFuncSetAttribute failed\n"); grid = -1; return; }
        int per_cu = 0;
        if (hipOccupancyMaxActiveBlocksPerMultiprocessor(&per_cu, (const void*)fwd_kernel, 512, LDS_BYTES) != hipSuccess || per_cu < 1) { fprintf(stderr, "kernel_launch: occupancy query reports %d workgroups per CU\n", per_cu); }
        (void)hipGetLastError();
#endif
        grid = cus;
    }
    if (grid < 0) return;
    if (hipMemsetAsync((char*)d_ws + WS_CTL, 0, CTL_ZERO_BYTES, stream) != hipSuccess) return;
    Params a{};
    for (int i = 0; i < 28; ++i) a.in[i] = (const float*)d_in[i];
    a.out = (float*)d_out; a.ws = (unsigned char*)d_ws;
#if MK_ONE_LAUNCH
    hipLaunchKernelGGL(fwd_kernel, dim3(grid), dim3(512), LDS_BYTES, stream, a);
#else
    for (int l = 0; l < DEPTH; ++l) launch_phases<0>(grid, a, l, stream);
#endif
}
```

```cpp
#include <hip/hip_runtime.h>
#include <cstdio>
#include <cstdint>

#define GAS __attribute__((address_space(1)))
#define LAS __attribute__((address_space(3)))
typedef unsigned short bf16;
typedef short bf16x8 __attribute__((ext_vector_type(8)));
typedef float f32x4 __attribute__((ext_vector_type(4)));
typedef float f32x2 __attribute__((ext_vector_type(2)));
typedef unsigned u32x4 __attribute__((ext_vector_type(4)));
typedef unsigned u32x2 __attribute__((ext_vector_type(2)));
typedef int i32x4 __attribute__((ext_vector_type(4)));

constexpr int D = 1024, NBATCH = 4, SEQ = 4096, M = NBATCH * SEQ, DEPTH = 2, MEML = 256, MM = NBATCH * MEML;
constexpr int NIN = 8456;
constexpr int PP = 5376;
constexpr int C_MQ = 0, C_MK = 512, C_MV = 1024, C_MO = 1536, C_AQ = 2048, C_AK = 2816, C_AV = 3584, C_GU = 4352, C_GV = 4864;
constexpr int NEXP = 16, DFF = 512;
constexpr int LCH = 128, NCH = SEQ / LCH;
constexpr float EPS = 1e-6f;
constexpr int MAXT = 144;

constexpr size_t MiB = 1u << 20;
constexpr size_t WS_CTL = 0, CTL_ZERO_BYTES = 1 * MiB;
constexpr size_t WS_SMALL = 1 * MiB;
constexpr size_t OFF_GATES = WS_SMALL;
constexpr size_t OFF_AMA = OFF_GATES + (size_t)M * 8 * 4;
constexpr size_t OFF_AMM = OFF_AMA + 16 * SEQ * 4;
constexpr size_t OFF_AMB = OFF_AMM + 16 * SEQ * 4;
constexpr size_t OFF_LSE = OFF_AMB + 16 * SEQ * 4;
constexpr size_t OFF_BIAS = OFF_LSE + (size_t)M * 12 * 4;
constexpr size_t OFF_TOKE = OFF_BIAS + 12 * 132 * 4;
constexpr size_t OFF_TOKP = OFF_TOKE + (size_t)M * 2 * 4;
constexpr size_t OFF_TOKW = OFF_TOKP + (size_t)M * 2 * 4;
constexpr size_t OFF_SLOT = OFF_TOKW + (size_t)M * 2 * 4;
constexpr size_t OFF_WROW = OFF_SLOT + (size_t)M * 2 * 4;
constexpr size_t OFF_NST = OFF_WROW + (size_t)MAXT * 256 * 4;
constexpr size_t OFF_MEMB = OFF_NST + (size_t)16 * NCH * 128 * 4;
constexpr size_t OFF_KV = OFF_MEMB + (size_t)MM * D * 2;
constexpr size_t OFF_CNTW = OFF_KV + (size_t)MM * 1024 * 2;
constexpr size_t OFF_SSQ = OFF_CNTW + 256 * 16 * 4;
constexpr size_t OFF_ROWTOK = OFF_SSQ + (size_t)M * 16 * 4;
constexpr size_t OFF_SMALL_END = OFF_ROWTOK + (size_t)MAXT * 256 * 4;
static_assert(OFF_SMALL_END <= 17 * MiB, "small region");
constexpr size_t WS_W = 17 * MiB;
constexpr size_t OFF_WIN1 = WS_W;
constexpr size_t OFF_WG = OFF_WIN1 + (size_t)5376 * 1024 * 2;
constexpr size_t OFF_WA = OFF_WG + (size_t)3072 * 1024 * 2;
constexpr size_t OFF_WB = OFF_WA + (size_t)1024 * 512 * 2;
constexpr size_t OFF_WC = OFF_WB + (size_t)1024 * 768 * 2;
constexpr size_t OFF_WOUT = OFF_WC + (size_t)1024 * 512 * 2;
constexpr size_t OFF_WXQ = OFF_WOUT + (size_t)1024 * 1024 * 2;
constexpr size_t OFF_WXKV = OFF_WXQ + (size_t)512 * 1024 * 2;
constexpr size_t OFF_WXO = OFF_WXKV + (size_t)1024 * 1024 * 2;
constexpr size_t OFF_WGU = OFF_WXO + (size_t)1024 * 512 * 2;
constexpr size_t OFF_WD = OFF_WGU + (size_t)16 * 1024 * 1024 * 2;
constexpr size_t OFF_W_END = OFF_WD + (size_t)16 * 1024 * 512 * 2;
static_assert(OFF_W_END <= 93 * MiB, "weight region");
constexpr size_t WS_XB = 93 * MiB;
constexpr size_t WS_PROJ = 125 * MiB;
constexpr size_t OFF_XG = WS_PROJ, OFF_HID = WS_PROJ + 72 * MiB;
constexpr size_t WS_X1B = WS_PROJ + 120 * MiB;
constexpr size_t WS_T = 293 * MiB;
constexpr size_t OFF_Q = WS_T, OFF_O = WS_T + 16 * MiB;
constexpr size_t WS_YA = 327 * MiB, WS_YC = 343 * MiB;
constexpr size_t WS_END = 359 * MiB;
constexpr int CW_TMO = 0, CW_CODE = 1;
constexpr int CW_CNT = 64;
constexpr int CW_BAR = 4096;

constexpr int LDS_BYTES = 147456;
constexpr int LDS_TAB = 145408;
constexpr int LDS_WOFF = 0;
constexpr int LDS_ROWL = 131072;
constexpr int LDS_MISC = 146944;

#define RLX_AGENT __ATOMIC_RELAXED, __HIP_MEMORY_SCOPE_AGENT
#define LDS_WAIT() asm volatile("s_waitcnt lgkmcnt(0)" ::: "memory")
#define VM_WAIT() asm volatile("s_waitcnt vmcnt(0)" ::: "memory")
typedef __bf16 bf16x2_t __attribute__((ext_vector_type(2)));
__device__ __forceinline__ unsigned pk2(float lo, float hi) { const f32x2 v = {lo, hi}; return __builtin_bit_cast(unsigned, __builtin_convertvector(v, bf16x2_t)); }
__device__ __forceinline__ unsigned f2bf(float f) { return pk2(f, 0.f) & 0xffffu; }
__device__ __forceinline__ float bf2f(unsigned h) { return __builtin_bit_cast(float, h << 16); }
__device__ __forceinline__ float bflo(unsigned w) { return __builtin_bit_cast(float, w << 16); }
__device__ __forceinline__ float bfhi(unsigned w) { return __builtin_bit_cast(float, w & 0xffff0000u); }
__device__ __forceinline__ float wave_sum(float v) {
#pragma unroll
    for (int o = 1; o < 64; o <<= 1) v += __shfl_xor(v, o);
    return v;
}
__device__ __forceinline__ float sigmoidf_(float x) { return __builtin_amdgcn_rcpf(1.f + __expf(-x)); }
__device__ __forceinline__ float siluf_(float x) { return x * __builtin_amdgcn_rcpf(1.f + __expf(-x)); }
__device__ __forceinline__ float gelu_tanh(float x) { const float u = 0.7978845608028654f * (x + 0.044715f * x * x * x); return x * __builtin_amdgcn_rcpf(1.f + __expf(-2.f * u)); }
__device__ __forceinline__ void unpack8(const u32x4 w, float (&f)[8]) { f[0] = bflo(w.x); f[1] = bfhi(w.x); f[2] = bflo(w.y); f[3] = bfhi(w.y); f[4] = bflo(w.z); f[5] = bfhi(w.z); f[6] = bflo(w.w); f[7] = bfhi(w.w); }
__device__ __forceinline__ u32x4 pack8(const float (&f)[8]) { u32x4 w; w.x = pk2(f[0], f[1]); w.y = pk2(f[2], f[3]); w.z = pk2(f[4], f[5]); w.w = pk2(f[6], f[7]); return w; }

namespace pg8 {
constexpr int BM = 256, BK = 64, HALF = 128, HTB = HALF * BK * 2  , STAGE_BYTES = 8 * HTB, NXCD = 8, WGM = 8;
__host__ __device__ __forceinline__ int lds_byte(int r, int c) { const int st = (r >> 4) * 2 + (c >> 5), rr = r & 15, cc = c & 31, ob = rr * 64 + cc * 2; return st * 1024 + (ob ^ (((ob >> 9) & 1) << 5)); }
__host__ __device__ __forceinline__ void stage_rc(int b, int& R, int& C) { const int st = b / 1024, sb = b % 1024, swz = sb ^ (((sb >> 9) & 1) << 5); R = (st >> 1) * 16 + swz / 64; C = (st & 1) * 32 + (swz % 64) / 2; }
__host__ __device__ __forceinline__ int perm32(int rho) { const int n = rho >> 4, i = rho & 15; return 8 * (i >> 2) + 4 * n + (i & 3); }

struct Unit { int pm, pn; };
struct Gemm { const bf16* A; const bf16* Bt; int lda, K; };

struct StaticOrder {
    int nM, nN, nwg, G, c;
    __host__ __device__ __forceinline__ void init(int M_, int N_, int G_, int c_) { nM = M_ / BM; nN = N_ / BM; nwg = nM * nN; G = G_; c = c_; }
    __host__ __device__ __forceinline__ bool next(int i, Unit& u) const {
        const long L = (long)i * G + c; if (L >= nwg) return false;
        int wgid = (int)L; { const int q = nwg / NXCD, r = nwg % NXCD, xcd = wgid % NXCD, off = wgid / NXCD; wgid = (xcd < r ? xcd * (q + 1) : r * (q + 1) + (xcd - r) * q) + off; }
        const int nig = WGM * nN, gid = wgid / nig, fm = gid * WGM, gsz = (nM - fm) < WGM ? (nM - fm) : WGM;
        u.pm = fm + ((wgid % nig) % gsz); u.pn = (wgid % nig) / gsz; return true;
    }
    __device__ __forceinline__ void a_ready(const Unit&) const {}
    __device__ __forceinline__ void done(const Unit&) const {}
};


__device__ __forceinline__ f32x4 mma16(const bf16x8 a, const bf16x8 b, const f32x4 c) { return __builtin_amdgcn_mfma_f32_16x16x32_bf16(a, b, c, 0, 0, 0); }
__device__ __forceinline__ i32x4 mma16(const bf16x8 a, const bf16x8 b, const i32x4 c) { return __builtin_amdgcn_mfma_i32_16x16x64_i8(__builtin_bit_cast(i32x4, a), __builtin_bit_cast(i32x4, b), c, 0, 0, 0); }
template <bool I8> struct AccSel { typedef f32x4 T; };
template <> struct AccSel<true> { typedef i32x4 T; };
template <class Epi, class Sched, bool ALIGN_EPI = false, bool I8 = false>
__device__ __forceinline__ void gemm_phase(LAS unsigned char* lds, const Gemm g, const Sched& S, const Epi& E) {
    int tid_ = threadIdx.x; asm volatile("" : "+v"(tid_));
    const int tid = tid_, wid = __builtin_amdgcn_readfirstlane(tid >> 6), lane = tid & 63, wr = wid >> 2, wc = wid & 3, fr = lane & 15, fq = lane >> 4;
    const int K = g.K, nt = K / BK, lda = g.lda;
    unsigned voffA[2], voffB[2];
#pragma unroll
    for (int i = 0; i < 2; ++i) { int R, C; stage_rc(tid * 16 + i * 8192, R, C); const int Rb = Epi::PERM ? ((R & ~31) + perm32(R & 31)) : R;
        voffA[i] = (unsigned)(R * lda + C) * 2u; voffB[i] = (unsigned)(Rb * K + C) * 2u; }
    const size_t kstep = (size_t)(BK * 2);
    const size_t hstepA = (size_t)HALF * lda * 2, hstepB = (size_t)HALF * K * 2;
    const size_t tstepA = 2 * hstepA, tstepB = 2 * hstepB;
    const unsigned ldsw = (unsigned)wid * 1024u;
    const int aoff = lds_byte(wr * 64 + fr, fq * 8), boff = lds_byte(wc * 32 + fr, fq * 8);
#define PG8_SA(b, h) (((b) * 2 + (h)) * HTB)
#define PG8_SB(b, h) ((4 + (b) * 2 + (h)) * HTB)
#define PG8_STAGE(bufoff, gbase, voff) do { _Pragma("unroll") for (int _i = 0; _i < 2; ++_i) \
        __builtin_amdgcn_global_load_lds((const unsigned*)((const char*)(gbase) + (voff)[_i]), (LAS unsigned*)(lds + (bufoff) + ldsw + _i * 8192), 16, 0, 0); } while (0)
#define PG8_LDA(dst, b, h) do { _Pragma("unroll") for (int m = 0; m < 4; ++m) _Pragma("unroll") for (int k = 0; k < 2; ++k) dst[m][k] = *(const LAS bf16x8*)(lds + PG8_SA(b, h) + aoff + m * 2048 + k * 1024); } while (0)
#define PG8_LDB(dst, b, h) do { _Pragma("unroll") for (int n = 0; n < 2; ++n) _Pragma("unroll") for (int k = 0; k < 2; ++k) dst[n][k] = *(const LAS bf16x8*)(lds + PG8_SB(b, h) + boff + n * 2048 + k * 1024); } while (0)
#define PG8_MMA(ai, bj, At, Bt) do { __builtin_amdgcn_s_setprio(1); _Pragma("unroll") for (int m = 0; m < 4; ++m) _Pragma("unroll") for (int n = 0; n < 2; ++n) _Pragma("unroll") for (int k = 0; k < 2; ++k) \
        acc[ai][bj][m][n] = mma16(Bt[n][k], At[m][k], acc[ai][bj][m][n]); __builtin_amdgcn_s_setprio(0); } while (0)
#define PG8_WAIT_V(n) asm volatile("s_waitcnt vmcnt(" #n ")" ::: "memory")
#define PG8_WAIT_L(n) asm volatile("s_waitcnt lgkmcnt(" #n ")" ::: "memory")
#define PG8_BAR __builtin_amdgcn_s_barrier()
#define PG8_SCHED __builtin_amdgcn_sched_barrier(0)
    Unit cur, nxt; int ui = 0;
    if (!S.next(0, cur)) return;
    typedef typename AccSel<I8>::T acc_t;
    acc_t acc[2][2][4][2];
#pragma unroll
    for (int a = 0; a < 2; ++a)
#pragma unroll
        for (int b = 0; b < 2; ++b)
#pragma unroll
            for (int m = 0; m < 4; ++m)
#pragma unroll
                for (int n = 0; n < 2; ++n) acc[a][b][m][n] = (acc_t){0, 0, 0, 0};
    bf16x8 At[4][2], B0[2][2], B1[2][2];
    const char* cA = (const char*)g.A + (size_t)cur.pm * tstepA; const char* cB = (const char*)g.Bt + (size_t)cur.pn * tstepB;
    S.a_ready(cur);
    PG8_STAGE(PG8_SB(0, 0), cB, voffB); PG8_STAGE(PG8_SB(0, 1), cB + hstepB, voffB); PG8_STAGE(PG8_SA(0, 0), cA, voffA); PG8_STAGE(PG8_SA(0, 1), cA + hstepA, voffA);
    if (wr == 1) PG8_BAR;
    PG8_WAIT_V(2); PG8_BAR;
    PG8_STAGE(PG8_SB(1, 0), cB + kstep, voffB); PG8_STAGE(PG8_SA(1, 0), cA + kstep, voffA); PG8_STAGE(PG8_SB(1, 1), cB + hstepB + kstep, voffB);
    PG8_WAIT_V(6); PG8_BAR;
    for (;;) {
        const bool has_next = S.next(ui + 1, nxt);
        const char* nA = has_next ? (const char*)g.A + (size_t)nxt.pm * tstepA : cA; const char* nB = has_next ? (const char*)g.Bt + (size_t)nxt.pn * tstepB : cB;
        for (int t = 0; t < nt; t += 2) {
            const bool last = (t == nt - 2);
            const char* a1 = cA + (size_t)(t + 1) * kstep;
            const char* a2 = last ? nA : cA + (size_t)(t + 2) * kstep; const char* b2 = last ? nB : cB + (size_t)(t + 2) * kstep;
            const char* a3 = a2 + kstep; const char* b3 = b2 + kstep;
            if (last && has_next) S.a_ready(nxt);
            PG8_LDB(B0, 0, 0); PG8_LDB(B1, 0, 1); PG8_SCHED; PG8_LDA(At, 0, 0); PG8_STAGE(PG8_SA(1, 1), a1 + hstepA, voffA);
            PG8_WAIT_V(8); PG8_WAIT_L(0); PG8_BAR; PG8_MMA(0, 0, At, B0); PG8_MMA(0, 1, At, B1); PG8_BAR; PG8_SCHED;
            PG8_LDA(At, 0, 1); PG8_STAGE(PG8_SB(0, 0), b2, voffB); PG8_STAGE(PG8_SB(0, 1), b2 + hstepB, voffB); PG8_STAGE(PG8_SA(0, 0), a2, voffA);
            PG8_WAIT_V(8); PG8_WAIT_L(0); PG8_BAR; PG8_MMA(1, 0, At, B0); PG8_MMA(1, 1, At, B1); PG8_BAR; PG8_SCHED;
            PG8_LDB(B0, 1, 0); PG8_LDB(B1, 1, 1); PG8_SCHED; PG8_LDA(At, 1, 0); PG8_STAGE(PG8_SA(0, 1), a2 + hstepA, voffA);
            PG8_WAIT_V(8); PG8_WAIT_L(0); PG8_BAR; PG8_MMA(0, 0, At, B0); PG8_MMA(0, 1, At, B1); PG8_BAR; PG8_SCHED;
            PG8_LDA(At, 1, 1); PG8_STAGE(PG8_SB(1, 0), b3, voffB); PG8_STAGE(PG8_SB(1, 1), b3 + hstepB, voffB); PG8_STAGE(PG8_SA(1, 0), a3, voffA);
            PG8_WAIT_V(8); PG8_WAIT_L(0); PG8_BAR; PG8_MMA(1, 0, At, B0); PG8_MMA(1, 1, At, B1); PG8_BAR; PG8_SCHED;
        }
        if constexpr (ALIGN_EPI) { if (wr == 0) PG8_BAR; }
        E(acc, cur, wr, wc, fr, fq); S.done(cur);
        if (!has_next) break;
#pragma unroll
        for (int a = 0; a < 2; ++a)
#pragma unroll
            for (int b = 0; b < 2; ++b)
#pragma unroll
                for (int m = 0; m < 4; ++m)
#pragma unroll
                    for (int n = 0; n < 2; ++n) acc[a][b][m][n] = (acc_t){0, 0, 0, 0};
        cur = nxt; cA = nA; cB = nB; ++ui;
        if constexpr (ALIGN_EPI) { if (wr == 1) PG8_BAR; }
    }
    PG8_WAIT_V(0);
    if constexpr (!ALIGN_EPI) { if (wr == 0) PG8_BAR; }
    PG8_BAR;
#undef PG8_SA
#undef PG8_SB
#undef PG8_STAGE
#undef PG8_LDA
#undef PG8_LDB
#undef PG8_MMA
#undef PG8_WAIT_V
#undef PG8_WAIT_L
#undef PG8_BAR
#undef PG8_SCHED
}

template <class Epi, class Sched, bool ALIGN_EPI = false>
__device__ __forceinline__ void gemm_phase_g(LAS unsigned char* lds, const Gemm g, const LAS int* rowl, const Sched& S, const Epi& E) {
    constexpr bool I8 = false;
    int tid_ = threadIdx.x; asm volatile("" : "+v"(tid_));
    const int tid = tid_, wid = __builtin_amdgcn_readfirstlane(tid >> 6), lane = tid & 63, wr = wid >> 2, wc = wid & 3, fr = lane & 15, fq = lane >> 4;
    const int K = g.K, nt = K / BK, lda = g.lda;
    unsigned voffB[2]; int RA[2], CA;
#pragma unroll
    for (int i = 0; i < 2; ++i) { int R, C; stage_rc(tid * 16 + i * 8192, R, C); const int Rb = Epi::PERM ? ((R & ~31) + perm32(R & 31)) : R;
        RA[i] = R; CA = C; voffB[i] = (unsigned)(Rb * K + C) * 2u; }
    size_t gc[2][2], gn[2][2];
#define PG8_GOFF(dst, ord) do { _Pragma("unroll") for (int h = 0; h < 2; ++h) _Pragma("unroll") for (int i = 0; i < 2; ++i) dst[h][i] = ((size_t)rowl[(ord) * BM + h * HALF + RA[i]] * lda + CA) * 2; } while (0)
#define PG8_STAGEG(bufoff, gbase, goffh) do { _Pragma("unroll") for (int _i = 0; _i < 2; ++_i) \
        __builtin_amdgcn_global_load_lds((const unsigned*)((const char*)(gbase) + (goffh)[_i]), (LAS unsigned*)(lds + (bufoff) + ldsw + _i * 8192), 16, 0, 0); } while (0)
    const size_t kstep = (size_t)(BK * 2);
    const size_t hstepA = (size_t)HALF * lda * 2, hstepB = (size_t)HALF * K * 2;
    const size_t tstepA = 2 * hstepA, tstepB = 2 * hstepB;
    const unsigned ldsw = (unsigned)wid * 1024u;
    const int aoff = lds_byte(wr * 64 + fr, fq * 8), boff = lds_byte(wc * 32 + fr, fq * 8);
#define PG8_SA(b, h) (((b) * 2 + (h)) * HTB)
#define PG8_SB(b, h) ((4 + (b) * 2 + (h)) * HTB)
#define PG8_STAGE(bufoff, gbase, voff) do { _Pragma("unroll") for (int _i = 0; _i < 2; ++_i) \
        __builtin_amdgcn_global_load_lds((const unsigned*)((const char*)(gbase) + (voff)[_i]), (LAS unsigned*)(lds + (bufoff) + ldsw + _i * 8192), 16, 0, 0); } while (0)
#define PG8_LDA(dst, b, h) do { _Pragma("unroll") for (int m = 0; m < 4; ++m) _Pragma("unroll") for (int k = 0; k < 2; ++k) dst[m][k] = *(const LAS bf16x8*)(lds + PG8_SA(b, h) + aoff + m * 2048 + k * 1024); } while (0)
#define PG8_LDB(dst, b, h) do { _Pragma("unroll") for (int n = 0; n < 2; ++n) _Pragma("unroll") for (int k = 0; k < 2; ++k) dst[n][k] = *(const LAS bf16x8*)(lds + PG8_SB(b, h) + boff + n * 2048 + k * 1024); } while (0)
#define PG8_MMA(ai, bj, At, Bt) do { __builtin_amdgcn_s_setprio(1); _Pragma("unroll") for (int m = 0; m < 4; ++m) _Pragma("unroll") for (int n = 0; n < 2; ++n) _Pragma("unroll") for (int k = 0; k < 2; ++k) \
        acc[ai][bj][m][n] = mma16(Bt[n][k], At[m][k], acc[ai][bj][m][n]); __builtin_amdgcn_s_setprio(0); } while (0)
#define PG8_WAIT_V(n) asm volatile("s_waitcnt vmcnt(" #n ")" ::: "memory")
#define PG8_WAIT_L(n) asm volatile("s_waitcnt lgkmcnt(" #n ")" ::: "memory")
#define PG8_BAR __builtin_amdgcn_s_barrier()
#define PG8_SCHED __builtin_amdgcn_sched_barrier(0)
    Unit cur, nxt; int ui = 0;
    if (!S.next(0, cur)) return;
    typedef typename AccSel<I8>::T acc_t;
    acc_t acc[2][2][4][2];
#pragma unroll
    for (int a = 0; a < 2; ++a)
#pragma unroll
        for (int b = 0; b < 2; ++b)
#pragma unroll
            for (int m = 0; m < 4; ++m)
#pragma unroll
                for (int n = 0; n < 2; ++n) acc[a][b][m][n] = (acc_t){0, 0, 0, 0};
    bf16x8 At[4][2], B0[2][2], B1[2][2];
    const char* const cA = (const char*)g.A; const char* cB = (const char*)g.Bt + (size_t)cur.pn * tstepB;
    PG8_GOFF(gc, 0);
    S.a_ready(cur);
    PG8_STAGE(PG8_SB(0, 0), cB, voffB); PG8_STAGE(PG8_SB(0, 1), cB + hstepB, voffB); PG8_STAGEG(PG8_SA(0, 0), cA, gc[0]); PG8_STAGEG(PG8_SA(0, 1), cA, gc[1]);
    if (wr == 1) PG8_BAR;
    PG8_WAIT_V(2); PG8_BAR;
    PG8_STAGE(PG8_SB(1, 0), cB + kstep, voffB); PG8_STAGEG(PG8_SA(1, 0), cA + kstep, gc[0]); PG8_STAGE(PG8_SB(1, 1), cB + hstepB + kstep, voffB);
    PG8_WAIT_V(6); PG8_BAR;
    for (;;) {
        const bool has_next = S.next(ui + 1, nxt);
        const char* nB = has_next ? (const char*)g.Bt + (size_t)nxt.pn * tstepB : cB;
        if (has_next) PG8_GOFF(gn, ui + 1); else {
#pragma unroll
            for (int h = 0; h < 2; ++h)
#pragma unroll
                for (int i = 0; i < 2; ++i) gn[h][i] = gc[h][i]; }
        for (int t = 0; t < nt; t += 2) {
            const bool last = (t == nt - 2);
            const char* a1 = cA + (size_t)(t + 1) * kstep;
            const char* a2 = last ? cA : cA + (size_t)(t + 2) * kstep; const char* b2 = last ? nB : cB + (size_t)(t + 2) * kstep;
            size_t g2[2][2];
#pragma unroll
            for (int h = 0; h < 2; ++h)
#pragma unroll
                for (int i = 0; i < 2; ++i) g2[h][i] = last ? gn[h][i] : gc[h][i];
            const char* a3 = a2 + kstep; const char* b3 = b2 + kstep;
            if (last && has_next) S.a_ready(nxt);
            PG8_LDB(B0, 0, 0); PG8_LDB(B1, 0, 1); PG8_SCHED; PG8_LDA(At, 0, 0); PG8_STAGEG(PG8_SA(1, 1), a1, gc[1]);
            PG8_WAIT_V(8); PG8_WAIT_L(0); PG8_BAR; PG8_MMA(0, 0, At, B0); PG8_MMA(0, 1, At, B1); PG8_BAR; PG8_SCHED;
            PG8_LDA(At, 0, 1); PG8_STAGE(PG8_SB(0, 0), b2, voffB); PG8_STAGE(PG8_SB(0, 1), b2 + hstepB, voffB); PG8_STAGEG(PG8_SA(0, 0), a2, g2[0]);
            PG8_WAIT_V(8); PG8_WAIT_L(0); PG8_BAR; PG8_MMA(1, 0, At, B0); PG8_MMA(1, 1, At, B1); PG8_BAR; PG8_SCHED;
            PG8_LDB(B0, 1, 0); PG8_LDB(B1, 1, 1); PG8_SCHED; PG8_LDA(At, 1, 0); PG8_STAGEG(PG8_SA(0, 1), a2, g2[1]);
            PG8_WAIT_V(8); PG8_WAIT_L(0); PG8_BAR; PG8_MMA(0, 0, At, B0); PG8_MMA(0, 1, At, B1); PG8_BAR; PG8_SCHED;
            PG8_LDA(At, 1, 1); PG8_STAGE(PG8_SB(1, 0), b3, voffB); PG8_STAGE(PG8_SB(1, 1), b3 + hstepB, voffB); PG8_STAGEG(PG8_SA(1, 0), a3, g2[0]);
            PG8_WAIT_V(8); PG8_WAIT_L(0); PG8_BAR; PG8_MMA(1, 0, At, B0); PG8_MMA(1, 1, At, B1); PG8_BAR; PG8_SCHED;
        }
        if constexpr (ALIGN_EPI) { if (wr == 0) PG8_BAR; }
        E(acc, cur, wr, wc, fr, fq); S.done(cur);
        if (!has_next) break;
#pragma unroll
        for (int a = 0; a < 2; ++a)
#pragma unroll
            for (int b = 0; b < 2; ++b)
#pragma unroll
                for (int m = 0; m < 4; ++m)
#pragma unroll
                    for (int n = 0; n < 2; ++n) acc[a][b][m][n] = (acc_t){0, 0, 0, 0};
        cur = nxt; cB = nB; ++ui;
#pragma unroll
        for (int h = 0; h < 2; ++h)
#pragma unroll
            for (int i = 0; i < 2; ++i) gc[h][i] = gn[h][i];
        if constexpr (ALIGN_EPI) { if (wr == 1) PG8_BAR; }
    }
    PG8_WAIT_V(0);
    if constexpr (!ALIGN_EPI) { if (wr == 0) PG8_BAR; }
    PG8_BAR;
#undef PG8_SA
#undef PG8_SB
#undef PG8_STAGE
#undef PG8_STAGEG
#undef PG8_GOFF
#undef PG8_LDA
#undef PG8_LDB
#undef PG8_MMA
#undef PG8_WAIT_V
#undef PG8_WAIT_L
#undef PG8_BAR
#undef PG8_SCHED
}

struct SUnit { int pm, pn, kind; const char* a; const char* b; int lda, K; };
template <class Epi, class Sched, bool ALIGN_EPI = false>
__device__ __forceinline__ void gemm_stream(LAS unsigned char* lds, const Sched& S, const Epi& E) {
    int tid_ = threadIdx.x; asm volatile("" : "+v"(tid_));
    const int tid = tid_, wid = __builtin_amdgcn_readfirstlane(tid >> 6), lane = tid & 63, wr = wid >> 2, wc = wid & 3, fr = lane & 15, fq = lane >> 4;
    int R0, C0; stage_rc(tid * 16, R0, C0); const int Rb0 = Epi::PERM ? ((R0 & ~31) + perm32(R0 & 31)) : R0;
    const size_t kstep = (size_t)(BK * 2);
    const unsigned ldsw = (unsigned)wid * 1024u;
    const int aoff = lds_byte(wr * 64 + fr, fq * 8), boff = lds_byte(wc * 32 + fr, fq * 8);
#define PG8_SA(b, h) (((b) * 2 + (h)) * HTB)
#define PG8_SB(b, h) ((4 + (b) * 2 + (h)) * HTB)
#define PG8_STG(bufoff, gbase, v0, p64) do { _Pragma("unroll") for (int _i = 0; _i < 2; ++_i) \
        __builtin_amdgcn_global_load_lds((const unsigned*)((const char*)(gbase) + (v0) + (size_t)_i * (p64)), (LAS unsigned*)(lds + (bufoff) + ldsw + _i * 8192), 16, 0, 0); } while (0)
#define PG8_LDA(dst, b, h) do { _Pragma("unroll") for (int m = 0; m < 4; ++m) _Pragma("unroll") for (int k = 0; k < 2; ++k) dst[m][k] = *(const LAS bf16x8*)(lds + PG8_SA(b, h) + aoff + m * 2048 + k * 1024); } while (0)
#define PG8_LDB(dst, b, h) do { _Pragma("unroll") for (int n = 0; n < 2; ++n) _Pragma("unroll") for (int k = 0; k < 2; ++k) dst[n][k] = *(const LAS bf16x8*)(lds + PG8_SB(b, h) + boff + n * 2048 + k * 1024); } while (0)
#define PG8_MMA(ai, bj, At, Bt) do { __builtin_amdgcn_s_setprio(1); _Pragma("unroll") for (int m = 0; m < 4; ++m) _Pragma("unroll") for (int n = 0; n < 2; ++n) _Pragma("unroll") for (int k = 0; k < 2; ++k) \
        acc[ai][bj][m][n] = mma16(Bt[n][k], At[m][k], acc[ai][bj][m][n]); __builtin_amdgcn_s_setprio(0); } while (0)
#define PG8_WAIT_V(n) asm volatile("s_waitcnt vmcnt(" #n ")" ::: "memory")
#define PG8_WAIT_L(n) asm volatile("s_waitcnt lgkmcnt(" #n ")" ::: "memory")
#define PG8_BAR __builtin_amdgcn_s_barrier()
#define PG8_SCHED __builtin_amdgcn_sched_barrier(0)
    SUnit cur, nxt; int ui = 0;
    if (!S.next(0, cur)) return;
    f32x4 acc[2][2][4][2];
#pragma unroll
    for (int a = 0; a < 2; ++a)
#pragma unroll
        for (int b = 0; b < 2; ++b)
#pragma unroll
            for (int m = 0; m < 4; ++m)
#pragma unroll
                for (int n = 0; n < 2; ++n) acc[a][b][m][n] = (f32x4){0.f, 0.f, 0.f, 0.f};
    bf16x8 At[4][2], B0[2][2], B1[2][2];
    const char* cA = cur.a; const char* cB = cur.b;
    unsigned vAc = (unsigned)(R0 * cur.lda + C0) * 2u, vBc = (unsigned)(Rb0 * cur.K + C0) * 2u;
    size_t pAc = (size_t)cur.lda * 128, pBc = (size_t)cur.K * 128;
    PG8_STG(PG8_SB(0, 0), cB, vBc, pBc); PG8_STG(PG8_SB(0, 1), cB + 2 * pBc, vBc, pBc); PG8_STG(PG8_SA(0, 0), cA, vAc, pAc); PG8_STG(PG8_SA(0, 1), cA + 2 * pAc, vAc, pAc);
    if (wr == 1) PG8_BAR;
    PG8_WAIT_V(2); PG8_BAR;
    PG8_STG(PG8_SB(1, 0), cB + kstep, vBc, pBc); PG8_STG(PG8_SA(1, 0), cA + kstep, vAc, pAc); PG8_STG(PG8_SB(1, 1), cB + 2 * pBc + kstep, vBc, pBc);
    PG8_WAIT_V(6); PG8_BAR;
    for (;;) {
        const bool has_next = S.next(ui + 1, nxt);
        const char* nA = has_next ? nxt.a : cA; const char* nB = has_next ? nxt.b : cB;
        const unsigned vAn = has_next ? (unsigned)(R0 * nxt.lda + C0) * 2u : vAc, vBn = has_next ? (unsigned)(Rb0 * nxt.K + C0) * 2u : vBc;
        const size_t pAn = has_next ? (size_t)nxt.lda * 128 : pAc, pBn = has_next ? (size_t)nxt.K * 128 : pBc;
        const int nt = cur.K / BK;
        for (int t = 0; t < nt; t += 2) {
            const bool last = (t == nt - 2);
            const char* a1 = cA + (size_t)(t + 1) * kstep;
            const char* a2 = last ? nA : cA + (size_t)(t + 2) * kstep; const char* b2 = last ? nB : cB + (size_t)(t + 2) * kstep;
            const char* a3 = a2 + kstep; const char* b3 = b2 + kstep;
            const unsigned va2 = last ? vAn : vAc, vb2 = last ? vBn : vBc; const size_t pa2 = last ? pAn : pAc, pb2 = last ? pBn : pBc;
            PG8_LDB(B0, 0, 0); PG8_LDB(B1, 0, 1); PG8_SCHED; PG8_LDA(At, 0, 0); PG8_STG(PG8_SA(1, 1), a1 + 2 * pAc, vAc, pAc);
            PG8_WAIT_V(8); PG8_WAIT_L(0); PG8_BAR; PG8_MMA(0, 0, At, B0); PG8_MMA(0, 1, At, B1); PG8_BAR; PG8_SCHED;
            PG8_LDA(At, 0, 1); PG8_STG(PG8_SB(0, 0), b2, vb2, pb2); PG8_STG(PG8_SB(0, 1), b2 + 2 * pb2, vb2, pb2); PG8_STG(PG8_SA(0, 0), a2, va2, pa2);
            PG8_WAIT_V(8); PG8_WAIT_L(0); PG8_BAR; PG8_MMA(1, 0, At, B0); PG8_MMA(1, 1, At, B1); PG8_BAR; PG8_SCHED;
            PG8_LDB(B0, 1, 0); PG8_LDB(B1, 1, 1); PG8_SCHED; PG8_LDA(At, 1, 0); PG8_STG(PG8_SA(0, 1), a2 + 2 * pa2, va2, pa2);
            PG8_WAIT_V(8); PG8_WAIT_L(0); PG8_BAR; PG8_MMA(0, 0, At, B0); PG8_MMA(0, 1, At, B1); PG8_BAR; PG8_SCHED;
            PG8_LDA(At, 1, 1); PG8_STG(PG8_SB(1, 0), b3, vb2, pb2); PG8_STG(PG8_SB(1, 1), b3 + 2 * pb2, vb2, pb2); PG8_STG(PG8_SA(1, 0), a3, va2, pa2);
            PG8_WAIT_V(8); PG8_WAIT_L(0); PG8_BAR; PG8_MMA(1, 0, At, B0); PG8_MMA(1, 1, At, B1); PG8_BAR; PG8_SCHED;
        }
        if constexpr (ALIGN_EPI) { if (wr == 0) PG8_BAR; }
#if defined(PROBE_EPI)
        { const unsigned long long te0_ = __builtin_amdgcn_s_memrealtime();
          E(acc, cur, wr, wc, fr, fq);
#if PROBE_EPI == 2
          asm volatile("s_waitcnt vmcnt(0)" ::: "memory");
#endif
          const unsigned long long dte_ = __builtin_amdgcn_s_memrealtime() - te0_, te1_ = __builtin_amdgcn_s_memrealtime();
          while (__builtin_amdgcn_s_memrealtime() - te1_ < 3 * dte_) __builtin_amdgcn_s_sleep(2); }
#else
        E(acc, cur, wr, wc, fr, fq);
#endif
        if (!has_next) break;
#pragma unroll
        for (int a = 0; a < 2; ++a)
#pragma unroll
            for (int b = 0; b < 2; ++b)
#pragma unroll
                for (int m = 0; m < 4; ++m)
#pragma unroll
                    for (int n = 0; n < 2; ++n) acc[a][b][m][n] = (f32x4){0.f, 0.f, 0.f, 0.f};
        cur = nxt; cA = nA; cB = nB; vAc = vAn; vBc = vBn; pAc = pAn; pBc = pBn; ++ui;
        if constexpr (ALIGN_EPI) { if (wr == 1) PG8_BAR; }
    }
    PG8_WAIT_V(0);
    if constexpr (!ALIGN_EPI) { if (wr == 0) PG8_BAR; }
    PG8_BAR;
#undef PG8_SA
#undef PG8_SB
#undef PG8_STG
#undef PG8_LDA
#undef PG8_LDB
#undef PG8_MMA
#undef PG8_WAIT_V
#undef PG8_WAIT_L
#undef PG8_BAR
#undef PG8_SCHED
}
}

namespace epi {
using pg8::Unit; using pg8::BM; using pg8::HALF;
__device__ __forceinline__ u32x4 pk8(const f32x4 v0, const f32x4 v1) { u32x4 w; w.x = pk2(v0[0], v0[1]); w.y = pk2(v0[2], v0[3]); w.z = pk2(v1[0], v1[1]); w.w = pk2(v1[2], v1[3]); return w; }
__device__ __forceinline__ void up8(const u32x4 w, f32x4& a, f32x4& b) { a = (f32x4){bflo(w.x), bfhi(w.x), bflo(w.y), bfhi(w.y)}; b = (f32x4){bflo(w.z), bfhi(w.z), bflo(w.w), bfhi(w.w)}; }
__device__ __forceinline__ int gcol(int tg) { return tg < 6 ? 256 * tg : 2816 + 256 * (tg - 6); }

struct Bf16Out {
    static constexpr bool PERM = true;
    bf16* O; int ldc;
    __device__ __forceinline__ void operator()(const f32x4 (&acc)[2][2][4][2], const Unit& u, int wr, int wc, int fr, int fq) const {
        const int row0 = u.pm * BM + wr * 64 + fr, col0 = u.pn * BM + wc * 32 + 8 * fq;
#pragma unroll
        for (int ai = 0; ai < 2; ++ai)
#pragma unroll
            for (int m = 0; m < 4; ++m) { bf16* rowp = O + (size_t)(row0 + ai * HALF + m * 16) * ldc + col0;
#pragma unroll
                for (int bj = 0; bj < 2; ++bj) {
#ifdef NT_STORE
                    __builtin_nontemporal_store(pk8(acc[ai][bj][m][0], acc[ai][bj][m][1]), (u32x4*)(rowp + bj * HALF));
#else
                    *(u32x4*)(rowp + bj * HALF) = pk8(acc[ai][bj][m][0], acc[ai][bj][m][1]);
#endif
                } }
    }
};
struct SigOut {
    static constexpr bool PERM = true;
    bf16* PROJ;
    __device__ __forceinline__ void operator()(const f32x4 (&acc)[2][2][4][2], const Unit& u, int wr, int wc, int fr, int fq) const {
        const int row0 = u.pm * BM + wr * 64 + fr, col0 = gcol(u.pn) + wc * 32 + 8 * fq;
#pragma unroll
        for (int ai = 0; ai < 2; ++ai)
#pragma unroll
            for (int m = 0; m < 4; ++m) { bf16* rowp = PROJ + (size_t)(row0 + ai * HALF + m * 16) * PP + col0;
#pragma unroll
                for (int bj = 0; bj < 2; ++bj) { f32x4 a = acc[ai][bj][m][0], b = acc[ai][bj][m][1];
#pragma unroll
                    for (int e = 0; e < 4; ++e) { a[e] = sigmoidf_(a[e]); b[e] = sigmoidf_(b[e]); }
                    *(u32x4*)(rowp + bj * HALF) = pk8(a, b); } }
    }
};
template <int BR> struct BranchOut {
    static constexpr bool PERM = true;
    const bf16* PROJ; bf16* T; bf16* OUT;
    __device__ __forceinline__ void operator()(const f32x4 (&acc)[2][2][4][2], const Unit& u, int wr, int wc, int fr, int fq) const {
        const int row0 = u.pm * BM + wr * 64 + fr, cw = wc * 32 + 8 * fq, gc0 = gcol(BR * 4 + u.pn) + cw, col0 = u.pn * BM + cw;
#pragma unroll
        for (int ai = 0; ai < 2; ++ai)
#pragma unroll
            for (int m = 0; m < 4; ++m) { const size_t row = (size_t)(row0 + ai * HALF + m * 16);
#pragma unroll
                for (int bj = 0; bj < 2; ++bj) {
                    f32x4 g0, g1; up8(*(const u32x4*)(PROJ + row * PP + gc0 + bj * HALF), g0, g1);
                    f32x4 v0 = g0 * acc[ai][bj][m][0], v1 = g1 * acc[ai][bj][m][1];
                    if (BR > 0) { f32x4 t0, t1; up8(*(const u32x4*)(T + row * 1024 + col0 + bj * HALF), t0, t1); v0 += t0; v1 += t1; }
                    bf16* dst = (BR == 2 ? OUT : T) + row * 1024 + col0 + bj * HALF;
                    *(u32x4*)dst = pk8(v0, v1); } }
    }
};
struct GateBranchOut {
    static constexpr bool PERM = true;
    bf16* PROJ; bf16* T;
    __device__ __forceinline__ void operator()(const f32x4 (&acc)[2][2][4][2], const pg8::SUnit& u, int wr, int wc, int fr, int fq) const {
        const int row0 = u.pm * BM + wr * 64 + fr, cw = wc * 32 + 8 * fq;
        if (u.kind < 3) {
            const int col0 = gcol(u.kind * 4 + u.pn) + cw;
#pragma unroll
            for (int ai = 0; ai < 2; ++ai)
#pragma unroll
                for (int m = 0; m < 4; ++m) { bf16* rowp = PROJ + (size_t)(row0 + ai * HALF + m * 16) * PP + col0;
#pragma unroll
                    for (int bj = 0; bj < 2; ++bj) { f32x4 a = acc[ai][bj][m][0], b = acc[ai][bj][m][1];
#pragma unroll
                        for (int e = 0; e < 4; ++e) { a[e] = sigmoidf_(a[e]); b[e] = sigmoidf_(b[e]); }
                        *(u32x4*)(rowp + bj * HALF) = pk8(a, b); } }
        } else {
            const int br = u.kind - 3, gc0 = gcol(br * 4 + u.pn) + cw, col0 = u.pn * BM + cw;
#pragma unroll
            for (int ai = 0; ai < 2; ++ai) {
                u32x4 gq[4][2], tq[4][2];
#pragma unroll
                for (int m = 0; m < 4; ++m)
#pragma unroll
                    for (int bj = 0; bj < 2; ++bj) { const size_t row = (size_t)(row0 + ai * HALF + m * 16); gq[m][bj] = *(const u32x4*)(PROJ + row * PP + gc0 + bj * HALF);
                        tq[m][bj] = br > 0 ? *(const u32x4*)(T + row * 1024 + col0 + bj * HALF) : (u32x4){0u, 0u, 0u, 0u}; }
#pragma unroll
                for (int m = 0; m < 4; ++m)
#pragma unroll
                    for (int bj = 0; bj < 2; ++bj) { const size_t row = (size_t)(row0 + ai * HALF + m * 16);
                        f32x4 g0, g1, t0, t1; up8(gq[m][bj], g0, g1); up8(tq[m][bj], t0, t1);
                        *(u32x4*)(T + row * 1024 + col0 + bj * HALF) = pk8(g0 * acc[ai][bj][m][0] + t0, g1 * acc[ai][bj][m][1] + t1); }
            }
        }
    }
};
struct ResidOut {
    static constexpr bool PERM = false;
    const float* SRC; float* DST;
    __device__ __forceinline__ void operator()(const f32x4 (&acc)[2][2][4][2], const Unit& u, int wr, int wc, int fr, int fq) const {
        const int row0 = u.pm * BM + wr * 64 + fr, col0 = u.pn * BM + wc * 32 + 4 * fq;
#pragma unroll
        for (int ai = 0; ai < 2; ++ai)
#pragma unroll
            for (int m = 0; m < 4; ++m) { const size_t off = (size_t)(row0 + ai * HALF + m * 16) * 1024 + col0;
#pragma unroll
                for (int bj = 0; bj < 2; ++bj)
#pragma unroll
                    for (int n = 0; n < 2; ++n) { const size_t o = off + bj * HALF + n * 16; *(f32x4*)(DST + o) = *(const f32x4*)(SRC + o) + acc[ai][bj][m][n]; } }
    }
};
template <bool SRC_F32> struct ResidBfOut {
    static constexpr bool PERM = true;
    const void* SRC; bf16* DST; float* SSQ;
    __device__ __forceinline__ void operator()(const f32x4 (&acc)[2][2][4][2], const Unit& u, int wr, int wc, int fr, int fq) const {
        const int row0 = u.pm * BM + wr * 64 + fr, col0 = u.pn * BM + wc * 32 + 8 * fq;
#pragma unroll
        for (int ai = 0; ai < 2; ++ai) {
            f32x4 sq[4][2][2];
#pragma unroll
            for (int m = 0; m < 4; ++m)
#pragma unroll
                for (int bj = 0; bj < 2; ++bj) { const size_t o = (size_t)(row0 + ai * HALF + m * 16) * 1024 + col0 + bj * HALF;
                    if (SRC_F32) { sq[m][bj][0] = *(const f32x4*)((const float*)SRC + o); sq[m][bj][1] = *(const f32x4*)((const float*)SRC + o + 4); } else up8(*(const u32x4*)((const bf16*)SRC + o), sq[m][bj][0], sq[m][bj][1]); }
#pragma unroll
            for (int m = 0; m < 4; ++m) { const int row = row0 + ai * HALF + m * 16; const size_t off = (size_t)row * 1024 + col0; float ss = 0.f;
#pragma unroll
                for (int bj = 0; bj < 2; ++bj) { const size_t o = off + bj * HALF;
                    const f32x4 v0 = sq[m][bj][0] + acc[ai][bj][m][0], v1 = sq[m][bj][1] + acc[ai][bj][m][1];
                    ss += ((v0[0] * v0[0] + v0[1] * v0[1]) + (v0[2] * v0[2] + v0[3] * v0[3])) + ((v1[0] * v1[0] + v1[1] * v1[1]) + (v1[2] * v1[2] + v1[3] * v1[3]));
                    *(u32x4*)(DST + o) = pk8(v0, v1); }
                if (SSQ) { ss += __shfl_xor(ss, 16); ss += __shfl_xor(ss, 32); if (fq == 0) SSQ[(size_t)row * 16 + u.pn * 4 + wc] = ss; } }
        }
    }
};
struct Bf16OutRs {
    static constexpr bool PERM = true;
    bf16* O; int ldc; const float* SSQ;
    __device__ __forceinline__ void operator()(const f32x4 (&acc)[2][2][4][2], const Unit& u, int wr, int wc, int fr, int fq) const {
        const int row0 = u.pm * BM + wr * 64 + fr, col0 = u.pn * BM + wc * 32 + 8 * fq;
        float rsv[2][4];
#pragma unroll
        for (int ai = 0; ai < 2; ++ai)
#pragma unroll
            for (int m = 0; m < 4; ++m) { const int row = row0 + ai * HALF + m * 16; const f32x4* sp = (const f32x4*)(SSQ + (size_t)row * 16);
                const f32x4 s0 = sp[0], s1 = sp[1], s2 = sp[2], s3 = sp[3]; const f32x4 st = (s0 + s1) + (s2 + s3);
                rsv[ai][m] = 1.f / sqrtf(((st[0] + st[1]) + (st[2] + st[3])) * (1.f / 1024.f) + EPS); }
#pragma unroll
        for (int ai = 0; ai < 2; ++ai)
#pragma unroll
            for (int m = 0; m < 4; ++m) { const int row = row0 + ai * HALF + m * 16; const float rs = rsv[ai][m]; bf16* rowp = O + (size_t)row * ldc + col0;
#pragma unroll
                for (int bj = 0; bj < 2; ++bj) *(u32x4*)(rowp + bj * HALF) = pk8(acc[ai][bj][m][0] * rs, acc[ai][bj][m][1] * rs); }
    }
};
struct GluOut {
    static constexpr bool PERM = true;
    bf16* HID;
    __device__ __forceinline__ void operator()(const f32x4 (&acc)[2][2][4][2], const Unit& u, int wr, int wc, int fr, int fq) const {
        const int row0 = u.pm * BM + wr * 64 + fr, col0 = (u.pn & 3) * 128 + wc * 32 + 8 * fq;
#pragma unroll
        for (int ai = 0; ai < 2; ++ai)
#pragma unroll
            for (int m = 0; m < 4; ++m) { f32x4 a = acc[ai][0][m][0], b = acc[ai][0][m][1]; const f32x4 ua = acc[ai][1][m][0], ub = acc[ai][1][m][1];
#pragma unroll
                for (int e = 0; e < 4; ++e) { a[e] = siluf_(a[e]) * ua[e]; b[e] = siluf_(b[e]) * ub[e]; }
                *(u32x4*)(HID + (size_t)(row0 + ai * HALF + m * 16) * DFF + col0) = pk8(a, b); }
    }
};
struct DownOut {
    static constexpr bool PERM = true;
    bf16* YE; const float* WROW;
    __device__ __forceinline__ void operator()(const f32x4 (&acc)[2][2][4][2], const Unit& u, int wr, int wc, int fr, int fq) const {
        const int row0 = u.pm * BM + wr * 64 + fr, col0 = (u.pn & 3) * BM + wc * 32 + 8 * fq;
#pragma unroll
        for (int ai = 0; ai < 2; ++ai)
#pragma unroll
            for (int m = 0; m < 4; ++m) { const int row = row0 + ai * HALF + m * 16; const float w = WROW[row]; bf16* rowp = YE + (size_t)row * 1024 + col0;
#pragma unroll
                for (int bj = 0; bj < 2; ++bj) *(u32x4*)(rowp + bj * HALF) = pk8(acc[ai][bj][m][0] * w, acc[ai][bj][m][1] * w); }
    }
};
}

struct MoeOrder {
    const LAS int* tab; int G, c;
    __device__ __forceinline__ bool next(int i, pg8::Unit& u) const {
        const int nT = tab[176];
        if (G % 8 != 0) { const int L = i * G + c; if (L >= 4 * nT) return false; const int pm = L >> 2; u.pm = pm; u.pn = tab[pm] * 4 + (L & 3); return true; }
        const int x = c & 7, j = c >> 3, per = G >> 3;
        const int t0 = (nT * x) >> 3, t1 = (nT * (x + 1)) >> 3;
        const int idx = i * per + j; if (idx >= 4 * (t1 - t0)) return false;
        const int pm = t0 + (idx >> 2); u.pm = pm; u.pn = tab[pm] * 4 + (idx & 3); return true;
    }
    __device__ __forceinline__ void a_ready(const pg8::Unit&) const {}
    __device__ __forceinline__ void done(const pg8::Unit&) const {}
};
#define XB_TMO      128
#define XB_XCNT(j)  (256  + 64 * (j))
#define XB_XSUB(j)  (1280 + 64 * (j))
#define XB_XGEN(j)  (2304 + 64 * (j))
#define XB_TOP      3328
#define XB_TOPGEN   3392
#define XCD_BAR_WORDS 3456
#define XB_SPIN_CAP (1u << 18)

__device__ __forceinline__ unsigned xb_ld(unsigned* p)              { return __hip_atomic_load(p, __ATOMIC_RELAXED, __HIP_MEMORY_SCOPE_AGENT); }
__device__ __forceinline__ unsigned xb_add(unsigned* p, unsigned v) { return __hip_atomic_fetch_add(p, v, __ATOMIC_RELAXED, __HIP_MEMORY_SCOPE_AGENT); }
__device__ __forceinline__ unsigned xb_xcc_id() { return (unsigned)__builtin_amdgcn_s_getreg((3 << 11) | 20) & 0xFu; }
#define XB_SPIN(cond, bar) do { unsigned _sp = 0; while (cond) { __builtin_amdgcn_s_sleep(1); \
    if ((++_sp & 255u) == 0u) { if (xb_ld(&(bar)[XB_TMO])) break; if (_sp > XB_SPIN_CAP) { atomicAdd(&(bar)[XB_TMO], 1u); break; } } } } while (0)

struct XcdBarrier {
    unsigned* bar; unsigned x;
    volatile LAS unsigned* st;
};

__device__ __forceinline__ XcdBarrier xcd_barrier_post(unsigned* bar, volatile LAS unsigned* st) {
    XcdBarrier b; b.bar = bar; b.x = xb_xcc_id(); b.st = st;
    if (threadIdx.x == 0) (void)xb_add(&bar[XB_XCNT(b.x)], 1u);
    return b;
}
__device__ __forceinline__ void xcd_barrier_complete(unsigned* bar, unsigned x, unsigned& nloc, unsigned& nx) {
    const unsigned G = gridDim.x * gridDim.y * gridDim.z;
    unsigned sum, cnt, mine, sp = 0u;
    for (;;) {
        sum = 0u; cnt = 0u; mine = 0u;
#pragma unroll
        for (unsigned j = 0; j < 16; ++j) { const unsigned c = xb_ld(&bar[XB_XCNT(j)]); sum += c; cnt += (c > 0u) ? 1u : 0u; mine = (j == x) ? c : mine; }
        if (sum == G) break;
        __builtin_amdgcn_s_sleep(1);
        if ((++sp & 255u) == 0u) { if (xb_ld(&bar[XB_TMO])) break; if (sp > XB_SPIN_CAP) { atomicAdd(&bar[XB_TMO], 1u); break; } }
    }
    nloc = mine > 0u ? mine : 1u; nx = cnt > 0u ? cnt : 1u;
}

__device__ __forceinline__ void xcd_barrier(const XcdBarrier& b) {
    asm volatile("s_waitcnt vmcnt(0)" ::: "memory");
    __syncthreads();
    if (threadIdx.x == 0) {
        unsigned* bar = b.bar;
        __builtin_amdgcn_s_waitcnt(0);
        unsigned nloc = b.st[0], nx = b.st[1];
        if (nloc == 0u) { xcd_barrier_complete(bar, b.x, nloc, nx); b.st[0] = nloc; b.st[1] = nx; }
        const unsigned old = xb_add(&bar[XB_XSUB(b.x)], 1u);
        const unsigned gen = old / nloc;
        if (old + 1u == (gen + 1u) * nloc) {
            __builtin_amdgcn_fence(__ATOMIC_RELEASE, "agent");
            asm volatile("s_waitcnt vmcnt(0)" ::: "memory");
            const unsigned og = xb_add(&bar[XB_TOP], 1u);
            const unsigned tg = og / nx;
            if (og + 1u == (tg + 1u) * nx) xb_add(&bar[XB_TOPGEN], 1u);
            else XB_SPIN(xb_ld(&bar[XB_TOPGEN]) == tg, bar);
            __builtin_amdgcn_fence(__ATOMIC_ACQUIRE, "agent");
            xb_add(&bar[XB_XGEN(b.x)], 1u);
            asm volatile("s_waitcnt vmcnt(0)" ::: "memory");
        } else {
            XB_SPIN(xb_ld(&bar[XB_XGEN(b.x)]) == gen, bar);
            __builtin_amdgcn_fence(__ATOMIC_ACQUIRE, "agent");
            asm volatile("s_waitcnt vmcnt(0)" ::: "memory");
        }
    }
    __syncthreads();
}

struct Params { const float* in[28]; float* out; unsigned char* ws; };
enum { I_X = 0, I_MEM, I_NORM_MIX, I_W_IN, I_CONV, I_GATE_B, I_MLSTM_NORM, I_ATTN_QKN, I_GMLP_NORM, I_GMLP_WS, I_GMLP_BS, I_WBA, I_WBB, I_WBC, I_WOUT, I_REL_BIAS,
       I_NORM_XATTN, I_NORM_MEM, I_WXQ, I_WXKV, I_XATTN_QKN, I_WXO, I_NORM_FFN, I_ROUTER_W, I_ROUTER_B, I_EG, I_EU, I_ED };

struct Ctx {
    LAS unsigned char* lds;
    unsigned char* ws;
    int tid, lane, wave, vcu, G, bx;
};
template <class T> __device__ __forceinline__ T* wsp(const Ctx& c, size_t off) { return (T*)(c.ws + off); }

__device__ const unsigned char REL_BUCKET[3][132] = {
  {0,1,2,3,4,5,6,7,8,9,10,11,12,13,14,15,16,16,16,16,16,16,17,17,17,17,17,17,17,17,18,18,18,18,18,18,18,18,18,18,19,19,19,19,19,19,19,19,19,19,19,19,19,19,20,20,20,20,20,20,20,20,20,20,20,20,20,20,20,20,20,20,20,21,21,21,21,21,21,21,21,21,21,21,21,21,21,21,21,21,21,21,21,21,21,21,21,21,21,22,22,22,22,22,22,22,22,22,22,22,22,22,22,22,22,22,22,22,22,22,22,22,22,22,22,22,22,22,22,0,0,0},
  {0,4,8,12,16,16,17,17,18,18,19,19,19,19,20,20,20,20,20,21,21,21,21,21,21,22,22,22,22,22,22,22,22,22,23,23,23,23,23,23,23,23,23,23,23,23,24,24,24,24,24,24,24,24,24,24,24,24,24,24,24,24,25,25,25,25,25,25,25,25,25,25,25,25,25,25,25,25,25,25,25,25,25,26,26,26,26,26,26,26,26,26,26,26,26,26,26,26,26,26,26,26,26,26,26,26,26,26,26,26,26,26,26,27,27,27,27,27,27,27,27,27,27,27,27,27,27,27,27,0,0,0},
  {0,16,18,19,20,21,21,22,22,23,23,23,24,24,24,24,25,25,25,25,25,26,26,26,26,26,26,26,26,27,27,27,27,27,27,27,27,27,27,28,28,28,28,28,28,28,28,28,28,28,28,28,29,29,29,29,29,29,29,29,29,29,29,29,29,29,29,29,29,29,30,30,30,30,30,30,30,30,30,30,30,30,30,30,30,30,30,30,30,30,30,30,30,30,30,31,31,31,31,31,31,31,31,31,31,31,31,31,31,31,31,31,31,31,31,31,31,31,31,31,31,31,31,31,31,31,31,31,31,0,0,0}};

template <class RowMap>
__device__ __forceinline__ void tr_item(const float* W, int ldw, int c0, const float* gain, bf16* WT, int K, LAS float* scr, int kb, int nb, int lane, RowMap rm) {
    const int k0 = 64 * kb, n0 = 64 * nb, lr = lane >> 4, lc = 4 * (lane & 15);
    f32x4 v[16];
#pragma unroll
    for (int i = 0; i < 16; ++i) v[i] = *(const f32x4*)(W + (size_t)(k0 + 4 * i + lr) * ldw + c0 + n0 + lc);
#pragma unroll
    for (int i = 0; i < 16; ++i) { const int kk = 4 * i + lr; const float gg = gain ? gain[k0 + kk] : 1.f; LAS float* s = scr + kk * 65 + lc; s[0] = v[i].x * gg; s[1] = v[i].y * gg; s[2] = v[i].z * gg; s[3] = v[i].w * gg; }
    LDS_WAIT(); asm volatile("" ::: "memory");
    const int c = lane & 7;
#pragma unroll
    for (int j = 0; j < 8; ++j) { const int n = (lane >> 3) + 8 * j; const LAS float* s = scr + (8 * c) * 65 + n;
        u32x4 o; o.x = pk2(s[0 * 65], s[1 * 65]); o.y = pk2(s[2 * 65], s[3 * 65]); o.z = pk2(s[4 * 65], s[5 * 65]); o.w = pk2(s[6 * 65], s[7 * 65]);
        *(u32x4*)(WT + (size_t)rm(n0 + n) * K + k0 + 8 * c) = o; }
    LDS_WAIT(); asm volatile("" ::: "memory");
}
struct RmId { int off; __device__ __forceinline__ int operator()(int n) const { return off + n; } };
struct RmGate { __device__ __forceinline__ int operator()(int n) const { return (n >> 7) * 256 + (n & 127); } };
struct RmUp { __device__ __forceinline__ int operator()(int n) const { return (n >> 7) * 256 + 128 + (n & 127); } };

__device__ __forceinline__ void phase_weights(const Ctx& c, const Params& p, int l) {
    LAS float* scr = (LAS float*)(c.lds + c.wave * 16640);
    const int gw = c.vcu * 8 + c.wave, NGW = c.G * 8;
    const float* w_in = p.in[I_W_IN] + (size_t)l * D * NIN;
    constexpr int N1 = 16 * 32, N2 = 16 * 52, N3 = 16 * 48, N4 = 8 * 16, N5 = 12 * 16, N6 = 8 * 16, N7 = 16 * 16, N8 = 16 * 8, N9 = 16 * 16, N10 = 8 * 16, NE = 16 * 8, NDN = 8 * 16;
    constexpr int NITEMS = N1 + N2 + N3 + N4 + N5 + N6 + N7 + N8 + N9 + N10 + 16 * NE * 2 + 16 * NDN;
    for (int it = gw; it < NITEMS; it += NGW) {
        int r = it;
        if (r < N1) { tr_item(w_in, NIN, 0, p.in[I_NORM_MIX] + l * D, wsp<bf16>(c, OFF_WIN1), D, scr, r / 32, r % 32, c.lane, RmId{0}); continue; } r -= N1;
        if (r < N2) { tr_item(w_in, NIN, 2056, p.in[I_NORM_MIX] + l * D, wsp<bf16>(c, OFF_WIN1), D, scr, r / 52, r % 52, c.lane, RmId{2048}); continue; } r -= N2;
        if (r < N3) { tr_item(w_in, NIN, 5384, p.in[I_NORM_MIX] + l * D, wsp<bf16>(c, OFF_WG), D, scr, r / 48, r % 48, c.lane, RmId{0}); continue; } r -= N3;
        if (r < N4) { tr_item(p.in[I_WBA] + (size_t)l * 512 * 1024, 1024, 0, nullptr, wsp<bf16>(c, OFF_WA), 512, scr, r / 16, r % 16, c.lane, RmId{0}); continue; } r -= N4;
        if (r < N5) { tr_item(p.in[I_WBB] + (size_t)l * 768 * 1024, 1024, 0, nullptr, wsp<bf16>(c, OFF_WB), 768, scr, r / 16, r % 16, c.lane, RmId{0}); continue; } r -= N5;
        if (r < N6) { tr_item(p.in[I_WBC] + (size_t)l * 512 * 1024, 1024, 0, nullptr, wsp<bf16>(c, OFF_WC), 512, scr, r / 16, r % 16, c.lane, RmId{0}); continue; } r -= N6;
        if (r < N7) { tr_item(p.in[I_WOUT] + (size_t)l * 1024 * 1024, 1024, 0, nullptr, wsp<bf16>(c, OFF_WOUT), 1024, scr, r / 16, r % 16, c.lane, RmId{0}); continue; } r -= N7;
        if (r < N8) { tr_item(p.in[I_WXQ] + (size_t)l * 1024 * 512, 512, 0, p.in[I_NORM_XATTN] + l * D, wsp<bf16>(c, OFF_WXQ), 1024, scr, r / 8, r % 8, c.lane, RmId{0}); continue; } r -= N8;
        if (r < N9) { tr_item(p.in[I_WXKV] + (size_t)l * 1024 * 1024, 1024, 0, p.in[I_NORM_MEM] + l * D, wsp<bf16>(c, OFF_WXKV), 1024, scr, r / 16, r % 16, c.lane, RmId{0}); continue; } r -= N9;
        if (r < N10) { tr_item(p.in[I_WXO] + (size_t)l * 512 * 1024, 1024, 0, nullptr, wsp<bf16>(c, OFF_WXO), 512, scr, r / 16, r % 16, c.lane, RmId{0}); continue; } r -= N10;
        if (r < 16 * NE) { const int e = r / NE, rr = r % NE; tr_item(p.in[I_EG] + ((size_t)l * 16 + e) * 1024 * 512, 512, 0, p.in[I_NORM_FFN] + l * D, wsp<bf16>(c, OFF_WGU) + (size_t)e * 1024 * 1024, 1024, scr, rr / 8, rr % 8, c.lane, RmGate{}); continue; } r -= 16 * NE;
        if (r < 16 * NE) { const int e = r / NE, rr = r % NE; tr_item(p.in[I_EU] + ((size_t)l * 16 + e) * 1024 * 512, 512, 0, p.in[I_NORM_FFN] + l * D, wsp<bf16>(c, OFF_WGU) + (size_t)e * 1024 * 1024, 1024, scr, rr / 8, rr % 8, c.lane, RmUp{}); continue; } r -= 16 * NE;
        { const int e = r / NDN, rr = r % NDN; tr_item(p.in[I_ED] + ((size_t)l * 16 + e) * 512 * 1024, 1024, 0, nullptr, wsp<bf16>(c, OFF_WD) + (size_t)e * 1024 * 512, 512, scr, rr / 16, rr % 16, c.lane, RmId{0}); }
    }
}

__device__ __forceinline__ void row_norm_store(f32x4 (&v)[4], bf16* xbrow, int lane) {
    float s = 0.f;
#pragma unroll
    for (int j = 0; j < 4; ++j) s += (v[j].x * v[j].x + v[j].y * v[j].y) + (v[j].z * v[j].z + v[j].w * v[j].w);
    const float rs = 1.f / sqrtf(wave_sum(s) * (1.f / D) + EPS);
    unsigned long long* o8 = (unsigned long long*)xbrow + lane;
#pragma unroll
    for (int j = 0; j < 4; ++j) { v[j] = v[j] * rs; o8[64 * j] = (unsigned long long)pk2(v[j].x, v[j].y) | ((unsigned long long)pk2(v[j].z, v[j].w) << 32); }
}
__device__ __forceinline__ float reduce8(const float (&a)[8], int lane) {
    float b[4], d[2];
    const bool h5 = lane & 32, h4 = lane & 16, h3 = lane & 8;
#pragma unroll
    for (int q = 0; q < 4; ++q) { const float mine = h5 ? a[q + 4] : a[q], other = h5 ? a[q] : a[q + 4]; b[q] = mine + __shfl_xor(other, 32); }
#pragma unroll
    for (int q = 0; q < 2; ++q) { const float mine = h4 ? b[q + 2] : b[q], other = h4 ? b[q] : b[q + 2]; d[q] = mine + __shfl_xor(other, 16); }
    const float mine = h3 ? d[1] : d[0], other = h3 ? d[0] : d[1]; float r = mine + __shfl_xor(other, 8);
    r += __shfl_xor(r, 4); r += __shfl_xor(r, 2); r += __shfl_xor(r, 1); return r;
}
__device__ __forceinline__ void row_gates2(const f32x4 (&v)[4], const f32x4 (&v2)[4], const LAS float* W8t, const float* gate_b, float* gates_row, float* gates_row2, int lane) {
    float a[8], a2[8];
#pragma unroll
    for (int q = 0; q < 8; ++q) { float s = 0.f, s2 = 0.f;
#pragma unroll
        for (int j = 0; j < 4; ++j) { const f32x4 w = *(const LAS f32x4*)(W8t + q * 1024 + 256 * j + 4 * lane);
            s += (v[j].x * w.x + v[j].y * w.y) + (v[j].z * w.z + v[j].w * w.w); s2 += (v2[j].x * w.x + v2[j].y * w.y) + (v2[j].z * w.z + v2[j].w * w.w); }
        a[q] = s; a2[q] = s2; if ((q & 3) == 3) __builtin_amdgcn_sched_barrier(0); }
    const float r = reduce8(a, lane), r2 = reduce8(a2, lane);
    if ((lane & 7) == 0) { const int q = lane >> 3; const float gb = gate_b[q]; gates_row[q] = r + gb; gates_row2[q] = r2 + gb; }
}
__device__ __forceinline__ void load_w8(const Ctx& c, const Params& p, int l) {
    LAS float* W8t = (LAS float*)c.lds; const float* w_in = p.in[I_W_IN] + (size_t)l * D * NIN; const float* g = p.in[I_NORM_MIX] + l * D;
    for (int idx = c.tid; idx < D * 8; idx += 512) { const int k = idx >> 3, q = idx & 7; W8t[q * 1024 + k] = w_in[(size_t)k * NIN + 2048 + q] * g[k]; }
    __syncthreads();
}
__device__ __forceinline__ void phase_rp0_input(const Ctx& c, const Params& p) {
    load_w8(c, p, 0);
    const int gw = c.vcu * 8 + c.wave, NGW = c.G * 8;
    const float* x = p.in[I_X];
    for (int m = gw; m < M; m += 2 * NGW) {
        const int m2 = m + NGW;
        f32x4 v[4], v2[4]; const f32x4* xr = (const f32x4*)(x + (size_t)m * D) + c.lane; const f32x4* xr2 = (const f32x4*)(x + (size_t)m2 * D) + c.lane;
#pragma unroll
        for (int j = 0; j < 4; ++j) { v[j] = xr[64 * j]; v2[j] = xr2[64 * j]; }
        row_norm_store(v, wsp<bf16>(c, WS_XB) + (size_t)m * D, c.lane); row_norm_store(v2, wsp<bf16>(c, WS_XB) + (size_t)m2 * D, c.lane);
        row_gates2(v, v2, (const LAS float*)c.lds, p.in[I_GATE_B], wsp<float>(c, OFF_GATES) + (size_t)m * 8, wsp<float>(c, OFF_GATES) + (size_t)m2 * 8, c.lane);
    }
    const float* mem = p.in[I_MEM];
    for (int m = gw; m < MM; m += NGW) {
        f32x4 v[4]; const f32x4* xr = (const f32x4*)(mem + (size_t)m * D) + c.lane;
#pragma unroll
        for (int j = 0; j < 4; ++j) v[j] = xr[64 * j];
        row_norm_store(v, wsp<bf16>(c, OFF_MEMB) + (size_t)m * D, c.lane);
    }
    if (c.bx == 0) { float* bt = wsp<float>(c, OFF_BIAS); const float* rb = p.in[I_REL_BIAS];
        for (int idx = c.tid; idx < 12 * 132; idx += 512) { const int h = idx / 132, dist = idx % 132; bt[idx] = rb[(int)REL_BUCKET[h >> 2][dist] * 12 + h]; } }
}
__device__ __forceinline__ void phase_rp1(const Ctx& c, const float* X) {
    const int gw = c.vcu * 8 + c.wave, NGW = c.G * 8;
    for (int m = gw; m < M; m += NGW) {
        f32x4 v[4]; const f32x4* xr = (const f32x4*)(X + (size_t)m * D) + c.lane;
#pragma unroll
        for (int j = 0; j < 4; ++j) v[j] = xr[64 * j];
        row_norm_store(v, wsp<bf16>(c, WS_XB) + (size_t)m * D, c.lane);
    }
}
__device__ __forceinline__ float reduce16(const float (&a)[16], int lane) {
    float b[8], c4[4], d[2];
    const bool h5 = lane & 32, h4 = lane & 16, h3 = lane & 8, h2 = lane & 4;
#pragma unroll
    for (int q = 0; q < 8; ++q) { const float mine = h5 ? a[q + 8] : a[q], other = h5 ? a[q] : a[q + 8]; b[q] = mine + __shfl_xor(other, 32); }
#pragma unroll
    for (int q = 0; q < 4; ++q) { const float mine = h4 ? b[q + 4] : b[q], other = h4 ? b[q] : b[q + 4]; c4[q] = mine + __shfl_xor(other, 16); }
#pragma unroll
    for (int q = 0; q < 2; ++q) { const float mine = h3 ? c4[q + 2] : c4[q], other = h3 ? c4[q] : c4[q + 2]; d[q] = mine + __shfl_xor(other, 8); }
    const float mine = h2 ? d[1] : d[0], other = h2 ? d[0] : d[1]; float r = mine + __shfl_xor(other, 4);
    r += __shfl_xor(r, 2); r += __shfl_xor(r, 1); return r;
}
__device__ __forceinline__ void route_token(const Ctx& c, float r, const float* rbias, LAS unsigned* lcnt, int m) {
    float a[16]; float mx = -3.0e38f;
#pragma unroll
    for (int q = 0; q < 16; ++q) { const int src = ((q & 8) ? 32 : 0) | ((q & 4) ? 16 : 0) | ((q & 2) ? 8 : 0) | ((q & 1) ? 4 : 0); a[q] = __shfl(r, src) + rbias[q]; mx = fmaxf(mx, a[q]); }
#pragma unroll
    for (int q = 0; q < 16; ++q) a[q] = __expf(a[q] - mx);
    float bs = -1.f, p1 = 0.f, p2 = 0.f; int e1 = 0, e2 = 1;
#pragma unroll
    for (int g = 0; g < 4; ++g) {
        const float q0 = a[4 * g], q1 = a[4 * g + 1], q2 = a[4 * g + 2], q3 = a[4 * g + 3];
        int i1 = 0; float m1 = q0; if (q1 > m1) { m1 = q1; i1 = 1; } if (q2 > m1) { m1 = q2; i1 = 2; } if (q3 > m1) { m1 = q3; i1 = 3; }
        int i2 = -1; float m2 = -1.f;
        if (i1 != 0 && q0 > m2) { m2 = q0; i2 = 0; } if (i1 != 1 && q1 > m2) { m2 = q1; i2 = 1; } if (i1 != 2 && q2 > m2) { m2 = q2; i2 = 2; } if (i1 != 3 && q3 > m2) { m2 = q3; i2 = 3; }
        const float sc = m1 + m2;
        if (sc > bs) { bs = sc; e1 = 4 * g + i1; e2 = 4 * g + i2; p1 = m1; p2 = m2; }
    }
    if (c.lane == 0) {
        const float inv = 1.f / (p1 + p2);
        const unsigned pos1 = __hip_atomic_fetch_add(lcnt + e1, 1u, __ATOMIC_RELAXED, __HIP_MEMORY_SCOPE_WORKGROUP), pos2 = __hip_atomic_fetch_add(lcnt + e2, 1u, __ATOMIC_RELAXED, __HIP_MEMORY_SCOPE_WORKGROUP);
        int* te = wsp<int>(c, OFF_TOKE) + 2 * m; int* tp = wsp<int>(c, OFF_TOKP) + 2 * m; float* tw = wsp<float>(c, OFF_TOKW) + 2 * m;
        te[0] = e1; te[1] = e2; tp[0] = (int)pos1; tp[1] = (int)pos2; tw[0] = p1 * inv; tw[1] = p2 * inv;
    }
}
__device__ __forceinline__ void phase_rp2_route(const Ctx& c, const Params& p, int l, const bf16* X) {
    LAS float* RWt = (LAS float*)c.lds;
    { const float* rw = p.in[I_ROUTER_W]; const float* g = p.in[I_NORM_FFN] + l * D;
      for (int idx = c.tid; idx < D * 16; idx += 512) RWt[(idx & 15) * 1024 + (idx >> 4)] = rw[idx] * g[idx >> 4];
      __syncthreads(); }
    const int gw = c.vcu * 8 + c.wave, NGW = c.G * 8;
    LAS unsigned* lcnt = (LAS unsigned*)(c.lds + LDS_TAB);
    if (c.tid < 16) lcnt[c.tid] = 0u;
    __syncthreads();
    const float* rbias = p.in[I_ROUTER_B];
    for (int m = gw; m < M; m += 2 * NGW) {
        const int m2 = m + NGW;
        f32x4 v[4], v2[4]; const u32x2* xr = (const u32x2*)(X + (size_t)m * D) + c.lane; const u32x2* xr2 = (const u32x2*)(X + (size_t)m2 * D) + c.lane;
        u32x2 w1[4], w2[4];
#pragma unroll
        for (int j = 0; j < 4; ++j) { w1[j] = xr[64 * j]; w2[j] = xr2[64 * j]; }
#pragma unroll
        for (int j = 0; j < 4; ++j) { v[j] = (f32x4){bflo(w1[j].x), bfhi(w1[j].x), bflo(w1[j].y), bfhi(w1[j].y)}; v2[j] = (f32x4){bflo(w2[j].x), bfhi(w2[j].x), bflo(w2[j].y), bfhi(w2[j].y)}; }
        row_norm_store(v, wsp<bf16>(c, WS_XB) + (size_t)m * D, c.lane);
        row_norm_store(v2, wsp<bf16>(c, WS_XB) + (size_t)m2 * D, c.lane);
        float a[16], a2[16];
#pragma unroll
        for (int q = 0; q < 16; ++q) { float s = 0.f, s2 = 0.f;
#pragma unroll
            for (int j = 0; j < 4; ++j) { const f32x4 w = *(const LAS f32x4*)(RWt + q * 1024 + 256 * j + 4 * c.lane);
                s += (v[j].x * w.x + v[j].y * w.y) + (v[j].z * w.z + v[j].w * w.w); s2 += (v2[j].x * w.x + v2[j].y * w.y) + (v2[j].z * w.z + v2[j].w * w.w); }
            a[q] = s; a2[q] = s2; if ((q & 3) == 3) __builtin_amdgcn_sched_barrier(0); }
        const float r = reduce16(a, c.lane), r2 = reduce16(a2, c.lane);
        route_token(c, r, rbias, lcnt, m);
        route_token(c, r2, rbias, lcnt, m2);
    }
    __syncthreads();
    if (c.tid < 16) wsp<unsigned>(c, OFF_CNTW)[c.vcu * 16 + c.tid] = lcnt[c.tid];
}
template <bool WITH_OFF>
__device__ __forceinline__ void moe_tables(const Ctx& c) {
    LAS int* tab = (LAS int*)(c.lds + LDS_TAB); LAS int* woff = (LAS int*)(c.lds + LDS_WOFF); LAS int* tot = tab + 180;
    const unsigned* cw = wsp<unsigned>(c, OFF_CNTW);
    if (c.tid < 16) { int s = 0;
#pragma unroll 8
        for (int v = 0; v < c.G; ++v) { if (WITH_OFF) woff[v * 16 + c.tid] = s; s += (int)cw[v * 16 + c.tid]; }
        tot[c.tid] = s; }
    __syncthreads();
    if (c.tid == 0) { int t = 0;
        for (int e = 0; e < 16; ++e) { const int nt = (tot[e] + 255) >> 8; tab[160 + e] = t * 256; for (int i = 0; i < nt && t < MAXT; ++i) tab[t++] = e; }
        tab[176] = t; }
    __syncthreads();
}
__device__ __forceinline__ void phase_assign(const Ctx& c) {
    moe_tables<true>(c);
    const LAS int* tab = (const LAS int*)(c.lds + LDS_TAB); const LAS int* woff = (const LAS int*)(c.lds + LDS_WOFF);
    const int gt = c.vcu * 512 + c.tid, NT = c.G * 512;
    const int* te = wsp<int>(c, OFF_TOKE); const int* tp = wsp<int>(c, OFF_TOKP); const float* tw = wsp<float>(c, OFF_TOKW);
    int* slot = wsp<int>(c, OFF_SLOT); float* wrow = wsp<float>(c, OFF_WROW); int* rowtok = wsp<int>(c, OFF_ROWTOK);
    for (int it = gt; it < 2 * M; it += NT) { const int e = te[it], m_ = it >> 1; const int s = tab[160 + e] + woff[((m_ % (c.G * 8)) >> 3) * 16 + e] + tp[it];
        slot[it] = s; wrow[s] = tw[it]; rowtok[s] = m_; }
    for (int it = gt; it < 16 * 256; it += NT) { const int e = it >> 8, r = it & 255; const int n = tab[180 + e], s = tab[160 + e] + n + r; if (r < ((256 - (n & 255)) & 255)) rowtok[s] = 0; }
}
template <bool NEXT>
__device__ __forceinline__ void phase_combine(const Ctx& c, const Params& p, int l, const bf16* Xsrc, bf16* Xnext, float* Xout) {
    if (NEXT) load_w8(c, p, l + 1);
    const int gw = c.vcu * 8 + c.wave, NGW = c.G * 8;
    const int* slot = wsp<int>(c, OFF_SLOT); const bf16* YE = wsp<bf16>(c, OFF_XG);
    for (int m0 = gw; m0 < M; m0 += 2 * NGW) {
        f32x4 v[2][4];
        { int s0[2], s1[2]; u32x2 x[2][4], ya[2][4], yb[2][4];
#pragma unroll
          for (int r = 0; r < 2; ++r) { const int m = m0 + r * NGW; s0[r] = slot[2 * m]; s1[r] = slot[2 * m + 1]; }
#pragma unroll
          for (int r = 0; r < 2; ++r) { const int m = m0 + r * NGW; const u32x2* xr = (const u32x2*)(Xsrc + (size_t)m * D) + c.lane;
              const u32x2* y0 = (const u32x2*)(YE + (size_t)s0[r] * D) + c.lane; const u32x2* y1 = (const u32x2*)(YE + (size_t)s1[r] * D) + c.lane;
#pragma unroll
              for (int j = 0; j < 4; ++j) { x[r][j] = xr[64 * j]; ya[r][j] = y0[64 * j]; yb[r][j] = y1[64 * j]; } }
#pragma unroll
          for (int r = 0; r < 2; ++r)
#pragma unroll
              for (int j = 0; j < 4; ++j) { const u32x2 a = ya[r][j], b = yb[r][j], xx = x[r][j];
                  v[r][j].x = (bflo(xx.x) + bflo(a.x)) + bflo(b.x); v[r][j].y = (bfhi(xx.x) + bfhi(a.x)) + bfhi(b.x); v[r][j].z = (bflo(xx.y) + bflo(a.y)) + bflo(b.y); v[r][j].w = (bfhi(xx.y) + bfhi(a.y)) + bfhi(b.y); } }
        if (NEXT) {
#pragma unroll
            for (int r = 0; r < 2; ++r) { const int m = m0 + r * NGW; unsigned long long* xo = (unsigned long long*)(Xnext + (size_t)m * D) + c.lane;
#pragma unroll
                for (int j = 0; j < 4; ++j) xo[64 * j] = (unsigned long long)pk2(v[r][j].x, v[r][j].y) | ((unsigned long long)pk2(v[r][j].z, v[r][j].w) << 32);
                row_norm_store(v[r], wsp<bf16>(c, WS_XB) + (size_t)m * D, c.lane); }
            row_gates2(v[0], v[1], (const LAS float*)c.lds, p.in[I_GATE_B] + 8 * (l + 1), wsp<float>(c, OFF_GATES) + (size_t)m0 * 8, wsp<float>(c, OFF_GATES) + (size_t)(m0 + NGW) * 8, c.lane);
        } else {
#pragma unroll
            for (int r = 0; r < 2; ++r) { f32x4* xo = (f32x4*)(Xout + (size_t)(m0 + r * NGW) * D) + c.lane;
#pragma unroll
                for (int j = 0; j < 4; ++j) xo[64 * j] = v[r][j]; }
        }
    }
}
__device__ __forceinline__ void gate_scan(const Ctx& c, int bh) {
    const int b = bh >> 2, h = bh & 3, tid = c.tid, lane = c.lane, w = c.wave;
    LAS float* ws_ = (LAS float*)c.lds;
    const float* G = wsp<float>(c, OFF_GATES) + ((size_t)b * SEQ + 8 * tid) * 8;
    float* Aa = wsp<float>(c, OFF_AMA) + bh * SEQ + 8 * tid; float* Am = wsp<float>(c, OFF_AMM) + bh * SEQ + 8 * tid; float* Ab = wsp<float>(c, OFF_AMB) + bh * SEQ + 8 * tid;
    float lf[8], ip[8];
#pragma unroll
    for (int i = 0; i < 8; ++i) { const float f = G[i * 8 + 4 + h]; ip[i] = G[i * 8 + h]; lf[i] = fminf(f, 0.f) - log1pf(__expf(-fabsf(f))); }
    float s = 0.f;
#pragma unroll
    for (int i = 0; i < 8; ++i) { s += lf[i]; lf[i] = s; }
    float incl = s;
#pragma unroll
    for (int o = 1; o < 64; o <<= 1) { const float t = __shfl_up(incl, o); if (lane >= o) incl += t; }
    if (lane == 63) ws_[w] = incl;
    __syncthreads();
    float base = incl - s;
    for (int ww = 0; ww < w; ++ww) base += ws_[ww];
    float av[8], mxl = -3.0e38f;
#pragma unroll
    for (int i = 0; i < 8; ++i) { const float Bc = base + lf[i]; lf[i] = Bc; av[i] = ip[i] - Bc; mxl = fmaxf(mxl, av[i]); }
    float inm = mxl;
#pragma unroll
    for (int o = 1; o < 64; o <<= 1) { const float t = __shfl_up(inm, o); if (lane >= o) inm = fmaxf(inm, t); }
    if (lane == 63) ws_[8 + w] = inm;
    __syncthreads();
    float run = __shfl_up(inm, 1); if (lane == 0) run = 0.f;
    run = fmaxf(run, 0.f);
    for (int ww = 0; ww < w; ++ww) run = fmaxf(run, ws_[8 + ww]);
    float mv[8];
#pragma unroll
    for (int i = 0; i < 8; ++i) { run = fmaxf(run, av[i]); mv[i] = run; }
    *(f32x4*)(Aa) = (f32x4){av[0], av[1], av[2], av[3]}; *(f32x4*)(Aa + 4) = (f32x4){av[4], av[5], av[6], av[7]};
    *(f32x4*)(Am) = (f32x4){mv[0], mv[1], mv[2], mv[3]}; *(f32x4*)(Am + 4) = (f32x4){mv[4], mv[5], mv[6], mv[7]};
    *(f32x4*)(Ab) = (f32x4){lf[0], lf[1], lf[2], lf[3]}; *(f32x4*)(Ab + 4) = (f32x4){lf[4], lf[5], lf[6], lf[7]};
    __syncthreads();
}

typedef short s16x4 __attribute__((ext_vector_type(4)));
__device__ __forceinline__ s16x4 ds_tr(const LAS bf16* p) { return __builtin_bit_cast(s16x4, __builtin_amdgcn_ds_read_tr16_b64_v4i16((LAS s16x4*)p)); }
__device__ __forceinline__ bf16x8 cat4(const s16x4 lo, const s16x4 hi) { return (bf16x8){lo[0], lo[1], lo[2], lo[3], hi[0], hi[1], hi[2], hi[3]}; }
__device__ __forceinline__ bf16x8 ldsA(const LAS bf16* p) { return *(const LAS bf16x8*)p; }
__device__ __forceinline__ bf16x8 pk8f(const f32x4 a, const f32x4 b) { u32x4 w; w.x = pk2(a[0], a[1]); w.y = pk2(a[2], a[3]); w.z = pk2(b[0], b[1]); w.w = pk2(b[2], b[3]); return __builtin_bit_cast(bf16x8, w); }
#define MFMA16(a, b, c) __builtin_amdgcn_mfma_f32_16x16x32_bf16((a), (b), (c), 0, 0, 0)
__device__ __forceinline__ float red4g_sum(float v) { v += __shfl_xor(v, 16); v += __shfl_xor(v, 32); return v; }
__device__ __forceinline__ float red4g_max(float v) { v = fmaxf(v, __shfl_xor(v, 16)); v = fmaxf(v, __shfl_xor(v, 32)); return v; }
__device__ __forceinline__ float red16_sum(float v) { v += __shfl_xor(v, 1); v += __shfl_xor(v, 2); v += __shfl_xor(v, 4); v += __shfl_xor(v, 8); return v; }
constexpr f32x4 Z4 = {0.f, 0.f, 0.f, 0.f};

constexpr int LS = 136;
constexpr int QS = 72;

__device__ __forceinline__ void conv4_silu(const u32x4 (&x)[7], const float* cw, float (&o)[4][8]) {
    float w[4][8];
#pragma unroll
    for (int jj = 0; jj < 4; ++jj) { const f32x4 w0 = *(const f32x4*)(cw + jj * 1024), w1 = *(const f32x4*)(cw + jj * 1024 + 4);
        w[jj][0] = w0.x; w[jj][1] = w0.y; w[jj][2] = w0.z; w[jj][3] = w0.w; w[jj][4] = w1.x; w[jj][5] = w1.y; w[jj][6] = w1.z; w[jj][7] = w1.w; }
    float xf[7][8];
#pragma unroll
    for (int a = 0; a < 7; ++a) unpack8(x[a], xf[a]);
#pragma unroll
    for (int rr = 0; rr < 4; ++rr)
#pragma unroll
        for (int e = 0; e < 8; ++e) { const float s = (w[0][e] * xf[rr][e] + w[1][e] * xf[rr + 1][e]) + (w[2][e] * xf[rr + 2][e] + w[3][e] * xf[rr + 3][e]); o[rr][e] = siluf_(s); }
}
__device__ __forceinline__ void load7(const bf16* colp, int t0, u32x4 (&x)[7]) {
#pragma unroll
    for (int a = 0; a < 7; ++a) { const int t = t0 - 3 + a; x[a] = (t >= 0) ? *(const u32x4*)(colp + (size_t)t * PP) : (u32x4){0u, 0u, 0u, 0u}; }
}

__device__ __forceinline__ void mlstm_delta_unit(const Ctx& c, const Params& p, int l, int bh, int j) {
    const int b = bh >> 2, h = bh & 3, tid = c.tid, lane = c.lane, w = c.wave, r16 = lane & 15, g = lane >> 4;
    LAS bf16* vv = (LAS bf16*)c.lds; LAS bf16* kw = vv + 128 * LS;
    const bf16* projb = wsp<bf16>(c, WS_PROJ) + (size_t)b * SEQ * PP;
    const float* Aa = wsp<float>(c, OFF_AMA) + bh * SEQ + LCH * j; const float Mend = wsp<float>(c, OFF_AMM)[bh * SEQ + LCH * j + LCH - 1];
    {
        const int rg = tid >> 4, c8 = (tid & 15) * 8, t0 = LCH * j + 4 * rg;
        u32x4 xk[7], xv[4];
        load7(projb + C_MK + h * 128 + c8, t0, xk);
#pragma unroll
        for (int rr = 0; rr < 4; ++rr) xv[rr] = *(const u32x4*)(projb + (size_t)(t0 + rr) * PP + C_MV + h * 128 + c8);
        const f32x4 a4 = *(const f32x4*)(Aa + 4 * rg);
        float k[4][8]; conv4_silu(xk, p.in[I_CONV] + (size_t)l * 4 * 1024 + 512 + h * 128 + c8, k);
#pragma unroll
        for (int rr = 0; rr < 4; ++rr) { const float wgt = __expf(a4[rr] - Mend) * 0.08838834764831845f;
#pragma unroll
            for (int e = 0; e < 8; ++e) k[rr][e] *= wgt;
            *(LAS u32x4*)(kw + (4 * rg + rr) * LS + c8) = pack8(k[rr]); *(LAS u32x4*)(vv + (4 * rg + rr) * LS + c8) = xv[rr]; }
    }
    __syncthreads();
    f32x4 acc[8];
#pragma unroll
    for (int nt = 0; nt < 8; ++nt) acc[nt] = Z4;
    const LAS bf16* ap = vv + (8 * g + (r16 >> 2)) * LS + 16 * w + 4 * (r16 & 3); const LAS bf16* bp = kw + (8 * g + (r16 >> 2)) * LS + 4 * (r16 & 3);
#pragma unroll
    for (int ks = 0; ks < 4; ++ks) { const bf16x8 a = cat4(ds_tr(ap + 32 * ks * LS), ds_tr(ap + (32 * ks + 4) * LS));
#pragma unroll
        for (int nt = 0; nt < 8; ++nt) { const bf16x8 bb = cat4(ds_tr(bp + 32 * ks * LS + 16 * nt), ds_tr(bp + (32 * ks + 4) * LS + 16 * nt)); acc[nt] = MFMA16(a, bb, acc[nt]); } }
    float* st = wsp<float>(c, WS_T) + (size_t)(bh * NCH + j) * (128 * 128);
#pragma unroll
    for (int nt = 0; nt < 8; ++nt)
#pragma unroll
        for (int i = 0; i < 4; ++i) st[(16 * w + 4 * g + i) * 128 + 16 * nt + r16] = acc[nt][i];
    if (tid < 128) { float s = 0.f;
#pragma unroll 8
        for (int r = 0; r < 128; ++r) s += bf2f(kw[r * LS + tid]);
        wsp<float>(c, OFF_NST)[(bh * NCH + j) * 128 + tid] = s; }
    __syncthreads();
}
__device__ __forceinline__ void mlstm_scan(const Ctx& c) {
    constexpr int EL4 = (128 * 128 + 128) / 4;
    const int gt = c.vcu * 512 + c.tid, NT = c.G * 512;
    for (int idx = gt; idx < 16 * EL4; idx += NT) {
        const int bh = idx / EL4, el = idx % EL4;
        const float* Am = wsp<float>(c, OFF_AMM) + bh * SEQ;
        f32x4* base = el < 4096 ? (f32x4*)(wsp<float>(c, WS_T) + (size_t)bh * NCH * 16384) + el : (f32x4*)(wsp<float>(c, OFF_NST) + bh * NCH * 128) + (el - 4096);
        const int stride = el < 4096 ? 4096 : 32;
        f32x4 cs = {0.f, 0.f, 0.f, 0.f}; float Mprev = 0.f;
#pragma unroll 1
        for (int j0 = 0; j0 < NCH; j0 += 8) {
            f32x4 dl[8]; float gg[8];
#pragma unroll
            for (int a = 0; a < 8; ++a) { dl[a] = base[(size_t)(j0 + a) * stride]; const float Mend = Am[LCH * (j0 + a) + LCH - 1]; gg[a] = __expf(Mprev - Mend); Mprev = Mend; }
#pragma unroll
            for (int a = 0; a < 8; ++a) { cs = cs * gg[a] + dl[a]; base[(size_t)(j0 + a) * stride] = cs; }
        }
    }
}
__device__ __forceinline__ void mlstm_out_unit(const Ctx& c, const Params& p, int l, int bh, int j) {
    const int b = bh >> 2, h = bh & 3, tid = c.tid, lane = c.lane, w = c.wave, r16 = lane & 15, g = lane >> 4;
    LAS bf16* qq = (LAS bf16*)c.lds; LAS bf16* kk = qq + 128 * LS; LAS bf16* vv = kk + 128 * LS; LAS bf16* CTb = vv + 128 * LS;
    LAS float* fa = (LAS float*)(CTb + 144 * LS); LAS float* fM = fa + 128; LAS float* fB = fM + 128;
    bf16* projb = wsp<bf16>(c, WS_PROJ) + (size_t)b * SEQ * PP;
    {
        const int rg = tid >> 4, c8 = (tid & 15) * 8, t0 = LCH * j + 4 * rg;
        u32x4 xq[7], xk[7], xv[4];
        load7(projb + C_MQ + h * 128 + c8, t0, xq); load7(projb + C_MK + h * 128 + c8, t0, xk);
#pragma unroll
        for (int rr = 0; rr < 4; ++rr) xv[rr] = *(const u32x4*)(projb + (size_t)(t0 + rr) * PP + C_MV + h * 128 + c8);
        const int e = tid >> 2, d0 = (tid & 3) * 32;
        f32x4 sv[8];
        if (j > 0) { const f32x4* sp = (const f32x4*)(wsp<float>(c, WS_T) + (size_t)(bh * NCH + j - 1) * 16384 + e * 128 + d0);
#pragma unroll
            for (int a = 0; a < 8; ++a) sv[a] = sp[a]; }
        else {
#pragma unroll
            for (int a = 0; a < 8; ++a) sv[a] = Z4; }
        const float* cwq = p.in[I_CONV] + (size_t)l * 4 * 1024 + h * 128 + c8;
        float o[4][8];
        conv4_silu(xq, cwq, o);
#pragma unroll
        for (int rr = 0; rr < 4; ++rr) *(LAS u32x4*)(qq + (4 * rg + rr) * LS + c8) = pack8(o[rr]);
        conv4_silu(xk, cwq + 512, o);
#pragma unroll
        for (int rr = 0; rr < 4; ++rr) {
#pragma unroll
            for (int e2 = 0; e2 < 8; ++e2) o[rr][e2] *= 0.08838834764831845f;
            *(LAS u32x4*)(kk + (4 * rg + rr) * LS + c8) = pack8(o[rr]); *(LAS u32x4*)(vv + (4 * rg + rr) * LS + c8) = xv[rr]; }
#pragma unroll
        for (int a = 0; a < 4; ++a) *(LAS bf16x8*)(CTb + e * LS + d0 + 8 * a) = pk8f(sv[2 * a], sv[2 * a + 1]);
    }
    if (tid < 256) { const int e = 128 + (tid >> 4), c8 = (tid & 15) * 8; float s8[8];
#pragma unroll
        for (int i = 0; i < 8; ++i) s8[i] = 0.f;
        if (e == 128 && j > 0) { const float* nn = wsp<float>(c, OFF_NST) + (bh * NCH + j - 1) * 128 + c8;
#pragma unroll
            for (int i = 0; i < 8; ++i) s8[i] = nn[i]; }
        *(LAS u32x4*)(CTb + e * LS + c8) = pack8(s8); }
    if (tid < 128) { const int t = bh * SEQ + LCH * j + tid; fa[tid] = wsp<float>(c, OFF_AMA)[t]; fM[tid] = wsp<float>(c, OFF_AMM)[t]; fB[tid] = wsp<float>(c, OFF_AMB)[t]; }
    __syncthreads();
    const float Mprev = j > 0 ? wsp<float>(c, OFF_AMM)[bh * SEQ + LCH * j - 1] : 0.f;
    const int tq = 16 * w + r16;
    f32x4 as[8], ai[9];
#pragma unroll
    for (int a = 0; a < 8; ++a) as[a] = Z4;
#pragma unroll
    for (int a = 0; a < 9; ++a) ai[a] = Z4;
#pragma unroll
    for (int ks = 0; ks < 4; ++ks) { const bf16x8 bq = ldsA(qq + tq * LS + 32 * ks + 8 * g);
#pragma unroll
        for (int mt = 0; mt < 8; ++mt) if (mt <= w) as[mt] = MFMA16(ldsA(kk + (16 * mt + r16) * LS + 32 * ks + 8 * g), bq, as[mt]);
#pragma unroll
        for (int et = 0; et < 9; ++et) ai[et] = MFMA16(ldsA(CTb + (16 * et + r16) * LS + 32 * ks + 8 * g), bq, ai[et]);
        __builtin_amdgcn_sched_barrier(0); }
    const float Mt = fM[tq], winter = __expf(Mprev - Mt);
    float den = 0.f;
#pragma unroll
    for (int mt = 0; mt < 8; ++mt)
#pragma unroll
        for (int i = 0; i < 4; ++i) { const int r = 16 * mt + 4 * g + i; const float wg = (mt <= w && r <= tq) ? __expf(fa[r] - Mt) : 0.f; const float sw = as[mt][i] * wg; as[mt][i] = sw; den += sw; }
    den = red4g_sum(den);
    const float dinter = __shfl(ai[8][0], r16);
    const float dd = den + winter * dinter;
    const float dn = fmaxf(fabsf(dd), __expf(-(fB[tq] + Mt)));
    f32x4 ao[8];
#pragma unroll
    for (int et = 0; et < 8; ++et) ao[et] = ai[et] * winter;
    const LAS bf16* vp = vv + (4 * g + (r16 >> 2)) * LS + 4 * (r16 & 3);
#pragma unroll
    for (int ks = 0; ks < 4; ++ks) if (2 * ks <= w) { const bf16x8 bp = pk8f(as[2 * ks], as[2 * ks + 1]);
#pragma unroll
        for (int et = 0; et < 8; ++et) ao[et] = MFMA16(cat4(ds_tr(vp + 32 * ks * LS + 16 * et), ds_tr(vp + (32 * ks + 16) * LS + 16 * et)), bp, ao[et]);
        __builtin_amdgcn_sched_barrier(0); }
    const float inv = 1.f / dn; float ss = 0.f;
#pragma unroll
    for (int et = 0; et < 8; ++et) { ao[et] = ao[et] * inv; ss += (ao[et][0] * ao[et][0] + ao[et][1] * ao[et][1]) + (ao[et][2] * ao[et][2] + ao[et][3] * ao[et][3]); }
    ss = red4g_sum(ss); const float rs = 1.f / sqrtf(ss * (1.f / 128.f) + EPS);
    const float* gain = p.in[I_MLSTM_NORM] + l * 512 + h * 128; const bf16* mrow = projb + (size_t)(LCH * j + tq) * PP + C_MO + h * 128;
    bf16* orow = wsp<bf16>(c, WS_YA) + ((size_t)b * SEQ + LCH * j + tq) * 512 + h * 128;
    u32x2 mo8[8]; f32x4 gn8[8];
#pragma unroll
    for (int et = 0; et < 8; ++et) { const int e0 = 16 * et + 4 * g; mo8[et] = *(const u32x2*)(mrow + e0); gn8[et] = *(const f32x4*)(gain + e0); }
#pragma unroll
    for (int et = 0; et < 8; ++et) { const int e0 = 16 * et + 4 * g; const u32x2 mo = mo8[et]; const f32x4 gn = gn8[et];
        u32x2 o; o.x = pk2(ao[et][0] * rs * gn[0] * sigmoidf_(bflo(mo.x)), ao[et][1] * rs * gn[1] * sigmoidf_(bfhi(mo.x))); o.y = pk2(ao[et][2] * rs * gn[2] * sigmoidf_(bflo(mo.y)), ao[et][3] * rs * gn[3] * sigmoidf_(bfhi(mo.y)));
        *(u32x2*)(orow + e0) = o; }
    __syncthreads();
}

struct DaRaw { u32x4 xk[4], xv[4], q0, q1; };
struct DaUnit { int b, h, dil, res, n; };
__device__ __forceinline__ DaUnit dattn_decode(int u) { DaUnit d; const int blk = u & 31, bh = u >> 5; d.b = bh / 12; d.h = bh % 12; const int grp = d.h >> 2; d.dil = grp == 0 ? 1 : (grp == 1 ? 4 : 16); const int nb = 32 / d.dil; d.res = blk / nb; d.n = blk % nb; return d; }
__device__ __forceinline__ void dattn_load(const Ctx& c, const DaUnit& d, DaRaw& r) {
    const int tid = c.tid, lane = c.lane, w = c.wave, r16 = lane & 15, g = lane >> 4, c8 = (tid & 7) * 8;
    const bf16* projb = wsp<bf16>(c, WS_PROJ) + (size_t)d.b * SEQ * PP;
#pragma unroll
    for (int a = 0; a < 4; ++a) { const int ki = (tid >> 3) + 64 * a, s = 128 * (d.n - 1) + ki;
        if (s >= 0) { const size_t pos = (size_t)(s * d.dil + d.res); r.xk[a] = *(const u32x4*)(projb + pos * PP + C_AK + d.h * 64 + c8); r.xv[a] = *(const u32x4*)(projb + pos * PP + C_AV + d.h * 64 + c8); }
        else { r.xk[a] = (u32x4){0u, 0u, 0u, 0u}; r.xv[a] = (u32x4){0u, 0u, 0u, 0u}; } }
    const size_t qpos = (size_t)((128 * d.n + 16 * w + r16) * d.dil + d.res); const bf16* qrow = projb + qpos * PP + C_AQ + d.h * 64;
    r.q0 = *(const u32x4*)(qrow + 8 * g); r.q1 = *(const u32x4*)(qrow + 32 + 8 * g);
}
__device__ __forceinline__ void dattn_phase(const Ctx& c, const Params& p, int l) {
    const int tid = c.tid, lane = c.lane, w = c.wave, r16 = lane & 15, g = lane >> 4;
    LAS bf16* kn = (LAS bf16*)c.lds; LAS bf16* vv = kn + 256 * QS; LAS float* bias = (LAS float*)(vv + 272 * QS);
    const float* gq = p.in[I_ATTN_QKN] + l * 128; const float* gk = gq + 64;
    constexpr int NU = NBATCH * 12 * 32;
    int u = c.bx; if (u >= NU) return;
    DaRaw raw; DaUnit d = dattn_decode(u); dattn_load(c, d, raw);
    if (tid < 144) *(LAS u32x4*)(vv + 256 * QS + tid * 8) = (u32x4){0u, 0u, 0u, 0u};
    for (;;) {
        bf16* projb = wsp<bf16>(c, WS_PROJ) + (size_t)d.b * SEQ * PP;
        {
            const int c8 = (tid & 7) * 8; const f32x4 g0 = *(const f32x4*)(gk + c8), g1 = *(const f32x4*)(gk + c8 + 4);
#pragma unroll
            for (int a = 0; a < 4; ++a) { const int ki = (tid >> 3) + 64 * a; float x[8]; unpack8(raw.xk[a], x);
                float ss = 0.f;
#pragma unroll
                for (int e = 0; e < 8; ++e) ss += x[e] * x[e];
                ss += __shfl_xor(ss, 1); ss += __shfl_xor(ss, 2); ss += __shfl_xor(ss, 4);
                const float rs = 1.f / sqrtf(ss * (1.f / 64.f) + EPS);
                x[0] *= rs * g0.x; x[1] *= rs * g0.y; x[2] *= rs * g0.z; x[3] *= rs * g0.w; x[4] *= rs * g1.x; x[5] *= rs * g1.y; x[6] *= rs * g1.z; x[7] *= rs * g1.w;
                *(LAS u32x4*)(kn + ki * QS + c8) = pack8(x); *(LAS u32x4*)(vv + ki * QS + c8) = raw.xv[a]; }
            if (tid < 132) bias[tid] = wsp<float>(c, OFF_BIAS)[d.h * 132 + tid];
        }
        const int qi = 16 * w + r16; const size_t qpos = (size_t)((128 * d.n + qi) * d.dil + d.res);
        bf16* qrow = projb + qpos * PP + C_AQ + d.h * 64;
        bf16x8 bq[2];
        { float x0[8], x1[8]; unpack8(raw.q0, x0); unpack8(raw.q1, x1);
          float ss = 0.f;
#pragma unroll
          for (int e = 0; e < 8; ++e) ss += x0[e] * x0[e] + x1[e] * x1[e];
          ss = red4g_sum(ss); const float rs = 0.125f / sqrtf(ss * (1.f / 64.f) + EPS);
#pragma unroll
          for (int e = 0; e < 8; ++e) { x0[e] *= rs * gq[8 * g + e]; x1[e] *= rs * gq[32 + 8 * g + e]; }
          bq[0] = __builtin_bit_cast(bf16x8, pack8(x0)); bq[1] = __builtin_bit_cast(bf16x8, pack8(x1)); }
        __syncthreads();
        const int un = u + c.G; const bool more = un < NU; const DaUnit dn = dattn_decode(more ? un : u);
        const int hcur = d.h, bcur = d.b, ncur = d.n;
        if (more) dattn_load(c, dn, raw);
        const int kb = 16 * w;
        f32x4 acc[10];
#pragma unroll
        for (int mt = 0; mt < 10; ++mt) acc[mt] = Z4;
#pragma unroll
        for (int ks = 0; ks < 2; ++ks)
#pragma unroll
            for (int mt = 0; mt < 9; ++mt) acc[mt] = MFMA16(ldsA(kn + (kb + 16 * mt + r16) * QS + 32 * ks + 8 * g), bq[ks], acc[mt]);
        float mx = -3.0e38f;
#pragma unroll
        for (int mt = 0; mt < 9; ++mt)
#pragma unroll
            for (int i = 0; i < 4; ++i) { const int ki = kb + 16 * mt + 4 * g + i, dist = 128 + qi - ki; const bool ok = dist >= 0 && dist <= 128 && (ncur > 0 || ki >= 128);
                const float lg = ok ? acc[mt][i] + bias[ok ? dist : 0] : -3.0e38f; acc[mt][i] = lg; mx = fmaxf(mx, lg); }
        mx = red4g_max(mx);
        float lsum = 0.f;
#pragma unroll
        for (int mt = 0; mt < 9; ++mt)
#pragma unroll
            for (int i = 0; i < 4; ++i) { const float lg = acc[mt][i]; const float pe = lg > -1.0e38f ? __expf(lg - mx) : 0.f; lsum += pe; acc[mt][i] = pe; }
        lsum = red4g_sum(lsum);
        f32x4 ao[4];
#pragma unroll
        for (int et = 0; et < 4; ++et) ao[et] = Z4;
        const LAS bf16* vp = vv + (kb + 4 * g + (r16 >> 2)) * QS + 4 * (r16 & 3);
#pragma unroll
        for (int ks = 0; ks < 5; ++ks) { const bf16x8 bp = pk8f(acc[2 * ks], acc[2 * ks + 1]);
#pragma unroll
            for (int et = 0; et < 4; ++et) ao[et] = MFMA16(cat4(ds_tr(vp + 32 * ks * QS + 16 * et), ds_tr(vp + (32 * ks + 16) * QS + 16 * et)), bp, ao[et]); }
        const float inv = __builtin_amdgcn_rcpf(lsum);
#pragma unroll
        for (int et = 0; et < 4; ++et) { u32x2 o; o.x = pk2(ao[et][0] * inv, ao[et][1] * inv); o.y = pk2(ao[et][2] * inv, ao[et][3] * inv); *(u32x2*)(qrow + 16 * et + 4 * g) = o; }
        if (g == 0) wsp<float>(c, OFF_LSE)[((size_t)bcur * SEQ + qpos) * 12 + hcur] = mx + __logf(lsum);
        __syncthreads();
        if (!more) break;
        u = un; d = dn;
    }
}
__device__ __forceinline__ void dattn_merge(const Ctx& c) {
    const int gt = c.vcu * 512 + c.tid, NT = c.G * 512;
    const float* LSE = wsp<float>(c, OFF_LSE); bf16* proj = wsp<bf16>(c, WS_PROJ);
    for (int it = gt; it < M * 96; it += NT) {
        const int m = it / 96, rr = it % 96, h = rr >> 3, c8 = (rr & 7) * 8, hg = h & 3;
        const float l0 = LSE[(size_t)m * 12 + hg], l1 = LSE[(size_t)m * 12 + 4 + hg], l2 = LSE[(size_t)m * 12 + 8 + hg], lm = LSE[(size_t)m * 12 + h];
        const float mxx = fmaxf(l0, fmaxf(l1, l2)); const float al = __expf(lm - mxx) / (__expf(l0 - mxx) + __expf(l1 - mxx) + __expf(l2 - mxx));
        u32x4* ptr = (u32x4*)(proj + (size_t)m * PP + C_AQ + h * 64 + c8); float x[8]; unpack8(*ptr, x);
#pragma unroll
        for (int e = 0; e < 8; ++e) x[e] *= al;
        *ptr = pack8(x);
    }
}

__device__ __forceinline__ void gmlp_unit(const Ctx& c, const Params& p, int l, int b, int n, int grp) {
    const int tid = c.tid, lane = c.lane, w = c.wave, r16 = lane & 15, g = lane >> 4;
    LAS bf16* Wc = (LAS bf16*)c.lds; LAS bf16* vn = Wc + 128 * LS;
    bf16* projb = wsp<bf16>(c, WS_PROJ) + ((size_t)b * SEQ + 128 * n) * PP;
    const float* ws = p.in[I_GMLP_WS] + ((size_t)l * 4 + grp) * 128 * 128; const float* gain = p.in[I_GMLP_NORM] + l * 512 + grp * 128; const float* bs = p.in[I_GMLP_BS] + (l * 4 + grp) * 128;
    {
        const int c8 = (tid & 15) * 8; u32x4 xv[4]; f32x4 wv[4][2];
#pragma unroll
        for (int a = 0; a < 4; ++a) { const int r = (tid >> 4) + 32 * a; xv[a] = *(const u32x4*)(projb + (size_t)r * PP + C_GV + grp * 128 + c8); wv[a][0] = *(const f32x4*)(ws + r * 128 + c8); wv[a][1] = *(const f32x4*)(ws + r * 128 + c8 + 4); }
        const f32x4 g0 = *(const f32x4*)(gain + c8), g1 = *(const f32x4*)(gain + c8 + 4);
#pragma unroll
        for (int a = 0; a < 4; ++a) { const int r = (tid >> 4) + 32 * a;
            float wf[8] = {wv[a][0].x, wv[a][0].y, wv[a][0].z, wv[a][0].w, wv[a][1].x, wv[a][1].y, wv[a][1].z, wv[a][1].w};
#pragma unroll
            for (int e = 0; e < 8; ++e) if (c8 + e > r) wf[e] = 0.f;
            *(LAS u32x4*)(Wc + r * LS + c8) = pack8(wf);
            float x[8]; unpack8(xv[a], x); float ss = 0.f;
#pragma unroll
            for (int e = 0; e < 8; ++e) { x[e] = gelu_tanh(x[e]); ss += x[e] * x[e]; }
            ss = red16_sum(ss); const float rs = 1.f / sqrtf(ss * (1.f / 128.f) + EPS);
            x[0] *= rs * g0.x; x[1] *= rs * g0.y; x[2] *= rs * g0.z; x[3] *= rs * g0.w; x[4] *= rs * g1.x; x[5] *= rs * g1.y; x[6] *= rs * g1.z; x[7] *= rs * g1.w;
            *(LAS u32x4*)(vn + r * LS + c8) = pack8(x); }
    }
    __syncthreads();
    const int tq = 16 * w + r16;
    f32x4 acc[8];
#pragma unroll
    for (int ct = 0; ct < 8; ++ct) acc[ct] = Z4;
    const LAS bf16* vp = vn + (8 * g + (r16 >> 2)) * LS + 4 * (r16 & 3);
#pragma unroll
    for (int ks = 0; ks < 4; ++ks) if (32 * ks <= 16 * w + 15) { const bf16x8 bw = ldsA(Wc + tq * LS + 32 * ks + 8 * g);
#pragma unroll
        for (int ct = 0; ct < 8; ++ct) acc[ct] = MFMA16(cat4(ds_tr(vp + 32 * ks * LS + 16 * ct), ds_tr(vp + (32 * ks + 4) * LS + 16 * ct)), bw, acc[ct]); }
    const float bb = bs[tq]; const bf16* urow = projb + (size_t)tq * PP + C_GU + grp * 128; bf16* orow = wsp<bf16>(c, WS_YC) + ((size_t)b * SEQ + 128 * n + tq) * 512 + grp * 128;
    u32x2 u8[8];
#pragma unroll
    for (int ct = 0; ct < 8; ++ct) u8[ct] = *(const u32x2*)(urow + 16 * ct + 4 * g);
#pragma unroll
    for (int ct = 0; ct < 8; ++ct) { const int c0 = 16 * ct + 4 * g; const u32x2 u = u8[ct];
        u32x2 o; o.x = pk2(gelu_tanh(bflo(u.x)) * (acc[ct][0] + bb), gelu_tanh(bfhi(u.x)) * (acc[ct][1] + bb)); o.y = pk2(gelu_tanh(bflo(u.y)) * (acc[ct][2] + bb), gelu_tanh(bfhi(u.y)) * (acc[ct][3] + bb));
        *(u32x2*)(orow + c0) = o; }
    __syncthreads();
}

__device__ __forceinline__ void xattn_unit(const Ctx& c, const Params& p, int l, int bh, int tp) {
    const int b = bh >> 2, h = bh & 3, tid = c.tid, lane = c.lane, w = c.wave, r16 = lane & 15, g = lane >> 4;
    LAS bf16* kn = (LAS bf16*)c.lds; LAS bf16* vv = kn + 256 * LS;
    const bf16* KV = wsp<bf16>(c, OFF_KV) + (size_t)b * MEML * 1024;
    const float* gq = p.in[I_XATTN_QKN] + l * 256; const float* gk = gq + 128;
    {
        const int c8 = (tid & 15) * 8; const f32x4 g0 = *(const f32x4*)(gk + c8), g1 = *(const f32x4*)(gk + c8 + 4);
#pragma unroll
        for (int half = 0; half < 2; ++half) { u32x4 xk[4], xv[4];
#pragma unroll
            for (int a = 0; a < 4; ++a) { const int ki = (tid >> 4) + 32 * (4 * half + a); xk[a] = *(const u32x4*)(KV + (size_t)ki * 1024 + h * 128 + c8); xv[a] = *(const u32x4*)(KV + (size_t)ki * 1024 + 512 + h * 128 + c8); }
#pragma unroll
            for (int a = 0; a < 4; ++a) { const int ki = (tid >> 4) + 32 * (4 * half + a); float x[8]; unpack8(xk[a], x); float ss = 0.f;
#pragma unroll
                for (int e = 0; e < 8; ++e) ss += x[e] * x[e];
                ss = red16_sum(ss); const float rs = 1.f / sqrtf(ss * (1.f / 128.f) + EPS);
                x[0] *= rs * g0.x; x[1] *= rs * g0.y; x[2] *= rs * g0.z; x[3] *= rs * g0.w; x[4] *= rs * g1.x; x[5] *= rs * g1.y; x[6] *= rs * g1.z; x[7] *= rs * g1.w;
                *(LAS u32x4*)(kn + ki * LS + c8) = pack8(x); *(LAS u32x4*)(vv + ki * LS + c8) = xv[a]; } }
    }
    __syncthreads();
    const LAS bf16* vp = vv + (4 * g + (r16 >> 2)) * LS + 4 * (r16 & 3);
    for (int tt = 2 * tp; tt < 2 * tp + 2; ++tt) {
        const size_t row = (size_t)b * SEQ + 128 * tt + 16 * w + r16;
        const bf16* qrow = wsp<bf16>(c, OFF_Q) + row * 512 + h * 128;
        bf16x8 bq[4];
        { float qf[4][8]; float ss = 0.f;
#pragma unroll
          for (int ks = 0; ks < 4; ++ks) { unpack8(*(const u32x4*)(qrow + 32 * ks + 8 * g), qf[ks]);
#pragma unroll
              for (int e = 0; e < 8; ++e) ss += qf[ks][e] * qf[ks][e]; }
          ss = red4g_sum(ss); const float rsq = 0.08838834764831845f / sqrtf(ss * (1.f / 128.f) + EPS);
#pragma unroll
          for (int ks = 0; ks < 4; ++ks) {
#pragma unroll
              for (int e = 0; e < 8; ++e) qf[ks][e] *= rsq * gq[32 * ks + 8 * g + e];
              bq[ks] = __builtin_bit_cast(bf16x8, pack8(qf[ks])); } }
        f32x4 acc[16];
#pragma unroll
        for (int mt = 0; mt < 16; ++mt) acc[mt] = Z4;
#pragma unroll
        for (int ks = 0; ks < 4; ++ks) {
#pragma unroll
            for (int mt = 0; mt < 16; ++mt) acc[mt] = MFMA16(ldsA(kn + (16 * mt + r16) * LS + 32 * ks + 8 * g), bq[ks], acc[mt]);
            __builtin_amdgcn_sched_barrier(0); }
        float mx = -3.0e38f;
#pragma unroll
        for (int mt = 0; mt < 16; ++mt) mx = fmaxf(fmaxf(mx, fmaxf(acc[mt][0], acc[mt][1])), fmaxf(acc[mt][2], acc[mt][3]));
        mx = red4g_max(mx);
        float lsum = 0.f;
#pragma unroll
        for (int mt = 0; mt < 16; ++mt)
#pragma unroll
            for (int i = 0; i < 4; ++i) { const float pe = __expf(acc[mt][i] - mx); lsum += pe; acc[mt][i] = pe; }
        lsum = red4g_sum(lsum);
        f32x4 ao[8];
#pragma unroll
        for (int et = 0; et < 8; ++et) ao[et] = Z4;
#pragma unroll
        for (int ks = 0; ks < 8; ++ks) { const bf16x8 bp = pk8f(acc[2 * ks], acc[2 * ks + 1]);
#pragma unroll
            for (int et = 0; et < 8; ++et) ao[et] = MFMA16(cat4(ds_tr(vp + 32 * ks * LS + 16 * et), ds_tr(vp + (32 * ks + 16) * LS + 16 * et)), bp, ao[et]);
            __builtin_amdgcn_sched_barrier(0); }
        const float inv = 1.f / lsum; bf16* orow = wsp<bf16>(c, OFF_O) + row * 512 + h * 128;
#pragma unroll
        for (int et = 0; et < 8; ++et) { u32x2 o; o.x = pk2(ao[et][0] * inv, ao[et][1] * inv); o.y = pk2(ao[et][2] * inv, ao[et][3] * inv); *(u32x2*)(orow + 16 * et + 4 * g) = o; }
    }
    __syncthreads();
}
enum { PH_PRE = 0, PH_A1, PH_MIXA, PH_MIXB, PH_MIXC, PH_GB, PH_WOUT, PH_XQ, PH_XA, PH_XO, PH_RP2, PH_GATHER, PH_GU, PH_DOWN, PH_COMB, NPH_LAYER };

struct GbOrder {
    pg8::StaticOrder so; const char* ws;
    __device__ __forceinline__ bool next(int i, pg8::SUnit& u) const {
        pg8::Unit t; if (!so.next(i / 6, t)) return false;
        const int k6 = i % 6, k = (k6 & 1) * 3 + (k6 >> 1); u.pm = t.pm; u.pn = t.pn; u.kind = k;
        if (k < 3) { u.a = ws + WS_XB + (size_t)t.pm * 256 * D * 2; u.lda = D; u.K = D; u.b = ws + OFF_WG + ((size_t)k * 1024 + t.pn * 256) * D * 2; }
        else { const int br = k - 3; const size_t ccol = br == 0 ? (size_t)C_MO : (br == 1 ? (size_t)C_AQ : (size_t)C_GU); const int kk = br == 1 ? 768 : 512;
            const size_t woff = br == 0 ? OFF_WA : (br == 1 ? OFF_WB : OFF_WC);
            if (br == 1) { u.a = ws + WS_PROJ + ((size_t)t.pm * 256 * PP + ccol) * 2; u.lda = PP; } else { u.a = ws + (br == 0 ? WS_YA : WS_YC) + (size_t)t.pm * 256 * 512 * 2; u.lda = 512; }
            u.K = kk; u.b = ws + woff + (size_t)t.pn * 256 * kk * 2; }
        return true;
    }
};

template <int PH>
__device__ __forceinline__ void run_phase(const Ctx& c, const Params& p, int l) {
    bf16* const XB = wsp<bf16>(c, WS_XB); bf16* const PROJ = wsp<bf16>(c, WS_PROJ);
    bf16* const XR = wsp<bf16>(c, WS_X1B);
    if constexpr (PH == PH_PRE) { phase_weights(c, p, 0); __syncthreads(); phase_rp0_input(c, p); }
    if constexpr (PH == PH_A1) {
        if (c.bx >= c.G - 16) gate_scan(c, c.bx - (c.G - 16));
        { pg8::Gemm g{XB, wsp<bf16>(c, OFF_WIN1), D, D}; pg8::StaticOrder S; S.init(M, PP, c.G, c.bx); epi::Bf16Out E{PROJ, PP};
          pg8::gemm_phase<epi::Bf16Out, pg8::StaticOrder, true>(c.lds, g, S, E); }
        { pg8::Gemm g{wsp<bf16>(c, OFF_MEMB), wsp<bf16>(c, OFF_WXKV), D, D}; pg8::StaticOrder S; S.init(MM, 1024, c.G, (c.bx + c.G - 64) % c.G); epi::Bf16Out E{wsp<bf16>(c, OFF_KV), 1024};
          pg8::gemm_phase<epi::Bf16Out, pg8::StaticOrder, true>(c.lds, g, S, E); }
    }
    if constexpr (PH == PH_MIXA) {
        for (int u = c.bx; u < 16 * NCH; u += c.G) mlstm_delta_unit(c, p, l, u / NCH, u % NCH);
        for (int u = c.bx; u < NBATCH * 32 * 4; u += c.G) gmlp_unit(c, p, l, u >> 7, (u >> 2) & 31, u & 3);
    }
    if constexpr (PH == PH_MIXB) {
        mlstm_scan(c);
        dattn_phase(c, p, l);
    }
    if constexpr (PH == PH_MIXC) { for (int u = c.bx; u < 16 * NCH; u += c.G) mlstm_out_unit(c, p, l, u / NCH, u % NCH); dattn_merge(c); }
    if constexpr (PH == PH_GB) { GbOrder S; S.so.init(M, 1024, c.G, c.bx); S.ws = (const char*)c.ws;
#ifdef GB_SKEW_US
        if ((c.bx >> 3) & 1) { const unsigned long long t0_ = __builtin_amdgcn_s_memrealtime(); while (__builtin_amdgcn_s_memrealtime() - t0_ < GB_SKEW_US * 100ull) __builtin_amdgcn_s_sleep(8); }
#endif
        epi::GateBranchOut E{PROJ, wsp<bf16>(c, WS_T)};
        pg8::gemm_stream<epi::GateBranchOut, GbOrder, true>(c.lds, S, E); }
    if constexpr (PH == PH_WOUT) { pg8::Gemm g{wsp<bf16>(c, WS_T), wsp<bf16>(c, OFF_WOUT), D, D}; pg8::StaticOrder S; S.init(M, 1024, c.G, c.bx);
        if (l == 0) { epi::ResidBfOut<true> E{p.in[I_X], XR, wsp<float>(c, OFF_SSQ)}; pg8::gemm_phase<epi::ResidBfOut<true>, pg8::StaticOrder, false>(c.lds, g, S, E); }
        else { epi::ResidBfOut<false> E{(const bf16*)p.out, XR, wsp<float>(c, OFF_SSQ)}; pg8::gemm_phase<epi::ResidBfOut<false>, pg8::StaticOrder, false>(c.lds, g, S, E); } }
    if constexpr (PH == PH_XQ) { pg8::Gemm g{wsp<bf16>(c, WS_X1B), wsp<bf16>(c, OFF_WXQ), D, D}; pg8::StaticOrder S; S.init(M, 512, c.G, c.bx); epi::Bf16OutRs E{wsp<bf16>(c, OFF_Q), 512, wsp<float>(c, OFF_SSQ)};
        pg8::gemm_phase<epi::Bf16OutRs, pg8::StaticOrder, false>(c.lds, g, S, E); }
    if constexpr (PH == PH_XA) { for (int u = c.bx; u < 16 * 16; u += c.G) xattn_unit(c, p, l, u >> 4, u & 15); }
    if constexpr (PH == PH_XO) { pg8::Gemm g{wsp<bf16>(c, OFF_O), wsp<bf16>(c, OFF_WXO), 512, 512}; pg8::StaticOrder S; S.init(M, 1024, c.G, c.bx); epi::ResidBfOut<false> E{XR, XR, nullptr};
        pg8::gemm_phase<epi::ResidBfOut<false>, pg8::StaticOrder, false>(c.lds, g, S, E); }
    if constexpr (PH == PH_RP2) phase_rp2_route(c, p, l, XR);
    if constexpr (PH == PH_GATHER) phase_assign(c);
    if constexpr (PH == PH_GU) { moe_tables<false>(c); pg8::Gemm g{XB, wsp<bf16>(c, OFF_WGU), D, D}; MoeOrder S{(const LAS int*)(c.lds + LDS_TAB), c.G, c.bx}; epi::GluOut E{wsp<bf16>(c, OFF_HID)};
        LAS int* rowl = (LAS int*)(c.lds + LDS_ROWL); const int* rowtok = wsp<int>(c, OFF_ROWTOK);
        for (int i = 0; i < 4; ++i) { pg8::Unit u; if (S.next(i, u) && c.tid < 256) rowl[i * 256 + c.tid] = rowtok[u.pm * 256 + c.tid]; }
        __syncthreads();
        pg8::gemm_phase_g<epi::GluOut, MoeOrder, true>(c.lds, g, rowl, S, E); }
    if constexpr (PH == PH_DOWN) { moe_tables<false>(c); pg8::Gemm g{wsp<bf16>(c, OFF_HID), wsp<bf16>(c, OFF_WD), DFF, DFF}; MoeOrder S{(const LAS int*)(c.lds + LDS_TAB), c.G, c.bx}; epi::DownOut E{wsp<bf16>(c, OFF_XG), wsp<float>(c, OFF_WROW)};
        pg8::gemm_phase<epi::DownOut, MoeOrder, true>(c.lds, g, S, E); }
    if constexpr (PH == PH_COMB) { if (l + 1 < DEPTH) { phase_combine<true>(c, p, l, XR, (bf16*)p.out, nullptr); __syncthreads(); phase_weights(c, p, l + 1); } else phase_combine<false>(c, p, l, XR, nullptr, p.out); }
}

__device__ __forceinline__ Ctx make_ctx(const Params& p, unsigned char* lds_raw) {
    Ctx c;
    c.lds = (LAS unsigned char*)lds_raw; c.ws = p.ws;
    int tid_ = threadIdx.x, bx = blockIdx.x, G_ = gridDim.x;
    asm volatile("" : "+v"(tid_), "+s"(bx), "+s"(G_));
    c.tid = tid_; c.lane = c.tid & 63; c.wave = __builtin_amdgcn_readfirstlane(c.tid >> 6);
    c.G = G_; c.bx = bx; c.vcu = (c.G % 8 == 0) ? (bx % 8) * (c.G / 8) + bx / 8 : bx;
    return c;
}
#ifndef MK_ONE_LAUNCH
#define MK_ONE_LAUNCH 1
#endif
#if !MK_ONE_LAUNCH
template <int PH>
__global__ void __launch_bounds__(512, 2) phase_kernel(Params p, int l) {
    extern __shared__ __attribute__((aligned(16))) unsigned char lds_raw[];
    const Ctx c = make_ctx(p, lds_raw);
    run_phase<PH>(c, p, l);
}
template <int PH> static void launch_phases(int grid, const Params& a, int l, hipStream_t stream) {
    if constexpr (PH < NPH_LAYER) {
        static bool attr_done = false;
        if (!attr_done) { (void)hipFuncSetAttribute((const void*)phase_kernel<PH>, hipFuncAttributeMaxDynamicSharedMemorySize, LDS_BYTES); attr_done = true; }
        if (!(PH == PH_PRE && l != 0)) hipLaunchKernelGGL(phase_kernel<PH>, dim3(grid), dim3(512), LDS_BYTES, stream, a, l);
        launch_phases<PH + 1>(grid, a, l, stream);
    }
}
#else
#if defined(__HIP_DEVICE_COMPILE__)
typedef const __attribute__((address_space(4))) Params* KParams;
#else
typedef const Params* KParams;
#endif
template <int PH>
__device__ __forceinline__ void phase_site(KParams kp, int l) {
    extern __shared__ __attribute__((aligned(16))) unsigned char lds_raw[];
    asm volatile("" : "+s"(kp));
    Params p;
#pragma unroll
    for (int i = 0; i < 28; ++i) p.in[i] = kp->in[i];
    p.out = kp->out; p.ws = kp->ws;
    const Ctx c = make_ctx(p, lds_raw);
    run_phase<PH>(c, p, l);
}
__device__ __forceinline__ void seam(KParams kp) {
    extern __shared__ __attribute__((aligned(16))) unsigned char lds_raw[];
    asm volatile("" : "+s"(kp));
    XcdBarrier b; b.bar = (unsigned*)(kp->ws + WS_CTL) + CW_BAR; b.x = xb_xcc_id(); b.st = (volatile LAS unsigned*)((LAS unsigned char*)lds_raw + LDS_MISC) + 8;
    xcd_barrier(b);
}
template <int PH> __device__ __forceinline__ void run_layer(KParams kp, int l) {
    if constexpr (PH < NPH_LAYER) {
        if (!(PH == PH_PRE && l != 0)) {
#ifdef PROBE_AMP
            const unsigned long long t0_ = __builtin_amdgcn_s_memrealtime();
#endif
            phase_site<PH>(kp, l); seam(kp);
#ifdef PROBE_AMP
            if ((PROBE_AMP >> PH) & 1) { const unsigned long long dt_ = __builtin_amdgcn_s_memrealtime() - t0_; const unsigned long long t1_ = __builtin_amdgcn_s_memrealtime();
                while (__builtin_amdgcn_s_memrealtime() - t1_ < 3 * dt_) __builtin_amdgcn_s_sleep(4); seam(kp); }
#endif
#ifdef PROBE_REPEAT
            if ((PROBE_REPEAT >> PH) & 1) { phase_site<PH>(kp, l); seam(kp); }
#endif
        }
        run_layer<PH + 1>(kp, l);
    }
}
__global__ void __launch_bounds__(512, 2) fwd_kernel(Params p) {
    extern __shared__ __attribute__((aligned(16))) unsigned char lds_raw[];
    volatile LAS unsigned* MISC = (volatile LAS unsigned*)((LAS unsigned char*)lds_raw + LDS_MISC);
    for (int u = threadIdx.x; u < (LDS_BYTES - LDS_MISC) / 4; u += 512) MISC[u] = 0u;
    __syncthreads();
    (void)xcd_barrier_post((unsigned*)(p.ws + WS_CTL) + CW_BAR, MISC + 8);
    KParams kp = (KParams)__builtin_amdgcn_kernarg_segment_ptr();
    run_layer<0>(kp, 0);
    run_layer<0>(kp, 1);
    static_assert(DEPTH == 2, "layers are written out");
}
#endif

extern "C" void kernel_launch(void* const* d_in, const int* in_sizes, int n_in, void* d_out, int out_size, void* d_ws, size_t ws_size, hipStream_t stream) {
    static int grid = 0;
    if (grid == 0) {
        if (n_in != 28 || in_sizes[0] != M * D || out_size != M * D || ws_size < WS_END) { fprintf(stderr, "kernel_launch: unexpected shapes (n_in %d, in0 %d, out %d, ws %zu < %zu); nothing launched\n", n_in, n_in > 0 ? in_sizes[0] : -1, out_size, ws_size, (size_t)WS_END); grid = -1; return; }
        int dev = 0, cus = 0;
        if (hipGetDevice(&dev) != hipSuccess || hipDeviceGetAttribute(&cus, hipDeviceAttributeMultiprocessorCount, dev) != hipSuccess) { grid = -1; return; }
#if MK_ONE_LAUNCH
        if (hipFuncSetAttribute((const void*)fwd_kernel, hipFuncAttributeMaxDynamicSharedMemorySize, LDS_BYTES) != hipSuccess) { fprintf(stderr, "kernel_launch: hipFuncSetAttribute failed\n"); grid = -1; return; }
        int per_cu = 0;
        if (hipOccupancyMaxActiveBlocksPerMultiprocessor(&per_cu, (const void*)fwd_kernel, 512, LDS_BYTES) != hipSuccess || per_cu < 1) { fprintf(stderr, "kernel_launch: occupancy query reports %d workgroups per CU\n", per_cu); }
        (void)hipGetLastError();
#endif
        grid = cus;
    }
    if (grid < 0) return;
    if (hipMemsetAsync((char*)d_ws + WS_CTL, 0, CTL_ZERO_BYTES, stream) != hipSuccess) return;
    Params a{};
    for (int i = 0; i < 28; ++i) a.in[i] = (const float*)d_in[i];
    a.out = (float*)d_out; a.ws = (unsigned char*)d_ws;
#if MK_ONE_LAUNCH
    hipLaunchKernelGGL(fwd_kernel, dim3(grid), dim3(512), LDS_BYTES, stream, a);
#else
    for (int l = 0; l < DEPTH; ++l) launch_phases<0>(grid, a, l, stream);
#endif
}
```

```cpp
#include <hip/hip_runtime.h>
#include <cstdio>
#include <cstdint>

#define GAS __attribute__((address_space(1)))
#define LAS __attribute__((address_space(3)))
typedef unsigned short bf16;
typedef short bf16x8 __attribute__((ext_vector_type(8)));
typedef float f32x4 __attribute__((ext_vector_type(4)));
typedef float f32x2 __attribute__((ext_vector_type(2)));
typedef unsigned u32x4 __attribute__((ext_vector_type(4)));
typedef unsigned u32x2 __attribute__((ext_vector_type(2)));
typedef int i32x4 __attribute__((ext_vector_type(4)));

constexpr int D = 1024, NBATCH = 4, SEQ = 4096, M = NBATCH * SEQ, DEPTH = 2, MEML = 256, MM = NBATCH * MEML;
constexpr int NIN = 8456;
constexpr int PP = 5376;
constexpr int C_MQ = 0, C_MK = 512, C_MV = 1024, C_MO = 1536, C_AQ = 2048, C_AK = 2816, C_AV = 3584, C_GU = 4352, C_GV = 4864;
constexpr int NEXP = 16, DFF = 512;
constexpr int LCH = 128, NCH = SEQ / LCH;
constexpr float EPS = 1e-6f;
constexpr int MAXT = 144;

constexpr size_t MiB = 1u << 20;
constexpr size_t WS_CTL = 0, CTL_ZERO_BYTES = 1 * MiB;
constexpr size_t WS_SMALL = 1 * MiB;
constexpr size_t OFF_GATES = WS_SMALL;
constexpr size_t OFF_AMA = OFF_GATES + (size_t)M * 8 * 4;
constexpr size_t OFF_AMM = OFF_AMA + 16 * SEQ * 4;
constexpr size_t OFF_AMB = OFF_AMM + 16 * SEQ * 4;
constexpr size_t OFF_LSE = OFF_AMB + 16 * SEQ * 4;
constexpr size_t OFF_BIAS = OFF_LSE + (size_t)M * 12 * 4;
constexpr size_t OFF_TOKE = OFF_BIAS + 12 * 132 * 4;
constexpr size_t OFF_TOKP = OFF_TOKE + (size_t)M * 2 * 4;
constexpr size_t OFF_TOKW = OFF_TOKP + (size_t)M * 2 * 4;
constexpr size_t OFF_SLOT = OFF_TOKW + (size_t)M * 2 * 4;
constexpr size_t OFF_WROW = OFF_SLOT + (size_t)M * 2 * 4;
constexpr size_t OFF_NST = OFF_WROW + (size_t)MAXT * 256 * 4;
constexpr size_t OFF_MEMB = OFF_NST + (size_t)16 * NCH * 128 * 4;
constexpr size_t OFF_KV = OFF_MEMB + (size_t)MM * D * 2;
constexpr size_t OFF_CNTW = OFF_KV + (size_t)MM * 1024 * 2;
constexpr size_t OFF_SSQ = OFF_CNTW + 256 * 16 * 4;
constexpr size_t OFF_ROWTOK = OFF_SSQ + (size_t)M * 16 * 4;
constexpr size_t OFF_SMALL_END = OFF_ROWTOK + (size_t)MAXT * 256 * 4;
static_assert(OFF_SMALL_END <= 17 * MiB, "small region");
constexpr size_t WS_W = 17 * MiB;
constexpr size_t OFF_WIN1 = WS_W;
constexpr size_t OFF_WG = OFF_WIN1 + (size_t)5376 * 1024 * 2;
constexpr size_t OFF_WA = OFF_WG + (size_t)3072 * 1024 * 2;
constexpr size_t OFF_WB = OFF_WA + (size_t)1024 * 512 * 2;
constexpr size_t OFF_WC = OFF_WB + (size_t)1024 * 768 * 2;
constexpr size_t OFF_WOUT = OFF_WC + (size_t)1024 * 512 * 2;
constexpr size_t OFF_WXQ = OFF_WOUT + (size_t)1024 * 1024 * 2;
constexpr size_t OFF_WXKV = OFF_WXQ + (size_t)512 * 1024 * 2;
constexpr size_t OFF_WXO = OFF_WXKV + (size_t)1024 * 1024 * 2;
constexpr size_t OFF_WGU = OFF_WXO + (size_t)1024 * 512 * 2;
constexpr size_t OFF_WD = OFF_WGU + (size_t)16 * 1024 * 1024 * 2;
constexpr size_t OFF_W_END = OFF_WD + (size_t)16 * 1024 * 512 * 2;
static_assert(OFF_W_END <= 93 * MiB, "weight region");
constexpr size_t WS_XB = 93 * MiB;
constexpr size_t WS_PROJ = 125 * MiB;
constexpr size_t OFF_XG = WS_PROJ, OFF_HID = WS_PROJ + 72 * MiB;
constexpr size_t WS_X1B = WS_PROJ + 120 * MiB;
constexpr size_t WS_T = 293 * MiB;
constexpr size_t OFF_Q = WS_T, OFF_O = WS_T + 16 * MiB;
constexpr size_t WS_YA = 327 * MiB, WS_YC = 343 * MiB;
constexpr size_t WS_END = 359 * MiB;
constexpr int CW_TMO = 0, CW_CODE = 1;
constexpr int CW_CNT = 64;
constexpr int CW_BAR = 4096;

constexpr int LDS_BYTES = 147456;
constexpr int LDS_TAB = 145408;
constexpr int LDS_WOFF = 0;
constexpr int LDS_ROWL = 131072;
constexpr int LDS_MISC = 146944;

#define RLX_AGENT __ATOMIC_RELAXED, __HIP_MEMORY_SCOPE_AGENT
#define LDS_WAIT() asm volatile("s_waitcnt lgkmcnt(0)" ::: "memory")
#define VM_WAIT() asm volatile("s_waitcnt vmcnt(0)" ::: "memory")
typedef __bf16 bf16x2_t __attribute__((ext_vector_type(2)));
__device__ __forceinline__ unsigned pk2(float lo, float hi) { const f32x2 v = {lo, hi}; return __builtin_bit_cast(unsigned, __builtin_convertvector(v, bf16x2_t)); }
__device__ __forceinline__ unsigned f2bf(float f) { return pk2(f, 0.f) & 0xffffu; }
__device__ __forceinline__ float bf2f(unsigned h) { return __builtin_bit_cast(float, h << 16); }
__device__ __forceinline__ float bflo(unsigned w) { return __builtin_bit_cast(float, w << 16); }
__device__ __forceinline__ float bfhi(unsigned w) { return __builtin_bit_cast(float, w & 0xffff0000u); }
__device__ __forceinline__ float wave_sum(float v) {
#pragma unroll
    for (int o = 1; o < 64; o <<= 1) v += __shfl_xor(v, o);
    return v;
}
__device__ __forceinline__ float sigmoidf_(float x) { return __builtin_amdgcn_rcpf(1.f + __expf(-x)); }
__device__ __forceinline__ float siluf_(float x) { return x * __builtin_amdgcn_rcpf(1.f + __expf(-x)); }
__device__ __forceinline__ float gelu_tanh(float x) { const float u = 0.7978845608028654f * (x + 0.044715f * x * x * x); return x * __builtin_amdgcn_rcpf(1.f + __expf(-2.f * u)); }
__device__ __forceinline__ void unpack8(const u32x4 w, float (&f)[8]) { f[0] = bflo(w.x); f[1] = bfhi(w.x); f[2] = bflo(w.y); f[3] = bfhi(w.y); f[4] = bflo(w.z); f[5] = bfhi(w.z); f[6] = bflo(w.w); f[7] = bfhi(w.w); }
__device__ __forceinline__ u32x4 pack8(const float (&f)[8]) { u32x4 w; w.x = pk2(f[0], f[1]); w.y = pk2(f[2], f[3]); w.z = pk2(f[4], f[5]); w.w = pk2(f[6], f[7]); return w; }

namespace pg8 {
constexpr int BM = 256, BK = 64, HALF = 128, HTB = HALF * BK * 2  , STAGE_BYTES = 8 * HTB, NXCD = 8, WGM = 8;
__host__ __device__ __forceinline__ int lds_byte(int r, int c) { const int st = (r >> 4) * 2 + (c >> 5), rr = r & 15, cc = c & 31, ob = rr * 64 + cc * 2; return st * 1024 + (ob ^ (((ob >> 9) & 1) << 5)); }
__host__ __device__ __forceinline__ void stage_rc(int b, int& R, int& C) { const int st = b / 1024, sb = b % 1024, swz = sb ^ (((sb >> 9) & 1) << 5); R = (st >> 1) * 16 + swz / 64; C = (st & 1) * 32 + (swz % 64) / 2; }
__host__ __device__ __forceinline__ int perm32(int rho) { const int n = rho >> 4, i = rho & 15; return 8 * (i >> 2) + 4 * n + (i & 3); }

struct Unit { int pm, pn; };
struct Gemm { const bf16* A; const bf16* Bt; int lda, K; };

struct StaticOrder {
    int nM, nN, nwg, G, c;
    __host__ __device__ __forceinline__ void init(int M_, int N_, int G_, int c_) { nM = M_ / BM; nN = N_ / BM; nwg = nM * nN; G = G_; c = c_; }
    __host__ __device__ __forceinline__ bool next(int i, Unit& u) const {
        const long L = (long)i * G + c; if (L >= nwg) return false;
        int wgid = (int)L; { const int q = nwg / NXCD, r = nwg % NXCD, xcd = wgid % NXCD, off = wgid / NXCD; wgid = (xcd < r ? xcd * (q + 1) : r * (q + 1) + (xcd - r) * q) + off; }
        const int nig = WGM * nN, gid = wgid / nig, fm = gid * WGM, gsz = (nM - fm) < WGM ? (nM - fm) : WGM;
        u.pm = fm + ((wgid % nig) % gsz); u.pn = (wgid % nig) / gsz; return true;
    }
    __device__ __forceinline__ void a_ready(const Unit&) const {}
    __device__ __forceinline__ void done(const Unit&) const {}
};


__device__ __forceinline__ f32x4 mma16(const bf16x8 a, const bf16x8 b, const f32x4 c) { return __builtin_amdgcn_mfma_f32_16x16x32_bf16(a, b, c, 0, 0, 0); }
__device__ __forceinline__ i32x4 mma16(const bf16x8 a, const bf16x8 b, const i32x4 c) { return __builtin_amdgcn_mfma_i32_16x16x64_i8(__builtin_bit_cast(i32x4, a), __builtin_bit_cast(i32x4, b), c, 0, 0, 0); }
template <bool I8> struct AccSel { typedef f32x4 T; };
template <> struct AccSel<true> { typedef i32x4 T; };
template <class Epi, class Sched, bool ALIGN_EPI = false, bool I8 = false>
__device__ __forceinline__ void gemm_phase(LAS unsigned char* lds, const Gemm g, const Sched& S, const Epi& E) {
    int tid_ = threadIdx.x; asm volatile("" : "+v"(tid_));
    const int tid = tid_, wid = __builtin_amdgcn_readfirstlane(tid >> 6), lane = tid & 63, wr = wid >> 2, wc = wid & 3, fr = lane & 15, fq = lane >> 4;
    const int K = g.K, nt = K / BK, lda = g.lda;
    unsigned voffA[2], voffB[2];
#pragma unroll
    for (int i = 0; i < 2; ++i) { int R, C; stage_rc(tid * 16 + i * 8192, R, C); const int Rb = Epi::PERM ? ((R & ~31) + perm32(R & 31)) : R;
        voffA[i] = (unsigned)(R * lda + C) * 2u; voffB[i] = (unsigned)(Rb * K + C) * 2u; }
    const size_t kstep = (size_t)(BK * 2);
    const size_t hstepA = (size_t)HALF * lda * 2, hstepB = (size_t)HALF * K * 2;
    const size_t tstepA = 2 * hstepA, tstepB = 2 * hstepB;
    const unsigned ldsw = (unsigned)wid * 1024u;
    const int aoff = lds_byte(wr * 64 + fr, fq * 8), boff = lds_byte(wc * 32 + fr, fq * 8);
#define PG8_SA(b, h) (((b) * 2 + (h)) * HTB)
#define PG8_SB(b, h) ((4 + (b) * 2 + (h)) * HTB)
#define PG8_STAGE(bufoff, gbase, voff) do { _Pragma("unroll") for (int _i = 0; _i < 2; ++_i) \
        __builtin_amdgcn_global_load_lds((const unsigned*)((const char*)(gbase) + (voff)[_i]), (LAS unsigned*)(lds + (bufoff) + ldsw + _i * 8192), 16, 0, 0); } while (0)
#define PG8_LDA(dst, b, h) do { _Pragma("unroll") for (int m = 0; m < 4; ++m) _Pragma("unroll") for (int k = 0; k < 2; ++k) dst[m][k] = *(const LAS bf16x8*)(lds + PG8_SA(b, h) + aoff + m * 2048 + k * 1024); } while (0)
#define PG8_LDB(dst, b, h) do { _Pragma("unroll") for (int n = 0; n < 2; ++n) _Pragma("unroll") for (int k = 0; k < 2; ++k) dst[n][k] = *(const LAS bf16x8*)(lds + PG8_SB(b, h) + boff + n * 2048 + k * 1024); } while (0)
#define PG8_MMA(ai, bj, At, Bt) do { __builtin_amdgcn_s_setprio(1); _Pragma("unroll") for (int m = 0; m < 4; ++m) _Pragma("unroll") for (int n = 0; n < 2; ++n) _Pragma("unroll") for (int k = 0; k < 2; ++k) \
        acc[ai][bj][m][n] = mma16(Bt[n][k], At[m][k], acc[ai][bj][m][n]); __builtin_amdgcn_s_setprio(0); } while (0)
#define PG8_WAIT_V(n) asm volatile("s_waitcnt vmcnt(" #n ")" ::: "memory")
#define PG8_WAIT_L(n) asm volatile("s_waitcnt lgkmcnt(" #n ")" ::: "memory")
#define PG8_BAR __builtin_amdgcn_s_barrier()
#define PG8_SCHED __builtin_amdgcn_sched_barrier(0)
    Unit cur, nxt; int ui = 0;
    if (!S.next(0, cur)) return;
    typedef typename AccSel<I8>::T acc_t;
    acc_t acc[2][2][4][2];
#pragma unroll
    for (int a = 0; a < 2; ++a)
#pragma unroll
        for (int b = 0; b < 2; ++b)
#pragma unroll
            for (int m = 0; m < 4; ++m)
#pragma unroll
                for (int n = 0; n < 2; ++n) acc[a][b][m][n] = (acc_t){0, 0, 0, 0};
    bf16x8 At[4][2], B0[2][2], B1[2][2];
    const char* cA = (const char*)g.A + (size_t)cur.pm * tstepA; const char* cB = (const char*)g.Bt + (size_t)cur.pn * tstepB;
    S.a_ready(cur);
    PG8_STAGE(PG8_SB(0, 0), cB, voffB); PG8_STAGE(PG8_SB(0, 1), cB + hstepB, voffB); PG8_STAGE(PG8_SA(0, 0), cA, voffA); PG8_STAGE(PG8_SA(0, 1), cA + hstepA, voffA);
    if (wr == 1) PG8_BAR;
    PG8_WAIT_V(2); PG8_BAR;
    PG8_STAGE(PG8_SB(1, 0), cB + kstep, voffB); PG8_STAGE(PG8_SA(1, 0), cA + kstep, voffA); PG8_STAGE(PG8_SB(1, 1), cB + hstepB + kstep, voffB);
    PG8_WAIT_V(6); PG8_BAR;
    for (;;) {
        const bool has_next = S.next(ui + 1, nxt);
        const char* nA = has_next ? (const char*)g.A + (size_t)nxt.pm * tstepA : cA; const char* nB = has_next ? (const char*)g.Bt + (size_t)nxt.pn * tstepB : cB;
        for (int t = 0; t < nt; t += 2) {
            const bool last = (t == nt - 2);
            const char* a1 = cA + (size_t)(t + 1) * kstep;
            const char* a2 = last ? nA : cA + (size_t)(t + 2) * kstep; const char* b2 = last ? nB : cB + (size_t)(t + 2) * kstep;
            const char* a3 = a2 + kstep; const char* b3 = b2 + kstep;
            if (last && has_next) S.a_ready(nxt);
            PG8_LDB(B0, 0, 0); PG8_LDB(B1, 0, 1); PG8_SCHED; PG8_LDA(At, 0, 0); PG8_STAGE(PG8_SA(1, 1), a1 + hstepA, voffA);
            PG8_WAIT_V(8); PG8_WAIT_L(0); PG8_BAR; PG8_MMA(0, 0, At, B0); PG8_MMA(0, 1, At, B1); PG8_BAR; PG8_SCHED;
            PG8_LDA(At, 0, 1); PG8_STAGE(PG8_SB(0, 0), b2, voffB); PG8_STAGE(PG8_SB(0, 1), b2 + hstepB, voffB); PG8_STAGE(PG8_SA(0, 0), a2, voffA);
            PG8_WAIT_V(8); PG8_WAIT_L(0); PG8_BAR; PG8_MMA(1, 0, At, B0); PG8_MMA(1, 1, At, B1); PG8_BAR; PG8_SCHED;
            PG8_LDB(B0, 1, 0); PG8_LDB(B1, 1, 1); PG8_SCHED; PG8_LDA(At, 1, 0); PG8_STAGE(PG8_SA(0, 1), a2 + hstepA, voffA);
            PG8_WAIT_V(8); PG8_WAIT_L(0); PG8_BAR; PG8_MMA(0, 0, At, B0); PG8_MMA(0, 1, At, B1); PG8_BAR; PG8_SCHED;
            PG8_LDA(At, 1, 1); PG8_STAGE(PG8_SB(1, 0), b3, voffB); PG8_STAGE(PG8_SB(1, 1), b3 + hstepB, voffB); PG8_STAGE(PG8_SA(1, 0), a3, voffA);
            PG8_WAIT_V(8); PG8_WAIT_L(0); PG8_BAR; PG8_MMA(1, 0, At, B0); PG8_MMA(1, 1, At, B1); PG8_BAR; PG8_SCHED;
        }
        if constexpr (ALIGN_EPI) { if (wr == 0) PG8_BAR; }
        E(acc, cur, wr, wc, fr, fq); S.done(cur);
        if (!has_next) break;
#pragma unroll
        for (int a = 0; a < 2; ++a)
#pragma unroll
            for (int b = 0; b < 2; ++b)
#pragma unroll
                for (int m = 0; m < 4; ++m)
#pragma unroll
                    for (int n = 0; n < 2; ++n) acc[a][b][m][n] = (acc_t){0, 0, 0, 0};
        cur = nxt; cA = nA; cB = nB; ++ui;
        if constexpr (ALIGN_EPI) { if (wr == 1) PG8_BAR; }
    }
    PG8_WAIT_V(0);
    if constexpr (!ALIGN_EPI) { if (wr == 0) PG8_BAR; }
    PG8_BAR;
#undef PG8_SA
#undef PG8_SB
#undef PG8_STAGE
#undef PG8_LDA
#undef PG8_LDB
#undef PG8_MMA
#undef PG8_WAIT_V
#undef PG8_WAIT_L
#undef PG8_BAR
#undef PG8_SCHED
}

template <class Epi, class Sched, bool ALIGN_EPI = false>
__device__ __forceinline__ void gemm_phase_g(LAS unsigned char* lds, const Gemm g, const LAS int* rowl, const Sched& S, const Epi& E) {
    constexpr bool I8 = false;
    int tid_ = threadIdx.x; asm volatile("" : "+v"(tid_));
    const int tid = tid_, wid = __builtin_amdgcn_readfirstlane(tid >> 6), lane = tid & 63, wr = wid >> 2, wc = wid & 3, fr = lane & 15, fq = lane >> 4;
    const int K = g.K, nt = K / BK, lda = g.lda;
    unsigned voffB[2]; int RA[2], CA;
#pragma unroll
    for (int i = 0; i < 2; ++i) { int R, C; stage_rc(tid * 16 + i * 8192, R, C); const int Rb = Epi::PERM ? ((R & ~31) + perm32(R & 31)) : R;
        RA[i] = R; CA = C; voffB[i] = (unsigned)(Rb * K + C) * 2u; }
    size_t gc[2][2], gn[2][2];
#define PG8_GOFF(dst, ord) do { _Pragma("unroll") for (int h = 0; h < 2; ++h) _Pragma("unroll") for (int i = 0; i < 2; ++i) dst[h][i] = ((size_t)rowl[(ord) * BM + h * HALF + RA[i]] * lda + CA) * 2; } while (0)
#define PG8_STAGEG(bufoff, gbase, goffh) do { _Pragma("unroll") for (int _i = 0; _i < 2; ++_i) \
        __builtin_amdgcn_global_load_lds((const unsigned*)((const char*)(gbase) + (goffh)[_i]), (LAS unsigned*)(lds + (bufoff) + ldsw + _i * 8192), 16, 0, 0); } while (0)
    const size_t kstep = (size_t)(BK * 2);
    const size_t hstepA = (size_t)HALF * lda * 2, hstepB = (size_t)HALF * K * 2;
    const size_t tstepA = 2 * hstepA, tstepB = 2 * hstepB;
    const unsigned ldsw = (unsigned)wid * 1024u;
    const int aoff = lds_byte(wr * 64 + fr, fq * 8), boff = lds_byte(wc * 32 + fr, fq * 8);
#define PG8_SA(b, h) (((b) * 2 + (h)) * HTB)
#define PG8_SB(b, h) ((4 + (b) * 2 + (h)) * HTB)
#define PG8_STAGE(bufoff, gbase, voff) do { _Pragma("unroll") for (int _i = 0; _i < 2; ++_i) \
        __builtin_amdgcn_global_load_lds((const unsigned*)((const char*)(gbase) + (voff)[_i]), (LAS unsigned*)(lds + (bufoff) + ldsw + _i * 8192), 16, 0, 0); } while (0)
#define PG8_LDA(dst, b, h) do { _Pragma("unroll") for (int m = 0; m < 4; ++m) _Pragma("unroll") for (int k = 0; k < 2; ++k) dst[m][k] = *(const LAS bf16x8*)(lds + PG8_SA(b, h) + aoff + m * 2048 + k * 1024); } while (0)
#define PG8_LDB(dst, b, h) do { _Pragma("unroll") for (int n = 0; n < 2; ++n) _Pragma("unroll") for (int k = 0; k < 2; ++k) dst[n][k] = *(const LAS bf16x8*)(lds + PG8_SB(b, h) + boff + n * 2048 + k * 1024); } while (0)
#define PG8_MMA(ai, bj, At, Bt) do { __builtin_amdgcn_s_setprio(1); _Pragma("unroll") for (int m = 0; m < 4; ++m) _Pragma("unroll") for (int n = 0; n < 2; ++n) _Pragma("unroll") for (int k = 0; k < 2; ++k) \
        acc[ai][bj][m][n] = mma16(Bt[n][k], At[m][k], acc[ai][bj][m][n]); __builtin_amdgcn_s_setprio(0); } while (0)
#define PG8_WAIT_V(n) asm volatile("s_waitcnt vmcnt(" #n ")" ::: "memory")
#define PG8_WAIT_L(n) asm volatile("s_waitcnt lgkmcnt(" #n ")" ::: "memory")
#define PG8_BAR __builtin_amdgcn_s_barrier()
#define PG8_SCHED __builtin_amdgcn_sched_barrier(0)
    Unit cur, nxt; int ui = 0;
    if (!S.next(0, cur)) return;
    typedef typename AccSel<I8>::T acc_t;
    acc_t acc[2][2][4][2];
#pragma unroll
    for (int a = 0; a < 2; ++a)
#pragma unroll
        for (int b = 0; b < 2; ++b)
#pragma unroll
            for (int m = 0; m < 4; ++m)
#pragma unroll
                for (int n = 0; n < 2; ++n) acc[a][b][m][n] = (acc_t){0, 0, 0, 0};
    bf16x8 At[4][2], B0[2][2], B1[2][2];
    const char* const cA = (const char*)g.A; const char* cB = (const char*)g.Bt + (size_t)cur.pn * tstepB;
    PG8_GOFF(gc, 0);
    S.a_ready(cur);
    PG8_STAGE(PG8_SB(0, 0), cB, voffB); PG8_STAGE(PG8_SB(0, 1), cB + hstepB, voffB); PG8_STAGEG(PG8_SA(0, 0), cA, gc[0]); PG8_STAGEG(PG8_SA(0, 1), cA, gc[1]);
    if (wr == 1) PG8_BAR;
    PG8_WAIT_V(2); PG8_BAR;
    PG8_STAGE(PG8_SB(1, 0), cB + kstep, voffB); PG8_STAGEG(PG8_SA(1, 0), cA + kstep, gc[0]); PG8_STAGE(PG8_SB(1, 1), cB + hstepB + kstep, voffB);
    PG8_WAIT_V(6); PG8_BAR;
    for (;;) {
        const bool has_next = S.next(ui + 1, nxt);
        const char* nB = has_next ? (const char*)g.Bt + (size_t)nxt.pn * tstepB : cB;
        if (has_next) PG8_GOFF(gn, ui + 1); else {
#pragma unroll
            for (int h = 0; h < 2; ++h)
#pragma unroll
                for (int i = 0; i < 2; ++i) gn[h][i] = gc[h][i]; }
        for (int t = 0; t < nt; t += 2) {
            const bool last = (t == nt - 2);
            const char* a1 = cA + (size_t)(t + 1) * kstep;
            const char* a2 = last ? cA : cA + (size_t)(t + 2) * kstep; const char* b2 = last ? nB : cB + (size_t)(t + 2) * kstep;
            size_t g2[2][2];
#pragma unroll
            for (int h = 0; h < 2; ++h)
#pragma unroll
                for (int i = 0; i < 2; ++i) g2[h][i] = last ? gn[h][i] : gc[h][i];
            const char* a3 = a2 + kstep; const char* b3 = b2 + kstep;
            if (last && has_next) S.a_ready(nxt);
            PG8_LDB(B0, 0, 0); PG8_LDB(B1, 0, 1); PG8_SCHED; PG8_LDA(At, 0, 0); PG8_STAGEG(PG8_SA(1, 1), a1, gc[1]);
            PG8_WAIT_V(8); PG8_WAIT_L(0); PG8_BAR; PG8_MMA(0, 0, At, B0); PG8_MMA(0, 1, At, B1); PG8_BAR; PG8_SCHED;
            PG8_LDA(At, 0, 1); PG8_STAGE(PG8_SB(0, 0), b2, voffB); PG8_STAGE(PG8_SB(0, 1), b2 + hstepB, voffB); PG8_STAGEG(PG8_SA(0, 0), a2, g2[0]);
            PG8_WAIT_V(8); PG8_WAIT_L(0); PG8_BAR; PG8_MMA(1, 0, At, B0); PG8_MMA(1, 1, At, B1); PG8_BAR; PG8_SCHED;
            PG8_LDB(B0, 1, 0); PG8_LDB(B1, 1, 1); PG8_SCHED; PG8_LDA(At, 1, 0); PG8_STAGEG(PG8_SA(0, 1), a2, g2[1]);
            PG8_WAIT_V(8); PG8_WAIT_L(0); PG8_BAR; PG8_MMA(0, 0, At, B0); PG8_MMA(0, 1, At, B1); PG8_BAR; PG8_SCHED;
            PG8_LDA(At, 1, 1); PG8_STAGE(PG8_SB(1, 0), b3, voffB); PG8_STAGE(PG8_SB(1, 1), b3 + hstepB, voffB); PG8_STAGEG(PG8_SA(1, 0), a3, g2[0]);
            PG8_WAIT_V(8); PG8_WAIT_L(0); PG8_BAR; PG8_MMA(1, 0, At, B0); PG8_MMA(1, 1, At, B1); PG8_BAR; PG8_SCHED;
        }
        if constexpr (ALIGN_EPI) { if (wr == 0) PG8_BAR; }
        E(acc, cur, wr, wc, fr, fq); S.done(cur);
        if (!has_next) break;
#pragma unroll
        for (int a = 0; a < 2; ++a)
#pragma unroll
            for (int b = 0; b < 2; ++b)
#pragma unroll
                for (int m = 0; m < 4; ++m)
#pragma unroll
                    for (int n = 0; n < 2; ++n) acc[a][b][m][n] = (acc_t){0, 0, 0, 0};
        cur = nxt; cB = nB; ++ui;
#pragma unroll
        for (int h = 0; h < 2; ++h)
#pragma unroll
            for (int i = 0; i < 2; ++i) gc[h][i] = gn[h][i];
        if constexpr (ALIGN_EPI) { if (wr == 1) PG8_BAR; }
    }
    PG8_WAIT_V(0);
    if constexpr (!ALIGN_EPI) { if (wr == 0) PG8_BAR; }
    PG8_BAR;
#undef PG8_SA
#undef PG8_SB
#undef PG8_STAGE
#undef PG8_STAGEG
#undef PG8_GOFF
#undef PG8_LDA
#undef PG8_LDB
#undef PG8_MMA
#undef PG8_WAIT_V
#undef PG8_WAIT_L
#undef PG8_BAR
#undef PG8_SCHED
}

struct SUnit { int pm, pn, kind; const char* a; const char* b; int lda, K; };
template <class Epi, class Sched, bool ALIGN_EPI = false>
__device__ __forceinline__ void gemm_stream(LAS unsigned char* lds, const Sched& S, const Epi& E) {
    int tid_ = threadIdx.x; asm volatile("" : "+v"(tid_));
    const int tid = tid_, wid = __builtin_amdgcn_readfirstlane(tid >> 6), lane = tid & 63, wr = wid >> 2, wc = wid & 3, fr = lane & 15, fq = lane >> 4;
    int R0, C0; stage_rc(tid * 16, R0, C0); const int Rb0 = Epi::PERM ? ((R0 & ~31) + perm32(R0 & 31)) : R0;
    const size_t kstep = (size_t)(BK * 2);
    const unsigned ldsw = (unsigned)wid * 1024u;
    const int aoff = lds_byte(wr * 64 + fr, fq * 8), boff = lds_byte(wc * 32 + fr, fq * 8);
#define PG8_SA(b, h) (((b) * 2 + (h)) * HTB)
#define PG8_SB(b, h) ((4 + (b) * 2 + (h)) * HTB)
#define PG8_STG(bufoff, gbase, v0, p64) do { _Pragma("unroll") for (int _i = 0; _i < 2; ++_i) \
        __builtin_amdgcn_global_load_lds((const unsigned*)((const char*)(gbase) + (v0) + (size_t)_i * (p64)), (LAS unsigned*)(lds + (bufoff) + ldsw + _i * 8192), 16, 0, 0); } while (0)
#define PG8_LDA(dst, b, h) do { _Pragma("unroll") for (int m = 0; m < 4; ++m) _Pragma("unroll") for (int k = 0; k < 2; ++k) dst[m][k] = *(const LAS bf16x8*)(lds + PG8_SA(b, h) + aoff + m * 2048 + k * 1024); } while (0)
#define PG8_LDB(dst, b, h) do { _Pragma("unroll") for (int n = 0; n < 2; ++n) _Pragma("unroll") for (int k = 0; k < 2; ++k) dst[n][k] = *(const LAS bf16x8*)(lds + PG8_SB(b, h) + boff + n * 2048 + k * 1024); } while (0)
#define PG8_MMA(ai, bj, At, Bt) do { __builtin_amdgcn_s_setprio(1); _Pragma("unroll") for (int m = 0; m < 4; ++m) _Pragma("unroll") for (int n = 0; n < 2; ++n) _Pragma("unroll") for (int k = 0; k < 2; ++k) \
        acc[ai][bj][m][n] = mma16(Bt[n][k], At[m][k], acc[ai][bj][m][n]); __builtin_amdgcn_s_setprio(0); } while (0)
#define PG8_WAIT_V(n) asm volatile("s_waitcnt vmcnt(" #n ")" ::: "memory")
#define PG8_WAIT_L(n) asm volatile("s_waitcnt lgkmcnt(" #n ")" ::: "memory")
#define PG8_BAR __builtin_amdgcn_s_barrier()
#define PG8_SCHED __builtin_amdgcn_sched_barrier(0)
    SUnit cur, nxt; int ui = 0;
    if (!S.next(0, cur)) return;
    f32x4 acc[2][2][4][2];
#pragma unroll
    for (int a = 0; a < 2; ++a)
#pragma unroll
        for (int b = 0; b < 2; ++b)
#pragma unroll
            for (int m = 0; m < 4; ++m)
#pragma unroll
                for (int n = 0; n < 2; ++n) acc[a][b][m][n] = (f32x4){0.f, 0.f, 0.f, 0.f};
    bf16x8 At[4][2], B0[2][2], B1[2][2];
    const char* cA = cur.a; const char* cB = cur.b;
    unsigned vAc = (unsigned)(R0 * cur.lda + C0) * 2u, vBc = (unsigned)(Rb0 * cur.K + C0) * 2u;
    size_t pAc = (size_t)cur.lda * 128, pBc = (size_t)cur.K * 128;
    PG8_STG(PG8_SB(0, 0), cB, vBc, pBc); PG8_STG(PG8_SB(0, 1), cB + 2 * pBc, vBc, pBc); PG8_STG(PG8_SA(0, 0), cA, vAc, pAc); PG8_STG(PG8_SA(0, 1), cA + 2 * pAc, vAc, pAc);
    if (wr == 1) PG8_BAR;
    PG8_WAIT_V(2); PG8_BAR;
    PG8_STG(PG8_SB(1, 0), cB + kstep, vBc, pBc); PG8_STG(PG8_SA(1, 0), cA + kstep, vAc, pAc); PG8_STG(PG8_SB(1, 1), cB + 2 * pBc + kstep, vBc, pBc);
    PG8_WAIT_V(6); PG8_BAR;
    for (;;) {
        const bool has_next = S.next(ui + 1, nxt);
        const char* nA = has_next ? nxt.a : cA; const char* nB = has_next ? nxt.b : cB;
        const unsigned vAn = has_next ? (unsigned)(R0 * nxt.lda + C0) * 2u : vAc, vBn = has_next ? (unsigned)(Rb0 * nxt.K + C0) * 2u : vBc;
        const size_t pAn = has_next ? (size_t)nxt.lda * 128 : pAc, pBn = has_next ? (size_t)nxt.K * 128 : pBc;
        const int nt = cur.K / BK;
        for (int t = 0; t < nt; t += 2) {
            const bool last = (t == nt - 2);
            const char* a1 = cA + (size_t)(t + 1) * kstep;
            const char* a2 = last ? nA : cA + (size_t)(t + 2) * kstep; const char* b2 = last ? nB : cB + (size_t)(t + 2) * kstep;
            const char* a3 = a2 + kstep; const char* b3 = b2 + kstep;
            const unsigned va2 = last ? vAn : vAc, vb2 = last ? vBn : vBc; const size_t pa2 = last ? pAn : pAc, pb2 = last ? pBn : pBc;
            PG8_LDB(B0, 0, 0); PG8_LDB(B1, 0, 1); PG8_SCHED; PG8_LDA(At, 0, 0); PG8_STG(PG8_SA(1, 1), a1 + 2 * pAc, vAc, pAc);
            PG8_WAIT_V(8); PG8_WAIT_L(0); PG8_BAR; PG8_MMA(0, 0, At, B0); PG8_MMA(0, 1, At, B1); PG8_BAR; PG8_SCHED;
            PG8_LDA(At, 0, 1); PG8_STG(PG8_SB(0, 0), b2, vb2, pb2); PG8_STG(PG8_SB(0, 1), b2 + 2 * pb2, vb2, pb2); PG8_STG(PG8_SA(0, 0), a2, va2, pa2);
            PG8_WAIT_V(8); PG8_WAIT_L(0); PG8_BAR; PG8_MMA(1, 0, At, B0); PG8_MMA(1, 1, At, B1); PG8_BAR; PG8_SCHED;
            PG8_LDB(B0, 1, 0); PG8_LDB(B1, 1, 1); PG8_SCHED; PG8_LDA(At, 1, 0); PG8_STG(PG8_SA(0, 1), a2 + 2 * pa2, va2, pa2);
            PG8_WAIT_V(8); PG8_WAIT_L(0); PG8_BAR; PG8_MMA(0, 0, At, B0); PG8_MMA(0, 1, At, B1); PG8_BAR; PG8_SCHED;
            PG8_LDA(At, 1, 1); PG8_STG(PG8_SB(1, 0), b3, vb2, pb2); PG8_STG(PG8_SB(1, 1), b3 + 2 * pb2, vb2, pb2); PG8_STG(PG8_SA(1, 0), a3, va2, pa2);
            PG8_WAIT_V(8); PG8_WAIT_L(0); PG8_BAR; PG8_MMA(1, 0, At, B0); PG8_MMA(1, 1, At, B1); PG8_BAR; PG8_SCHED;
        }
        if constexpr (ALIGN_EPI) { if (wr == 0) PG8_BAR; }
#if defined(PROBE_EPI)
        { const unsigned long long te0_ = __builtin_amdgcn_s_memrealtime();
          E(acc, cur, wr, wc, fr, fq);
#if PROBE_EPI == 2
          asm volatile("s_waitcnt vmcnt(0)" ::: "memory");
#endif
          const unsigned long long dte_ = __builtin_amdgcn_s_memrealtime() - te0_, te1_ = __builtin_amdgcn_s_memrealtime();
          while (__builtin_amdgcn_s_memrealtime() - te1_ < 3 * dte_) __builtin_amdgcn_s_sleep(2); }
#else
        E(acc, cur, wr, wc, fr, fq);
#endif
        if (!has_next) break;
#pragma unroll
        for (int a = 0; a < 2; ++a)
#pragma unroll
            for (int b = 0; b < 2; ++b)
#pragma unroll
                for (int m = 0; m < 4; ++m)
#pragma unroll
                    for (int n = 0; n < 2; ++n) acc[a][b][m][n] = (f32x4){0.f, 0.f, 0.f, 0.f};
        cur = nxt; cA = nA; cB = nB; vAc = vAn; vBc = vBn; pAc = pAn; pBc = pBn; ++ui;
        if constexpr (ALIGN_EPI) { if (wr == 1) PG8_BAR; }
    }
    PG8_WAIT_V(0);
    if constexpr (!ALIGN_EPI) { if (wr == 0) PG8_BAR; }
    PG8_BAR;
#undef PG8_SA
#undef PG8_SB
#undef PG8_STG
#undef PG8_LDA
#undef PG8_LDB
#undef PG8_MMA
#undef PG8_WAIT_V
#undef PG8_WAIT_L
#undef PG8_BAR
#undef PG8_SCHED
}
}

namespace epi {
using pg8::Unit; using pg8::BM; using pg8::HALF;
__device__ __forceinline__ u32x4 pk8(const f32x4 v0, const f32x4 v1) { u32x4 w; w.x = pk2(v0[0], v0[1]); w.y = pk2(v0[2], v0[3]); w.z = pk2(v1[0], v1[1]); w.w = pk2(v1[2], v1[3]); return w; }
__device__ __forceinline__ void up8(const u32x4 w, f32x4& a, f32x4& b) { a = (f32x4){bflo(w.x), bfhi(w.x), bflo(w.y), bfhi(w.y)}; b = (f32x4){bflo(w.z), bfhi(w.z), bflo(w.w), bfhi(w.w)}; }
__device__ __forceinline__ int gcol(int tg) { return tg < 6 ? 256 * tg : 2816 + 256 * (tg - 6); }

struct Bf16Out {
    static constexpr bool PERM = true;
    bf16* O; int ldc;
    __device__ __forceinline__ void operator()(const f32x4 (&acc)[2][2][4][2], const Unit& u, int wr, int wc, int fr, int fq) const {
        const int row0 = u.pm * BM + wr * 64 + fr, col0 = u.pn * BM + wc * 32 + 8 * fq;
#pragma unroll
        for (int ai = 0; ai < 2; ++ai)
#pragma unroll
            for (int m = 0; m < 4; ++m) { bf16* rowp = O + (size_t)(row0 + ai * HALF + m * 16) * ldc + col0;
#pragma unroll
                for (int bj = 0; bj < 2; ++bj) {
#ifdef NT_STORE
                    __builtin_nontemporal_store(pk8(acc[ai][bj][m][0], acc[ai][bj][m][1]), (u32x4*)(rowp + bj * HALF));
#else
                    *(u32x4*)(rowp + bj * HALF) = pk8(acc[ai][bj][m][0], acc[ai][bj][m][1]);
#endif
                } }
    }
};
struct SigOut {
    static constexpr bool PERM = true;
    bf16* PROJ;
    __device__ __forceinline__ void operator()(const f32x4 (&acc)[2][2][4][2], const Unit& u, int wr, int wc, int fr, int fq) const {
        const int row0 = u.pm * BM + wr * 64 + fr, col0 = gcol(u.pn) + wc * 32 + 8 * fq;
#pragma unroll
        for (int ai = 0; ai < 2; ++ai)
#pragma unroll
            for (int m = 0; m < 4; ++m) { bf16* rowp = PROJ + (size_t)(row0 + ai * HALF + m * 16) * PP + col0;
#pragma unroll
                for (int bj = 0; bj < 2; ++bj) { f32x4 a = acc[ai][bj][m][0], b = acc[ai][bj][m][1];
#pragma unroll
                    for (int e = 0; e < 4; ++e) { a[e] = sigmoidf_(a[e]); b[e] = sigmoidf_(b[e]); }
                    *(u32x4*)(rowp + bj * HALF) = pk8(a, b); } }
    }
};
template <int BR> struct BranchOut {
    static constexpr bool PERM = true;
    const bf16* PROJ; bf16* T; bf16* OUT;
    __device__ __forceinline__ void operator()(const f32x4 (&acc)[2][2][4][2], const Unit& u, int wr, int wc, int fr, int fq) const {
        const int row0 = u.pm * BM + wr * 64 + fr, cw = wc * 32 + 8 * fq, gc0 = gcol(BR * 4 + u.pn) + cw, col0 = u.pn * BM + cw;
#pragma unroll
        for (int ai = 0; ai < 2; ++ai)
#pragma unroll
            for (int m = 0; m < 4; ++m) { const size_t row = (size_t)(row0 + ai * HALF + m * 16);
#pragma unroll
                for (int bj = 0; bj < 2; ++bj) {
                    f32x4 g0, g1; up8(*(const u32x4*)(PROJ + row * PP + gc0 + bj * HALF), g0, g1);
                    f32x4 v0 = g0 * acc[ai][bj][m][0], v1 = g1 * acc[ai][bj][m][1];
                    if (BR > 0) { f32x4 t0, t1; up8(*(const u32x4*)(T + row * 1024 + col0 + bj * HALF), t0, t1); v0 += t0; v1 += t1; }
                    bf16* dst = (BR == 2 ? OUT : T) + row * 1024 + col0 + bj * HALF;
                    *(u32x4*)dst = pk8(v0, v1); } }
    }
};
struct GateBranchOut {
    static constexpr bool PERM = true;
    bf16* PROJ; bf16* T;
    __device__ __forceinline__ void operator()(const f32x4 (&acc)[2][2][4][2], const pg8::SUnit& u, int wr, int wc, int fr, int fq) const {
        const int row0 = u.pm * BM + wr * 64 + fr, cw = wc * 32 + 8 * fq;
        if (u.kind < 3) {
            const int col0 = gcol(u.kind * 4 + u.pn) + cw;
#pragma unroll
            for (int ai = 0; ai < 2; ++ai)
#pragma unroll
                for (int m = 0; m < 4; ++m) { bf16* rowp = PROJ + (size_t)(row0 + ai * HALF + m * 16) * PP + col0;
#pragma unroll
                    for (int bj = 0; bj < 2; ++bj) { f32x4 a = acc[ai][bj][m][0], b = acc[ai][bj][m][1];
#pragma unroll
                        for (int e = 0; e < 4; ++e) { a[e] = sigmoidf_(a[e]); b[e] = sigmoidf_(b[e]); }
                        *(u32x4*)(rowp + bj * HALF) = pk8(a, b); } }
        } else {
            const int br = u.kind - 3, gc0 = gcol(br * 4 + u.pn) + cw, col0 = u.pn * BM + cw;
#pragma unroll
            for (int ai = 0; ai < 2; ++ai) {
                u32x4 gq[4][2], tq[4][2];
#pragma unroll
                for (int m = 0; m < 4; ++m)
#pragma unroll
                    for (int bj = 0; bj < 2; ++bj) { const size_t row = (size_t)(row0 + ai * HALF + m * 16); gq[m][bj] = *(const u32x4*)(PROJ + row * PP + gc0 + bj * HALF);
                        tq[m][bj] = br > 0 ? *(const u32x4*)(T + row * 1024 + col0 + bj * HALF) : (u32x4){0u, 0u, 0u, 0u}; }
#pragma unroll
                for (int m = 0; m < 4; ++m)
#pragma unroll
                    for (int bj = 0; bj < 2; ++bj) { const size_t row = (size_t)(row0 + ai * HALF + m * 16);
                        f32x4 g0, g1, t0, t1; up8(gq[m][bj], g0, g1); up8(tq[m][bj], t0, t1);
                        *(u32x4*)(T + row * 1024 + col0 + bj * HALF) = pk8(g0 * acc[ai][bj][m][0] + t0, g1 * acc[ai][bj][m][1] + t1); }
            }
        }
    }
};
struct ResidOut {
    static constexpr bool PERM = false;
    const float* SRC; float* DST;
    __device__ __forceinline__ void operator()(const f32x4 (&acc)[2][2][4][2], const Unit& u, int wr, int wc, int fr, int fq) const {
        const int row0 = u.pm * BM + wr * 64 + fr, col0 = u.pn * BM + wc * 32 + 4 * fq;
#pragma unroll
        for (int ai = 0; ai < 2; ++ai)
#pragma unroll
            for (int m = 0; m < 4; ++m) { const size_t off = (size_t)(row0 + ai * HALF + m * 16) * 1024 + col0;
#pragma unroll
                for (int bj = 0; bj < 2; ++bj)
#pragma unroll
                    for (int n = 0; n < 2; ++n) { const size_t o = off + bj * HALF + n * 16; *(f32x4*)(DST + o) = *(const f32x4*)(SRC + o) + acc[ai][bj][m][n]; } }
    }
};
template <bool SRC_F32> struct ResidBfOut {
    static constexpr bool PERM = true;
    const void* SRC; bf16* DST; float* SSQ;
    __device__ __forceinline__ void operator()(const f32x4 (&acc)[2][2][4][2], const Unit& u, int wr, int wc, int fr, int fq) const {
        const int row0 = u.pm * BM + wr * 64 + fr, col0 = u.pn * BM + wc * 32 + 8 * fq;
#pragma unroll
        for (int ai = 0; ai < 2; ++ai) {
            f32x4 sq[4][2][2];
#pragma unroll
            for (int m = 0; m < 4; ++m)
#pragma unroll
                for (int bj = 0; bj < 2; ++bj) { const size_t o = (size_t)(row0 + ai * HALF + m * 16) * 1024 + col0 + bj * HALF;
                    if (SRC_F32) { sq[m][bj][0] = *(const f32x4*)((const float*)SRC + o); sq[m][bj][1] = *(const f32x4*)((const float*)SRC + o + 4); } else up8(*(const u32x4*)((const bf16*)SRC + o), sq[m][bj][0], sq[m][bj][1]); }
#pragma unroll
            for (int m = 0; m < 4; ++m) { const int row = row0 + ai * HALF + m * 16; const size_t off = (size_t)row * 1024 + col0; float ss = 0.f;
#pragma unroll
                for (int bj = 0; bj < 2; ++bj) { const size_t o = off + bj * HALF;
                    const f32x4 v0 = sq[m][bj][0] + acc[ai][bj][m][0], v1 = sq[m][bj][1] + acc[ai][bj][m][1];
                    ss += ((v0[0] * v0[0] + v0[1] * v0[1]) + (v0[2] * v0[2] + v0[3] * v0[3])) + ((v1[0] * v1[0] + v1[1] * v1[1]) + (v1[2] * v1[2] + v1[3] * v1[3]));
                    *(u32x4*)(DST + o) = pk8(v0, v1); }
                if (SSQ) { ss += __shfl_xor(ss, 16); ss += __shfl_xor(ss, 32); if (fq == 0) SSQ[(size_t)row * 16 + u.pn * 4 + wc] = ss; } }
        }
    }
};
struct Bf16OutRs {
    static constexpr bool PERM = true;
    bf16* O; int ldc; const float* SSQ;
    __device__ __forceinline__ void operator()(const f32x4 (&acc)[2][2][4][2], const Unit& u, int wr, int wc, int fr, int fq) const {
        const int row0 = u.pm * BM + wr * 64 + fr, col0 = u.pn * BM + wc * 32 + 8 * fq;
        float rsv[2][4];
#pragma unroll
        for (int ai = 0; ai < 2; ++ai)
#pragma unroll
            for (int m = 0; m < 4; ++m) { const int row = row0 + ai * HALF + m * 16; const f32x4* sp = (const f32x4*)(SSQ + (size_t)row * 16);
                const f32x4 s0 = sp[0], s1 = sp[1], s2 = sp[2], s3 = sp[3]; const f32x4 st = (s0 + s1) + (s2 + s3);
                rsv[ai][m] = 1.f / sqrtf(((st[0] + st[1]) + (st[2] + st[3])) * (1.f / 1024.f) + EPS); }
#pragma unroll
        for (int ai = 0; ai < 2; ++ai)
#pragma unroll
            for (int m = 0; m < 4; ++m) { const int row = row0 + ai * HALF + m * 16; const float rs = rsv[ai][m]; bf16* rowp = O + (size_t)row * ldc + col0;
#pragma unroll
                for (int bj = 0; bj < 2; ++bj) *(u32x4*)(rowp + bj * HALF) = pk8(acc[ai][bj][m][0] * rs, acc[ai][bj][m][1] * rs); }
    }
};
struct GluOut {
    static constexpr bool PERM = true;
    bf16* HID;
    __device__ __forceinline__ void operator()(const f32x4 (&acc)[2][2][4][2], const Unit& u, int wr, int wc, int fr, int fq) const {
        const int row0 = u.pm * BM + wr * 64 + fr, col0 = (u.pn & 3) * 128 + wc * 32 + 8 * fq;
#pragma unroll
        for (int ai = 0; ai < 2; ++ai)
#pragma unroll
            for (int m = 0; m < 4; ++m) { f32x4 a = acc[ai][0][m][0], b = acc[ai][0][m][1]; const f32x4 ua = acc[ai][1][m][0], ub = acc[ai][1][m][1];
#pragma unroll
                for (int e = 0; e < 4; ++e) { a[e] = siluf_(a[e]) * ua[e]; b[e] = siluf_(b[e]) * ub[e]; }
                *(u32x4*)(HID + (size_t)(row0 + ai * HALF + m * 16) * DFF + col0) = pk8(a, b); }
    }
};
struct DownOut {
    static constexpr bool PERM = true;
    bf16* YE; const float* WROW;
    __device__ __forceinline__ void operator()(const f32x4 (&acc)[2][2][4][2], const Unit& u, int wr, int wc, int fr, int fq) const {
        const int row0 = u.pm * BM + wr * 64 + fr, col0 = (u.pn & 3) * BM + wc * 32 + 8 * fq;
#pragma unroll
        for (int ai = 0; ai < 2; ++ai)
#pragma unroll
            for (int m = 0; m < 4; ++m) { const int row = row0 + ai * HALF + m * 16; const float w = WROW[row]; bf16* rowp = YE + (size_t)row * 1024 + col0;
#pragma unroll
                for (int bj = 0; bj < 2; ++bj) *(u32x4*)(rowp + bj * HALF) = pk8(acc[ai][bj][m][0] * w, acc[ai][bj][m][1] * w); }
    }
};
}

struct MoeOrder {
    const LAS int* tab; int G, c;
    __device__ __forceinline__ bool next(int i, pg8::Unit& u) const {
        const int nT = tab[176];
        if (G % 8 != 0) { const int L = i * G + c; if (L >= 4 * nT) return false; const int pm = L >> 2; u.pm = pm; u.pn = tab[pm] * 4 + (L & 3); return true; }
        const int x = c & 7, j = c >> 3, per = G >> 3;
        const int t0 = (nT * x) >> 3, t1 = (nT * (x + 1)) >> 3;
        const int idx = i * per + j; if (idx >= 4 * (t1 - t0)) return false;
        const int pm = t0 + (idx >> 2); u.pm = pm; u.pn = tab[pm] * 4 + (idx & 3); return true;
    }
    __device__ __forceinline__ void a_ready(const pg8::Unit&) const {}
    __device__ __forceinline__ void done(const pg8::Unit&) const {}
};
#define XB_TMO      128
#define XB_XCNT(j)  (256  + 64 * (j))
#define XB_XSUB(j)  (1280 + 64 * (j))
#define XB_XGEN(j)  (2304 + 64 * (j))
#define XB_TOP      3328
#define XB_TOPGEN   3392
#define XCD_BAR_WORDS 3456
#define XB_SPIN_CAP (1u << 18)

__device__ __forceinline__ unsigned xb_ld(unsigned* p)              { return __hip_atomic_load(p, __ATOMIC_RELAXED, __HIP_MEMORY_SCOPE_AGENT); }
__device__ __forceinline__ unsigned xb_add(unsigned* p, unsigned v) { return __hip_atomic_fetch_add(p, v, __ATOMIC_RELAXED, __HIP_MEMORY_SCOPE_AGENT); }
__device__ __forceinline__ unsigned xb_xcc_id() { return (unsigned)__builtin_amdgcn_s_getreg((3 << 11) | 20) & 0xFu; }
#define XB_SPIN(cond, bar) do { unsigned _sp = 0; while (cond) { __builtin_amdgcn_s_sleep(1); \
    if ((++_sp & 255u) == 0u) { if (xb_ld(&(bar)[XB_TMO])) break; if (_sp > XB_SPIN_CAP) { atomicAdd(&(bar)[XB_TMO], 1u); break; } } } } while (0)

struct XcdBarrier {
    unsigned* bar; unsigned x;
    volatile LAS unsigned* st;
};

__device__ __forceinline__ XcdBarrier xcd_barrier_post(unsigned* bar, volatile LAS unsigned* st) {
    XcdBarrier b; b.bar = bar; b.x = xb_xcc_id(); b.st = st;
    if (threadIdx.x == 0) (void)xb_add(&bar[XB_XCNT(b.x)], 1u);
    return b;
}
__device__ __forceinline__ void xcd_barrier_complete(unsigned* bar, unsigned x, unsigned& nloc, unsigned& nx) {
    const unsigned G = gridDim.x * gridDim.y * gridDim.z;
    unsigned sum, cnt, mine, sp = 0u;
    for (;;) {
        sum = 0u; cnt = 0u; mine = 0u;
#pragma unroll
        for (unsigned j = 0; j < 16; ++j) { const unsigned c = xb_ld(&bar[XB_XCNT(j)]); sum += c; cnt += (c > 0u) ? 1u : 0u; mine = (j == x) ? c : mine; }
        if (sum == G) break;
        __builtin_amdgcn_s_sleep(1);
        if ((++sp & 255u) == 0u) { if (xb_ld(&bar[XB_TMO])) break; if (sp > XB_SPIN_CAP) { atomicAdd(&bar[XB_TMO], 1u); break; } }
    }
    nloc = mine > 0u ? mine : 1u; nx = cnt > 0u ? cnt : 1u;
}

__device__ __forceinline__ void xcd_barrier(const XcdBarrier& b) {
    asm volatile("s_waitcnt vmcnt(0)" ::: "memory");
    __syncthreads();
    if (threadIdx.x == 0) {
        unsigned* bar = b.bar;
        __builtin_amdgcn_s_waitcnt(0);
        unsigned nloc = b.st[0], nx = b.st[1];
        if (nloc == 0u) { xcd_barrier_complete(bar, b.x, nloc, nx); b.st[0] = nloc; b.st[1] = nx; }
        const unsigned old = xb_add(&bar[XB_XSUB(b.x)], 1u);
        const unsigned gen = old / nloc;
        if (old + 1u == (gen + 1u) * nloc) {
            __builtin_amdgcn_fence(__ATOMIC_RELEASE, "agent");
            asm volatile("s_waitcnt vmcnt(0)" ::: "memory");
            const unsigned og = xb_add(&bar[XB_TOP], 1u);
            const unsigned tg = og / nx;
            if (og + 1u == (tg + 1u) * nx) xb_add(&bar[XB_TOPGEN], 1u);
            else XB_SPIN(xb_ld(&bar[XB_TOPGEN]) == tg, bar);
            __builtin_amdgcn_fence(__ATOMIC_ACQUIRE, "agent");
            xb_add(&bar[XB_XGEN(b.x)], 1u);
            asm volatile("s_waitcnt vmcnt(0)" ::: "memory");
        } else {
            XB_SPIN(xb_ld(&bar[XB_XGEN(b.x)]) == gen, bar);
            __builtin_amdgcn_fence(__ATOMIC_ACQUIRE, "agent");
            asm volatile("s_waitcnt vmcnt(0)" ::: "memory");
        }
    }
    __syncthreads();
}

struct Params { const float* in[28]; float* out; unsigned char* ws; };
enum { I_X = 0, I_MEM, I_NORM_MIX, I_W_IN, I_CONV, I_GATE_B, I_MLSTM_NORM, I_ATTN_QKN, I_GMLP_NORM, I_GMLP_WS, I_GMLP_BS, I_WBA, I_WBB, I_WBC, I_WOUT, I_REL_BIAS,
       I_NORM_XATTN, I_NORM_MEM, I_WXQ, I_WXKV, I_XATTN_QKN, I_WXO, I_NORM_FFN, I_ROUTER_W, I_ROUTER_B, I_EG, I_EU, I_ED };

struct Ctx {
    LAS unsigned char* lds;
    unsigned char* ws;
    int tid, lane, wave, vcu, G, bx;
};
template <class T> __device__ __forceinline__ T* wsp(const Ctx& c, size_t off) { return (T*)(c.ws + off); }

__device__ const unsigned char REL_BUCKET[3][132] = {
  {0,1,2,3,4,5,6,7,8,9,10,11,12,13,14,15,16,16,16,16,16,16,17,17,17,17,17,17,17,17,18,18,18,18,18,18,18,18,18,18,19,19,19,19,19,19,19,19,19,19,19,19,19,19,20,20,20,20,20,20,20,20,20,20,20,20,20,20,20,20,20,20,20,21,21,21,21,21,21,21,21,21,21,21,21,21,21,21,21,21,21,21,21,21,21,21,21,21,21,22,22,22,22,22,22,22,22,22,22,22,22,22,22,22,22,22,22,22,22,22,22,22,22,22,22,22,22,22,22,0,0,0},
  {0,4,8,12,16,16,17,17,18,18,19,19,19,19,20,20,20,20,20,21,21,21,21,21,21,22,22,22,22,22,22,22,22,22,23,23,23,23,23,23,23,23,23,23,23,23,24,24,24,24,24,24,24,24,24,24,24,24,24,24,24,24,25,25,25,25,25,25,25,25,25,25,25,25,25,25,25,25,25,25,25,25,25,26,26,26,26,26,26,26,26,26,26,26,26,26,26,26,26,26,26,26,26,26,26,26,26,26,26,26,26,26,26,27,27,27,27,27,27,27,27,27,27,27,27,27,27,27,27,0,0,0},
  {0,16,18,19,20,21,21,22,22,23,23,23,24,24,24,24,25,25,25,25,25,26,26,26,26,26,26,26,26,27,27,27,27,27,27,27,27,27,27,28,28,28,28,28,28,28,28,28,28,28,28,28,29,29,29,29,29,29,29,29,29,29,29,29,29,29,29,29,29,29,30,30,30,30,30,30,30,30,30,30,30,30,30,30,30,30,30,30,30,30,30,30,30,30,30,31,31,31,31,31,31,31,31,31,31,31,31,31,31,31,31,31,31,31,31,31,31,31,31,31,31,31,31,31,31,31,31,31,31,0,0,0}};

template <class RowMap>
__device__ __forceinline__ void tr_item(const float* W, int ldw, int c0, const float* gain, bf16* WT, int K, LAS float* scr, int kb, int nb, int lane, RowMap rm) {
    const int k0 = 64 * kb, n0 = 64 * nb, lr = lane >> 4, lc = 4 * (lane & 15);
    f32x4 v[16];
#pragma unroll
    for (int i = 0; i < 16; ++i) v[i] = *(const f32x4*)(W + (size_t)(k0 + 4 * i + lr) * ldw + c0 + n0 + lc);
#pragma unroll
    for (int i = 0; i < 16; ++i) { const int kk = 4 * i + lr; const float gg = gain ? gain[k0 + kk] : 1.f; LAS float* s = scr + kk * 65 + lc; s[0] = v[i].x * gg; s[1] = v[i].y * gg; s[2] = v[i].z * gg; s[3] = v[i].w * gg; }
    LDS_WAIT(); asm volatile("" ::: "memory");
    const int c = lane & 7;
#pragma unroll
    for (int j = 0; j < 8; ++j) { const int n = (lane >> 3) + 8 * j; const LAS float* s = scr + (8 * c) * 65 + n;
        u32x4 o; o.x = pk2(s[0 * 65], s[1 * 65]); o.y = pk2(s[2 * 65], s[3 * 65]); o.z = pk2(s[4 * 65], s[5 * 65]); o.w = pk2(s[6 * 65], s[7 * 65]);
        *(u32x4*)(WT + (size_t)rm(n0 + n) * K + k0 + 8 * c) = o; }
    LDS_WAIT(); asm volatile("" ::: "memory");
}
struct RmId { int off; __device__ __forceinline__ int operator()(int n) const { return off + n; } };
struct RmGate { __device__ __forceinline__ int operator()(int n) const { return (n >> 7) * 256 + (n & 127); } };
struct RmUp { __device__ __forceinline__ int operator()(int n) const { return (n >> 7) * 256 + 128 + (n & 127); } };

__device__ __forceinline__ void phase_weights(const Ctx& c, const Params& p, int l) {
    LAS float* scr = (LAS float*)(c.lds + c.wave * 16640);
    const int gw = c.vcu * 8 + c.wave, NGW = c.G * 8;
    const float* w_in = p.in[I_W_IN] + (size_t)l * D * NIN;
    constexpr int N1 = 16 * 32, N2 = 16 * 52, N3 = 16 * 48, N4 = 8 * 16, N5 = 12 * 16, N6 = 8 * 16, N7 = 16 * 16, N8 = 16 * 8, N9 = 16 * 16, N10 = 8 * 16, NE = 16 * 8, NDN = 8 * 16;
    constexpr int NITEMS = N1 + N2 + N3 + N4 + N5 + N6 + N7 + N8 + N9 + N10 + 16 * NE * 2 + 16 * NDN;
    for (int it = gw; it < NITEMS; it += NGW) {
        int r = it;
        if (r < N1) { tr_item(w_in, NIN, 0, p.in[I_NORM_MIX] + l * D, wsp<bf16>(c, OFF_WIN1), D, scr, r / 32, r % 32, c.lane, RmId{0}); continue; } r -= N1;
        if (r < N2) { tr_item(w_in, NIN, 2056, p.in[I_NORM_MIX] + l * D, wsp<bf16>(c, OFF_WIN1), D, scr, r / 52, r % 52, c.lane, RmId{2048}); continue; } r -= N2;
        if (r < N3) { tr_item(w_in, NIN, 5384, p.in[I_NORM_MIX] + l * D, wsp<bf16>(c, OFF_WG), D, scr, r / 48, r % 48, c.lane, RmId{0}); continue; } r -= N3;
        if (r < N4) { tr_item(p.in[I_WBA] + (size_t)l * 512 * 1024, 1024, 0, nullptr, wsp<bf16>(c, OFF_WA), 512, scr, r / 16, r % 16, c.lane, RmId{0}); continue; } r -= N4;
        if (r < N5) { tr_item(p.in[I_WBB] + (size_t)l * 768 * 1024, 1024, 0, nullptr, wsp<bf16>(c, OFF_WB), 768, scr, r / 16, r % 16, c.lane, RmId{0}); continue; } r -= N5;
        if (r < N6) { tr_item(p.in[I_WBC] + (size_t)l * 512 * 1024, 1024, 0, nullptr, wsp<bf16>(c, OFF_WC), 512, scr, r / 16, r % 16, c.lane, RmId{0}); continue; } r -= N6;
        if (r < N7) { tr_item(p.in[I_WOUT] + (size_t)l * 1024 * 1024, 1024, 0, nullptr, wsp<bf16>(c, OFF_WOUT), 1024, scr, r / 16, r % 16, c.lane, RmId{0}); continue; } r -= N7;
        if (r < N8) { tr_item(p.in[I_WXQ] + (size_t)l * 1024 * 512, 512, 0, p.in[I_NORM_XATTN] + l * D, wsp<bf16>(c, OFF_WXQ), 1024, scr, r / 8, r % 8, c.lane, RmId{0}); continue; } r -= N8;
        if (r < N9) { tr_item(p.in[I_WXKV] + (size_t)l * 1024 * 1024, 1024, 0, p.in[I_NORM_MEM] + l * D, wsp<bf16>(c, OFF_WXKV), 1024, scr, r / 16, r % 16, c.lane, RmId{0}); continue; } r -= N9;
        if (r < N10) { tr_item(p.in[I_WXO] + (size_t)l * 512 * 1024, 1024, 0, nullptr, wsp<bf16>(c, OFF_WXO), 512, scr, r / 16, r % 16, c.lane, RmId{0}); continue; } r -= N10;
        if (r < 16 * NE) { const int e = r / NE, rr = r % NE; tr_item(p.in[I_EG] + ((size_t)l * 16 + e) * 1024 * 512, 512, 0, p.in[I_NORM_FFN] + l * D, wsp<bf16>(c, OFF_WGU) + (size_t)e * 1024 * 1024, 1024, scr, rr / 8, rr % 8, c.lane, RmGate{}); continue; } r -= 16 * NE;
        if (r < 16 * NE) { const int e = r / NE, rr = r % NE; tr_item(p.in[I_EU] + ((size_t)l * 16 + e) * 1024 * 512, 512, 0, p.in[I_NORM_FFN] + l * D, wsp<bf16>(c, OFF_WGU) + (size_t)e * 1024 * 1024, 1024, scr, rr / 8, rr % 8, c.lane, RmUp{}); continue; } r -= 16 * NE;
        { const int e = r / NDN, rr = r % NDN; tr_item(p.in[I_ED] + ((size_t)l * 16 + e) * 512 * 1024, 1024, 0, nullptr, wsp<bf16>(c, OFF_WD) + (size_t)e * 1024 * 512, 512, scr, rr / 16, rr % 16, c.lane, RmId{0}); }
    }
}

__device__ __forceinline__ void row_norm_store(f32x4 (&v)[4], bf16* xbrow, int lane) {
    float s = 0.f;
#pragma unroll
    for (int j = 0; j < 4; ++j) s += (v[j].x * v[j].x + v[j].y * v[j].y) + (v[j].z * v[j].z + v[j].w * v[j].w);
    const float rs = 1.f / sqrtf(wave_sum(s) * (1.f / D) + EPS);
    unsigned long long* o8 = (unsigned long long*)xbrow + lane;
#pragma unroll
    for (int j = 0; j < 4; ++j) { v[j] = v[j] * rs; o8[64 * j] = (unsigned long long)pk2(v[j].x, v[j].y) | ((unsigned long long)pk2(v[j].z, v[j].w) << 32); }
}
__device__ __forceinline__ float reduce8(const float (&a)[8], int lane) {
    float b[4], d[2];
    const bool h5 = lane & 32, h4 = lane & 16, h3 = lane & 8;
#pragma unroll
    for (int q = 0; q < 4; ++q) { const float mine = h5 ? a[q + 4] : a[q], other = h5 ? a[q] : a[q + 4]; b[q] = mine + __shfl_xor(other, 32); }
#pragma unroll
    for (int q = 0; q < 2; ++q) { const float mine = h4 ? b[q + 2] : b[q], other = h4 ? b[q] : b[q + 2]; d[q] = mine + __shfl_xor(other, 16); }
    const float mine = h3 ? d[1] : d[0], other = h3 ? d[0] : d[1]; float r = mine + __shfl_xor(other, 8);
    r += __shfl_xor(r, 4); r += __shfl_xor(r, 2); r += __shfl_xor(r, 1); return r;
}
__device__ __forceinline__ void row_gates2(const f32x4 (&v)[4], const f32x4 (&v2)[4], const LAS float* W8t, const float* gate_b, float* gates_row, float* gates_row2, int lane) {
    float a[8], a2[8];
#pragma unroll
    for (int q = 0; q < 8; ++q) { float s = 0.f, s2 = 0.f;
#pragma unroll
        for (int j = 0; j < 4; ++j) { const f32x4 w = *(const LAS f32x4*)(W8t + q * 1024 + 256 * j + 4 * lane);
            s += (v[j].x * w.x + v[j].y * w.y) + (v[j].z * w.z + v[j].w * w.w); s2 += (v2[j].x * w.x + v2[j].y * w.y) + (v2[j].z * w.z + v2[j].w * w.w); }
        a[q] = s; a2[q] = s2; if ((q & 3) == 3) __builtin_amdgcn_sched_barrier(0); }
    const float r = reduce8(a, lane), r2 = reduce8(a2, lane);
    if ((lane & 7) == 0) { const int q = lane >> 3; const float gb = gate_b[q]; gates_row[q] = r + gb; gates_row2[q] = r2 + gb; }
}
__device__ __forceinline__ void load_w8(const Ctx& c, const Params& p, int l) {
    LAS float* W8t = (LAS float*)c.lds; const float* w_in = p.in[I_W_IN] + (size_t)l * D * NIN; const float* g = p.in[I_NORM_MIX] + l * D;
    for (int idx = c.tid; idx < D * 8; idx += 512) { const int k = idx >> 3, q = idx & 7; W8t[q * 1024 + k] = w_in[(size_t)k * NIN + 2048 + q] * g[k]; }
    __syncthreads();
}
__device__ __forceinline__ void phase_rp0_input(const Ctx& c, const Params& p) {
    load_w8(c, p, 0);
    const int gw = c.vcu * 8 + c.wave, NGW = c.G * 8;
    const float* x = p.in[I_X];
    for (int m = gw; m < M; m += 2 * NGW) {
        const int m2 = m + NGW;
        f32x4 v[4], v2[4]; const f32x4* xr = (const f32x4*)(x + (size_t)m * D) + c.lane; const f32x4* xr2 = (const f32x4*)(x + (size_t)m2 * D) + c.lane;
#pragma unroll
        for (int j = 0; j < 4; ++j) { v[j] = xr[64 * j]; v2[j] = xr2[64 * j]; }
        row_norm_store(v, wsp<bf16>(c, WS_XB) + (size_t)m * D, c.lane); row_norm_store(v2, wsp<bf16>(c, WS_XB) + (size_t)m2 * D, c.lane);
        row_gates2(v, v2, (const LAS float*)c.lds, p.in[I_GATE_B], wsp<float>(c, OFF_GATES) + (size_t)m * 8, wsp<float>(c, OFF_GATES) + (size_t)m2 * 8, c.lane);
    }
    const float* mem = p.in[I_MEM];
    for (int m = gw; m < MM; m += NGW) {
        f32x4 v[4]; const f32x4* xr = (const f32x4*)(mem + (size_t)m * D) + c.lane;
#pragma unroll
        for (int j = 0; j < 4; ++j) v[j] = xr[64 * j];
        row_norm_store(v, wsp<bf16>(c, OFF_MEMB) + (size_t)m * D, c.lane);
    }
    if (c.bx == 0) { float* bt = wsp<float>(c, OFF_BIAS); const float* rb = p.in[I_REL_BIAS];
        for (int idx = c.tid; idx < 12 * 132; idx += 512) { const int h = idx / 132, dist = idx % 132; bt[idx] = rb[(int)REL_BUCKET[h >> 2][dist] * 12 + h]; } }
}
__device__ __forceinline__ void phase_rp1(const Ctx& c, const float* X) {
    const int gw = c.vcu * 8 + c.wave, NGW = c.G * 8;
    for (int m = gw; m < M; m += NGW) {
        f32x4 v[4]; const f32x4* xr = (const f32x4*)(X + (size_t)m * D) + c.lane;
#pragma unroll
        for (int j = 0; j < 4; ++j) v[j] = xr[64 * j];
        row_norm_store(v, wsp<bf16>(c, WS_XB) + (size_t)m * D, c.lane);
    }
}
__device__ __forceinline__ float reduce16(const float (&a)[16], int lane) {
    float b[8], c4[4], d[2];
    const bool h5 = lane & 32, h4 = lane & 16, h3 = lane & 8, h2 = lane & 4;
#pragma unroll
    for (int q = 0; q < 8; ++q) { const float mine = h5 ? a[q + 8] : a[q], other = h5 ? a[q] : a[q + 8]; b[q] = mine + __shfl_xor(other, 32); }
#pragma unroll
    for (int q = 0; q < 4; ++q) { const float mine = h4 ? b[q + 4] : b[q], other = h4 ? b[q] : b[q + 4]; c4[q] = mine + __shfl_xor(other, 16); }
#pragma unroll
    for (int q = 0; q < 2; ++q) { const float mine = h3 ? c4[q + 2] : c4[q], other = h3 ? c4[q] : c4[q + 2]; d[q] = mine + __shfl_xor(other, 8); }
    const float mine = h2 ? d[1] : d[0], other = h2 ? d[0] : d[1]; float r = mine + __shfl_xor(other, 4);
    r += __shfl_xor(r, 2); r += __shfl_xor(r, 1); return r;
}
__device__ __forceinline__ void route_token(const Ctx& c, float r, const float* rbias, LAS unsigned* lcnt, int m) {
    float a[16]; float mx = -3.0e38f;
#pragma unroll
    for (int q = 0; q < 16; ++q) { const int src = ((q & 8) ? 32 : 0) | ((q & 4) ? 16 : 0) | ((q & 2) ? 8 : 0) | ((q & 1) ? 4 : 0); a[q] = __shfl(r, src) + rbias[q]; mx = fmaxf(mx, a[q]); }
#pragma unroll
    for (int q = 0; q < 16; ++q) a[q] = __expf(a[q] - mx);
    float bs = -1.f, p1 = 0.f, p2 = 0.f; int e1 = 0, e2 = 1;
#pragma unroll
    for (int g = 0; g < 4; ++g) {
        const float q0 = a[4 * g], q1 = a[4 * g + 1], q2 = a[4 * g + 2], q3 = a[4 * g + 3];
        int i1 = 0; float m1 = q0; if (q1 > m1) { m1 = q1; i1 = 1; } if (q2 > m1) { m1 = q2; i1 = 2; } if (q3 > m1) { m1 = q3; i1 = 3; }
        int i2 = -1; float m2 = -1.f;
        if (i1 != 0 && q0 > m2) { m2 = q0; i2 = 0; } if (i1 != 1 && q1 > m2) { m2 = q1; i2 = 1; } if (i1 != 2 && q2 > m2) { m2 = q2; i2 = 2; } if (i1 != 3 && q3 > m2) { m2 = q3; i2 = 3; }
        const float sc = m1 + m2;
        if (sc > bs) { bs = sc; e1 = 4 * g + i1; e2 = 4 * g + i2; p1 = m1; p2 = m2; }
    }
    if (c.lane == 0) {
        const float inv = 1.f / (p1 + p2);
        const unsigned pos1 = __hip_atomic_fetch_add(lcnt + e1, 1u, __ATOMIC_RELAXED, __HIP_MEMORY_SCOPE_WORKGROUP), pos2 = __hip_atomic_fetch_add(lcnt + e2, 1u, __ATOMIC_RELAXED, __HIP_MEMORY_SCOPE_WORKGROUP);
        int* te = wsp<int>(c, OFF_TOKE) + 2 * m; int* tp = wsp<int>(c, OFF_TOKP) + 2 * m; float* tw = wsp<float>(c, OFF_TOKW) + 2 * m;
        te[0] = e1; te[1] = e2; tp[0] = (int)pos1; tp[1] = (int)pos2; tw[0] = p1 * inv; tw[1] = p2 * inv;
    }
}
__device__ __forceinline__ void phase_rp2_route(const Ctx& c, const Params& p, int l, const bf16* X) {
    LAS float* RWt = (LAS float*)c.lds;
    { const float* rw = p.in[I_ROUTER_W]; const float* g = p.in[I_NORM_FFN] + l * D;
      for (int idx = c.tid; idx < D * 16; idx += 512) RWt[(idx & 15) * 1024 + (idx >> 4)] = rw[idx] * g[idx >> 4];
      __syncthreads(); }
    const int gw = c.vcu * 8 + c.wave, NGW = c.G * 8;
    LAS unsigned* lcnt = (LAS unsigned*)(c.lds + LDS_TAB);
    if (c.tid < 16) lcnt[c.tid] = 0u;
    __syncthreads();
    const float* rbias = p.in[I_ROUTER_B];
    for (int m = gw; m < M; m += 2 * NGW) {
        const int m2 = m + NGW;
        f32x4 v[4], v2[4]; const u32x2* xr = (const u32x2*)(X + (size_t)m * D) + c.lane; const u32x2* xr2 = (const u32x2*)(X + (size_t)m2 * D) + c.lane;
        u32x2 w1[4], w2[4];
#pragma unroll
        for (int j = 0; j < 4; ++j) { w1[j] = xr[64 * j]; w2[j] = xr2[64 * j]; }
#pragma unroll
        for (int j = 0; j < 4; ++j) { v[j] = (f32x4){bflo(w1[j].x), bfhi(w1[j].x), bflo(w1[j].y), bfhi(w1[j].y)}; v2[j] = (f32x4){bflo(w2[j].x), bfhi(w2[j].x), bflo(w2[j].y), bfhi(w2[j].y)}; }
        row_norm_store(v, wsp<bf16>(c, WS_XB) + (size_t)m * D, c.lane);
        row_norm_store(v2, wsp<bf16>(c, WS_XB) + (size_t)m2 * D, c.lane);
        float a[16], a2[16];
#pragma unroll
        for (int q = 0; q < 16; ++q) { float s = 0.f, s2 = 0.f;
#pragma unroll
            for (int j = 0; j < 4; ++j) { const f32x4 w = *(const LAS f32x4*)(RWt + q * 1024 + 256 * j + 4 * c.lane);
                s += (v[j].x * w.x + v[j].y * w.y) + (v[j].z * w.z + v[j].w * w.w); s2 += (v2[j].x * w.x + v2[j].y * w.y) + (v2[j].z * w.z + v2[j].w * w.w); }
            a[q] = s; a2[q] = s2; if ((q & 3) == 3) __builtin_amdgcn_sched_barrier(0); }
        const float r = reduce16(a, c.lane), r2 = reduce16(a2, c.lane);
        route_token(c, r, rbias, lcnt, m);
        route_token(c, r2, rbias, lcnt, m2);
    }
    __syncthreads();
    if (c.tid < 16) wsp<unsigned>(c, OFF_CNTW)[c.vcu * 16 + c.tid] = lcnt[c.tid];
}
template <bool WITH_OFF>
__device__ __forceinline__ void moe_tables(const Ctx& c) {
    LAS int* tab = (LAS int*)(c.lds + LDS_TAB); LAS int* woff = (LAS int*)(c.lds + LDS_WOFF); LAS int* tot = tab + 180;
    const unsigned* cw = wsp<unsigned>(c, OFF_CNTW);
    if (c.tid < 16) { int s = 0;
#pragma unroll 8
        for (int v = 0; v < c.G; ++v) { if (WITH_OFF) woff[v * 16 + c.tid] = s; s += (int)cw[v * 16 + c.tid]; }
        tot[c.tid] = s; }
    __syncthreads();
    if (c.tid == 0) { int t = 0;
        for (int e = 0; e < 16; ++e) { const int nt = (tot[e] + 255) >> 8; tab[160 + e] = t * 256; for (int i = 0; i < nt && t < MAXT; ++i) tab[t++] = e; }
        tab[176] = t; }
    __syncthreads();
}
__device__ __forceinline__ void phase_assign(const Ctx& c) {
    moe_tables<true>(c);
    const LAS int* tab = (const LAS int*)(c.lds + LDS_TAB); const LAS int* woff = (const LAS int*)(c.lds + LDS_WOFF);
    const int gt = c.vcu * 512 + c.tid, NT = c.G * 512;
    const int* te = wsp<int>(c, OFF_TOKE); const int* tp = wsp<int>(c, OFF_TOKP); const float* tw = wsp<float>(c, OFF_TOKW);
    int* slot = wsp<int>(c, OFF_SLOT); float* wrow = wsp<float>(c, OFF_WROW); int* rowtok = wsp<int>(c, OFF_ROWTOK);
    for (int it = gt; it < 2 * M; it += NT) { const int e = te[it], m_ = it >> 1; const int s = tab[160 + e] + woff[((m_ % (c.G * 8)) >> 3) * 16 + e] + tp[it];
        slot[it] = s; wrow[s] = tw[it]; rowtok[s] = m_; }
    for (int it = gt; it < 16 * 256; it += NT) { const int e = it >> 8, r = it & 255; const int n = tab[180 + e], s = tab[160 + e] + n + r; if (r < ((256 - (n & 255)) & 255)) rowtok[s] = 0; }
}
template <bool NEXT>
__device__ __forceinline__ void phase_combine(const Ctx& c, const Params& p, int l, const bf16* Xsrc, bf16* Xnext, float* Xout) {
    if (NEXT) load_w8(c, p, l + 1);
    const int gw = c.vcu * 8 + c.wave, NGW = c.G * 8;
    const int* slot = wsp<int>(c, OFF_SLOT); const bf16* YE = wsp<bf16>(c, OFF_XG);
    for (int m0 = gw; m0 < M; m0 += 2 * NGW) {
        f32x4 v[2][4];
        { int s0[2], s1[2]; u32x2 x[2][4], ya[2][4], yb[2][4];
#pragma unroll
          for (int r = 0; r < 2; ++r) { const int m = m0 + r * NGW; s0[r] = slot[2 * m]; s1[r] = slot[2 * m + 1]; }
#pragma unroll
          for (int r = 0; r < 2; ++r) { const int m = m0 + r * NGW; const u32x2* xr = (const u32x2*)(Xsrc + (size_t)m * D) + c.lane;
              const u32x2* y0 = (const u32x2*)(YE + (size_t)s0[r] * D) + c.lane; const u32x2* y1 = (const u32x2*)(YE + (size_t)s1[r] * D) + c.lane;
#pragma unroll
              for (int j = 0; j < 4; ++j) { x[r][j] = xr[64 * j]; ya[r][j] = y0[64 * j]; yb[r][j] = y1[64 * j]; } }
#pragma unroll
          for (int r = 0; r < 2; ++r)
#pragma unroll
              for (int j = 0; j < 4; ++j) { const u32x2 a = ya[r][j], b = yb[r][j], xx = x[r][j];
                  v[r][j].x = (bflo(xx.x) + bflo(a.x)) + bflo(b.x); v[r][j].y = (bfhi(xx.x) + bfhi(a.x)) + bfhi(b.x); v[r][j].z = (bflo(xx.y) + bflo(a.y)) + bflo(b.y); v[r][j].w = (bfhi(xx.y) + bfhi(a.y)) + bfhi(b.y); } }
        if (NEXT) {
#pragma unroll
            for (int r = 0; r < 2; ++r) { const int m = m0 + r * NGW; unsigned long long* xo = (unsigned long long*)(Xnext + (size_t)m * D) + c.lane;
#pragma unroll
                for (int j = 0; j < 4; ++j) xo[64 * j] = (unsigned long long)pk2(v[r][j].x, v[r][j].y) | ((unsigned long long)pk2(v[r][j].z, v[r][j].w) << 32);
                row_norm_store(v[r], wsp<bf16>(c, WS_XB) + (size_t)m * D, c.lane); }
            row_gates2(v[0], v[1], (const LAS float*)c.lds, p.in[I_GATE_B] + 8 * (l + 1), wsp<float>(c, OFF_GATES) + (size_t)m0 * 8, wsp<float>(c, OFF_GATES) + (size_t)(m0 + NGW) * 8, c.lane);
        } else {
#pragma unroll
            for (int r = 0; r < 2; ++r) { f32x4* xo = (f32x4*)(Xout + (size_t)(m0 + r * NGW) * D) + c.lane;
#pragma unroll
                for (int j = 0; j < 4; ++j) xo[64 * j] = v[r][j]; }
        }
    }
}
__device__ __forceinline__ void gate_scan(const Ctx& c, int bh) {
    const int b = bh >> 2, h = bh & 3, tid = c.tid, lane = c.lane, w = c.wave;
    LAS float* ws_ = (LAS float*)c.lds;
    const float* G = wsp<float>(c, OFF_GATES) + ((size_t)b * SEQ + 8 * tid) * 8;
    float* Aa = wsp<float>(c, OFF_AMA) + bh * SEQ + 8 * tid; float* Am = wsp<float>(c, OFF_AMM) + bh * SEQ + 8 * tid; float* Ab = wsp<float>(c, OFF_AMB) + bh * SEQ + 8 * tid;
    float lf[8], ip[8];
#pragma unroll
    for (int i = 0; i < 8; ++i) { const float f = G[i * 8 + 4 + h]; ip[i] = G[i * 8 + h]; lf[i] = fminf(f, 0.f) - log1pf(__expf(-fabsf(f))); }
    float s = 0.f;
#pragma unroll
    for (int i = 0; i < 8; ++i) { s += lf[i]; lf[i] = s; }
    float incl = s;
#pragma unroll
    for (int o = 1; o < 64; o <<= 1) { const float t = __shfl_up(incl, o); if (lane >= o) incl += t; }
    if (lane == 63) ws_[w] = incl;
    __syncthreads();
    float base = incl - s;
    for (int ww = 0; ww < w; ++ww) base += ws_[ww];
    float av[8], mxl = -3.0e38f;
#pragma unroll
    for (int i = 0; i < 8; ++i) { const float Bc = base + lf[i]; lf[i] = Bc; av[i] = ip[i] - Bc; mxl = fmaxf(mxl, av[i]); }
    float inm = mxl;
#pragma unroll
    for (int o = 1; o < 64; o <<= 1) { const float t = __shfl_up(inm, o); if (lane >= o) inm = fmaxf(inm, t); }
    if (lane == 63) ws_[8 + w] = inm;
    __syncthreads();
    float run = __shfl_up(inm, 1); if (lane == 0) run = 0.f;
    run = fmaxf(run, 0.f);
    for (int ww = 0; ww < w; ++ww) run = fmaxf(run, ws_[8 + ww]);
    float mv[8];
#pragma unroll
    for (int i = 0; i < 8; ++i) { run = fmaxf(run, av[i]); mv[i] = run; }
    *(f32x4*)(Aa) = (f32x4){av[0], av[1], av[2], av[3]}; *(f32x4*)(Aa + 4) = (f32x4){av[4], av[5], av[6], av[7]};
    *(f32x4*)(Am) = (f32x4){mv[0], mv[1], mv[2], mv[3]}; *(f32x4*)(Am + 4) = (f32x4){mv[4], mv[5], mv[6], mv[7]};
    *(f32x4*)(Ab) = (f32x4){lf[0], lf[1], lf[2], lf[3]}; *(f32x4*)(Ab + 4) = (f32x4){lf[4], lf[5], lf[6], lf[7]};
    __syncthreads();
}

typedef short s16x4 __attribute__((ext_vector_type(4)));
__device__ __forceinline__ s16x4 ds_tr(const LAS bf16* p) { return __builtin_bit_cast(s16x4, __builtin_amdgcn_ds_read_tr16_b64_v4i16((LAS s16x4*)p)); }
__device__ __forceinline__ bf16x8 cat4(const s16x4 lo, const s16x4 hi) { return (bf16x8){lo[0], lo[1], lo[2], lo[3], hi[0], hi[1], hi[2], hi[3]}; }
__device__ __forceinline__ bf16x8 ldsA(const LAS bf16* p) { return *(const LAS bf16x8*)p; }
__device__ __forceinline__ bf16x8 pk8f(const f32x4 a, const f32x4 b) { u32x4 w; w.x = pk2(a[0], a[1]); w.y = pk2(a[2], a[3]); w.z = pk2(b[0], b[1]); w.w = pk2(b[2], b[3]); return __builtin_bit_cast(bf16x8, w); }
#define MFMA16(a, b, c) __builtin_amdgcn_mfma_f32_16x16x32_bf16((a), (b), (c), 0, 0, 0)
__device__ __forceinline__ float red4g_sum(float v) { v += __shfl_xor(v, 16); v += __shfl_xor(v, 32); return v; }
__device__ __forceinline__ float red4g_max(float v) { v = fmaxf(v, __shfl_xor(v, 16)); v = fmaxf(v, __shfl_xor(v, 32)); return v; }
__device__ __forceinline__ float red16_sum(float v) { v += __shfl_xor(v, 1); v += __shfl_xor(v, 2); v += __shfl_xor(v, 4); v += __shfl_xor(v, 8); return v; }
constexpr f32x4 Z4 = {0.f, 0.f, 0.f, 0.f};

constexpr int LS = 136;
constexpr int QS = 72;

__device__ __forceinline__ void conv4_silu(const u32x4 (&x)[7], const float* cw, float (&o)[4][8]) {
    float w[4][8];
#pragma unroll
    for (int jj = 0; jj < 4; ++jj) { const f32x4 w0 = *(const f32x4*)(cw + jj * 1024), w1 = *(const f32x4*)(cw + jj * 1024 + 4);
        w[jj][0] = w0.x; w[jj][1] = w0.y; w[jj][2] = w0.z; w[jj][3] = w0.w; w[jj][4] = w1.x; w[jj][5] = w1.y; w[jj][6] = w1.z; w[jj][7] = w1.w; }
    float xf[7][8];
#pragma unroll
    for (int a = 0; a < 7; ++a) unpack8(x[a], xf[a]);
#pragma unroll
    for (int rr = 0; rr < 4; ++rr)
#pragma unroll
        for (int e = 0; e < 8; ++e) { const float s = (w[0][e] * xf[rr][e] + w[1][e] * xf[rr + 1][e]) + (w[2][e] * xf[rr + 2][e] + w[3][e] * xf[rr + 3][e]); o[rr][e] = siluf_(s); }
}
__device__ __forceinline__ void load7(const bf16* colp, int t0, u32x4 (&x)[7]) {
#pragma unroll
    for (int a = 0; a < 7; ++a) { const int t = t0 - 3 + a; x[a] = (t >= 0) ? *(const u32x4*)(colp + (size_t)t * PP) : (u32x4){0u, 0u, 0u, 0u}; }
}

__device__ __forceinline__ void mlstm_delta_unit(const Ctx& c, const Params& p, int l, int bh, int j) {
    const int b = bh >> 2, h = bh & 3, tid = c.tid, lane = c.lane, w = c.wave, r16 = lane & 15, g = lane >> 4;
    LAS bf16* vv = (LAS bf16*)c.lds; LAS bf16* kw = vv + 128 * LS;
    const bf16* projb = wsp<bf16>(c, WS_PROJ) + (size_t)b * SEQ * PP;
    const float* Aa = wsp<float>(c, OFF_AMA) + bh * SEQ + LCH * j; const float Mend = wsp<float>(c, OFF_AMM)[bh * SEQ + LCH * j + LCH - 1];
    {
        const int rg = tid >> 4, c8 = (tid & 15) * 8, t0 = LCH * j + 4 * rg;
        u32x4 xk[7], xv[4];
        load7(projb + C_MK + h * 128 + c8, t0, xk);
#pragma unroll
        for (int rr = 0; rr < 4; ++rr) xv[rr] = *(const u32x4*)(projb + (size_t)(t0 + rr) * PP + C_MV + h * 128 + c8);
        const f32x4 a4 = *(const f32x4*)(Aa + 4 * rg);
        float k[4][8]; conv4_silu(xk, p.in[I_CONV] + (size_t)l * 4 * 1024 + 512 + h * 128 + c8, k);
#pragma unroll
        for (int rr = 0; rr < 4; ++rr) { const float wgt = __expf(a4[rr] - Mend) * 0.08838834764831845f;
#pragma unroll
            for (int e = 0; e < 8; ++e) k[rr][e] *= wgt;
            *(LAS u32x4*)(kw + (4 * rg + rr) * LS + c8) = pack8(k[rr]); *(LAS u32x4*)(vv + (4 * rg + rr) * LS + c8) = xv[rr]; }
    }
    __syncthreads();
    f32x4 acc[8];
#pragma unroll
    for (int nt = 0; nt < 8; ++nt) acc[nt] = Z4;
    const LAS bf16* ap = vv + (8 * g + (r16 >> 2)) * LS + 16 * w + 4 * (r16 & 3); const LAS bf16* bp = kw + (8 * g + (r16 >> 2)) * LS + 4 * (r16 & 3);
#pragma unroll
    for (int ks = 0; ks < 4; ++ks) { const bf16x8 a = cat4(ds_tr(ap + 32 * ks * LS), ds_tr(ap + (32 * ks + 4) * LS));
#pragma unroll
        for (int nt = 0; nt < 8; ++nt) { const bf16x8 bb = cat4(ds_tr(bp + 32 * ks * LS + 16 * nt), ds_tr(bp + (32 * ks + 4) * LS + 16 * nt)); acc[nt] = MFMA16(a, bb, acc[nt]); } }
    float* st = wsp<float>(c, WS_T) + (size_t)(bh * NCH + j) * (128 * 128);
#pragma unroll
    for (int nt = 0; nt < 8; ++nt)
#pragma unroll
        for (int i = 0; i < 4; ++i) st[(16 * w + 4 * g + i) * 128 + 16 * nt + r16] = acc[nt][i];
    if (tid < 128) { float s = 0.f;
#pragma unroll 8
        for (int r = 0; r < 128; ++r) s += bf2f(kw[r * LS + tid]);
        wsp<float>(c, OFF_NST)[(bh * NCH + j) * 128 + tid] = s; }
    __syncthreads();
}
__device__ __forceinline__ void mlstm_scan(const Ctx& c) {
    constexpr int EL4 = (128 * 128 + 128) / 4;
    const int gt = c.vcu * 512 + c.tid, NT = c.G * 512;
    for (int idx = gt; idx < 16 * EL4; idx += NT) {
        const int bh = idx / EL4, el = idx % EL4;
        const float* Am = wsp<float>(c, OFF_AMM) + bh * SEQ;
        f32x4* base = el < 4096 ? (f32x4*)(wsp<float>(c, WS_T) + (size_t)bh * NCH * 16384) + el : (f32x4*)(wsp<float>(c, OFF_NST) + bh * NCH * 128) + (el - 4096);
        const int stride = el < 4096 ? 4096 : 32;
        f32x4 cs = {0.f, 0.f, 0.f, 0.f}; float Mprev = 0.f;
#pragma unroll 1
        for (int j0 = 0; j0 < NCH; j0 += 8) {
            f32x4 dl[8]; float gg[8];
#pragma unroll
            for (int a = 0; a < 8; ++a) { dl[a] = base[(size_t)(j0 + a) * stride]; const float Mend = Am[LCH * (j0 + a) + LCH - 1]; gg[a] = __expf(Mprev - Mend); Mprev = Mend; }
#pragma unroll
            for (int a = 0; a < 8; ++a) { cs = cs * gg[a] + dl[a]; base[(size_t)(j0 + a) * stride] = cs; }
        }
    }
}
__device__ __forceinline__ void mlstm_out_unit(const Ctx& c, const Params& p, int l, int bh, int j) {
    const int b = bh >> 2, h = bh & 3, tid = c.tid, lane = c.lane, w = c.wave, r16 = lane & 15, g = lane >> 4;
    LAS bf16* qq = (LAS bf16*)c.lds; LAS bf16* kk = qq + 128 * LS; LAS bf16* vv = kk + 128 * LS; LAS bf16* CTb = vv + 128 * LS;
    LAS float* fa = (LAS float*)(CTb + 144 * LS); LAS float* fM = fa + 128; LAS float* fB = fM + 128;
    bf16* projb = wsp<bf16>(c, WS_PROJ) + (size_t)b * SEQ * PP;
    {
        const int rg = tid >> 4, c8 = (tid & 15) * 8, t0 = LCH * j + 4 * rg;
        u32x4 xq[7], xk[7], xv[4];
        load7(projb + C_MQ + h * 128 + c8, t0, xq); load7(projb + C_MK + h * 128 + c8, t0, xk);
#pragma unroll
        for (int rr = 0; rr < 4; ++rr) xv[rr] = *(const u32x4*)(projb + (size_t)(t0 + rr) * PP + C_MV + h * 128 + c8);
        const int e = tid >> 2, d0 = (tid & 3) * 32;
        f32x4 sv[8];
        if (j > 0) { const f32x4* sp = (const f32x4*)(wsp<float>(c, WS_T) + (size_t)(bh * NCH + j - 1) * 16384 + e * 128 + d0);
#pragma unroll
            for (int a = 0; a < 8; ++a) sv[a] = sp[a]; }
        else {
#pragma unroll
            for (int a = 0; a < 8; ++a) sv[a] = Z4; }
        const float* cwq = p.in[I_CONV] + (size_t)l * 4 * 1024 + h * 128 + c8;
        float o[4][8];
        conv4_silu(xq, cwq, o);
#pragma unroll
        for (int rr = 0; rr < 4; ++rr) *(LAS u32x4*)(qq + (4 * rg + rr) * LS + c8) = pack8(o[rr]);
        conv4_silu(xk, cwq + 512, o);
#pragma unroll
        for (int rr = 0; rr < 4; ++rr) {
#pragma unroll
            for (int e2 = 0; e2 < 8; ++e2) o[rr][e2] *= 0.08838834764831845f;
            *(LAS u32x4*)(kk + (4 * rg + rr) * LS + c8) = pack8(o[rr]); *(LAS u32x4*)(vv + (4 * rg + rr) * LS + c8) = xv[rr]; }
#pragma unroll
        for (int a = 0; a < 4; ++a) *(LAS bf16x8*)(CTb + e * LS + d0 + 8 * a) = pk8f(sv[2 * a], sv[2 * a + 1]);
    }
    if (tid < 256) { const int e = 128 + (tid >> 4), c8 = (tid & 15) * 8; float s8[8];
#pragma unroll
        for (int i = 0; i < 8; ++i) s8[i] = 0.f;
        if (e == 128 && j > 0) { const float* nn = wsp<float>(c, OFF_NST) + (bh * NCH + j - 1) * 128 + c8;
#pragma unroll
            for (int i = 0; i < 8; ++i) s8[i] = nn[i]; }
        *(LAS u32x4*)(CTb + e * LS + c8) = pack8(s8); }
    if (tid < 128) { const int t = bh * SEQ + LCH * j + tid; fa[tid] = wsp<float>(c, OFF_AMA)[t]; fM[tid] = wsp<float>(c, OFF_AMM)[t]; fB[tid] = wsp<float>(c, OFF_AMB)[t]; }
    __syncthreads();
    const float Mprev = j > 0 ? wsp<float>(c, OFF_AMM)[bh * SEQ + LCH * j - 1] : 0.f;
    const int tq = 16 * w + r16;
    f32x4 as[8], ai[9];
#pragma unroll
    for (int a = 0; a < 8; ++a) as[a] = Z4;
#pragma unroll
    for (int a = 0; a < 9; ++a) ai[a] = Z4;
#pragma unroll
    for (int ks = 0; ks < 4; ++ks) { const bf16x8 bq = ldsA(qq + tq * LS + 32 * ks + 8 * g);
#pragma unroll
        for (int mt = 0; mt < 8; ++mt) if (mt <= w) as[mt] = MFMA16(ldsA(kk + (16 * mt + r16) * LS + 32 * ks + 8 * g), bq, as[mt]);
#pragma unroll
        for (int et = 0; et < 9; ++et) ai[et] = MFMA16(ldsA(CTb + (16 * et + r16) * LS + 32 * ks + 8 * g), bq, ai[et]);
        __builtin_amdgcn_sched_barrier(0); }
    const float Mt = fM[tq], winter = __expf(Mprev - Mt);
    float den = 0.f;
#pragma unroll
    for (int mt = 0; mt < 8; ++mt)
#pragma unroll
        for (int i = 0; i < 4; ++i) { const int r = 16 * mt + 4 * g + i; const float wg = (mt <= w && r <= tq) ? __expf(fa[r] - Mt) : 0.f; const float sw = as[mt][i] * wg; as[mt][i] = sw; den += sw; }
    den = red4g_sum(den);
    const float dinter = __shfl(ai[8][0], r16);
    const float dd = den + winter * dinter;
    const float dn = fmaxf(fabsf(dd), __expf(-(fB[tq] + Mt)));
    f32x4 ao[8];
#pragma unroll
    for (int et = 0; et < 8; ++et) ao[et] = ai[et] * winter;
    const LAS bf16* vp = vv + (4 * g + (r16 >> 2)) * LS + 4 * (r16 & 3);
#pragma unroll
    for (int ks = 0; ks < 4; ++ks) if (2 * ks <= w) { const bf16x8 bp = pk8f(as[2 * ks], as[2 * ks + 1]);
#pragma unroll
        for (int et = 0; et < 8; ++et) ao[et] = MFMA16(cat4(ds_tr(vp + 32 * ks * LS + 16 * et), ds_tr(vp + (32 * ks + 16) * LS + 16 * et)), bp, ao[et]);
        __builtin_amdgcn_sched_barrier(0); }
    const float inv = 1.f / dn; float ss = 0.f;
#pragma unroll
    for (int et = 0; et < 8; ++et) { ao[et] = ao[et] * inv; ss += (ao[et][0] * ao[et][0] + ao[et][1] * ao[et][1]) + (ao[et][2] * ao[et][2] + ao[et][3] * ao[et][3]); }
    ss = red4g_sum(ss); const float rs = 1.f / sqrtf(ss * (1.f / 128.f) + EPS);
    const float* gain = p.in[I_MLSTM_NORM] + l * 512 + h * 128; const bf16* mrow = projb + (size_t)(LCH * j + tq) * PP + C_MO + h * 128;
    bf16* orow = wsp<bf16>(c, WS_YA) + ((size_t)b * SEQ + LCH * j + tq) * 512 + h * 128;
    u32x2 mo8[8]; f32x4 gn8[8];
#pragma unroll
    for (int et = 0; et < 8; ++et) { const int e0 = 16 * et + 4 * g; mo8[et] = *(const u32x2*)(mrow + e0); gn8[et] = *(const f32x4*)(gain + e0); }
#pragma unroll
    for (int et = 0; et < 8; ++et) { const int e0 = 16 * et + 4 * g; const u32x2 mo = mo8[et]; const f32x4 gn = gn8[et];
        u32x2 o; o.x = pk2(ao[et][0] * rs * gn[0] * sigmoidf_(bflo(mo.x)), ao[et][1] * rs * gn[1] * sigmoidf_(bfhi(mo.x))); o.y = pk2(ao[et][2] * rs * gn[2] * sigmoidf_(bflo(mo.y)), ao[et][3] * rs * gn[3] * sigmoidf_(bfhi(mo.y)));
        *(u32x2*)(orow + e0) = o; }
    __syncthreads();
}

__device__ __forceinline__ void dattn_phase(const Ctx& c, const Params& p, int l) {
    const int tid = c.tid, lane = c.lane, w = c.wave, r16 = lane & 15, g = lane >> 4;
    LAS bf16* kn = (LAS bf16*)c.lds; LAS bf16* vv = kn + 384 * QS; LAS float* bias = (LAS float*)(vv + 384 * QS);
    const float* gq = p.in[I_ATTN_QKN] + l * 128; const float* gk = gq + 64;
    for (int u = c.bx; u < NBATCH * 12 * 16; u += c.G) {
        const int pr = u & 15, bh = u >> 4, b = bh / 12, h = bh % 12, grp = h >> 2, dil = grp == 0 ? 1 : (grp == 1 ? 4 : 16), npair = 16 / dil, res = pr / npair, n2 = pr % npair;
        bf16* projb = wsp<bf16>(c, WS_PROJ) + (size_t)b * SEQ * PP;
        {
            const int c8 = (tid & 7) * 8; u32x4 xk[6], xv[6];
#pragma unroll
            for (int a = 0; a < 6; ++a) { const int ki = (tid >> 3) + 64 * a, s = 128 * (2 * n2 - 1) + ki;
                if (s >= 0) { const size_t pos = (size_t)(s * dil + res); xk[a] = *(const u32x4*)(projb + pos * PP + C_AK + h * 64 + c8); xv[a] = *(const u32x4*)(projb + pos * PP + C_AV + h * 64 + c8); }
                else { xk[a] = (u32x4){0u, 0u, 0u, 0u}; xv[a] = (u32x4){0u, 0u, 0u, 0u}; } }
            const f32x4 g0 = *(const f32x4*)(gk + c8), g1 = *(const f32x4*)(gk + c8 + 4);
#pragma unroll
            for (int a = 0; a < 6; ++a) { const int ki = (tid >> 3) + 64 * a; float x[8]; unpack8(xk[a], x);
                float ss = 0.f;
#pragma unroll
                for (int e = 0; e < 8; ++e) ss += x[e] * x[e];
                ss += __shfl_xor(ss, 1); ss += __shfl_xor(ss, 2); ss += __shfl_xor(ss, 4);
                const float rs = 1.f / sqrtf(ss * (1.f / 64.f) + EPS);
                x[0] *= rs * g0.x; x[1] *= rs * g0.y; x[2] *= rs * g0.z; x[3] *= rs * g0.w; x[4] *= rs * g1.x; x[5] *= rs * g1.y; x[6] *= rs * g1.z; x[7] *= rs * g1.w;
                *(LAS u32x4*)(kn + ki * QS + c8) = pack8(x); *(LAS u32x4*)(vv + ki * QS + c8) = xv[a]; }
            if (tid < 132) bias[tid] = wsp<float>(c, OFF_BIAS)[h * 132 + tid];
        }
        bf16x8 bq[2][2]; bf16* qrow[2]; size_t qpos[2];
#pragma unroll
        for (int ct = 0; ct < 2; ++ct) { const int qi = 32 * w + 16 * ct + r16; qpos[ct] = (size_t)((256 * n2 + qi) * dil + res); qrow[ct] = projb + qpos[ct] * PP + C_AQ + h * 64;
            float x0[8], x1[8]; unpack8(*(const u32x4*)(qrow[ct] + 8 * g), x0); unpack8(*(const u32x4*)(qrow[ct] + 32 + 8 * g), x1);
            float ss = 0.f;
#pragma unroll
            for (int e = 0; e < 8; ++e) ss += x0[e] * x0[e] + x1[e] * x1[e];
            ss = red4g_sum(ss); const float rs = 0.125f / sqrtf(ss * (1.f / 64.f) + EPS);
#pragma unroll
            for (int e = 0; e < 8; ++e) { x0[e] *= rs * gq[8 * g + e]; x1[e] *= rs * gq[32 + 8 * g + e]; }
            bq[ct][0] = __builtin_bit_cast(bf16x8, pack8(x0)); bq[ct][1] = __builtin_bit_cast(bf16x8, pack8(x1)); }
        __syncthreads();
        const int kb = 32 * w;
        f32x4 acc[2][10];
#pragma unroll
        for (int ct = 0; ct < 2; ++ct)
#pragma unroll
            for (int kt = 0; kt < 10; ++kt) acc[ct][kt] = Z4;
#pragma unroll
        for (int ks = 0; ks < 2; ++ks) {
#pragma unroll
            for (int kt = 0; kt < 10; ++kt) { const bf16x8 a = ldsA(kn + (kb + 16 * kt + r16) * QS + 32 * ks + 8 * g);
                if (kt < 9) acc[0][kt] = MFMA16(a, bq[0][ks], acc[0][kt]);
                if (kt > 0) acc[1][kt] = MFMA16(a, bq[1][ks], acc[1][kt]); }
            __builtin_amdgcn_sched_barrier(0); }
        float inv[2], lse[2];
#pragma unroll
        for (int ct = 0; ct < 2; ++ct) {
            float mx = -3.0e38f;
#pragma unroll
            for (int kt = 0; kt < 10; ++kt)
#pragma unroll
                for (int i = 0; i < 4; ++i) { const int ki = kb + 16 * kt + 4 * g + i, dist = 128 + 16 * ct + r16 - 16 * kt - 4 * g - i; const bool ok = dist >= 0 && dist <= 128 && (n2 > 0 || ki >= 128);
                    const float lg = ok ? acc[ct][kt][i] + bias[ok ? dist : 0] : -3.0e38f; acc[ct][kt][i] = lg; mx = fmaxf(mx, lg); }
            mx = red4g_max(mx);
            float lsum = 0.f;
#pragma unroll
            for (int kt = 0; kt < 10; ++kt)
#pragma unroll
                for (int i = 0; i < 4; ++i) { const float lg = acc[ct][kt][i]; const float pe = lg > -1.0e38f ? __expf(lg - mx) : 0.f; lsum += pe; acc[ct][kt][i] = pe; }
            lsum = red4g_sum(lsum); inv[ct] = __builtin_amdgcn_rcpf(lsum); lse[ct] = mx + __logf(lsum);
        }
        f32x4 ao[2][4];
#pragma unroll
        for (int ct = 0; ct < 2; ++ct)
#pragma unroll
            for (int et = 0; et < 4; ++et) ao[ct][et] = Z4;
        const LAS bf16* vp = vv + (kb + 4 * g + (r16 >> 2)) * QS + 4 * (r16 & 3);
#pragma unroll
        for (int ks = 0; ks < 5; ++ks) { const bf16x8 bp0 = pk8f(acc[0][2 * ks], acc[0][2 * ks + 1]), bp1 = pk8f(acc[1][2 * ks], acc[1][2 * ks + 1]);
#pragma unroll
            for (int et = 0; et < 4; ++et) { const bf16x8 a = cat4(ds_tr(vp + 32 * ks * QS + 16 * et), ds_tr(vp + (32 * ks + 16) * QS + 16 * et)); ao[0][et] = MFMA16(a, bp0, ao[0][et]); ao[1][et] = MFMA16(a, bp1, ao[1][et]); }
            __builtin_amdgcn_sched_barrier(0); }
#pragma unroll
        for (int ct = 0; ct < 2; ++ct) {
#pragma unroll
            for (int et = 0; et < 4; ++et) { u32x2 o; o.x = pk2(ao[ct][et][0] * inv[ct], ao[ct][et][1] * inv[ct]); o.y = pk2(ao[ct][et][2] * inv[ct], ao[ct][et][3] * inv[ct]); *(u32x2*)(qrow[ct] + 16 * et + 4 * g) = o; }
            if (g == 0) wsp<float>(c, OFF_LSE)[((size_t)b * SEQ + qpos[ct]) * 12 + h] = lse[ct]; }
        __syncthreads();
    }
}
__device__ __forceinline__ void dattn_merge(const Ctx& c) {
    const int gt = c.vcu * 512 + c.tid, NT = c.G * 512;
    const float* LSE = wsp<float>(c, OFF_LSE); bf16* proj = wsp<bf16>(c, WS_PROJ);
    for (int it = gt; it < M * 96; it += NT) {
        const int m = it / 96, rr = it % 96, h = rr >> 3, c8 = (rr & 7) * 8, hg = h & 3;
        const float l0 = LSE[(size_t)m * 12 + hg], l1 = LSE[(size_t)m * 12 + 4 + hg], l2 = LSE[(size_t)m * 12 + 8 + hg], lm = LSE[(size_t)m * 12 + h];
        const float mxx = fmaxf(l0, fmaxf(l1, l2)); const float al = __expf(lm - mxx) / (__expf(l0 - mxx) + __expf(l1 - mxx) + __expf(l2 - mxx));
        u32x4* ptr = (u32x4*)(proj + (size_t)m * PP + C_AQ + h * 64 + c8); float x[8]; unpack8(*ptr, x);
#pragma unroll
        for (int e = 0; e < 8; ++e) x[e] *= al;
        *ptr = pack8(x);
    }
}

__device__ __forceinline__ void gmlp_unit(const Ctx& c, const Params& p, int l, int b, int n, int grp) {
    const int tid = c.tid, lane = c.lane, w = c.wave, r16 = lane & 15, g = lane >> 4;
    LAS bf16* Wc = (LAS bf16*)c.lds; LAS bf16* vn = Wc + 128 * LS;
    bf16* projb = wsp<bf16>(c, WS_PROJ) + ((size_t)b * SEQ + 128 * n) * PP;
    const float* ws = p.in[I_GMLP_WS] + ((size_t)l * 4 + grp) * 128 * 128; const float* gain = p.in[I_GMLP_NORM] + l * 512 + grp * 128; const float* bs = p.in[I_GMLP_BS] + (l * 4 + grp) * 128;
    {
        const int c8 = (tid & 15) * 8; u32x4 xv[4]; f32x4 wv[4][2];
#pragma unroll
        for (int a = 0; a < 4; ++a) { const int r = (tid >> 4) + 32 * a; xv[a] = *(const u32x4*)(projb + (size_t)r * PP + C_GV + grp * 128 + c8); wv[a][0] = *(const f32x4*)(ws + r * 128 + c8); wv[a][1] = *(const f32x4*)(ws + r * 128 + c8 + 4); }
        const f32x4 g0 = *(const f32x4*)(gain + c8), g1 = *(const f32x4*)(gain + c8 + 4);
#pragma unroll
        for (int a = 0; a < 4; ++a) { const int r = (tid >> 4) + 32 * a;
            float wf[8] = {wv[a][0].x, wv[a][0].y, wv[a][0].z, wv[a][0].w, wv[a][1].x, wv[a][1].y, wv[a][1].z, wv[a][1].w};
#pragma unroll
            for (int e = 0; e < 8; ++e) if (c8 + e > r) wf[e] = 0.f;
            *(LAS u32x4*)(Wc + r * LS + c8) = pack8(wf);
            float x[8]; unpack8(xv[a], x); float ss = 0.f;
#pragma unroll
            for (int e = 0; e < 8; ++e) { x[e] = gelu_tanh(x[e]); ss += x[e] * x[e]; }
            ss = red16_sum(ss); const float rs = 1.f / sqrtf(ss * (1.f / 128.f) + EPS);
            x[0] *= rs * g0.x; x[1] *= rs * g0.y; x[2] *= rs * g0.z; x[3] *= rs * g0.w; x[4] *= rs * g1.x; x[5] *= rs * g1.y; x[6] *= rs * g1.z; x[7] *= rs * g1.w;
            *(LAS u32x4*)(vn + r * LS + c8) = pack8(x); }
    }
    __syncthreads();
    const int tq = 16 * w + r16;
    f32x4 acc[8];
#pragma unroll
    for (int ct = 0; ct < 8; ++ct) acc[ct] = Z4;
    const LAS bf16* vp = vn + (8 * g + (r16 >> 2)) * LS + 4 * (r16 & 3);
#pragma unroll
    for (int ks = 0; ks < 4; ++ks) if (32 * ks <= 16 * w + 15) { const bf16x8 bw = ldsA(Wc + tq * LS + 32 * ks + 8 * g);
#pragma unroll
        for (int ct = 0; ct < 8; ++ct) acc[ct] = MFMA16(cat4(ds_tr(vp + 32 * ks * LS + 16 * ct), ds_tr(vp + (32 * ks + 4) * LS + 16 * ct)), bw, acc[ct]); }
    const float bb = bs[tq]; const bf16* urow = projb + (size_t)tq * PP + C_GU + grp * 128; bf16* orow = wsp<bf16>(c, WS_YC) + ((size_t)b * SEQ + 128 * n + tq) * 512 + grp * 128;
    u32x2 u8[8];
#pragma unroll
    for (int ct = 0; ct < 8; ++ct) u8[ct] = *(const u32x2*)(urow + 16 * ct + 4 * g);
#pragma unroll
    for (int ct = 0; ct < 8; ++ct) { const int c0 = 16 * ct + 4 * g; const u32x2 u = u8[ct];
        u32x2 o; o.x = pk2(gelu_tanh(bflo(u.x)) * (acc[ct][0] + bb), gelu_tanh(bfhi(u.x)) * (acc[ct][1] + bb)); o.y = pk2(gelu_tanh(bflo(u.y)) * (acc[ct][2] + bb), gelu_tanh(bfhi(u.y)) * (acc[ct][3] + bb));
        *(u32x2*)(orow + c0) = o; }
    __syncthreads();
}

__device__ __forceinline__ void xattn_unit(const Ctx& c, const Params& p, int l, int bh, int tp) {
    const int b = bh >> 2, h = bh & 3, tid = c.tid, lane = c.lane, w = c.wave, r16 = lane & 15, g = lane >> 4;
    LAS bf16* kn = (LAS bf16*)c.lds; LAS bf16* vv = kn + 256 * LS;
    const bf16* KV = wsp<bf16>(c, OFF_KV) + (size_t)b * MEML * 1024;
    const float* gq = p.in[I_XATTN_QKN] + l * 256; const float* gk = gq + 128;
    {
        const int c8 = (tid & 15) * 8; const f32x4 g0 = *(const f32x4*)(gk + c8), g1 = *(const f32x4*)(gk + c8 + 4);
#pragma unroll
        for (int half = 0; half < 2; ++half) { u32x4 xk[4], xv[4];
#pragma unroll
            for (int a = 0; a < 4; ++a) { const int ki = (tid >> 4) + 32 * (4 * half + a); xk[a] = *(const u32x4*)(KV + (size_t)ki * 1024 + h * 128 + c8); xv[a] = *(const u32x4*)(KV + (size_t)ki * 1024 + 512 + h * 128 + c8); }
#pragma unroll
            for (int a = 0; a < 4; ++a) { const int ki = (tid >> 4) + 32 * (4 * half + a); float x[8]; unpack8(xk[a], x); float ss = 0.f;
#pragma unroll
                for (int e = 0; e < 8; ++e) ss += x[e] * x[e];
                ss = red16_sum(ss); const float rs = 1.f / sqrtf(ss * (1.f / 128.f) + EPS);
                x[0] *= rs * g0.x; x[1] *= rs * g0.y; x[2] *= rs * g0.z; x[3] *= rs * g0.w; x[4] *= rs * g1.x; x[5] *= rs * g1.y; x[6] *= rs * g1.z; x[7] *= rs * g1.w;
                *(LAS u32x4*)(kn + ki * LS + c8) = pack8(x); *(LAS u32x4*)(vv + ki * LS + c8) = xv[a]; } }
    }
    __syncthreads();
    const LAS bf16* vp = vv + (4 * g + (r16 >> 2)) * LS + 4 * (r16 & 3);
    for (int tt = 2 * tp; tt < 2 * tp + 2; ++tt) {
        const size_t row = (size_t)b * SEQ + 128 * tt + 16 * w + r16;
        const bf16* qrow = wsp<bf16>(c, OFF_Q) + row * 512 + h * 128;
        bf16x8 bq[4];
        { float qf[4][8]; float ss = 0.f;
#pragma unroll
          for (int ks = 0; ks < 4; ++ks) { unpack8(*(const u32x4*)(qrow + 32 * ks + 8 * g), qf[ks]);
#pragma unroll
              for (int e = 0; e < 8; ++e) ss += qf[ks][e] * qf[ks][e]; }
          ss = red4g_sum(ss); const float rsq = 0.08838834764831845f / sqrtf(ss * (1.f / 128.f) + EPS);
#pragma unroll
          for (int ks = 0; ks < 4; ++ks) {
#pragma unroll
              for (int e = 0; e < 8; ++e) qf[ks][e] *= rsq * gq[32 * ks + 8 * g + e];
              bq[ks] = __builtin_bit_cast(bf16x8, pack8(qf[ks])); } }
        f32x4 acc[16];
#pragma unroll
        for (int mt = 0; mt < 16; ++mt) acc[mt] = Z4;
#pragma unroll
        for (int ks = 0; ks < 4; ++ks) {
#pragma unroll
            for (int mt = 0; mt < 16; ++mt) acc[mt] = MFMA16(ldsA(kn + (16 * mt + r16) * LS + 32 * ks + 8 * g), bq[ks], acc[mt]);
            __builtin_amdgcn_sched_barrier(0); }
        float mx = -3.0e38f;
#pragma unroll
        for (int mt = 0; mt < 16; ++mt) mx = fmaxf(fmaxf(mx, fmaxf(acc[mt][0], acc[mt][1])), fmaxf(acc[mt][2], acc[mt][3]));
        mx = red4g_max(mx);
        float lsum = 0.f;
#pragma unroll
        for (int mt = 0; mt < 16; ++mt)
#pragma unroll
            for (int i = 0; i < 4; ++i) { const float pe = __expf(acc[mt][i] - mx); lsum += pe; acc[mt][i] = pe; }
        lsum = red4g_sum(lsum);
        f32x4 ao[8];
#pragma unroll
        for (int et = 0; et < 8; ++et) ao[et] = Z4;
#pragma unroll
        for (int ks = 0; ks < 8; ++ks) { const bf16x8 bp = pk8f(acc[2 * ks], acc[2 * ks + 1]);
#pragma unroll
            for (int et = 0; et < 8; ++et) ao[et] = MFMA16(cat4(ds_tr(vp + 32 * ks * LS + 16 * et), ds_tr(vp + (32 * ks + 16) * LS + 16 * et)), bp, ao[et]);
            __builtin_amdgcn_sched_barrier(0); }
        const float inv = 1.f / lsum; bf16* orow = wsp<bf16>(c, OFF_O) + row * 512 + h * 128;
#pragma unroll
        for (int et = 0; et < 8; ++et) { u32x2 o; o.x = pk2(ao[et][0] * inv, ao[et][1] * inv); o.y = pk2(ao[et][2] * inv, ao[et][3] * inv); *(u32x2*)(orow + 16 * et + 4 * g) = o; }
    }
    __syncthreads();
}
enum { PH_PRE = 0, PH_A1, PH_MIXA, PH_MIXB, PH_MIXC, PH_GB, PH_WOUT, PH_XQ, PH_XA, PH_XO, PH_RP2, PH_GATHER, PH_GU, PH_DOWN, PH_COMB, NPH_LAYER };

constexpr int A1_SKIP = 8;
struct A1Order { pg8::StaticOrder so;
    __device__ __forceinline__ bool next(int i, pg8::Unit& u) const { if (!so.next(i, u)) return false; if (u.pn >= A1_SKIP) ++u.pn; return true; }
    __device__ __forceinline__ void a_ready(const pg8::Unit&) const {}
    __device__ __forceinline__ void done(const pg8::Unit&) const {} };
struct OneTileOrder { int pm, pn; bool on;
    __device__ __forceinline__ bool next(int i, pg8::Unit& u) const { if (i > 0 || !on) return false; u.pm = pm; u.pn = pn; return true; }
    __device__ __forceinline__ void a_ready(const pg8::Unit&) const {}
    __device__ __forceinline__ void done(const pg8::Unit&) const {} };
struct GbOrder {
    pg8::StaticOrder so; const char* ws;
    __device__ __forceinline__ bool next(int i, pg8::SUnit& u) const {
        pg8::Unit t; if (!so.next(i / 6, t)) return false;
        const int k6 = i % 6, k = (k6 & 1) * 3 + (k6 >> 1); u.pm = t.pm; u.pn = t.pn; u.kind = k;
        if (k < 3) { u.a = ws + WS_XB + (size_t)t.pm * 256 * D * 2; u.lda = D; u.K = D; u.b = ws + OFF_WG + ((size_t)k * 1024 + t.pn * 256) * D * 2; }
        else { const int br = k - 3; const size_t ccol = br == 0 ? (size_t)C_MO : (br == 1 ? (size_t)C_AQ : (size_t)C_GU); const int kk = br == 1 ? 768 : 512;
            const size_t woff = br == 0 ? OFF_WA : (br == 1 ? OFF_WB : OFF_WC);
            if (br == 1) { u.a = ws + WS_PROJ + ((size_t)t.pm * 256 * PP + ccol) * 2; u.lda = PP; } else { u.a = ws + (br == 0 ? WS_YA : WS_YC) + (size_t)t.pm * 256 * 512 * 2; u.lda = 512; }
            u.K = kk; u.b = ws + woff + (size_t)t.pn * 256 * kk * 2; }
        return true;
    }
};

template <int PH>
__device__ __forceinline__ void run_phase(const Ctx& c, const Params& p, int l) {
    bf16* const XB = wsp<bf16>(c, WS_XB); bf16* const PROJ = wsp<bf16>(c, WS_PROJ);
    bf16* const XR = wsp<bf16>(c, WS_X1B);
    if constexpr (PH == PH_PRE) { phase_weights(c, p, 0); __syncthreads(); phase_rp0_input(c, p); }
    if constexpr (PH == PH_A1) {
        if (c.bx >= c.G - 16) gate_scan(c, c.bx - (c.G - 16));
        { pg8::Gemm g{XB, wsp<bf16>(c, OFF_WIN1), D, D}; A1Order S; S.so.init(M, PP - 256, c.G, c.bx); epi::Bf16Out E{PROJ, PP};
          pg8::gemm_phase<epi::Bf16Out, A1Order, true>(c.lds, g, S, E); }
    }
    if constexpr (PH == PH_MIXA) {
        const bool few = c.bx < 64 && c.G == 256;
        if (c.G == 256) { pg8::Gemm g{XB, wsp<bf16>(c, OFF_WIN1), D, D}; OneTileOrder S{c.bx, A1_SKIP, few}; epi::Bf16Out E{PROJ, PP}; pg8::gemm_phase<epi::Bf16Out, OneTileOrder, false>(c.lds, g, S, E); }
        else { pg8::Gemm g{XB, wsp<bf16>(c, OFF_WIN1), D, D}; OneTileOrder S{c.bx, A1_SKIP, c.bx < 64}; epi::Bf16Out E{PROJ, PP}; pg8::gemm_phase<epi::Bf16Out, OneTileOrder, false>(c.lds, g, S, E); }
        int u = few ? c.bx : (c.G == 256 ? 64 + (c.bx - 64) : c.bx); const int step = few ? 64 : (c.G == 256 ? 192 : c.G), lim = few ? 64 : 1024;
        for (; u < lim; u += step) { if (u < 512) mlstm_delta_unit(c, p, l, u / NCH, u % NCH); else { const int v = u - 512; gmlp_unit(c, p, l, v >> 7, (v >> 2) & 31, v & 3); } }
    }
    if constexpr (PH == PH_MIXB) {
        mlstm_scan(c);
        dattn_phase(c, p, l);
    }
    if constexpr (PH == PH_MIXC) { for (int u = c.bx; u < 16 * NCH; u += c.G) mlstm_out_unit(c, p, l, u / NCH, u % NCH); dattn_merge(c); }
    if constexpr (PH == PH_GB) { GbOrder S; S.so.init(M, 1024, c.G, c.bx); S.ws = (const char*)c.ws;
#ifdef GB_SKEW_US
        if ((c.bx >> 3) & 1) { const unsigned long long t0_ = __builtin_amdgcn_s_memrealtime(); while (__builtin_amdgcn_s_memrealtime() - t0_ < GB_SKEW_US * 100ull) __builtin_amdgcn_s_sleep(8); }
#endif
        epi::GateBranchOut E{PROJ, wsp<bf16>(c, WS_T)};
        pg8::gemm_stream<epi::GateBranchOut, GbOrder, true>(c.lds, S, E); }
    if constexpr (PH == PH_WOUT) { pg8::Gemm g{wsp<bf16>(c, WS_T), wsp<bf16>(c, OFF_WOUT), D, D}; pg8::StaticOrder S; S.init(M, 1024, c.G, c.bx);
        if (l == 0) { epi::ResidBfOut<true> E{p.in[I_X], XR, wsp<float>(c, OFF_SSQ)}; pg8::gemm_phase<epi::ResidBfOut<true>, pg8::StaticOrder, false>(c.lds, g, S, E); }
        else { epi::ResidBfOut<false> E{(const bf16*)p.out, XR, wsp<float>(c, OFF_SSQ)}; pg8::gemm_phase<epi::ResidBfOut<false>, pg8::StaticOrder, false>(c.lds, g, S, E); } }
    if constexpr (PH == PH_XQ) { pg8::Gemm g{wsp<bf16>(c, WS_X1B), wsp<bf16>(c, OFF_WXQ), D, D}; pg8::StaticOrder S; S.init(M, 512, c.G, c.bx); epi::Bf16OutRs E{wsp<bf16>(c, OFF_Q), 512, wsp<float>(c, OFF_SSQ)};
        pg8::gemm_phase<epi::Bf16OutRs, pg8::StaticOrder, false>(c.lds, g, S, E);
        { pg8::Gemm g2{wsp<bf16>(c, OFF_MEMB), wsp<bf16>(c, OFF_WXKV), D, D}; pg8::StaticOrder S2; S2.init(MM, 1024, c.G, (c.bx + c.G - 128) % c.G); epi::Bf16Out E2{wsp<bf16>(c, OFF_KV), 1024};
          pg8::gemm_phase<epi::Bf16Out, pg8::StaticOrder, false>(c.lds, g2, S2, E2); } }
    if constexpr (PH == PH_XA) { for (int u = c.bx; u < 16 * 16; u += c.G) xattn_unit(c, p, l, u >> 4, u & 15); }
    if constexpr (PH == PH_XO) { pg8::Gemm g{wsp<bf16>(c, OFF_O), wsp<bf16>(c, OFF_WXO), 512, 512}; pg8::StaticOrder S; S.init(M, 1024, c.G, c.bx); epi::ResidBfOut<false> E{XR, XR, nullptr};
        pg8::gemm_phase<epi::ResidBfOut<false>, pg8::StaticOrder, false>(c.lds, g, S, E); }
    if constexpr (PH == PH_RP2) phase_rp2_route(c, p, l, XR);
    if constexpr (PH == PH_GATHER) phase_assign(c);
    if constexpr (PH == PH_GU) { moe_tables<false>(c); pg8::Gemm g{XB, wsp<bf16>(c, OFF_WGU), D, D}; MoeOrder S{(const LAS int*)(c.lds + LDS_TAB), c.G, c.bx}; epi::GluOut E{wsp<bf16>(c, OFF_HID)};
        LAS int* rowl = (LAS int*)(c.lds + LDS_ROWL); const int* rowtok = wsp<int>(c, OFF_ROWTOK);
        for (int i = 0; i < 4; ++i) { pg8::Unit u; if (S.next(i, u) && c.tid < 256) rowl[i * 256 + c.tid] = rowtok[u.pm * 256 + c.tid]; }
        __syncthreads();
        pg8::gemm_phase_g<epi::GluOut, MoeOrder, true>(c.lds, g, rowl, S, E); }
    if constexpr (PH == PH_DOWN) { moe_tables<false>(c); pg8::Gemm g{wsp<bf16>(c, OFF_HID), wsp<bf16>(c, OFF_WD), DFF, DFF}; MoeOrder S{(const LAS int*)(c.lds + LDS_TAB), c.G, c.bx}; epi::DownOut E{wsp<bf16>(c, OFF_XG), wsp<float>(c, OFF_WROW)};
        pg8::gemm_phase<epi::DownOut, MoeOrder, true>(c.lds, g, S, E); }
    if constexpr (PH == PH_COMB) { if (l + 1 < DEPTH) { phase_combine<true>(c, p, l, XR, (bf16*)p.out, nullptr); __syncthreads(); phase_weights(c, p, l + 1); } else phase_combine<false>(c, p, l, XR, nullptr, p.out); }
}

__device__ __forceinline__ Ctx make_ctx(const Params& p, unsigned char* lds_raw) {
    Ctx c;
    c.lds = (LAS unsigned char*)lds_raw; c.ws = p.ws;
    int tid_ = threadIdx.x, bx = blockIdx.x, G_ = gridDim.x;
    asm volatile("" : "+v"(tid_), "+s"(bx), "+s"(G_));
    c.tid = tid_; c.lane = c.tid & 63; c.wave = __builtin_amdgcn_readfirstlane(c.tid >> 6);
    c.G = G_; c.bx = bx; c.vcu = (c.G % 8 == 0) ? (bx % 8) * (c.G / 8) + bx / 8 : bx;
    return c;
}
#ifndef MK_ONE_LAUNCH
#define MK_ONE_LAUNCH 1
#endif
#if !MK_ONE_LAUNCH
template <int PH>
__global__ void __launch_bounds__(512, 2) phase_kernel(Params p, int l) {
    extern __shared__ __attribute__((aligned(16))) unsigned char lds_raw[];
    const Ctx c = make_ctx(p, lds_raw);
    run_phase<PH>(c, p, l);
}
template <int PH> static void launch_phases(int grid, const Params& a, int l, hipStream_t stream) {
    if constexpr (PH < NPH_LAYER) {
        static bool attr_done = false;
        if (!attr_done) { (void)hipFuncSetAttribute((const void*)phase_kernel<PH>, hipFuncAttributeMaxDynamicSharedMemorySize, LDS_BYTES); attr_done = true; }
        if (!(PH == PH_PRE && l != 0)) hipLaunchKernelGGL(phase_kernel<PH>, dim3(grid), dim3(512), LDS_BYTES, stream, a, l);
        launch_phases<PH + 1>(grid, a, l, stream);
    }
}
#else
#if defined(__HIP_DEVICE_COMPILE__)
typedef const __attribute__((address_space(4))) Params* KParams;
#else
typedef const Params* KParams;
#endif
template <int PH>
__device__ __forceinline__ void phase_site(KParams kp, int l) {
    extern __shared__ __attribute__((aligned(16))) unsigned char lds_raw[];
    asm volatile("" : "+s"(kp));
    Params p;
#pragma unroll
    for (int i = 0; i < 28; ++i) p.in[i] = kp->in[i];
    p.out = kp->out; p.ws = kp->ws;
    const Ctx c = make_ctx(p, lds_raw);
    run_phase<PH>(c, p, l);
}
__device__ __forceinline__ void seam(KParams kp) {
    extern __shared__ __attribute__((aligned(16))) unsigned char lds_raw[];
    asm volatile("" : "+s"(kp));
    XcdBarrier b; b.bar = (unsigned*)(kp->ws + WS_CTL) + CW_BAR; b.x = xb_xcc_id(); b.st = (volatile LAS unsigned*)((LAS unsigned char*)lds_raw + LDS_MISC) + 8;
    xcd_barrier(b);
}
template <int PH> __device__ __forceinline__ void run_layer(KParams kp, int l) {
    if constexpr (PH < NPH_LAYER) {
        if (!(PH == PH_PRE && l != 0)) {
#ifdef PROBE_AMP
            const unsigned long long t0_ = __builtin_amdgcn_s_memrealtime();
#endif
            phase_site<PH>(kp, l); seam(kp);
#ifdef PROBE_AMP
            if ((PROBE_AMP >> PH) & 1) { const unsigned long long dt_ = __builtin_amdgcn_s_memrealtime() - t0_; const unsigned long long t1_ = __builtin_amdgcn_s_memrealtime();
                while (__builtin_amdgcn_s_memrealtime() - t1_ < 3 * dt_) __builtin_amdgcn_s_sleep(4); seam(kp); }
#endif
#ifdef PROBE_REPEAT
            if ((PROBE_REPEAT >> PH) & 1) { phase_site<PH>(kp, l); seam(kp); }
#endif
        }
        run_layer<PH + 1>(kp, l);
    }
}
__global__ void __launch_bounds__(512, 2) fwd_kernel(Params p) {
    extern __shared__ __attribute__((aligned(16))) unsigned char lds_raw[];
    volatile LAS unsigned* MISC = (volatile LAS unsigned*)((LAS unsigned char*)lds_raw + LDS_MISC);
    for (int u = threadIdx.x; u < (LDS_BYTES - LDS_MISC) / 4; u += 512) MISC[u] = 0u;
    __syncthreads();
    (void)xcd_barrier_post((unsigned*)(p.ws + WS_CTL) + CW_BAR, MISC + 8);
    KParams kp = (KParams)__builtin_amdgcn_kernarg_segment_ptr();
    run_layer<0>(kp, 0);
    run_layer<0>(kp, 1);
    static_assert(DEPTH == 2, "layers are written out");
}
#endif

extern "C" void kernel_launch(void* const* d_in, const int* in_sizes, int n_in, void* d_out, int out_size, void* d_ws, size_t ws_size, hipStream_t stream) {
    static int grid = 0;
    if (grid == 0) {
        if (n_in != 28 || in_sizes[0] != M * D || out_size != M * D || ws_size < WS_END) { fprintf(stderr, "kernel_launch: unexpected shapes (n_in %d, in0 %d, out %d, ws %zu < %zu); nothing launched\n", n_in, n_in > 0 ? in_sizes[0] : -1, out_size, ws_size, (size_t)WS_END); grid = -1; return; }
        int dev = 0, cus = 0;
        if (hipGetDevice(&dev) != hipSuccess || hipDeviceGetAttribute(&cus, hipDeviceAttributeMultiprocessorCount, dev) != hipSuccess) { grid = -1; return; }
#if MK_ONE_LAUNCH
        if (hipFuncSetAttribute((const void*)fwd_kernel, hipFuncAttributeMaxDynamicSharedMemorySize, LDS_BYTES) != hipSuccess) { fprintf(stderr, "kernel_launch: hipFuncSetAttribute failed\n"); grid = -1; return; }
        int per_cu = 0;
        if (hipOccupancyMaxActiveBlocksPerMultiprocessor(&per_cu, (const void*)fwd_kernel, 512, LDS_BYTES) != hipSuccess || per_cu < 1) { fprintf(stderr, "kernel_launch: occupancy query reports %d workgroups per CU\n", per_cu); }
        (void)hipGetLastError();
#endif
        grid = cus;
    }
    if (grid < 0) return;
    if (hipMemsetAsync((char*)d_ws + WS_CTL, 0, CTL_ZERO_BYTES, stream) != hipSuccess) return;
    Params a{};
    for (int i = 0; i < 28; ++i) a.in[i] = (const float*)d_in[i];
    a.out = (float*)d_out; a.ws = (unsigned char*)d_ws;
#if MK_ONE_LAUNCH
    hipLaunchKernelGGL(fwd_kernel, dim3(grid), dim3(512), LDS_BYTES, stream, a);
#else
    for (int l = 0; l < DEPTH; ++l) launch_phases<0>(grid, a, l, stream);
#endif
}
```
